# Optimizing an MI355X kernel written in HIP

```python
import math
import jax, jax.numpy as jnp
from jax import lax
import numpy as np


D_MODEL = 1024
BATCH = 2
SEQ = 8192
DEPTH = 1

MEM_LEN = 256
CONV_CH = 512
CONV_WIDTH = 31
N_HEADS = 8
N_KV_HEADS = 2
HEAD_DIM = 64
GQ = N_HEADS // N_KV_HEADS
ATTN_W = N_HEADS * HEAD_DIM
KV_W = N_KV_HEADS * HEAD_DIM
WINDOW = 128
BLOCK = 128
D_MIX = CONV_CH + ATTN_W
D_IN = 2 * CONV_CH + ATTN_W + 2 * KV_W
MEM_HEADS = 4
MEM_HEAD_DIM = D_MODEL // MEM_HEADS
N_GROUPS = 4
EXPERTS_PER_GROUP = 4
N_EXPERTS = N_GROUPS * EXPERTS_PER_GROUP
TOP_K = 2
D_EXPERT = D_MODEL // 2
ALPHA = (2.0 * DEPTH) ** 0.25
BETA = (8.0 * DEPTH) ** -0.25
LN_EPS = 1e-5

kernel_name = 'hybrid_conformer_swa_sink_memory_hmoe'


def layer_norm(x, g, b):
    xf = x.astype(jnp.float32)
    mu = jnp.mean(xf, axis=-1, keepdims=True)
    var = jnp.mean(jnp.square(xf - mu), axis=-1, keepdims=True)
    return ((xf - mu) * lax.rsqrt(var + LN_EPS) * g + b).astype(x.dtype)


def conformer_conv(u, w_dw, b_dw, g_cn, b_cn):
    a, gate = jnp.split(u, 2, axis=-1)
    h = a * jax.nn.sigmoid(gate)
    h = lax.conv_general_dilated(
        h, w_dw[:, None, :].astype(h.dtype), window_strides=(1,),
        padding=[(CONV_WIDTH - 1, 0)],
        dimension_numbers=('NWC', 'WIO', 'NWC'),
        feature_group_count=h.shape[-1]) + b_dw
    h = layer_norm(h, g_cn, b_cn)
    return jax.nn.silu(h)


def sliding_window_sink_attention(q, k, v, sinks):
    B, S, _ = q.shape
    nb = S // BLOCK
    qb = q.reshape(B, nb, BLOCK, N_KV_HEADS, GQ, HEAD_DIM)

    def band(t):
        t = t.reshape(B, S, N_KV_HEADS, HEAD_DIM)
        t = jnp.pad(t, ((0, 0), (BLOCK, 0), (0, 0), (0, 0)))
        t = t.reshape(B, nb + 1, BLOCK, N_KV_HEADS, HEAD_DIM)
        return jnp.concatenate([t[:, :-1], t[:, 1:]], axis=2)

    kb, vb = band(k), band(v)
    s = jnp.einsum('bnqhgd,bnkhd->bnhgqk', qb, kb).astype(jnp.float32) * (HEAD_DIM ** -0.5)
    qi = jnp.arange(BLOCK)[:, None]
    kj = jnp.arange(2 * BLOCK)[None, :]
    dist = qi + BLOCK - kj
    blk = jnp.arange(nb)[:, None, None]
    valid = (dist >= 0) & (dist < WINDOW) & (blk * BLOCK - BLOCK + kj >= 0)
    s = jnp.where(valid[None, :, None, None], s, -jnp.inf)
    sink = jnp.broadcast_to(sinks.astype(jnp.float32).reshape(1, 1, N_KV_HEADS, GQ, 1, 1),
                            s.shape[:-1] + (1,))
    p = jax.nn.softmax(jnp.concatenate([s, sink], axis=-1), axis=-1)[..., :-1]
    o = jnp.einsum('bnhgqk,bnkhd->bnqhgd', p.astype(vb.dtype), vb)
    return o.reshape(B, S, ATTN_W)


def memory_cross_attention(x, mem, w_q, w_kv, w_o):
    B, S, _ = x.shape
    q = (x @ w_q).reshape(B, S, MEM_HEADS, MEM_HEAD_DIM)
    k, v = jnp.split(mem @ w_kv, 2, axis=-1)
    k = k.reshape(B, -1, MEM_HEADS, MEM_HEAD_DIM)
    v = v.reshape(B, -1, MEM_HEADS, MEM_HEAD_DIM)
    s = jnp.einsum('bshd,bmhd->bhsm', q, k).astype(jnp.float32) * (MEM_HEAD_DIM ** -0.5)
    p = jax.nn.softmax(s, axis=-1).astype(v.dtype)
    o = jnp.einsum('bhsm,bmhd->bshd', p, v).reshape(B, S, D_MODEL)
    return o @ w_o


def hierarchical_moe(x, w_group, b_group, w_router, b_router, w_gate, w_up, w_down):
    B, S, D = x.shape
    t = x.reshape(B * S, D)
    g_prob = jax.nn.softmax((t @ w_group).astype(jnp.float32) + b_group, axis=-1)
    g_p, g_idx = lax.top_k(g_prob, 1)
    e_logits = jnp.einsum('td,gde->tge', t, w_router).astype(jnp.float32) + b_router
    e_logits = jnp.take_along_axis(e_logits, g_idx[:, :, None], axis=1)[:, 0]
    e_top, e_idx = lax.top_k(e_logits, TOP_K)
    gate = g_p * jax.nn.softmax(e_top, axis=-1)
    expert_id = g_idx * EXPERTS_PER_GROUP + e_idx
    combine = jnp.sum(jax.nn.one_hot(expert_id, N_EXPERTS, dtype=jnp.float32) * gate[..., None], axis=1)
    h = jax.nn.silu(jnp.einsum('td,edf->tef', t, w_gate)) * jnp.einsum('td,edf->tef', t, w_up)
    h = h * combine[..., None].astype(h.dtype)
    y = jnp.einsum('tef,efd->td', h, w_down)
    return y.reshape(B, S, D)


def setup_inputs(seed: int = 0) -> dict:
    key = jax.random.key(seed)
    ks = jax.random.split(key, 26)
    L = DEPTH

    def nrm(k, shape, scale):
        return jax.random.normal(k, shape, jnp.float32) * scale

    return {
        'x': nrm(ks[0], (BATCH, SEQ, D_MODEL), 1.0),
        'mem': nrm(ks[1], (BATCH, MEM_LEN, D_MODEL), 1.0),
        'w_in': nrm(ks[2], (L, D_MODEL, D_IN), D_MODEL ** -0.5),
        'b_in': nrm(ks[3], (L, D_IN), 0.01),
        'w_dw': nrm(ks[4], (L, CONV_WIDTH, CONV_CH), CONV_WIDTH ** -0.5),
        'b_dw': nrm(ks[5], (L, CONV_CH), 0.01),
        'g_conv_norm': 1.0 + nrm(ks[6], (L, CONV_CH), 0.02),
        'b_conv_norm': nrm(ks[7], (L, CONV_CH), 0.01),
        'attn_sinks': nrm(ks[8], (L, N_HEADS), 0.5),
        'w_out': nrm(ks[9], (L, D_MIX, D_MODEL), BETA * D_MIX ** -0.5),
        'g_ln1': 1.0 + nrm(ks[10], (L, D_MODEL), 0.02),
        'b_ln1': nrm(ks[11], (L, D_MODEL), 0.01),
        'w_mq': nrm(ks[12], (L, D_MODEL, D_MODEL), D_MODEL ** -0.5),
        'w_mkv': nrm(ks[13], (L, D_MODEL, 2 * D_MODEL), D_MODEL ** -0.5),
        'w_mo': nrm(ks[14], (L, D_MODEL, D_MODEL), BETA * D_MODEL ** -0.5),
        'g_ln2': 1.0 + nrm(ks[15], (L, D_MODEL), 0.02),
        'b_ln2': nrm(ks[16], (L, D_MODEL), 0.01),
        'w_group': nrm(ks[17], (L, D_MODEL, N_GROUPS), D_MODEL ** -0.5),
        'b_group': nrm(ks[18], (L, N_GROUPS), 0.01),
        'w_router': nrm(ks[19], (L, N_GROUPS, D_MODEL, EXPERTS_PER_GROUP), D_MODEL ** -0.5),
        'b_router': nrm(ks[20], (L, N_GROUPS, EXPERTS_PER_GROUP), 0.01),
        'w_gate': nrm(ks[21], (L, N_EXPERTS, D_MODEL, D_EXPERT), D_MODEL ** -0.5),
        'w_up': nrm(ks[22], (L, N_EXPERTS, D_MODEL, D_EXPERT), D_MODEL ** -0.5),
        'w_down': nrm(ks[23], (L, N_EXPERTS, D_EXPERT, D_MODEL), BETA * D_EXPERT ** -0.5),
        'g_ln3': 1.0 + nrm(ks[24], (L, D_MODEL), 0.02),
        'b_ln3': nrm(ks[25], (L, D_MODEL), 0.01),
    }


def reference(x, mem, w_in, b_in, w_dw, b_dw, g_conv_norm, b_conv_norm, attn_sinks, w_out,
              g_ln1, b_ln1, w_mq, w_mkv, w_mo, g_ln2, b_ln2, w_group, b_group, w_router,
              b_router, w_gate, w_up, w_down, g_ln3, b_ln3):
    splits = [2 * CONV_CH, 2 * CONV_CH + ATTN_W, 2 * CONV_CH + ATTN_W + KV_W]
    for l in range(DEPTH):
        u = x @ w_in[l] + b_in[l]
        u_conv, q, k, v = jnp.split(u, splits, axis=-1)
        y_conv = conformer_conv(u_conv, w_dw[l], b_dw[l], g_conv_norm[l], b_conv_norm[l])
        y_attn = sliding_window_sink_attention(q, k, v, attn_sinks[l])
        mix = jnp.concatenate([y_conv, y_attn], axis=-1) @ w_out[l]
        x = layer_norm(ALPHA * x + mix, g_ln1[l], b_ln1[l])
        x = layer_norm(ALPHA * x + memory_cross_attention(x, mem, w_mq[l], w_mkv[l], w_mo[l]),
                       g_ln2[l], b_ln2[l])
        x = layer_norm(ALPHA * x + hierarchical_moe(x, w_group[l], b_group[l], w_router[l], b_router[l],
                                                    w_gate[l], w_up[l], w_down[l]),
                       g_ln3[l], b_ln3[l])
    return x
```

```cpp
#include <hip/hip_runtime.h>
#include <hip/hip_cooperative_groups.h>
#include <cstdio>
#include <cstdint>
namespace cg = cooperative_groups;

#ifndef MK_N_LAUNCHES
#define MK_N_LAUNCHES 1
#endif

typedef unsigned short bf16;
typedef float f32x4 __attribute__((ext_vector_type(4)));
typedef unsigned u32x4 __attribute__((ext_vector_type(4)));
typedef unsigned u32x2 __attribute__((ext_vector_type(2)));

constexpr int BATCH = 2, SEQ = 8192, D = 1024, T = BATCH * SEQ, MEM = 256, NMEM = BATCH * MEM;
constexpr int CONV_CH = 512, CONV_W = 31, NH = 8, NKV = 2, HD = 64, ATTN_W = 512, KV_W = 128, WINDOW = 128;
constexpr int D_IN = 1792, MH = 4, MHD = 256, NG = 4, EPG = 4, NE = 16, DE = 512;
constexpr float ALPHA = 1.189207115002721f, LN_EPS = 1e-5f;
constexpr int NPAIR = 2 * T, NPAIR_PAD = NPAIR + NE * 256;

constexpr size_t MiB = 1u << 20;
constexpr size_t WS_CTL = 0;
constexpr size_t WS_ROUTE = 1 * MiB;
constexpr size_t WS_BLKCNT = 1 * MiB + 512 * 1024;
constexpr size_t WS_SEG = 1 * MiB + 640 * 1024;
constexpr size_t WS_RANK = 2 * MiB;
constexpr size_t WS_PTOK = 2 * MiB + 256 * 1024;
constexpr size_t WS_PGATE = 2 * MiB + 512 * 1024;
constexpr size_t WS_KMEM = 3 * MiB;
constexpr size_t WS_VMEMT = 4 * MiB;
constexpr size_t WS_MEMB = 5 * MiB;
constexpr size_t WS_A = 8 * MiB;
constexpr size_t WS_B = 48 * MiB;
constexpr size_t WS_DD = 88 * MiB;
constexpr size_t WS_END = 164 * MiB;

struct Params { const float* in[26]; float* out; unsigned char* ws; int ph_lo, ph_hi; };

__device__ __forceinline__ unsigned f2bf(float f) { unsigned u = __builtin_bit_cast(unsigned, f); return (u + 0x7fffu + ((u >> 16) & 1u)) >> 16; }
__device__ __forceinline__ float bf2f(bf16 b) { return __builtin_bit_cast(float, (unsigned)b << 16); }
__device__ __forceinline__ unsigned pk2(float lo, float hi) { return f2bf(lo) | (f2bf(hi) << 16); }
__device__ __forceinline__ float wave_sum(float v) {
#pragma unroll
    for (int o = 1; o < 64; o <<= 1) v += __shfl_xor(v, o);
    return v;
}
__device__ __forceinline__ float wave_max(float v) {
#pragma unroll
    for (int o = 1; o < 64; o <<= 1) v = fmaxf(v, __shfl_xor(v, o));
    return v;
}
__device__ __forceinline__ float ldA(const bf16* p) { return bf2f(*p); }
__device__ __forceinline__ float ldA(const float* p) { return *p; }

template <int NB, class FA, class FB, class FE>
__device__ __forceinline__ void ngemm_tile(float* lds, int K, int m0, int n0, FA fa, FB fb, FE fe) {
    float* As = lds;
    float* Bs = lds + 16 * 132;
    const int tid = threadIdx.x, ty = tid >> 4, tx = tid & 15;
    float acc[NB][4][4];
#pragma unroll
    for (int b = 0; b < NB; ++b)
#pragma unroll
        for (int i = 0; i < 4; ++i)
#pragma unroll
            for (int j = 0; j < 4; ++j) acc[b][i][j] = 0.f;
    for (int k0 = 0; k0 < K; k0 += 16) {
        { const int r = tid >> 2, kk = (tid & 3) * 4;
#pragma unroll
            for (int i = 0; i < 4; ++i) As[(kk + i) * 132 + r] = fa(m0 + r, k0 + kk + i); }
#pragma unroll
        for (int b = 0; b < NB; ++b) { const int kk = tid >> 5, nn = (tid & 31) * 2;
            Bs[(b * 16 + kk) * 68 + nn] = fb(b, k0 + kk, n0 + nn); Bs[(b * 16 + kk) * 68 + nn + 1] = fb(b, k0 + kk, n0 + nn + 1); }
        __syncthreads();
#pragma unroll
        for (int k = 0; k < 16; ++k) {
            const f32x4 a = *(const f32x4*)&As[k * 132 + ty * 4];
#pragma unroll
            for (int b = 0; b < NB; ++b) { const f32x4 bb = *(const f32x4*)&Bs[(b * 16 + k) * 68 + tx * 4];
#pragma unroll
                for (int i = 0; i < 4; ++i)
#pragma unroll
                    for (int j = 0; j < 4; ++j) acc[b][i][j] += a[i] * bb[j]; }
        }
        __syncthreads();
    }
#pragma unroll
    for (int i = 0; i < 4; ++i)
#pragma unroll
        for (int j = 0; j < 4; ++j) fe(m0 + ty * 4 + i, n0 + tx * 4 + j, acc[0][i][j], acc[NB - 1][i][j]);
}

__device__ __forceinline__ void ln_row(const float* src, const float* g, const float* b, f32x4 (&v)[4], int lane) {
    const f32x4* xr = (const f32x4*)src + lane; float s = 0.f;
#pragma unroll
    for (int j = 0; j < 4; ++j) { v[j] = xr[64 * j]; s += (v[j].x + v[j].y) + (v[j].z + v[j].w); }
    const float mean = wave_sum(s) * (1.f / D); float s2 = 0.f;
#pragma unroll
    for (int j = 0; j < 4; ++j) { v[j] = v[j] - mean; s2 += (v[j].x * v[j].x + v[j].y * v[j].y) + (v[j].z * v[j].z + v[j].w * v[j].w); }
    const float rstd = 1.f / sqrtf(wave_sum(s2) * (1.f / D) + LN_EPS);
#pragma unroll
    for (int j = 0; j < 4; ++j) { const f32x4 gg = ((const f32x4*)g)[lane + 64 * j], bb = ((const f32x4*)b)[lane + 64 * j]; v[j] = v[j] * rstd * gg + bb; }
}
__device__ __forceinline__ void st_row_f32(float* dst, const f32x4 (&v)[4], float scale, int lane) {
#pragma unroll
    for (int j = 0; j < 4; ++j) ((f32x4*)dst)[lane + 64 * j] = v[j] * scale;
}
__device__ __forceinline__ void st_row_bf16(bf16* dst, const f32x4 (&v)[4], int lane) {
#pragma unroll
    for (int j = 0; j < 4; ++j) { u32x2 w; w.x = pk2(v[j].x, v[j].y); w.y = pk2(v[j].z, v[j].w); ((u32x2*)dst)[lane + 64 * j] = w; }
}

__global__ void __launch_bounds__(512, 2) fwd_kernel(Params p) {
    extern __shared__ __attribute__((aligned(16))) unsigned char lds_raw[];
    float* ldsf = (float*)lds_raw;
    cg::grid_group grid = cg::this_grid();
    const int tid = threadIdx.x, lane = tid & 63, wave = tid >> 6, G = gridDim.x, bid = blockIdx.x;
    const int gw = bid * 8 + wave, NGW = G * 8;
    unsigned char* ws = p.ws;
    const float *x = p.in[0], *mem = p.in[1], *w_in = p.in[2], *b_in = p.in[3], *w_dw = p.in[4], *b_dw = p.in[5], *g_cn = p.in[6], *b_cn = p.in[7], *sinks = p.in[8],
                *w_out = p.in[9], *g_ln1 = p.in[10], *b_ln1 = p.in[11], *w_mq = p.in[12], *w_mkv = p.in[13], *w_mo = p.in[14], *g_ln2 = p.in[15], *b_ln2 = p.in[16],
                *w_group = p.in[17], *b_group = p.in[18], *w_router = p.in[19], *b_router = p.in[20], *w_gate = p.in[21], *w_up = p.in[22], *w_down = p.in[23],
                *g_ln3 = p.in[24], *b_ln3 = p.in[25];
    float* out = p.out;
    bf16* xb = (bf16*)(ws + WS_A); bf16* ycat = (bf16*)(ws + WS_A); bf16* qm = (bf16*)(ws + WS_A); bf16* om = (bf16*)(ws + WS_A); bf16* Hs = (bf16*)(ws + WS_A);
    bf16* hglu = (bf16*)(ws + WS_B); bf16* qkv = (bf16*)(ws + WS_B + (size_t)T * 512 * 2); bf16* x1b = (bf16*)(ws + WS_B); bf16* Pb = (bf16*)(ws + WS_B); bf16* x2b = (bf16*)(ws + WS_B);
    float* Sbuf = (float*)(ws + WS_DD); bf16* Xs = (bf16*)(ws + WS_DD);
    bf16* kmem = (bf16*)(ws + WS_KMEM); bf16* vmemT = (bf16*)(ws + WS_VMEMT); bf16* memb = (bf16*)(ws + WS_MEMB);
    int* route_e = (int*)(ws + WS_ROUTE); float* route_g = (float*)(ws + WS_ROUTE + (size_t)T * 8);
    int* blkcnt = (int*)(ws + WS_BLKCNT); int* segw = (int*)(ws + WS_SEG); int* rank = (int*)(ws + WS_RANK);
    int* pair_tok = (int*)(ws + WS_PTOK); float* pair_gate = (float*)(ws + WS_PGATE);

    const int lo = p.ph_lo, hi = p.ph_hi;
    int ph = 0;
#define PHASE_BEGIN if (lo <= ph && ph < hi) {
#define PHASE_END } if (lo <= ph && ph + 1 < hi) grid.sync(); ++ph;

    PHASE_BEGIN
    for (size_t i = (size_t)bid * 512 + tid; i < (size_t)T * D / 4; i += (size_t)G * 512) { const f32x4 v = ((const f32x4*)x)[i]; u32x2 w; w.x = pk2(v.x, v.y); w.y = pk2(v.z, v.w); ((u32x2*)xb)[i] = w; }
    for (size_t i = (size_t)bid * 512 + tid; i < (size_t)NMEM * D / 4; i += (size_t)G * 512) { const f32x4 v = ((const f32x4*)mem)[i]; u32x2 w; w.x = pk2(v.x, v.y); w.y = pk2(v.z, v.w); ((u32x2*)memb)[i] = w; }
    PHASE_END

    PHASE_BEGIN
    constexpr int U_GLU = 128 * 8, U_QKV = 128 * 12, U_KVM = 4 * 32;
    for (int u = bid; u < U_GLU + U_QKV + U_KVM; u += G) {
        if (u < U_GLU) { const int mt = u / 8, nt = u % 8;
            ngemm_tile<2>(ldsf, D, mt * 128, nt * 64,
                [&](int m, int k) { return bf2f(xb[(size_t)m * D + k]); },
                [&](int b, int k, int n) { return w_in[(size_t)k * D_IN + n + b * 512]; },
                [&](int m, int n, float a, float g) { a += b_in[n]; g += b_in[512 + n]; hglu[(size_t)m * 512 + n] = (bf16)f2bf(a / (1.f + __expf(-g))); });
        } else if (u < U_GLU + U_QKV) { const int r = u - U_GLU, mt = r / 12, nt = r % 12;
            ngemm_tile<1>(ldsf, D, mt * 128, nt * 64,
                [&](int m, int k) { return bf2f(xb[(size_t)m * D + k]); },
                [&](int b, int k, int n) { return w_in[(size_t)k * D_IN + 1024 + n]; },
                [&](int m, int n, float a, float) { qkv[(size_t)m * 768 + n] = (bf16)f2bf(a + b_in[1024 + n]); });
        } else { const int r = u - U_GLU - U_QKV, mt = r / 32, nt = r % 32;
            ngemm_tile<1>(ldsf, D, mt * 128, nt * 64,
                [&](int m, int k) { return bf2f(memb[(size_t)m * D + k]); },
                [&](int b, int k, int n) { return w_mkv[(size_t)k * 2048 + n]; },
                [&](int m, int n, float a, float) { if (n < 1024) kmem[(size_t)m * 1024 + n] = (bf16)f2bf(a); else vmemT[(size_t)(n - 1024) * 512 + m] = (bf16)f2bf(a); });
        }
    }
    PHASE_END

    PHASE_BEGIN
    {
        float wreg[CONV_W];
#pragma unroll
        for (int j = 0; j < CONV_W; ++j) wreg[j] = w_dw[j * CONV_CH + tid];
        const float bdw = b_dw[tid];
        float* cbuf = ldsf;
        for (int it = bid; it < T / 16; it += G) {
            const int t0 = it * 16, s0 = t0 % SEQ;
            for (int tt = 0; tt < 16; ++tt) {
                float acc = bdw;
#pragma unroll
                for (int j = 0; j < CONV_W; ++j) { const int sp = s0 + tt - (CONV_W - 1) + j; if (sp >= 0) acc += wreg[j] * bf2f(hglu[(size_t)(t0 + tt - (CONV_W - 1) + j) * 512 + tid]); }
                cbuf[tt * 512 + tid] = acc;
            }
            __syncthreads();
            for (int r = wave; r < 16; r += 8) {
                f32x4 v[2]; float s = 0.f;
#pragma unroll
                for (int j = 0; j < 2; ++j) { v[j] = ((const f32x4*)(cbuf + r * 512))[lane + 64 * j]; s += (v[j].x + v[j].y) + (v[j].z + v[j].w); }
                const float mean = wave_sum(s) * (1.f / 512.f); float s2 = 0.f;
#pragma unroll
                for (int j = 0; j < 2; ++j) { v[j] = v[j] - mean; s2 += (v[j].x * v[j].x + v[j].y * v[j].y) + (v[j].z * v[j].z + v[j].w * v[j].w); }
                const float rstd = 1.f / sqrtf(wave_sum(s2) * (1.f / 512.f) + LN_EPS);
#pragma unroll
                for (int j = 0; j < 2; ++j) { const f32x4 gg = ((const f32x4*)g_cn)[lane + 64 * j], bb = ((const f32x4*)b_cn)[lane + 64 * j]; f32x4 y = v[j] * rstd * gg + bb;
                    y.x = y.x / (1.f + __expf(-y.x)); y.y = y.y / (1.f + __expf(-y.y)); y.z = y.z / (1.f + __expf(-y.z)); y.w = y.w / (1.f + __expf(-y.w));
                    u32x2 w; w.x = pk2(y.x, y.y); w.y = pk2(y.z, y.w); ((u32x2*)(ycat + (size_t)(t0 + r) * 1024))[lane + 64 * j] = w; }
            }
            __syncthreads();
        }
    }
    {
        float* wq = ldsf + wave * 192; float* wp = wq + 64;
        for (int task = gw; task < T * NH; task += NGW) {
            const int t = task >> 3, hq = task & 7, kvh = hq >> 2, s = t % SEQ;
            wq[lane] = bf2f(qkv[(size_t)t * 768 + hq * 64 + lane]);
            __builtin_amdgcn_wave_barrier(); asm volatile("s_waitcnt lgkmcnt(0)" ::: "memory");
            float sc[2];
#pragma unroll
            for (int h2 = 0; h2 < 2; ++h2) { const int j = lane + 64 * h2, kp = s - (WINDOW - 1) + j;
                float a = -INFINITY;
                if (kp >= 0) { const u32x4* kr = (const u32x4*)(qkv + (size_t)(t - (WINDOW - 1) + j) * 768 + 512 + kvh * 64); a = 0.f;
#pragma unroll
                    for (int c = 0; c < 8; ++c) { const u32x4 kk = kr[c];
#pragma unroll
                        for (int i = 0; i < 4; ++i) { a += wq[c * 8 + 2 * i] * __builtin_bit_cast(float, kk[i] << 16); a += wq[c * 8 + 2 * i + 1] * __builtin_bit_cast(float, kk[i] & 0xffff0000u); } }
                    a *= 0.125f; }
                sc[h2] = a; }
            const float sk = sinks[hq];
            const float mx = fmaxf(wave_max(fmaxf(sc[0], sc[1])), sk);
            const float p0 = __expf(sc[0] - mx), p1 = __expf(sc[1] - mx);
            const float den = wave_sum(p0 + p1) + __expf(sk - mx);
            wp[lane] = p0; wp[lane + 64] = p1;
            __builtin_amdgcn_wave_barrier(); asm volatile("s_waitcnt lgkmcnt(0)" ::: "memory");
            float o = 0.f;
            for (int j = 0; j < WINDOW; ++j) { const int kp = s - (WINDOW - 1) + j; if (kp >= 0) o += wp[j] * bf2f(qkv[(size_t)(t - (WINDOW - 1) + j) * 768 + 640 + kvh * 64 + lane]); }
            ycat[(size_t)t * 1024 + 512 + hq * 64 + lane] = (bf16)f2bf(o / den);
            __builtin_amdgcn_wave_barrier(); asm volatile("s_waitcnt lgkmcnt(0)" ::: "memory");
        }
    }
    PHASE_END

    PHASE_BEGIN
    for (int u = bid; u < 128 * 16; u += G) { const int mt = u / 16, nt = u % 16;
        ngemm_tile<1>(ldsf, D, mt * 128, nt * 64,
            [&](int m, int k) { return bf2f(ycat[(size_t)m * D + k]); },
            [&](int b, int k, int n) { return w_out[(size_t)k * D + n]; },
            [&](int m, int n, float a, float) { out[(size_t)m * D + n] = ALPHA * x[(size_t)m * D + n] + a; });
    }
    PHASE_END
    PHASE_BEGIN
    for (int m = gw; m < T; m += NGW) { f32x4 v[4]; ln_row(out + (size_t)m * D, g_ln1, b_ln1, v, lane); st_row_f32(out + (size_t)m * D, v, 1.f, lane); st_row_bf16(x1b + (size_t)m * D, v, lane); }
    PHASE_END
    PHASE_BEGIN
    for (int u = bid; u < 128 * 16; u += G) { const int mt = u / 16, nt = u % 16;
        ngemm_tile<1>(ldsf, D, mt * 128, nt * 64,
            [&](int m, int k) { return bf2f(x1b[(size_t)m * D + k]); },
            [&](int b, int k, int n) { return w_mq[(size_t)k * D + n]; },
            [&](int m, int n, float a, float) { qm[(size_t)m * D + n] = (bf16)f2bf(a); });
    }
    PHASE_END
    PHASE_BEGIN
    for (int u = bid; u < 128 * 16; u += G) { const int mt = u / 16, h = (u % 16) / 4, nt = u % 4; const int b = (mt * 128) / SEQ;
        ngemm_tile<1>(ldsf, MHD, mt * 128, nt * 64,
            [&](int m, int k) { return bf2f(qm[(size_t)m * D + h * MHD + k]); },
            [&](int bb, int k, int n) { return bf2f(kmem[(size_t)(b * MEM + n) * D + h * MHD + k]); },
            [&](int m, int n, float a, float) { Sbuf[(size_t)m * D + h * MHD + n] = a * 0.0625f; });
    }
    PHASE_END
    PHASE_BEGIN
    for (int m = gw; m < T; m += NGW) {
#pragma unroll
        for (int h = 0; h < 4; ++h) { const f32x4 v = ((const f32x4*)(Sbuf + (size_t)m * D + h * MHD))[lane];
            const float mx = wave_max(fmaxf(fmaxf(v.x, v.y), fmaxf(v.z, v.w)));
            const float e0 = __expf(v.x - mx), e1 = __expf(v.y - mx), e2 = __expf(v.z - mx), e3 = __expf(v.w - mx);
            const float inv = 1.f / wave_sum((e0 + e1) + (e2 + e3));
            u32x2 w; w.x = pk2(e0 * inv, e1 * inv); w.y = pk2(e2 * inv, e3 * inv); ((u32x2*)(Pb + (size_t)m * D + h * MHD))[lane] = w; }
    }
    PHASE_END
    PHASE_BEGIN
    for (int u = bid; u < 128 * 16; u += G) { const int mt = u / 16, h = (u % 16) / 4, nt = u % 4; const int b = (mt * 128) / SEQ;
        ngemm_tile<1>(ldsf, MEM, mt * 128, nt * 64,
            [&](int m, int k) { return bf2f(Pb[(size_t)m * D + h * MHD + k]); },
            [&](int bb, int k, int n) { return bf2f(vmemT[(size_t)(h * MHD + n) * NMEM + b * MEM + k]); },
            [&](int m, int n, float a, float) { om[(size_t)m * D + h * MHD + n] = (bf16)f2bf(a); });
    }
    PHASE_END
    PHASE_BEGIN
    for (int u = bid; u < 128 * 16; u += G) { const int mt = u / 16, nt = u % 16;
        ngemm_tile<1>(ldsf, D, mt * 128, nt * 64,
            [&](int m, int k) { return bf2f(om[(size_t)m * D + k]); },
            [&](int b, int k, int n) { return w_mo[(size_t)k * D + n]; },
            [&](int m, int n, float a, float) { out[(size_t)m * D + n] = ALPHA * out[(size_t)m * D + n] + a; });
    }
    PHASE_END
    PHASE_BEGIN
    for (int m = gw; m < T; m += NGW) {
        f32x4 v[4]; ln_row(out + (size_t)m * D, g_ln2, b_ln2, v, lane); st_row_f32(out + (size_t)m * D, v, ALPHA, lane); st_row_bf16(x2b + (size_t)m * D, v, lane);
        float lg[20];
#pragma unroll
        for (int c = 0; c < 20; ++c) lg[c] = 0.f;
#pragma unroll
        for (int j = 0; j < 4; ++j)
#pragma unroll
            for (int i = 0; i < 4; ++i) { const int k = 4 * lane + 256 * j + i; const float xv = v[j][i];
                const f32x4 wg = *(const f32x4*)(w_group + (size_t)k * 4);
                lg[0] += xv * wg.x; lg[1] += xv * wg.y; lg[2] += xv * wg.z; lg[3] += xv * wg.w;
#pragma unroll
                for (int gq = 0; gq < 4; ++gq) { const f32x4 wr = *(const f32x4*)(w_router + ((size_t)gq * D + k) * 4);
                    lg[4 + gq * 4 + 0] += xv * wr.x; lg[4 + gq * 4 + 1] += xv * wr.y; lg[4 + gq * 4 + 2] += xv * wr.z; lg[4 + gq * 4 + 3] += xv * wr.w; } }
#pragma unroll
        for (int c = 0; c < 20; ++c) lg[c] = wave_sum(lg[c]);
        if (lane == 0) {
            float gl[4]; int gi = 0; float gmx = -INFINITY;
#pragma unroll
            for (int i = 0; i < 4; ++i) { gl[i] = lg[i] + b_group[i]; if (gl[i] > gmx) { gmx = gl[i]; gi = i; } }
            float gs = 0.f;
#pragma unroll
            for (int i = 0; i < 4; ++i) gs += __expf(gl[i] - gmx);
            const float gp = 1.f / gs;
            float el[4];
#pragma unroll
            for (int i = 0; i < 4; ++i) { float a = lg[4 + i], bq = b_router[i];
                a = (gi == 1) ? lg[8 + i] : a; a = (gi == 2) ? lg[12 + i] : a; a = (gi == 3) ? lg[16 + i] : a;
                bq = (gi == 1) ? b_router[4 + i] : bq; bq = (gi == 2) ? b_router[8 + i] : bq; bq = (gi == 3) ? b_router[12 + i] : bq;
                el[i] = a + bq; }
            int i0 = 0; float v0 = el[0];
#pragma unroll
            for (int i = 1; i < 4; ++i) if (el[i] > v0) { v0 = el[i]; i0 = i; }
            int i1 = -1; float v1 = -INFINITY;
#pragma unroll
            for (int i = 0; i < 4; ++i) if (i != i0 && el[i] > v1) { v1 = el[i]; i1 = i; }
            const float w0 = 1.f / (1.f + __expf(v1 - v0)), w1 = 1.f - w0;
            route_e[2 * m] = gi * 4 + i0; route_e[2 * m + 1] = gi * 4 + i1; route_g[2 * m] = gp * w0; route_g[2 * m + 1] = gp * w1;
        }
    }
    PHASE_END
    const int TPB = (T + G - 1) / G;
    PHASE_BEGIN
    if (tid == 0) {
        const int t0 = bid * TPB, t1 = (t0 + TPB < T) ? t0 + TPB : T;
        int* lcnt = (int*)lds_raw;
        for (int e = 0; e < 16; ++e) lcnt[e] = 0;
        for (int pi = 2 * t0; pi < 2 * t1; ++pi) { const int e = route_e[pi]; rank[pi] = lcnt[e]; lcnt[e] = lcnt[e] + 1; }
        for (int e = 0; e < 16; ++e) blkcnt[bid * 16 + e] = lcnt[e];
    }
    PHASE_END
    PHASE_BEGIN
    {
        int* sh = (int*)lds_raw;
        if (tid < 16) { int tot = 0, base = 0; for (int b = 0; b < G; ++b) { const int c = blkcnt[b * 16 + tid]; tot += c; if (b < bid) base += c; } sh[tid] = base; sh[64 + tid] = tot; }
        __syncthreads();
        if (tid == 0) { int s = 0; for (int e = 0; e < 16; ++e) { sh[16 + e] = s; s += (sh[64 + e] + 255) & ~255; } sh[32] = s; if (bid == 0) for (int e = 0; e <= 16; ++e) segw[e] = sh[16 + e]; }
        __syncthreads();
        if (bid == 0) { for (int e = 0; e < 16; ++e) for (int pos = sh[16 + e] + sh[64 + e] + tid; pos < sh[16 + e + 1]; pos += 512) { pair_tok[pos] = -1; pair_gate[pos] = 0.f; } }
        const int t0 = bid * TPB, t1 = (t0 + TPB < T) ? t0 + TPB : T;
        for (int pi = 2 * t0 + wave; pi < 2 * t1; pi += 8) { const int e = route_e[pi], pos = sh[16 + e] + sh[e] + rank[pi], tok = pi >> 1;
            if (lane == 0) { pair_tok[pos] = tok; pair_gate[pos] = route_g[pi]; }
            const u32x4* src = (const u32x4*)(x2b + (size_t)tok * D); u32x4* dst = (u32x4*)(Xs + (size_t)pos * D);
            dst[lane] = src[lane]; dst[lane + 64] = src[lane + 64]; }
    }
    PHASE_END
    PHASE_BEGIN
    { const int nmt = segw[16] / 128;
      for (int u = bid; u < nmt * 8; u += G) { const int mt = u / 8, nt = u % 8; int e = 0;
#pragma unroll
        for (int i = 1; i < 16; ++i) if (mt * 128 >= segw[i]) e = i;
        const float* wg = w_gate + (size_t)e * D * DE; const float* wu = w_up + (size_t)e * D * DE;
        ngemm_tile<2>(ldsf, D, mt * 128, nt * 64,
            [&](int m, int k) { return bf2f(Xs[(size_t)m * D + k]); },
            [&](int b, int k, int n) { return (b == 0 ? wg : wu)[(size_t)k * DE + n]; },
            [&](int m, int n, float g, float uu) { const float pg = pair_gate[m]; const float hv = (pair_tok[m] >= 0) ? (g / (1.f + __expf(-g))) * uu * pg : 0.f; Hs[(size_t)m * DE + n] = (bf16)f2bf(hv); });
      } }
    PHASE_END
    PHASE_BEGIN
    { const int nmt = segw[16] / 128;
      for (int u = bid; u < nmt * 16; u += G) { const int mt = u / 16, nt = u % 16; int e = 0;
#pragma unroll
        for (int i = 1; i < 16; ++i) if (mt * 128 >= segw[i]) e = i;
        const float* wd = w_down + (size_t)e * DE * D;
        ngemm_tile<1>(ldsf, DE, mt * 128, nt * 64,
            [&](int m, int k) { return bf2f(Hs[(size_t)m * DE + k]); },
            [&](int b, int k, int n) { return wd[(size_t)k * D + n]; },
            [&](int m, int n, float a, float) { const int tok = pair_tok[m]; if (tok >= 0) atomicAdd(out + (size_t)tok * D + n, a); });
      } }
    PHASE_END
    PHASE_BEGIN
    for (int m = gw; m < T; m += NGW) { f32x4 v[4]; ln_row(out + (size_t)m * D, g_ln3, b_ln3, v, lane); st_row_f32(out + (size_t)m * D, v, 1.f, lane); }
    PHASE_END
}

constexpr int N_PHASES = 16;
constexpr int LDS_BYTES = 147456;

extern "C" void kernel_launch(void* const* d_in, const int* in_sizes, int n_in, void* d_out, int out_size, void* d_ws, size_t ws_size, hipStream_t stream) {
    static int grid = 0;
    if (grid == 0) {
        int dev = 0, cus = 0, per_cu = 0;
        hipGetDevice(&dev);
        hipDeviceGetAttribute(&cus, hipDeviceAttributeMultiprocessorCount, dev);
        hipFuncSetAttribute((const void*)fwd_kernel, hipFuncAttributeMaxDynamicSharedMemorySize, LDS_BYTES);
        hipOccupancyMaxActiveBlocksPerMultiprocessor(&per_cu, (const void*)fwd_kernel, 512, LDS_BYTES);
        if (per_cu < 1) { fprintf(stderr, "occupancy query returned %d\n", per_cu); per_cu = 1; }
        grid = cus * 1;
        if (ws_size < WS_END) { fprintf(stderr, "workspace too small\n"); grid = -1; }
    }
    if (grid < 0) return;
    Params p{};
    for (int i = 0; i < 26; ++i) p.in[i] = (const float*)d_in[i];
    p.out = (float*)d_out; p.ws = (unsigned char*)d_ws;
#if MK_N_LAUNCHES == 1
    p.ph_lo = 0; p.ph_hi = N_PHASES;
    void* args[] = {&p};
    hipError_t e = hipLaunchCooperativeKernel((const void*)fwd_kernel, dim3(grid), dim3(512), args, LDS_BYTES, stream);
    if (e != hipSuccess) fprintf(stderr, "cooperative launch failed: %s (grid %d)\n", hipGetErrorString(e), grid);
#else
    for (int ph = 0; ph < N_PHASES; ++ph) { p.ph_lo = ph; p.ph_hi = ph + 1; hipLaunchKernelGGL(fwd_kernel, dim3(grid), dim3(512), LDS_BYTES, stream, p); }
#endif
}
```

```cpp
#include <hip/hip_runtime.h>
#include <hip/hip_cooperative_groups.h>
#include <cstdio>
#include <cstdint>
namespace cg = cooperative_groups;

#ifndef FAST_P1
#define FAST_P1 1
#endif
#ifndef FAST_DENSE
#define FAST_DENSE 1
#endif
#ifndef FAST_XATT
#define FAST_XATT 1
#endif
#ifndef FAST_MOE
#define FAST_MOE 1
#endif
#ifndef MK_N_LAUNCHES
#define MK_N_LAUNCHES 1
#endif

typedef unsigned short bf16;
typedef float f32x4 __attribute__((ext_vector_type(4)));
typedef unsigned u32x4 __attribute__((ext_vector_type(4)));
typedef unsigned u32x2 __attribute__((ext_vector_type(2)));

constexpr int BATCH = 2, SEQ = 8192, D = 1024, T = BATCH * SEQ, MEM = 256, NMEM = BATCH * MEM;
constexpr int CONV_CH = 512, CONV_W = 31, NH = 8, NKV = 2, HD = 64, ATTN_W = 512, KV_W = 128, WINDOW = 128;
constexpr int D_IN = 1792, MH = 4, MHD = 256, NG = 4, EPG = 4, NE = 16, DE = 512;
constexpr float ALPHA = 1.189207115002721f, LN_EPS = 1e-5f;
constexpr int NPAIR = 2 * T, NPAIR_PAD = NPAIR + NE * 256;

constexpr size_t MiB = 1u << 20;
constexpr size_t WS_CTL = 0;
constexpr size_t WS_ROUTE = 1 * MiB;
constexpr size_t WS_BLKCNT = 1 * MiB + 512 * 1024;
constexpr size_t WS_SEG = 1 * MiB + 640 * 1024;
constexpr size_t WS_RANK = 2 * MiB;
constexpr size_t WS_PTOK = 2 * MiB + 256 * 1024;
constexpr size_t WS_PGATE = 2 * MiB + 512 * 1024;
constexpr size_t WS_KMEM = 3 * MiB;
constexpr size_t WS_VMEMT = 4 * MiB;
constexpr size_t WS_MEMB = 5 * MiB;
constexpr size_t WS_A = 8 * MiB;
constexpr size_t WS_B = 48 * MiB;
constexpr size_t WS_DD = 88 * MiB;
constexpr size_t WS_WIN = 164 * MiB;
constexpr size_t WS_WOUT = 168 * MiB, WS_WMQ = 170 * MiB, WS_WMKV = 172 * MiB, WS_WMO = 176 * MiB;
constexpr size_t WS_WGU = 178 * MiB;
constexpr size_t WS_WDN = 210 * MiB;
constexpr size_t WS_END = 226 * MiB;

struct Params { const float* in[26]; float* out; unsigned char* ws; int ph_lo, ph_hi; };

__device__ __forceinline__ unsigned f2bf(float f) { unsigned u = __builtin_bit_cast(unsigned, f); return (u + 0x7fffu + ((u >> 16) & 1u)) >> 16; }
__device__ __forceinline__ float bf2f(bf16 b) { return __builtin_bit_cast(float, (unsigned)b << 16); }
__device__ __forceinline__ unsigned pk2(float lo, float hi) { return f2bf(lo) | (f2bf(hi) << 16); }
__device__ __forceinline__ float wave_sum(float v) {
#pragma unroll
    for (int o = 1; o < 64; o <<= 1) v += __shfl_xor(v, o);
    return v;
}
__device__ __forceinline__ float wave_max(float v) {
#pragma unroll
    for (int o = 1; o < 64; o <<= 1) v = fmaxf(v, __shfl_xor(v, o));
    return v;
}
__device__ __forceinline__ float ldA(const bf16* p) { return bf2f(*p); }
__device__ __forceinline__ float ldA(const float* p) { return *p; }

template <int NB, class FA, class FB, class FE>
__device__ __forceinline__ void ngemm_tile(float* lds, int K, int m0, int n0, FA fa, FB fb, FE fe) {
    float* As = lds;
    float* Bs = lds + 16 * 132;
    int tid = threadIdx.x; asm volatile("" : "+v"(tid));
    const int ty = tid >> 4, tx = tid & 15;
    float acc[NB][4][4];
#pragma unroll
    for (int b = 0; b < NB; ++b)
#pragma unroll
        for (int i = 0; i < 4; ++i)
#pragma unroll
            for (int j = 0; j < 4; ++j) acc[b][i][j] = 0.f;
    for (int k0 = 0; k0 < K; k0 += 16) {
        { const int r = tid >> 2, kk = (tid & 3) * 4;
#pragma unroll
            for (int i = 0; i < 4; ++i) As[(kk + i) * 132 + r] = fa(m0 + r, k0 + kk + i); }
#pragma unroll
        for (int b = 0; b < NB; ++b) { const int kk = tid >> 5, nn = (tid & 31) * 2;
            Bs[(b * 16 + kk) * 68 + nn] = fb(b, k0 + kk, n0 + nn); Bs[(b * 16 + kk) * 68 + nn + 1] = fb(b, k0 + kk, n0 + nn + 1); }
        __syncthreads();
#pragma unroll 4
        for (int k = 0; k < 16; ++k) {
            const f32x4 a = *(const f32x4*)&As[k * 132 + ty * 4];
#pragma unroll
            for (int b = 0; b < NB; ++b) { const f32x4 bb = *(const f32x4*)&Bs[(b * 16 + k) * 68 + tx * 4];
#pragma unroll
                for (int i = 0; i < 4; ++i)
#pragma unroll
                    for (int j = 0; j < 4; ++j) acc[b][i][j] += a[i] * bb[j]; }
        }
        __syncthreads();
    }
#pragma unroll
    for (int i = 0; i < 4; ++i)
#pragma unroll
        for (int j = 0; j < 4; ++j) fe(m0 + ty * 4 + i, n0 + tx * 4 + j, acc[0][i][j], acc[NB - 1][i][j]);
}

__device__ __forceinline__ void ln_row(const float* src, const float* g, const float* b, f32x4 (&v)[4], int lane) {
    const f32x4* xr = (const f32x4*)src + lane; float s = 0.f;
#pragma unroll
    for (int j = 0; j < 4; ++j) { v[j] = xr[64 * j]; s += (v[j].x + v[j].y) + (v[j].z + v[j].w); }
    const float mean = wave_sum(s) * (1.f / D); float s2 = 0.f;
#pragma unroll
    for (int j = 0; j < 4; ++j) { v[j] = v[j] - mean; s2 += (v[j].x * v[j].x + v[j].y * v[j].y) + (v[j].z * v[j].z + v[j].w * v[j].w); }
    const float rstd = 1.f / sqrtf(wave_sum(s2) * (1.f / D) + LN_EPS);
#pragma unroll
    for (int j = 0; j < 4; ++j) { const f32x4 gg = ((const f32x4*)g)[lane + 64 * j], bb = ((const f32x4*)b)[lane + 64 * j]; v[j] = v[j] * rstd * gg + bb; }
}
__device__ __forceinline__ void st_row_f32(float* dst, const f32x4 (&v)[4], float scale, int lane) {
#pragma unroll
    for (int j = 0; j < 4; ++j) ((f32x4*)dst)[lane + 64 * j] = v[j] * scale;
}
__device__ __forceinline__ void st_row_bf16(bf16* dst, const f32x4 (&v)[4], int lane) {
#pragma unroll
    for (int j = 0; j < 4; ++j) { u32x2 w; w.x = pk2(v[j].x, v[j].y); w.y = pk2(v[j].z, v[j].w); ((u32x2*)dst)[lane + 64 * j] = w; }
}


namespace pg8 {
#define PG8_LAS __attribute__((address_space(3)))
typedef unsigned short bf16_t;
typedef short bf16x8 __attribute__((ext_vector_type(8)));
constexpr int BM = 256, BK = 64, HALF = 128, HTB = HALF * BK * 2, STAGE_BYTES = 8 * HTB, NXCD = 8, WGM = 8;
__device__ __forceinline__ int lds_byte(int r, int c) { const int st = (r >> 4) * 2 + (c >> 5), rr = r & 15, cc = c & 31, ob = rr * 64 + cc * 2; return st * 1024 + (ob ^ (((ob >> 9) & 1) << 5)); }
__device__ __forceinline__ void stage_rc(int b, int& R, int& C) { const int st = b / 1024, sb = b % 1024, swz = sb ^ (((sb >> 9) & 1) << 5); R = (st >> 1) * 16 + swz / 64; C = (st & 1) * 32 + (swz % 64) / 2; }
__device__ __forceinline__ int perm32(int rho) { const int n = rho >> 4, i = rho & 15; return 8 * (i >> 2) + 4 * n + (i & 3); }
struct Unit { const char* A; const char* B; int pm, pn, kind, aux; };
struct Gemm { int lda, ldb, K; };
__device__ __forceinline__ void tile_of(int L, int nM, int nN, int& pm, int& pn) {
    const int nwg = nM * nN; int wgid = L; { const int q = nwg / NXCD, r = nwg % NXCD, xcd = wgid % NXCD, off = wgid / NXCD; wgid = (xcd < r ? xcd * (q + 1) : r * (q + 1) + (xcd - r) * q) + off; }
    const int nig = WGM * nN, gid = wgid / nig, fm = gid * WGM, gsz = (nM - fm) < WGM ? (nM - fm) : WGM;
    pm = fm + ((wgid % nig) % gsz); pn = (wgid % nig) / gsz;
}
__device__ __forceinline__ unsigned cvt_pk_bf16(float lo, float hi) { unsigned r; asm volatile("v_cvt_pk_bf16_f32 %0, %1, %2" : "=v"(r) : "v"(lo), "v"(hi)); return r; }

template <class Epi, class Sched>
__device__ __forceinline__ void gemm_phase(PG8_LAS unsigned char* lds, const Gemm g, const Sched& S, const Epi& E) {
    int tid = threadIdx.x; asm volatile("" : "+v"(tid));
    const int wid = __builtin_amdgcn_readfirstlane(tid >> 6), lane = tid & 63, wr = wid >> 2, wc = wid & 3, fr = lane & 15, fq = lane >> 4;
    const int K = g.K, nt = K / BK;
    unsigned voffA[2], voffB[2];
#pragma unroll
    for (int i = 0; i < 2; ++i) { int R, C; stage_rc(tid * 16 + i * 8192, R, C); const int Rb = Epi::PERM ? ((R & ~31) + perm32(R & 31)) : R;
        voffA[i] = (unsigned)(R * g.lda + C) * 2u; voffB[i] = (unsigned)(Rb * g.ldb + C) * 2u; }
    const size_t kstep = (size_t)(BK * 2);
    const size_t hstepA = (size_t)HALF * g.lda * 2, hstepB = (size_t)HALF * g.ldb * 2;
    const unsigned ldsw = (unsigned)wid * 1024u;
    const int aoff = lds_byte(wr * 64 + fr, fq * 8), boff = lds_byte(wc * 32 + fr, fq * 8);
#define PG8_SA(b, h) (((b) * 2 + (h)) * HTB)
#define PG8_SB(b, h) ((4 + (b) * 2 + (h)) * HTB)
#define PG8_STAGE(bufoff, gbase, voff) do { _Pragma("unroll") for (int _i = 0; _i < 2; ++_i) \
        __builtin_amdgcn_global_load_lds((const unsigned*)((const char*)(gbase) + (voff)[_i]), (PG8_LAS unsigned*)(lds + (bufoff) + ldsw + _i * 8192), 16, 0, 0); } while (0)
#define PG8_LDA(dst, b, h) do { _Pragma("unroll") for (int m = 0; m < 4; ++m) _Pragma("unroll") for (int k = 0; k < 2; ++k) dst[m][k] = *(const PG8_LAS bf16x8*)(lds + PG8_SA(b, h) + aoff + m * 2048 + k * 1024); } while (0)
#define PG8_LDB(dst, b, h) do { _Pragma("unroll") for (int n = 0; n < 2; ++n) _Pragma("unroll") for (int k = 0; k < 2; ++k) dst[n][k] = *(const PG8_LAS bf16x8*)(lds + PG8_SB(b, h) + boff + n * 2048 + k * 1024); } while (0)
#define PG8_MMA(ai, bj, At, Bt) do { __builtin_amdgcn_s_setprio(1); _Pragma("unroll") for (int m = 0; m < 4; ++m) _Pragma("unroll") for (int n = 0; n < 2; ++n) _Pragma("unroll") for (int k = 0; k < 2; ++k) \
        acc[ai][bj][m][n] = __builtin_amdgcn_mfma_f32_16x16x32_bf16(Bt[n][k], At[m][k], acc[ai][bj][m][n], 0, 0, 0); __builtin_amdgcn_s_setprio(0); } while (0)
#define PG8_WAIT_V(n) asm volatile("s_waitcnt vmcnt(" #n ")" ::: "memory")
#define PG8_WAIT_L(n) asm volatile("s_waitcnt lgkmcnt(" #n ")" ::: "memory")
#define PG8_BAR __builtin_amdgcn_s_barrier()
#define PG8_SCHED __builtin_amdgcn_sched_barrier(0)
    Unit cur, nxt; int ui = 0;
    if (!S.next(0, cur)) return;
    f32x4 acc[2][2][4][2];
#pragma unroll
    for (int a = 0; a < 2; ++a)
#pragma unroll
        for (int b = 0; b < 2; ++b)
#pragma unroll
            for (int m = 0; m < 4; ++m)
#pragma unroll
                for (int n = 0; n < 2; ++n) acc[a][b][m][n] = (f32x4){0.f, 0.f, 0.f, 0.f};
    bf16x8 At[4][2], B0[2][2], B1[2][2];
    const char* cA = cur.A; const char* cB = cur.B;
    PG8_STAGE(PG8_SB(0, 0), cB, voffB); PG8_STAGE(PG8_SB(0, 1), cB + hstepB, voffB); PG8_STAGE(PG8_SA(0, 0), cA, voffA); PG8_STAGE(PG8_SA(0, 1), cA + hstepA, voffA);
    if (wr == 1) PG8_BAR;
    PG8_WAIT_V(2); PG8_BAR;
    PG8_STAGE(PG8_SB(1, 0), cB + kstep, voffB); PG8_STAGE(PG8_SA(1, 0), cA + kstep, voffA); PG8_STAGE(PG8_SB(1, 1), cB + hstepB + kstep, voffB);
    PG8_WAIT_V(6); PG8_BAR;
    for (;;) {
        const bool has_next = S.next(ui + 1, nxt);
        const char* nA = has_next ? nxt.A : cA; const char* nB = has_next ? nxt.B : cB;
        for (int t = 0; t < nt; t += 2) {
            const bool last = (t == nt - 2);
            const char* a1 = cA + (size_t)(t + 1) * kstep;
            const char* a2 = last ? nA : cA + (size_t)(t + 2) * kstep; const char* b2 = last ? nB : cB + (size_t)(t + 2) * kstep;
            const char* a3 = a2 + kstep; const char* b3 = b2 + kstep;
            PG8_LDB(B0, 0, 0); PG8_LDB(B1, 0, 1); PG8_SCHED; PG8_LDA(At, 0, 0); PG8_STAGE(PG8_SA(1, 1), a1 + hstepA, voffA);
            PG8_WAIT_V(8); PG8_WAIT_L(0); PG8_BAR; PG8_MMA(0, 0, At, B0); PG8_MMA(0, 1, At, B1); PG8_BAR; PG8_SCHED;
            PG8_LDA(At, 0, 1); PG8_STAGE(PG8_SB(0, 0), b2, voffB); PG8_STAGE(PG8_SB(0, 1), b2 + hstepB, voffB); PG8_STAGE(PG8_SA(0, 0), a2, voffA);
            PG8_WAIT_V(8); PG8_WAIT_L(0); PG8_BAR; PG8_MMA(1, 0, At, B0); PG8_MMA(1, 1, At, B1); PG8_BAR; PG8_SCHED;
            PG8_LDB(B0, 1, 0); PG8_LDB(B1, 1, 1); PG8_SCHED; PG8_LDA(At, 1, 0); PG8_STAGE(PG8_SA(0, 1), a2 + hstepA, voffA);
            PG8_WAIT_V(8); PG8_WAIT_L(0); PG8_BAR; PG8_MMA(0, 0, At, B0); PG8_MMA(0, 1, At, B1); PG8_BAR; PG8_SCHED;
            PG8_LDA(At, 1, 1); PG8_STAGE(PG8_SB(1, 0), b3, voffB); PG8_STAGE(PG8_SB(1, 1), b3 + hstepB, voffB); PG8_STAGE(PG8_SA(1, 0), a3, voffA);
            PG8_WAIT_V(8); PG8_WAIT_L(0); PG8_BAR; PG8_MMA(1, 0, At, B0); PG8_MMA(1, 1, At, B1); PG8_BAR; PG8_SCHED;
        }
        if (wr == 0) PG8_BAR;
        E(acc, cur, wr, wc, fr, fq);
        if (!has_next) break;
#pragma unroll
        for (int a = 0; a < 2; ++a)
#pragma unroll
            for (int b = 0; b < 2; ++b)
#pragma unroll
                for (int m = 0; m < 4; ++m)
#pragma unroll
                    for (int n = 0; n < 2; ++n) acc[a][b][m][n] = (f32x4){0.f, 0.f, 0.f, 0.f};
        cur = nxt; cA = nA; cB = nB; ++ui;
        if (wr == 1) PG8_BAR;
    }
    PG8_WAIT_V(0);
    PG8_BAR;
#undef PG8_SA
#undef PG8_SB
#undef PG8_STAGE
#undef PG8_LDA
#undef PG8_LDB
#undef PG8_MMA
#undef PG8_WAIT_V
#undef PG8_WAIT_L
#undef PG8_BAR
#undef PG8_SCHED
}

__device__ __forceinline__ u32x4 pack8(const f32x4 v0, const f32x4 v1) { u32x4 w; w.x = cvt_pk_bf16(v0[0], v0[1]); w.y = cvt_pk_bf16(v0[2], v0[3]); w.z = cvt_pk_bf16(v1[0], v1[1]); w.w = cvt_pk_bf16(v1[2], v1[3]); return w; }
__device__ __forceinline__ float sigm(float g) { return __builtin_amdgcn_rcpf(1.f + __expf(-g)); }

struct EpiBf16 {
    static constexpr bool PERM = true;
    bf16_t* O; int ldc; const float* bias;
    __device__ __forceinline__ void operator()(const f32x4 (&acc)[2][2][4][2], const Unit& u, int wr, int wc, int fr, int fq) const {
        const int row0 = u.pm * BM + wr * 64 + fr, col0 = u.pn * BM + wc * 32 + 8 * fq;
        f32x4 bv[2][2];
#pragma unroll
        for (int bj = 0; bj < 2; ++bj)
#pragma unroll
            for (int n = 0; n < 2; ++n) bv[bj][n] = bias ? *(const f32x4*)(bias + col0 + bj * HALF + 4 * n) : (f32x4){0.f, 0.f, 0.f, 0.f};
#pragma unroll
        for (int ai = 0; ai < 2; ++ai)
#pragma unroll
            for (int m = 0; m < 4; ++m) { bf16_t* rowp = O + (size_t)(row0 + ai * HALF + m * 16) * ldc + col0;
#pragma unroll
                for (int bj = 0; bj < 2; ++bj) *(u32x4*)(rowp + bj * HALF) = pack8(acc[ai][bj][m][0] + bv[bj][0], acc[ai][bj][m][1] + bv[bj][1]); }
    }
};
struct EpiP1 {
    static constexpr bool PERM = true;
    bf16_t *hglu, *qkv, *kmem, *vmemT; const float* b_in;
    __device__ __forceinline__ void operator()(const f32x4 (&acc)[2][2][4][2], const Unit& u, int wr, int wc, int fr, int fq) const {
        if (u.kind == 0) {
            const int row0 = u.pm * BM + wr * 64 + fr, cb = u.pn * 128 + wc * 32 + 8 * fq;
            f32x4 ba[2], bg[2];
#pragma unroll
            for (int n = 0; n < 2; ++n) { ba[n] = *(const f32x4*)(b_in + cb + 4 * n); bg[n] = *(const f32x4*)(b_in + 512 + cb + 4 * n); }
#pragma unroll
            for (int ai = 0; ai < 2; ++ai)
#pragma unroll
                for (int m = 0; m < 4; ++m) { f32x4 h[2];
#pragma unroll
                    for (int n = 0; n < 2; ++n) { const f32x4 a = acc[ai][0][m][n] + ba[n], gt = acc[ai][1][m][n] + bg[n];
                        h[n] = (f32x4){a[0] * sigm(gt[0]), a[1] * sigm(gt[1]), a[2] * sigm(gt[2]), a[3] * sigm(gt[3])}; }
                    *(u32x4*)(hglu + (size_t)(row0 + ai * HALF + m * 16) * 512 + cb) = pack8(h[0], h[1]); }
        } else if (u.kind == 1) { EpiBf16 e{qkv - 1024, 768, b_in}; e(acc, u, wr, wc, fr, fq);
        } else if (u.kind == 2) { EpiBf16 e{kmem, 1024, nullptr}; e(acc, u, wr, wc, fr, fq);
        } else { EpiBf16 e{vmemT, 512, nullptr}; e(acc, u, wr, wc, fr, fq); }
    }
};
struct EpiResF32 {
    static constexpr bool PERM = false;
    const float* res; float* out; float alpha;
    __device__ __forceinline__ void operator()(const f32x4 (&acc)[2][2][4][2], const Unit& u, int wr, int wc, int fr, int fq) const {
        const int row0 = u.pm * BM + wr * 64 + fr, col0 = u.pn * BM + wc * 32 + 4 * fq;
#pragma unroll
        for (int ai = 0; ai < 2; ++ai)
#pragma unroll
            for (int m = 0; m < 4; ++m) { const size_t off = (size_t)(row0 + ai * HALF + m * 16) * 1024 + col0;
#pragma unroll
                for (int bj = 0; bj < 2; ++bj)
#pragma unroll
                    for (int n = 0; n < 2; ++n) { const f32x4 r = *(const f32x4*)(res + off + bj * HALF + n * 16); *(f32x4*)(out + off + bj * HALF + n * 16) = r * alpha + acc[ai][bj][m][n]; } }
    }
};
struct EpiSoftmax {
    static constexpr bool PERM = true;
    bf16_t* P; PG8_LAS float* xl;
    __device__ __forceinline__ void operator()(const f32x4 (&acc)[2][2][4][2], const Unit& u, int wr, int wc, int fr, int fq) const {
        const float sc = 0.0625f * 1.4426950408889634f;
#pragma unroll
        for (int ai = 0; ai < 2; ++ai)
#pragma unroll
            for (int m = 0; m < 4; ++m) { float mx = -INFINITY;
#pragma unroll
                for (int bj = 0; bj < 2; ++bj)
#pragma unroll
                    for (int n = 0; n < 2; ++n) { const f32x4 v = acc[ai][bj][m][n]; mx = fmaxf(mx, fmaxf(fmaxf(v[0], v[1]), fmaxf(v[2], v[3]))); }
                mx = fmaxf(mx, __shfl_xor(mx, 16)); mx = fmaxf(mx, __shfl_xor(mx, 32));
                float s = 0.f;
#pragma unroll
                for (int bj = 0; bj < 2; ++bj)
#pragma unroll
                    for (int n = 0; n < 2; ++n) { const f32x4 v = acc[ai][bj][m][n]; s += (__builtin_amdgcn_exp2f((v[0] - mx) * sc) + __builtin_amdgcn_exp2f((v[1] - mx) * sc)) + (__builtin_amdgcn_exp2f((v[2] - mx) * sc) + __builtin_amdgcn_exp2f((v[3] - mx) * sc)); }
                s += __shfl_xor(s, 16); s += __shfl_xor(s, 32);
                if (fq == 0) { PG8_LAS float* q = xl + ((ai * HALF + wr * 64 + m * 16 + fr) * 4 + wc) * 2; q[0] = mx; q[1] = s; } }
        asm volatile("s_waitcnt lgkmcnt(0)" ::: "memory"); __builtin_amdgcn_s_barrier(); asm volatile("" ::: "memory");
        const int row0 = u.pm * BM + wr * 64 + fr, col0 = u.pn * BM + wc * 32 + 8 * fq;
#pragma unroll
        for (int ai = 0; ai < 2; ++ai)
#pragma unroll
            for (int m = 0; m < 4; ++m) { const PG8_LAS f32x4* q = (const PG8_LAS f32x4*)(xl + (ai * HALF + wr * 64 + m * 16 + fr) * 8); const f32x4 q0 = q[0], q1 = q[1];
                const float M = fmaxf(fmaxf(q0[0], q0[2]), fmaxf(q1[0], q1[2]));
                const float S = (q0[1] * __builtin_amdgcn_exp2f((q0[0] - M) * sc) + q0[3] * __builtin_amdgcn_exp2f((q0[2] - M) * sc)) + (q1[1] * __builtin_amdgcn_exp2f((q1[0] - M) * sc) + q1[3] * __builtin_amdgcn_exp2f((q1[2] - M) * sc));
                const float inv = 1.f / S; bf16_t* rowp = P + (size_t)(row0 + ai * HALF + m * 16) * 1024 + col0;
#pragma unroll
                for (int bj = 0; bj < 2; ++bj) { f32x4 p[2];
#pragma unroll
                    for (int n = 0; n < 2; ++n) { const f32x4 v = acc[ai][bj][m][n];
                        p[n] = (f32x4){__builtin_amdgcn_exp2f((v[0] - M) * sc) * inv, __builtin_amdgcn_exp2f((v[1] - M) * sc) * inv, __builtin_amdgcn_exp2f((v[2] - M) * sc) * inv, __builtin_amdgcn_exp2f((v[3] - M) * sc) * inv}; }
                    *(u32x4*)(rowp + bj * HALF) = pack8(p[0], p[1]); } }
        asm volatile("s_waitcnt lgkmcnt(0)" ::: "memory"); __builtin_amdgcn_s_barrier(); asm volatile("" ::: "memory");
    }
};
struct EpiGateUp {
    static constexpr bool PERM = true;
    bf16_t* Hs; const float* pair_gate;
    __device__ __forceinline__ void operator()(const f32x4 (&acc)[2][2][4][2], const Unit& u, int wr, int wc, int fr, int fq) const {
        const int row0 = u.pm * BM + wr * 64 + fr, cb = u.pn * 128 + wc * 32 + 8 * fq;
#pragma unroll
        for (int ai = 0; ai < 2; ++ai)
#pragma unroll
            for (int m = 0; m < 4; ++m) { const int row = row0 + ai * HALF + m * 16; const float pg = pair_gate[row]; f32x4 h[2];
#pragma unroll
                for (int n = 0; n < 2; ++n) { const f32x4 gt = acc[ai][0][m][n], up = acc[ai][1][m][n];
                    h[n] = (f32x4){gt[0] * sigm(gt[0]) * up[0] * pg, gt[1] * sigm(gt[1]) * up[1] * pg, gt[2] * sigm(gt[2]) * up[2] * pg, gt[3] * sigm(gt[3]) * up[3] * pg}; }
                if (pg == 0.f) { h[0] = (f32x4){0.f, 0.f, 0.f, 0.f}; h[1] = h[0]; }
                *(u32x4*)(Hs + (size_t)row * 512 + cb) = pack8(h[0], h[1]); }
    }
};
struct EpiDown {
    static constexpr bool PERM = false;
    float* out; const int* pair_tok;
    __device__ __forceinline__ void operator()(const f32x4 (&acc)[2][2][4][2], const Unit& u, int wr, int wc, int fr, int fq) const {
        const int row0 = u.pm * BM + wr * 64 + fr, col0 = u.pn * BM + wc * 32 + 4 * fq;
#pragma unroll
        for (int ai = 0; ai < 2; ++ai)
#pragma unroll
            for (int m = 0; m < 4; ++m) { const int tok = pair_tok[row0 + ai * HALF + m * 16];
                if (tok >= 0) { float* rp = out + (size_t)tok * 1024 + col0;
#pragma unroll
                    for (int bj = 0; bj < 2; ++bj)
#pragma unroll
                        for (int n = 0; n < 2; ++n)
#pragma unroll
                            for (int i = 0; i < 4; ++i) unsafeAtomicAdd(rp + bj * HALF + n * 16 + i, acc[ai][bj][m][n][i]); } }
    }
};
struct DenseSched {
    const char* A; const char* B; int nM, nN, G, c; size_t strideA, strideB;
    __device__ __forceinline__ bool next(int i, Unit& u) const { const int L = i * G + c; if (L >= nM * nN) return false; tile_of(L, nM, nN, u.pm, u.pn); u.A = A + (size_t)u.pm * strideA; u.B = B + (size_t)u.pn * strideB; u.kind = 0; u.aux = 0; return true; }
};
}


#define LAS __attribute__((address_space(3)))
__device__ __forceinline__ void transpose_item(const float* W, int N, bf16* WT, int Kd, int k0, int n0, int drow0, LAS float* scr, int lane) {
#pragma unroll 8
    for (int i = 0; i < 32; ++i) { const int kk = 2 * i + (lane >> 5); scr[kk * 33 + (lane & 31)] = W[(size_t)(k0 + kk) * N + n0 + (lane & 31)]; }
    asm volatile("s_waitcnt lgkmcnt(0)" ::: "memory");
    const int c = lane & 7;
#pragma unroll
    for (int j = 0; j < 4; ++j) { const int n = (lane >> 3) + 8 * j; const LAS float* sp = scr + (8 * c) * 33 + n;
        u32x4 o; o.x = pk2(sp[0 * 33], sp[1 * 33]); o.y = pk2(sp[2 * 33], sp[3 * 33]); o.z = pk2(sp[4 * 33], sp[5 * 33]); o.w = pk2(sp[6 * 33], sp[7 * 33]);
        *(u32x4*)(WT + (size_t)(drow0 + n) * Kd + k0 + 8 * c) = o; }
    asm volatile("s_waitcnt lgkmcnt(0)" ::: "memory");
}


struct SchedMoE { const char* A; const char* W; const int* seg; int nmt, nN, G, c; size_t strideA, strideE, strideN;
    __device__ __forceinline__ bool next(int i, pg8::Unit& u) const { const int L = i * G + c; if (L >= nmt * nN) return false; pg8::tile_of(L, nmt, nN, u.pm, u.pn); int e = 0;
#pragma unroll
        for (int j = 1; j < 16; ++j) if (u.pm * 256 >= seg[j]) e = j;
        u.kind = 0; u.aux = e; u.A = A + (size_t)u.pm * strideA; u.B = W + (size_t)e * strideE + (size_t)u.pn * strideN; return true; } };

__global__ void __launch_bounds__(512, 2) fwd_kernel(Params p) {
    extern __shared__ __attribute__((aligned(16))) unsigned char lds_raw[];
    float* ldsf = (float*)lds_raw;
    cg::grid_group grid = cg::this_grid();
    const int G = gridDim.x, bid = blockIdx.x, NGW = G * 8;
    unsigned char* ws = p.ws;
    const float *x = p.in[0], *mem = p.in[1], *w_in = p.in[2], *b_in = p.in[3], *w_dw = p.in[4], *b_dw = p.in[5], *g_cn = p.in[6], *b_cn = p.in[7], *sinks = p.in[8],
                *w_out = p.in[9], *g_ln1 = p.in[10], *b_ln1 = p.in[11], *w_mq = p.in[12], *w_mkv = p.in[13], *w_mo = p.in[14], *g_ln2 = p.in[15], *b_ln2 = p.in[16],
                *w_group = p.in[17], *b_group = p.in[18], *w_router = p.in[19], *b_router = p.in[20], *w_gate = p.in[21], *w_up = p.in[22], *w_down = p.in[23],
                *g_ln3 = p.in[24], *b_ln3 = p.in[25];
    float* out = p.out;
    bf16* xb = (bf16*)(ws + WS_A); bf16* ycat = (bf16*)(ws + WS_A); bf16* qm = (bf16*)(ws + WS_A); bf16* om = (bf16*)(ws + WS_A); bf16* Hs = (bf16*)(ws + WS_A);
    bf16* hglu = (bf16*)(ws + WS_B); bf16* qkv = (bf16*)(ws + WS_B + (size_t)T * 512 * 2); bf16* x1b = (bf16*)(ws + WS_B); bf16* Pb = (bf16*)(ws + WS_B); bf16* x2b = (bf16*)(ws + WS_B);
    float* Sbuf = (float*)(ws + WS_DD); bf16* Xs = (bf16*)(ws + WS_DD);
    bf16* kmem = (bf16*)(ws + WS_KMEM); bf16* vmemT = (bf16*)(ws + WS_VMEMT); bf16* memb = (bf16*)(ws + WS_MEMB);
    bf16* Wt_in = (bf16*)(ws + WS_WIN); bf16* Wt_out = (bf16*)(ws + WS_WOUT); bf16* Wt_mq = (bf16*)(ws + WS_WMQ); bf16* Wt_mkv = (bf16*)(ws + WS_WMKV); bf16* Wt_mo = (bf16*)(ws + WS_WMO);
    bf16* Wt_gu = (bf16*)(ws + WS_WGU); bf16* Wt_dn = (bf16*)(ws + WS_WDN);
    PG8_LAS unsigned char* ldsp = (PG8_LAS unsigned char*)lds_raw;
    int* route_e = (int*)(ws + WS_ROUTE); float* route_g = (float*)(ws + WS_ROUTE + (size_t)T * 8);
    int* blkcnt = (int*)(ws + WS_BLKCNT); int* segw = (int*)(ws + WS_SEG); int* rank = (int*)(ws + WS_RANK);
    int* pair_tok = (int*)(ws + WS_PTOK); float* pair_gate = (float*)(ws + WS_PGATE);

    const int lo = p.ph_lo, hi = p.ph_hi;
    int ph = 0;
#define PHASE_BEGIN if (lo <= ph && ph < hi) { int tid = threadIdx.x; asm volatile("" : "+v"(tid)); const int lane = tid & 63, wave = tid >> 6, gw = bid * 8 + wave; (void)lane; (void)wave; (void)gw;
#define PHASE_END } if (lo <= ph && ph + 1 < hi) grid.sync(); ++ph;

    PHASE_BEGIN
    for (size_t i = (size_t)bid * 512 + tid; i < (size_t)T * D / 4; i += (size_t)G * 512) { const f32x4 v = ((const f32x4*)x)[i]; u32x2 w; w.x = pk2(v.x, v.y); w.y = pk2(v.z, v.w); ((u32x2*)xb)[i] = w; }
    for (size_t i = (size_t)bid * 512 + tid; i < (size_t)NMEM * D / 4; i += (size_t)G * 512) { const f32x4 v = ((const f32x4*)mem)[i]; u32x2 w; w.x = pk2(v.x, v.y); w.y = pk2(v.z, v.w); ((u32x2*)memb)[i] = w; }
    {
        LAS float* scr = (LAS float*)(ldsp + wave * 16384);
        constexpr int I_IN = 16 * 56, I_SQ = 16 * 32, I_KV = 16 * 64, I_EX = 16 * 256;
        constexpr int NITEMS = I_IN + 3 * I_SQ + I_KV + 3 * I_EX;
        for (int it = gw; it < NITEMS; it += NGW) { int r = it;
            if (r < I_IN) { const int kb = r / 56, nb = r % 56, n0 = nb * 32; const int dr = n0 < 512 ? (n0 >> 7) * 256 + (n0 & 127) : (n0 < 1024 ? ((n0 - 512) >> 7) * 256 + 128 + (n0 & 127) : n0);
                transpose_item(w_in, D_IN, Wt_in, 1024, kb * 64, n0, dr, scr, lane); continue; } r -= I_IN;
            if (r < I_SQ) { transpose_item(w_out, 1024, Wt_out, 1024, (r / 32) * 64, (r % 32) * 32, (r % 32) * 32, scr, lane); continue; } r -= I_SQ;
            if (r < I_SQ) { transpose_item(w_mq, 1024, Wt_mq, 1024, (r / 32) * 64, (r % 32) * 32, (r % 32) * 32, scr, lane); continue; } r -= I_SQ;
            if (r < I_SQ) { transpose_item(w_mo, 1024, Wt_mo, 1024, (r / 32) * 64, (r % 32) * 32, (r % 32) * 32, scr, lane); continue; } r -= I_SQ;
            if (r < I_KV) { transpose_item(w_mkv, 2048, Wt_mkv, 1024, (r / 64) * 64, (r % 64) * 32, (r % 64) * 32, scr, lane); continue; } r -= I_KV;
            if (r < I_EX) { const int e = r / 256, q = r % 256, n0 = (q % 16) * 32; transpose_item(w_gate + (size_t)e * D * DE, DE, Wt_gu + (size_t)e * 1024 * 1024, 1024, (q / 16) * 64, n0, (n0 >> 7) * 256 + (n0 & 127), scr, lane); continue; } r -= I_EX;
            if (r < I_EX) { const int e = r / 256, q = r % 256, n0 = (q % 16) * 32; transpose_item(w_up + (size_t)e * D * DE, DE, Wt_gu + (size_t)e * 1024 * 1024, 1024, (q / 16) * 64, n0, (n0 >> 7) * 256 + 128 + (n0 & 127), scr, lane); continue; } r -= I_EX;
            { const int e = r / 256, q = r % 256; transpose_item(w_down + (size_t)e * DE * D, D, Wt_dn + (size_t)e * 1024 * 512, 512, (q / 32) * 64, (q % 32) * 32, (q % 32) * 32, scr, lane); }
        }
    }
    PHASE_END

    PHASE_BEGIN
#if FAST_P1
    {
        struct SchedP1 { const char *xb, *win, *memb, *wkv; int G, c;
            __device__ __forceinline__ bool next(int i, pg8::Unit& u) const { const int L = i * G + c; u.aux = 0;
                if (L < 448) { pg8::tile_of(L, 64, 7, u.pm, u.pn); u.A = xb + (size_t)u.pm * 256 * 2048; u.B = win + (size_t)u.pn * 256 * 2048; u.kind = u.pn < 4 ? 0 : 1; return true; }
                if (L < 456) { const int r = L - 448; u.pm = r >> 2; u.pn = r & 3; u.A = memb + (size_t)u.pm * 256 * 2048; u.B = wkv + (size_t)u.pn * 256 * 2048; u.kind = 2; return true; }
                if (L < 464) { const int r = L - 456; u.pm = r >> 1; u.pn = r & 1; u.A = wkv + (size_t)(4 + u.pm) * 256 * 2048; u.B = memb + (size_t)u.pn * 256 * 2048; u.kind = 3; return true; }
                return false; } };
        const SchedP1 S{(const char*)xb, (const char*)Wt_in, (const char*)memb, (const char*)Wt_mkv, G, bid};
        const pg8::EpiP1 E{hglu, qkv, kmem, vmemT, b_in};
        pg8::gemm_phase(ldsp, pg8::Gemm{1024, 1024, 1024}, S, E);
    }
#else
    constexpr int U_GLU = 128 * 8, U_QKV = 128 * 12, U_KVM = 4 * 32;
    for (int u = bid; u < U_GLU + U_QKV + U_KVM; u += G) {
        if (u < U_GLU) { const int mt = u / 8, nt = u % 8;
            ngemm_tile<2>(ldsf, D, mt * 128, nt * 64,
                [&](int m, int k) { return bf2f(xb[(size_t)m * D + k]); },
                [&](int b, int k, int n) { return w_in[(size_t)k * D_IN + n + b * 512]; },
                [&](int m, int n, float a, float g) { a += b_in[n]; g += b_in[512 + n]; hglu[(size_t)m * 512 + n] = (bf16)f2bf(a / (1.f + __expf(-g))); });
        } else if (u < U_GLU + U_QKV) { const int r = u - U_GLU, mt = r / 12, nt = r % 12;
            ngemm_tile<1>(ldsf, D, mt * 128, nt * 64,
                [&](int m, int k) { return bf2f(xb[(size_t)m * D + k]); },
                [&](int b, int k, int n) { return w_in[(size_t)k * D_IN + 1024 + n]; },
                [&](int m, int n, float a, float) { qkv[(size_t)m * 768 + n] = (bf16)f2bf(a + b_in[1024 + n]); });
        } else { const int r = u - U_GLU - U_QKV, mt = r / 32, nt = r % 32;
            ngemm_tile<1>(ldsf, D, mt * 128, nt * 64,
                [&](int m, int k) { return bf2f(memb[(size_t)m * D + k]); },
                [&](int b, int k, int n) { return w_mkv[(size_t)k * 2048 + n]; },
                [&](int m, int n, float a, float) { if (n < 1024) kmem[(size_t)m * 1024 + n] = (bf16)f2bf(a); else vmemT[(size_t)(n - 1024) * 512 + m] = (bf16)f2bf(a); });
        }
    }
#endif
    PHASE_END

    PHASE_BEGIN
    {
        float wreg[CONV_W];
#pragma unroll
        for (int j = 0; j < CONV_W; ++j) wreg[j] = w_dw[j * CONV_CH + tid];
        const float bdw = b_dw[tid];
        float* cbuf = ldsf;
        for (int it = bid; it < T / 16; it += G) {
            const int t0 = it * 16, s0 = t0 % SEQ;
            for (int tt = 0; tt < 16; ++tt) {
                float acc = bdw;
#pragma unroll
                for (int j = 0; j < CONV_W; ++j) { const int sp = s0 + tt - (CONV_W - 1) + j; if (sp >= 0) acc += wreg[j] * bf2f(hglu[(size_t)(t0 + tt - (CONV_W - 1) + j) * 512 + tid]); }
                cbuf[tt * 512 + tid] = acc;
            }
            __syncthreads();
            for (int r = wave; r < 16; r += 8) {
                f32x4 v[2]; float s = 0.f;
#pragma unroll
                for (int j = 0; j < 2; ++j) { v[j] = ((const f32x4*)(cbuf + r * 512))[lane + 64 * j]; s += (v[j].x + v[j].y) + (v[j].z + v[j].w); }
                const float mean = wave_sum(s) * (1.f / 512.f); float s2 = 0.f;
#pragma unroll
                for (int j = 0; j < 2; ++j) { v[j] = v[j] - mean; s2 += (v[j].x * v[j].x + v[j].y * v[j].y) + (v[j].z * v[j].z + v[j].w * v[j].w); }
                const float rstd = 1.f / sqrtf(wave_sum(s2) * (1.f / 512.f) + LN_EPS);
#pragma unroll
                for (int j = 0; j < 2; ++j) { const f32x4 gg = ((const f32x4*)g_cn)[lane + 64 * j], bb = ((const f32x4*)b_cn)[lane + 64 * j]; f32x4 y = v[j] * rstd * gg + bb;
                    y.x = y.x / (1.f + __expf(-y.x)); y.y = y.y / (1.f + __expf(-y.y)); y.z = y.z / (1.f + __expf(-y.z)); y.w = y.w / (1.f + __expf(-y.w));
                    u32x2 w; w.x = pk2(y.x, y.y); w.y = pk2(y.z, y.w); ((u32x2*)(ycat + (size_t)(t0 + r) * 1024))[lane + 64 * j] = w; }
            }
            __syncthreads();
        }
    }
    {
        float* wq = ldsf + wave * 192; float* wp = wq + 64;
        for (int task = gw; task < T * NH; task += NGW) {
            const int t = task >> 3, hq = task & 7, kvh = hq >> 2, s = t % SEQ;
            wq[lane] = bf2f(qkv[(size_t)t * 768 + hq * 64 + lane]);
            __builtin_amdgcn_wave_barrier(); asm volatile("s_waitcnt lgkmcnt(0)" ::: "memory");
            float sc[2];
#pragma unroll
            for (int h2 = 0; h2 < 2; ++h2) { const int j = lane + 64 * h2, kp = s - (WINDOW - 1) + j;
                float a = -INFINITY;
                if (kp >= 0) { const u32x4* kr = (const u32x4*)(qkv + (size_t)(t - (WINDOW - 1) + j) * 768 + 512 + kvh * 64); a = 0.f;
#pragma unroll
                    for (int c = 0; c < 8; ++c) { const u32x4 kk = kr[c];
#pragma unroll
                        for (int i = 0; i < 4; ++i) { a += wq[c * 8 + 2 * i] * __builtin_bit_cast(float, kk[i] << 16); a += wq[c * 8 + 2 * i + 1] * __builtin_bit_cast(float, kk[i] & 0xffff0000u); } }
                    a *= 0.125f; }
                sc[h2] = a; }
            const float sk = sinks[hq];
            const float mx = fmaxf(wave_max(fmaxf(sc[0], sc[1])), sk);
            const float p0 = __expf(sc[0] - mx), p1 = __expf(sc[1] - mx);
            const float den = wave_sum(p0 + p1) + __expf(sk - mx);
            wp[lane] = p0; wp[lane + 64] = p1;
            __builtin_amdgcn_wave_barrier(); asm volatile("s_waitcnt lgkmcnt(0)" ::: "memory");
            float o = 0.f;
            for (int j = 0; j < WINDOW; ++j) { const int kp = s - (WINDOW - 1) + j; if (kp >= 0) o += wp[j] * bf2f(qkv[(size_t)(t - (WINDOW - 1) + j) * 768 + 640 + kvh * 64 + lane]); }
            ycat[(size_t)t * 1024 + 512 + hq * 64 + lane] = (bf16)f2bf(o / den);
            __builtin_amdgcn_wave_barrier(); asm volatile("s_waitcnt lgkmcnt(0)" ::: "memory");
        }
    }
    PHASE_END

    PHASE_BEGIN
#if FAST_DENSE
    { const pg8::DenseSched S{(const char*)ycat, (const char*)Wt_out, 64, 4, G, bid, (size_t)256 * 2048, (size_t)256 * 2048};
      const pg8::EpiResF32 E{x, out, ALPHA}; pg8::gemm_phase(ldsp, pg8::Gemm{1024, 1024, 1024}, S, E); }
#else
    for (int u = bid; u < 128 * 16; u += G) { const int mt = u / 16, nt = u % 16;
        ngemm_tile<1>(ldsf, D, mt * 128, nt * 64,
            [&](int m, int k) { return bf2f(ycat[(size_t)m * D + k]); },
            [&](int b, int k, int n) { return w_out[(size_t)k * D + n]; },
            [&](int m, int n, float a, float) { out[(size_t)m * D + n] = ALPHA * x[(size_t)m * D + n] + a; });
    }
#endif
    PHASE_END
    PHASE_BEGIN
    for (int m = gw; m < T; m += NGW) { f32x4 v[4]; ln_row(out + (size_t)m * D, g_ln1, b_ln1, v, lane); st_row_f32(out + (size_t)m * D, v, 1.f, lane); st_row_bf16(x1b + (size_t)m * D, v, lane); }
    PHASE_END
    PHASE_BEGIN
#if FAST_DENSE
    { const pg8::DenseSched S{(const char*)x1b, (const char*)Wt_mq, 64, 4, G, bid, (size_t)256 * 2048, (size_t)256 * 2048};
      const pg8::EpiBf16 E{qm, 1024, nullptr}; pg8::gemm_phase(ldsp, pg8::Gemm{1024, 1024, 1024}, S, E); }
#else
    for (int u = bid; u < 128 * 16; u += G) { const int mt = u / 16, nt = u % 16;
        ngemm_tile<1>(ldsf, D, mt * 128, nt * 64,
            [&](int m, int k) { return bf2f(x1b[(size_t)m * D + k]); },
            [&](int b, int k, int n) { return w_mq[(size_t)k * D + n]; },
            [&](int m, int n, float a, float) { qm[(size_t)m * D + n] = (bf16)f2bf(a); });
    }
#endif
    PHASE_END
    PHASE_BEGIN
#if FAST_XATT
    {
        struct SchedS { const char *qm, *kmem; int G, c;
            __device__ __forceinline__ bool next(int i, pg8::Unit& u) const { const int L = i * G + c; if (L >= 256) return false; pg8::tile_of(L, 64, 4, u.pm, u.pn); u.kind = 0; u.aux = 0;
                u.A = qm + ((size_t)u.pm * 256 * 1024 + u.pn * 256) * 2; u.B = kmem + ((size_t)(u.pm >> 5) * 256 * 1024 + u.pn * 256) * 2; return true; } };
        const SchedS S{(const char*)qm, (const char*)kmem, G, bid};
        const pg8::EpiSoftmax E{Pb, (PG8_LAS float*)(ldsp + 131072)};
        pg8::gemm_phase(ldsp, pg8::Gemm{1024, 1024, 256}, S, E);
    }
#else
    for (int u = bid; u < 128 * 16; u += G) { const int mt = u / 16, h = (u % 16) / 4, nt = u % 4; const int b = (mt * 128) / SEQ;
        ngemm_tile<1>(ldsf, MHD, mt * 128, nt * 64,
            [&](int m, int k) { return bf2f(qm[(size_t)m * D + h * MHD + k]); },
            [&](int bb, int k, int n) { return bf2f(kmem[(size_t)(b * MEM + n) * D + h * MHD + k]); },
            [&](int m, int n, float a, float) { Sbuf[(size_t)m * D + h * MHD + n] = a * 0.0625f; });
    }
#endif
    PHASE_END
    PHASE_BEGIN
#if FAST_XATT
#else
    for (int m = gw; m < T; m += NGW) {
#pragma unroll
        for (int h = 0; h < 4; ++h) { const f32x4 v = ((const f32x4*)(Sbuf + (size_t)m * D + h * MHD))[lane];
            const float mx = wave_max(fmaxf(fmaxf(v.x, v.y), fmaxf(v.z, v.w)));
            const float e0 = __expf(v.x - mx), e1 = __expf(v.y - mx), e2 = __expf(v.z - mx), e3 = __expf(v.w - mx);
            const float inv = 1.f / wave_sum((e0 + e1) + (e2 + e3));
            u32x2 w; w.x = pk2(e0 * inv, e1 * inv); w.y = pk2(e2 * inv, e3 * inv); ((u32x2*)(Pb + (size_t)m * D + h * MHD))[lane] = w; }
    }
#endif
    PHASE_END
    PHASE_BEGIN
#if FAST_XATT
    {
        struct SchedO { const char *P, *vT; int G, c;
            __device__ __forceinline__ bool next(int i, pg8::Unit& u) const { const int L = i * G + c; if (L >= 256) return false; pg8::tile_of(L, 64, 4, u.pm, u.pn); u.kind = 0; u.aux = 0;
                u.A = P + ((size_t)u.pm * 256 * 1024 + u.pn * 256) * 2; u.B = vT + ((size_t)u.pn * 256 * 512 + (u.pm >> 5) * 256) * 2; return true; } };
        const SchedO S{(const char*)Pb, (const char*)vmemT, G, bid};
        const pg8::EpiBf16 E{om, 1024, nullptr};
        pg8::gemm_phase(ldsp, pg8::Gemm{1024, 512, 256}, S, E);
    }
#else
    for (int u = bid; u < 128 * 16; u += G) { const int mt = u / 16, h = (u % 16) / 4, nt = u % 4; const int b = (mt * 128) / SEQ;
        ngemm_tile<1>(ldsf, MEM, mt * 128, nt * 64,
            [&](int m, int k) { return bf2f(Pb[(size_t)m * D + h * MHD + k]); },
            [&](int bb, int k, int n) { return bf2f(vmemT[(size_t)(h * MHD + n) * NMEM + b * MEM + k]); },
            [&](int m, int n, float a, float) { om[(size_t)m * D + h * MHD + n] = (bf16)f2bf(a); });
    }
#endif
    PHASE_END
    PHASE_BEGIN
#if FAST_DENSE
    { const pg8::DenseSched S{(const char*)om, (const char*)Wt_mo, 64, 4, G, bid, (size_t)256 * 2048, (size_t)256 * 2048};
      const pg8::EpiResF32 E{out, out, ALPHA}; pg8::gemm_phase(ldsp, pg8::Gemm{1024, 1024, 1024}, S, E); }
#else
    for (int u = bid; u < 128 * 16; u += G) { const int mt = u / 16, nt = u % 16;
        ngemm_tile<1>(ldsf, D, mt * 128, nt * 64,
            [&](int m, int k) { return bf2f(om[(size_t)m * D + k]); },
            [&](int b, int k, int n) { return w_mo[(size_t)k * D + n]; },
            [&](int m, int n, float a, float) { out[(size_t)m * D + n] = ALPHA * out[(size_t)m * D + n] + a; });
    }
#endif
    PHASE_END
    PHASE_BEGIN
    for (int m = gw; m < T; m += NGW) {
        f32x4 v[4]; ln_row(out + (size_t)m * D, g_ln2, b_ln2, v, lane); st_row_f32(out + (size_t)m * D, v, ALPHA, lane); st_row_bf16(x2b + (size_t)m * D, v, lane);
        float* rowl = ldsf + wave * 1024;
#pragma unroll
        for (int j = 0; j < 4; ++j) ((f32x4*)rowl)[lane + 64 * j] = v[j];
        asm volatile("s_waitcnt lgkmcnt(0)" ::: "memory");
        float lg[20];
#pragma unroll
        for (int c = 0; c < 20; ++c) lg[c] = 0.f;
#pragma unroll 2
        for (int it = 0; it < 16; ++it) { const int k = lane + 64 * it; const float xv = rowl[k];
            const f32x4 wg = *(const f32x4*)(w_group + (size_t)k * 4);
            lg[0] += xv * wg.x; lg[1] += xv * wg.y; lg[2] += xv * wg.z; lg[3] += xv * wg.w;
#pragma unroll
            for (int gq = 0; gq < 4; ++gq) { const f32x4 wr = *(const f32x4*)(w_router + ((size_t)gq * D + k) * 4);
                lg[4 + gq * 4 + 0] += xv * wr.x; lg[4 + gq * 4 + 1] += xv * wr.y; lg[4 + gq * 4 + 2] += xv * wr.z; lg[4 + gq * 4 + 3] += xv * wr.w; } }
        asm volatile("s_waitcnt lgkmcnt(0)" ::: "memory");
#pragma unroll
        for (int c = 0; c < 20; ++c) lg[c] = wave_sum(lg[c]);
        if (lane == 0) {
            float gl[4]; int gi = 0; float gmx = -INFINITY;
#pragma unroll
            for (int i = 0; i < 4; ++i) { gl[i] = lg[i] + b_group[i]; if (gl[i] > gmx) { gmx = gl[i]; gi = i; } }
            float gs = 0.f;
#pragma unroll
            for (int i = 0; i < 4; ++i) gs += __expf(gl[i] - gmx);
            const float gp = 1.f / gs;
            float el[4];
#pragma unroll
            for (int i = 0; i < 4; ++i) { float a = lg[4 + i], bq = b_router[i];
                a = (gi == 1) ? lg[8 + i] : a; a = (gi == 2) ? lg[12 + i] : a; a = (gi == 3) ? lg[16 + i] : a;
                bq = (gi == 1) ? b_router[4 + i] : bq; bq = (gi == 2) ? b_router[8 + i] : bq; bq = (gi == 3) ? b_router[12 + i] : bq;
                el[i] = a + bq; }
            int i0 = 0; float v0 = el[0];
#pragma unroll
            for (int i = 1; i < 4; ++i) if (el[i] > v0) { v0 = el[i]; i0 = i; }
            int i1 = -1; float v1 = -INFINITY;
#pragma unroll
            for (int i = 0; i < 4; ++i) if (i != i0 && el[i] > v1) { v1 = el[i]; i1 = i; }
            const float w0 = 1.f / (1.f + __expf(v1 - v0)), w1 = 1.f - w0;
            route_e[2 * m] = gi * 4 + i0; route_e[2 * m + 1] = gi * 4 + i1; route_g[2 * m] = gp * w0; route_g[2 * m + 1] = gp * w1;
        }
    }
    PHASE_END
    const int TPB = (T + G - 1) / G;
    PHASE_BEGIN
    if (tid == 0) {
        const int t0 = bid * TPB, t1 = (t0 + TPB < T) ? t0 + TPB : T;
        int* lcnt = (int*)lds_raw;
        for (int e = 0; e < 16; ++e) lcnt[e] = 0;
        for (int pi = 2 * t0; pi < 2 * t1; ++pi) { const int e = route_e[pi]; rank[pi] = lcnt[e]; lcnt[e] = lcnt[e] + 1; }
        for (int e = 0; e < 16; ++e) blkcnt[bid * 16 + e] = lcnt[e];
    }
    PHASE_END
    PHASE_BEGIN
    {
        int* sh = (int*)lds_raw;
        if (tid < 16) { int tot = 0, base = 0; for (int b = 0; b < G; ++b) { const int c = blkcnt[b * 16 + tid]; tot += c; if (b < bid) base += c; } sh[tid] = base; sh[64 + tid] = tot; }
        __syncthreads();
        if (tid == 0) { int s = 0; for (int e = 0; e < 16; ++e) { sh[16 + e] = s; s += (sh[64 + e] + 255) & ~255; } sh[32] = s; if (bid == 0) for (int e = 0; e <= 16; ++e) segw[e] = sh[16 + e]; }
        __syncthreads();
        if (bid == 0) { for (int e = 0; e < 16; ++e) for (int pos = sh[16 + e] + sh[64 + e] + tid; pos < sh[16 + e + 1]; pos += 512) { pair_tok[pos] = -1; pair_gate[pos] = 0.f; } }
        const int t0 = bid * TPB, t1 = (t0 + TPB < T) ? t0 + TPB : T;
        for (int pi = 2 * t0 + wave; pi < 2 * t1; pi += 8) { const int e = route_e[pi], pos = sh[16 + e] + sh[e] + rank[pi], tok = pi >> 1;
            if (lane == 0) { pair_tok[pos] = tok; pair_gate[pos] = route_g[pi]; }
            const u32x4* src = (const u32x4*)(x2b + (size_t)tok * D); u32x4* dst = (u32x4*)(Xs + (size_t)pos * D);
            dst[lane] = src[lane]; dst[lane + 64] = src[lane + 64]; }
    }
    PHASE_END
    PHASE_BEGIN
#if FAST_MOE
    { const SchedMoE S{(const char*)Xs, (const char*)Wt_gu, segw, segw[16] / 256, 4, G, bid, (size_t)256 * 2048, (size_t)1024 * 2048, (size_t)256 * 2048};
      const pg8::EpiGateUp E{Hs, pair_gate}; pg8::gemm_phase(ldsp, pg8::Gemm{1024, 1024, 1024}, S, E); }
#else
    { const int nmt = segw[16] / 128;
      for (int u = bid; u < nmt * 8; u += G) { const int mt = u / 8, nt = u % 8; int e = 0;
#pragma unroll
        for (int i = 1; i < 16; ++i) if (mt * 128 >= segw[i]) e = i;
        const float* wg = w_gate + (size_t)e * D * DE; const float* wu = w_up + (size_t)e * D * DE;
        ngemm_tile<2>(ldsf, D, mt * 128, nt * 64,
            [&](int m, int k) { return bf2f(Xs[(size_t)m * D + k]); },
            [&](int b, int k, int n) { return (b == 0 ? wg : wu)[(size_t)k * DE + n]; },
            [&](int m, int n, float g, float uu) { const float pg = pair_gate[m]; const float hv = (pair_tok[m] >= 0) ? (g / (1.f + __expf(-g))) * uu * pg : 0.f; Hs[(size_t)m * DE + n] = (bf16)f2bf(hv); });
      } }
#endif
    PHASE_END
    PHASE_BEGIN
#if FAST_MOE
    { const SchedMoE S{(const char*)Hs, (const char*)Wt_dn, segw, segw[16] / 256, 4, G, bid, (size_t)256 * 1024, (size_t)1024 * 1024, (size_t)256 * 1024};
      const pg8::EpiDown E{out, pair_tok}; pg8::gemm_phase(ldsp, pg8::Gemm{512, 512, 512}, S, E); }
#else
    { const int nmt = segw[16] / 128;
      for (int u = bid; u < nmt * 16; u += G) { const int mt = u / 16, nt = u % 16; int e = 0;
#pragma unroll
        for (int i = 1; i < 16; ++i) if (mt * 128 >= segw[i]) e = i;
        const float* wd = w_down + (size_t)e * DE * D;
        ngemm_tile<1>(ldsf, DE, mt * 128, nt * 64,
            [&](int m, int k) { return bf2f(Hs[(size_t)m * DE + k]); },
            [&](int b, int k, int n) { return wd[(size_t)k * D + n]; },
            [&](int m, int n, float a, float) { const int tok = pair_tok[m]; if (tok >= 0) atomicAdd(out + (size_t)tok * D + n, a); });
      } }
#endif
    PHASE_END
    PHASE_BEGIN
    for (int m = gw; m < T; m += NGW) { f32x4 v[4]; ln_row(out + (size_t)m * D, g_ln3, b_ln3, v, lane); st_row_f32(out + (size_t)m * D, v, 1.f, lane); }
    PHASE_END
}

constexpr int N_PHASES = 16;
constexpr int LDS_BYTES = 147456;

extern "C" void kernel_launch(void* const* d_in, const int* in_sizes, int n_in, void* d_out, int out_size, void* d_ws, size_t ws_size, hipStream_t stream) {
    static int grid = 0;
    if (grid == 0) {
        int dev = 0, cus = 0, per_cu = 0;
        hipGetDevice(&dev);
        hipDeviceGetAttribute(&cus, hipDeviceAttributeMultiprocessorCount, dev);
        hipFuncSetAttribute((const void*)fwd_kernel, hipFuncAttributeMaxDynamicSharedMemorySize, LDS_BYTES);
        hipOccupancyMaxActiveBlocksPerMultiprocessor(&per_cu, (const void*)fwd_kernel, 512, LDS_BYTES);
        if (per_cu < 1) { fprintf(stderr, "occupancy query returned %d\n", per_cu); per_cu = 1; }
        grid = cus * 1;
        if (ws_size < WS_END) { fprintf(stderr, "workspace too small\n"); grid = -1; }
    }
    if (grid < 0) return;
    Params p{};
    for (int i = 0; i < 26; ++i) p.in[i] = (const float*)d_in[i];
    p.out = (float*)d_out; p.ws = (unsigned char*)d_ws;
#if MK_N_LAUNCHES == 1
    p.ph_lo = 0; p.ph_hi = N_PHASES;
    void* args[] = {&p};
    hipError_t e = hipLaunchCooperativeKernel((const void*)fwd_kernel, dim3(grid), dim3(512), args, LDS_BYTES, stream);
    if (e != hipSuccess) fprintf(stderr, "cooperative launch failed: %s (grid %d)\n", hipGetErrorString(e), grid);
#else
    for (int ph = 0; ph < N_PHASES; ++ph) { p.ph_lo = ph; p.ph_hi = ph + 1; hipLaunchKernelGGL(fwd_kernel, dim3(grid), dim3(512), LDS_BYTES, stream, p); }
#endif
}
```

```cpp
#include <hip/hip_runtime.h>
#include <hip/hip_cooperative_groups.h>
#include <cstdio>
#include <cstdint>
namespace cg = cooperative_groups;

#ifndef FAST_P1
#define FAST_P1 1
#endif
#ifndef PROBE_MASK
#define PROBE_MASK 0
#endif
#ifndef FAST_P2
#define FAST_P2 1
#endif
#ifndef FAST_DENSE
#define FAST_DENSE 1
#endif
#ifndef FAST_XATT
#define FAST_XATT 1
#endif
#ifndef FAST_MOE
#define FAST_MOE 1
#endif
#ifndef MK_N_LAUNCHES
#define MK_N_LAUNCHES 1
#endif

typedef unsigned short bf16;
typedef float f32x4 __attribute__((ext_vector_type(4)));
typedef unsigned u32x4 __attribute__((ext_vector_type(4)));
typedef unsigned u32x2 __attribute__((ext_vector_type(2)));

constexpr int BATCH = 2, SEQ = 8192, D = 1024, T = BATCH * SEQ, MEM = 256, NMEM = BATCH * MEM;
constexpr int CONV_CH = 512, CONV_W = 31, NH = 8, NKV = 2, HD = 64, ATTN_W = 512, KV_W = 128, WINDOW = 128;
constexpr int D_IN = 1792, MH = 4, MHD = 256, NG = 4, EPG = 4, NE = 16, DE = 512;
constexpr float ALPHA = 1.189207115002721f, LN_EPS = 1e-5f;
constexpr int NPAIR = 2 * T, NPAIR_PAD = NPAIR + NE * 256;

constexpr size_t MiB = 1u << 20;
constexpr size_t WS_CTL = 0;
constexpr size_t WS_ROUTE = 1 * MiB;
constexpr size_t WS_BLKCNT = 1 * MiB + 512 * 1024;
constexpr size_t WS_SEG = 1 * MiB + 640 * 1024;
constexpr size_t WS_RANK = 2 * MiB;
constexpr size_t WS_PTOK = 2 * MiB + 256 * 1024;
constexpr size_t WS_PGATE = 2 * MiB + 512 * 1024;
constexpr size_t WS_TOKPOS = 2 * MiB + 768 * 1024;
constexpr size_t WS_KMEM = 3 * MiB;
constexpr size_t WS_VMEMT = 4 * MiB;
constexpr size_t WS_MEMB = 5 * MiB;
constexpr size_t WS_A = 8 * MiB;
constexpr size_t WS_B = 48 * MiB;
constexpr size_t WS_DD = 88 * MiB;
constexpr size_t WS_WIN = 164 * MiB;
constexpr size_t WS_WOUT = 168 * MiB, WS_WMQ = 170 * MiB, WS_WMKV = 172 * MiB, WS_WMO = 176 * MiB;
constexpr size_t WS_WGU = 178 * MiB;
constexpr size_t WS_WDN = 210 * MiB;
constexpr size_t WS_END = 226 * MiB;

struct Params { const float* in[26]; float* out; unsigned char* ws; int ph_lo, ph_hi; };

__device__ __forceinline__ unsigned f2bf(float f) { unsigned u = __builtin_bit_cast(unsigned, f); return (u + 0x7fffu + ((u >> 16) & 1u)) >> 16; }
__device__ __forceinline__ float bf2f(bf16 b) { return __builtin_bit_cast(float, (unsigned)b << 16); }
__device__ __forceinline__ unsigned pk2(float lo, float hi) { return f2bf(lo) | (f2bf(hi) << 16); }
__device__ __forceinline__ float wave_sum(float v) {
#pragma unroll
    for (int o = 1; o < 64; o <<= 1) v += __shfl_xor(v, o);
    return v;
}
__device__ __forceinline__ float wave_max(float v) {
#pragma unroll
    for (int o = 1; o < 64; o <<= 1) v = fmaxf(v, __shfl_xor(v, o));
    return v;
}
__device__ __forceinline__ float ldA(const bf16* p) { return bf2f(*p); }
__device__ __forceinline__ float ldA(const float* p) { return *p; }

template <int NB, class FA, class FB, class FE>
__device__ __forceinline__ void ngemm_tile(float* lds, int K, int m0, int n0, FA fa, FB fb, FE fe) {
    float* As = lds;
    float* Bs = lds + 16 * 132;
    int tid = threadIdx.x; asm volatile("" : "+v"(tid));
    const int ty = tid >> 4, tx = tid & 15;
    float acc[NB][4][4];
#pragma unroll
    for (int b = 0; b < NB; ++b)
#pragma unroll
        for (int i = 0; i < 4; ++i)
#pragma unroll
            for (int j = 0; j < 4; ++j) acc[b][i][j] = 0.f;
    for (int k0 = 0; k0 < K; k0 += 16) {
        { const int r = tid >> 2, kk = (tid & 3) * 4;
#pragma unroll
            for (int i = 0; i < 4; ++i) As[(kk + i) * 132 + r] = fa(m0 + r, k0 + kk + i); }
#pragma unroll
        for (int b = 0; b < NB; ++b) { const int kk = tid >> 5, nn = (tid & 31) * 2;
            Bs[(b * 16 + kk) * 68 + nn] = fb(b, k0 + kk, n0 + nn); Bs[(b * 16 + kk) * 68 + nn + 1] = fb(b, k0 + kk, n0 + nn + 1); }
        __syncthreads();
#pragma unroll 4
        for (int k = 0; k < 16; ++k) {
            const f32x4 a = *(const f32x4*)&As[k * 132 + ty * 4];
#pragma unroll
            for (int b = 0; b < NB; ++b) { const f32x4 bb = *(const f32x4*)&Bs[(b * 16 + k) * 68 + tx * 4];
#pragma unroll
                for (int i = 0; i < 4; ++i)
#pragma unroll
                    for (int j = 0; j < 4; ++j) acc[b][i][j] += a[i] * bb[j]; }
        }
        __syncthreads();
    }
#pragma unroll
    for (int i = 0; i < 4; ++i)
#pragma unroll
        for (int j = 0; j < 4; ++j) fe(m0 + ty * 4 + i, n0 + tx * 4 + j, acc[0][i][j], acc[NB - 1][i][j]);
}

__device__ __forceinline__ void ln_row(const float* src, const float* g, const float* b, f32x4 (&v)[4], int lane) {
    const f32x4* xr = (const f32x4*)src + lane; float s = 0.f;
#pragma unroll
    for (int j = 0; j < 4; ++j) { v[j] = xr[64 * j]; s += (v[j].x + v[j].y) + (v[j].z + v[j].w); }
    const float mean = wave_sum(s) * (1.f / D); float s2 = 0.f;
#pragma unroll
    for (int j = 0; j < 4; ++j) { v[j] = v[j] - mean; s2 += (v[j].x * v[j].x + v[j].y * v[j].y) + (v[j].z * v[j].z + v[j].w * v[j].w); }
    const float rstd = 1.f / sqrtf(wave_sum(s2) * (1.f / D) + LN_EPS);
#pragma unroll
    for (int j = 0; j < 4; ++j) { const f32x4 gg = ((const f32x4*)g)[lane + 64 * j], bb = ((const f32x4*)b)[lane + 64 * j]; v[j] = v[j] * rstd * gg + bb; }
}
__device__ __forceinline__ void st_row_f32(float* dst, const f32x4 (&v)[4], float scale, int lane) {
#pragma unroll
    for (int j = 0; j < 4; ++j) ((f32x4*)dst)[lane + 64 * j] = v[j] * scale;
}
__device__ __forceinline__ void st_row_bf16(bf16* dst, const f32x4 (&v)[4], int lane) {
#pragma unroll
    for (int j = 0; j < 4; ++j) { u32x2 w; w.x = pk2(v[j].x, v[j].y); w.y = pk2(v[j].z, v[j].w); ((u32x2*)dst)[lane + 64 * j] = w; }
}


namespace pg8 {
#define PG8_LAS __attribute__((address_space(3)))
typedef unsigned short bf16_t;
typedef short bf16x8 __attribute__((ext_vector_type(8)));
constexpr int BM = 256, BK = 64, HALF = 128, HTB = HALF * BK * 2, STAGE_BYTES = 8 * HTB, NXCD = 8, WGM = 8;
__device__ __forceinline__ int lds_byte(int r, int c) { const int st = (r >> 4) * 2 + (c >> 5), rr = r & 15, cc = c & 31, ob = rr * 64 + cc * 2; return st * 1024 + (ob ^ (((ob >> 9) & 1) << 5)); }
__device__ __forceinline__ void stage_rc(int b, int& R, int& C) { const int st = b / 1024, sb = b % 1024, swz = sb ^ (((sb >> 9) & 1) << 5); R = (st >> 1) * 16 + swz / 64; C = (st & 1) * 32 + (swz % 64) / 2; }
__device__ __forceinline__ int perm32(int rho) { const int n = rho >> 4, i = rho & 15; return 8 * (i >> 2) + 4 * n + (i & 3); }
struct Unit { const char* A; const char* B; int pm, pn, kind, aux; };
struct Gemm { int lda, ldb, K; };
__device__ __forceinline__ void tile_of(int L, int nM, int nN, int& pm, int& pn) {
    const int nwg = nM * nN; int wgid = L; { const int q = nwg / NXCD, r = nwg % NXCD, xcd = wgid % NXCD, off = wgid / NXCD; wgid = (xcd < r ? xcd * (q + 1) : r * (q + 1) + (xcd - r) * q) + off; }
    const int nig = WGM * nN, gid = wgid / nig, fm = gid * WGM, gsz = (nM - fm) < WGM ? (nM - fm) : WGM;
    pm = fm + ((wgid % nig) % gsz); pn = (wgid % nig) / gsz;
}
__device__ __forceinline__ unsigned cvt_pk_bf16(float lo, float hi) { unsigned r; asm volatile("v_cvt_pk_bf16_f32 %0, %1, %2" : "=v"(r) : "v"(lo), "v"(hi)); return r; }

template <class Epi, class Sched>
__device__ __forceinline__ void gemm_phase(PG8_LAS unsigned char* lds, const Gemm g, const Sched& S, const Epi& E) {
    int tid = threadIdx.x; asm volatile("" : "+v"(tid));
    const int wid = __builtin_amdgcn_readfirstlane(tid >> 6), lane = tid & 63, wr = wid >> 2, wc = wid & 3, fr = lane & 15, fq = lane >> 4;
    const int K = g.K, nt = K / BK;
    unsigned voffA[2], voffB[2];
#pragma unroll
    for (int i = 0; i < 2; ++i) { int R, C; stage_rc(tid * 16 + i * 8192, R, C); const int Rb = Epi::PERM ? ((R & ~31) + perm32(R & 31)) : R;
        voffA[i] = (unsigned)(R * g.lda + C) * 2u; voffB[i] = (unsigned)(Rb * g.ldb + C) * 2u; }
    const size_t kstep = (size_t)(BK * 2);
    const size_t hstepA = (size_t)HALF * g.lda * 2, hstepB = (size_t)HALF * g.ldb * 2;
    const unsigned ldsw = (unsigned)wid * 1024u;
    const int aoff = lds_byte(wr * 64 + fr, fq * 8), boff = lds_byte(wc * 32 + fr, fq * 8);
#define PG8_SA(b, h) (((b) * 2 + (h)) * HTB)
#define PG8_SB(b, h) ((4 + (b) * 2 + (h)) * HTB)
#define PG8_STAGE(bufoff, gbase, voff) do { _Pragma("unroll") for (int _i = 0; _i < 2; ++_i) \
        __builtin_amdgcn_global_load_lds((const unsigned*)((const char*)(gbase) + (voff)[_i]), (PG8_LAS unsigned*)(lds + (bufoff) + ldsw + _i * 8192), 16, 0, 0); } while (0)
#define PG8_LDA(dst, b, h) do { _Pragma("unroll") for (int m = 0; m < 4; ++m) _Pragma("unroll") for (int k = 0; k < 2; ++k) dst[m][k] = *(const PG8_LAS bf16x8*)(lds + PG8_SA(b, h) + aoff + m * 2048 + k * 1024); } while (0)
#define PG8_LDB(dst, b, h) do { _Pragma("unroll") for (int n = 0; n < 2; ++n) _Pragma("unroll") for (int k = 0; k < 2; ++k) dst[n][k] = *(const PG8_LAS bf16x8*)(lds + PG8_SB(b, h) + boff + n * 2048 + k * 1024); } while (0)
#define PG8_MMA(ai, bj, At, Bt) do { __builtin_amdgcn_s_setprio(1); _Pragma("unroll") for (int m = 0; m < 4; ++m) _Pragma("unroll") for (int n = 0; n < 2; ++n) _Pragma("unroll") for (int k = 0; k < 2; ++k) \
        acc[ai][bj][m][n] = __builtin_amdgcn_mfma_f32_16x16x32_bf16(Bt[n][k], At[m][k], acc[ai][bj][m][n], 0, 0, 0); __builtin_amdgcn_s_setprio(0); } while (0)
#define PG8_WAIT_V(n) asm volatile("s_waitcnt vmcnt(" #n ")" ::: "memory")
#define PG8_WAIT_L(n) asm volatile("s_waitcnt lgkmcnt(" #n ")" ::: "memory")
#define PG8_BAR __builtin_amdgcn_s_barrier()
#define PG8_SCHED __builtin_amdgcn_sched_barrier(0)
    Unit cur, nxt; int ui = 0;
    if (!S.next(0, cur)) return;
    f32x4 acc[2][2][4][2];
#pragma unroll
    for (int a = 0; a < 2; ++a)
#pragma unroll
        for (int b = 0; b < 2; ++b)
#pragma unroll
            for (int m = 0; m < 4; ++m)
#pragma unroll
                for (int n = 0; n < 2; ++n) acc[a][b][m][n] = (f32x4){0.f, 0.f, 0.f, 0.f};
    bf16x8 At[4][2], B0[2][2], B1[2][2];
    const char* cA = cur.A; const char* cB = cur.B;
    PG8_STAGE(PG8_SB(0, 0), cB, voffB); PG8_STAGE(PG8_SB(0, 1), cB + hstepB, voffB); PG8_STAGE(PG8_SA(0, 0), cA, voffA); PG8_STAGE(PG8_SA(0, 1), cA + hstepA, voffA);
    if (wr == 1) PG8_BAR;
    PG8_WAIT_V(2); PG8_BAR;
    PG8_STAGE(PG8_SB(1, 0), cB + kstep, voffB); PG8_STAGE(PG8_SA(1, 0), cA + kstep, voffA); PG8_STAGE(PG8_SB(1, 1), cB + hstepB + kstep, voffB);
    PG8_WAIT_V(6); PG8_BAR;
    for (;;) {
        const bool has_next = S.next(ui + 1, nxt);
        const char* nA = has_next ? nxt.A : cA; const char* nB = has_next ? nxt.B : cB;
        for (int t = 0; t < nt; t += 2) {
            const bool last = (t == nt - 2);
            const char* a1 = cA + (size_t)(t + 1) * kstep;
            const char* a2 = last ? nA : cA + (size_t)(t + 2) * kstep; const char* b2 = last ? nB : cB + (size_t)(t + 2) * kstep;
            const char* a3 = a2 + kstep; const char* b3 = b2 + kstep;
            PG8_LDB(B0, 0, 0); PG8_LDB(B1, 0, 1); PG8_SCHED; PG8_LDA(At, 0, 0); PG8_STAGE(PG8_SA(1, 1), a1 + hstepA, voffA);
            PG8_WAIT_V(8); PG8_WAIT_L(0); PG8_BAR; PG8_MMA(0, 0, At, B0); PG8_MMA(0, 1, At, B1); PG8_BAR; PG8_SCHED;
            PG8_LDA(At, 0, 1); PG8_STAGE(PG8_SB(0, 0), b2, voffB); PG8_STAGE(PG8_SB(0, 1), b2 + hstepB, voffB); PG8_STAGE(PG8_SA(0, 0), a2, voffA);
            PG8_WAIT_V(8); PG8_WAIT_L(0); PG8_BAR; PG8_MMA(1, 0, At, B0); PG8_MMA(1, 1, At, B1); PG8_BAR; PG8_SCHED;
            PG8_LDB(B0, 1, 0); PG8_LDB(B1, 1, 1); PG8_SCHED; PG8_LDA(At, 1, 0); PG8_STAGE(PG8_SA(0, 1), a2 + hstepA, voffA);
            PG8_WAIT_V(8); PG8_WAIT_L(0); PG8_BAR; PG8_MMA(0, 0, At, B0); PG8_MMA(0, 1, At, B1); PG8_BAR; PG8_SCHED;
            PG8_LDA(At, 1, 1); PG8_STAGE(PG8_SB(1, 0), b3, voffB); PG8_STAGE(PG8_SB(1, 1), b3 + hstepB, voffB); PG8_STAGE(PG8_SA(1, 0), a3, voffA);
            PG8_WAIT_V(8); PG8_WAIT_L(0); PG8_BAR; PG8_MMA(1, 0, At, B0); PG8_MMA(1, 1, At, B1); PG8_BAR; PG8_SCHED;
        }
        if (wr == 0) PG8_BAR;
        E(acc, cur, wr, wc, fr, fq);
        if (!has_next) break;
#pragma unroll
        for (int a = 0; a < 2; ++a)
#pragma unroll
            for (int b = 0; b < 2; ++b)
#pragma unroll
                for (int m = 0; m < 4; ++m)
#pragma unroll
                    for (int n = 0; n < 2; ++n) acc[a][b][m][n] = (f32x4){0.f, 0.f, 0.f, 0.f};
        cur = nxt; cA = nA; cB = nB; ++ui;
        if (wr == 1) PG8_BAR;
    }
    PG8_WAIT_V(0);
    PG8_BAR;
#undef PG8_SA
#undef PG8_SB
#undef PG8_STAGE
#undef PG8_LDA
#undef PG8_LDB
#undef PG8_MMA
#undef PG8_WAIT_V
#undef PG8_WAIT_L
#undef PG8_BAR
#undef PG8_SCHED
}

__device__ __forceinline__ u32x4 pack8(const f32x4 v0, const f32x4 v1) { u32x4 w; w.x = cvt_pk_bf16(v0[0], v0[1]); w.y = cvt_pk_bf16(v0[2], v0[3]); w.z = cvt_pk_bf16(v1[0], v1[1]); w.w = cvt_pk_bf16(v1[2], v1[3]); return w; }
__device__ __forceinline__ float sigm(float g) { return __builtin_amdgcn_rcpf(1.f + __expf(-g)); }

struct EpiBf16 {
    static constexpr bool PERM = true;
    bf16_t* O; int ldc; const float* bias;
    __device__ __forceinline__ void operator()(const f32x4 (&acc)[2][2][4][2], const Unit& u, int wr, int wc, int fr, int fq) const {
        const int row0 = u.pm * BM + wr * 64 + fr, col0 = u.pn * BM + wc * 32 + 8 * fq;
        f32x4 bv[2][2];
#pragma unroll
        for (int bj = 0; bj < 2; ++bj)
#pragma unroll
            for (int n = 0; n < 2; ++n) bv[bj][n] = bias ? *(const f32x4*)(bias + col0 + bj * HALF + 4 * n) : (f32x4){0.f, 0.f, 0.f, 0.f};
#pragma unroll
        for (int ai = 0; ai < 2; ++ai)
#pragma unroll
            for (int m = 0; m < 4; ++m) { bf16_t* rowp = O + (size_t)(row0 + ai * HALF + m * 16) * ldc + col0;
#pragma unroll
                for (int bj = 0; bj < 2; ++bj) *(u32x4*)(rowp + bj * HALF) = pack8(acc[ai][bj][m][0] + bv[bj][0], acc[ai][bj][m][1] + bv[bj][1]); }
    }
};
struct EpiP1 {
    static constexpr bool PERM = true;
    bf16_t *hglu, *qkv, *kmem, *vmemT; const float* b_in;
    __device__ __forceinline__ void operator()(const f32x4 (&acc)[2][2][4][2], const Unit& u, int wr, int wc, int fr, int fq) const {
        if (u.kind == 0) {
            const int row0 = u.pm * BM + wr * 64 + fr, cb = u.pn * 128 + wc * 32 + 8 * fq;
            f32x4 ba[2], bg[2];
#pragma unroll
            for (int n = 0; n < 2; ++n) { ba[n] = *(const f32x4*)(b_in + cb + 4 * n); bg[n] = *(const f32x4*)(b_in + 512 + cb + 4 * n); }
#pragma unroll
            for (int ai = 0; ai < 2; ++ai)
#pragma unroll
                for (int m = 0; m < 4; ++m) { f32x4 h[2];
#pragma unroll
                    for (int n = 0; n < 2; ++n) { const f32x4 a = acc[ai][0][m][n] + ba[n], gt = acc[ai][1][m][n] + bg[n];
                        h[n] = (f32x4){a[0] * sigm(gt[0]), a[1] * sigm(gt[1]), a[2] * sigm(gt[2]), a[3] * sigm(gt[3])}; }
                    *(u32x4*)(hglu + (size_t)(row0 + ai * HALF + m * 16) * 512 + cb) = pack8(h[0], h[1]); }
        } else if (u.kind == 1) { EpiBf16 e{qkv - 1024, 768, b_in}; e(acc, u, wr, wc, fr, fq);
        } else if (u.kind == 2) { EpiBf16 e{kmem, 1024, nullptr}; e(acc, u, wr, wc, fr, fq);
        } else { EpiBf16 e{vmemT, 512, nullptr}; e(acc, u, wr, wc, fr, fq); }
    }
};
struct EpiResF32 {
    static constexpr bool PERM = false;
    const float* res; float* out; float alpha;
    __device__ __forceinline__ void operator()(const f32x4 (&acc)[2][2][4][2], const Unit& u, int wr, int wc, int fr, int fq) const {
        const int row0 = u.pm * BM + wr * 64 + fr, col0 = u.pn * BM + wc * 32 + 4 * fq;
#pragma unroll
        for (int ai = 0; ai < 2; ++ai)
#pragma unroll
            for (int m = 0; m < 4; ++m) { const size_t off = (size_t)(row0 + ai * HALF + m * 16) * 1024 + col0;
#pragma unroll
                for (int bj = 0; bj < 2; ++bj)
#pragma unroll
                    for (int n = 0; n < 2; ++n) { const f32x4 r = *(const f32x4*)(res + off + bj * HALF + n * 16); *(f32x4*)(out + off + bj * HALF + n * 16) = r * alpha + acc[ai][bj][m][n]; } }
    }
};
struct EpiSoftmax {
    static constexpr bool PERM = true;
    bf16_t* P; PG8_LAS float* xl;
    __device__ __forceinline__ void operator()(const f32x4 (&acc)[2][2][4][2], const Unit& u, int wr, int wc, int fr, int fq) const {
        const float sc = 0.0625f * 1.4426950408889634f;
#pragma unroll
        for (int ai = 0; ai < 2; ++ai)
#pragma unroll
            for (int m = 0; m < 4; ++m) { float mx = -INFINITY;
#pragma unroll
                for (int bj = 0; bj < 2; ++bj)
#pragma unroll
                    for (int n = 0; n < 2; ++n) { const f32x4 v = acc[ai][bj][m][n]; mx = fmaxf(mx, fmaxf(fmaxf(v[0], v[1]), fmaxf(v[2], v[3]))); }
                mx = fmaxf(mx, __shfl_xor(mx, 16)); mx = fmaxf(mx, __shfl_xor(mx, 32));
                float s = 0.f;
#pragma unroll
                for (int bj = 0; bj < 2; ++bj)
#pragma unroll
                    for (int n = 0; n < 2; ++n) { const f32x4 v = acc[ai][bj][m][n]; s += (__builtin_amdgcn_exp2f((v[0] - mx) * sc) + __builtin_amdgcn_exp2f((v[1] - mx) * sc)) + (__builtin_amdgcn_exp2f((v[2] - mx) * sc) + __builtin_amdgcn_exp2f((v[3] - mx) * sc)); }
                s += __shfl_xor(s, 16); s += __shfl_xor(s, 32);
                if (fq == 0) { PG8_LAS float* q = xl + ((ai * HALF + wr * 64 + m * 16 + fr) * 4 + wc) * 2; q[0] = mx; q[1] = s; } }
        asm volatile("s_waitcnt lgkmcnt(0)" ::: "memory"); __builtin_amdgcn_s_barrier(); asm volatile("" ::: "memory");
        const int row0 = u.pm * BM + wr * 64 + fr, col0 = u.pn * BM + wc * 32 + 8 * fq;
#pragma unroll
        for (int ai = 0; ai < 2; ++ai)
#pragma unroll
            for (int m = 0; m < 4; ++m) { const PG8_LAS f32x4* q = (const PG8_LAS f32x4*)(xl + (ai * HALF + wr * 64 + m * 16 + fr) * 8); const f32x4 q0 = q[0], q1 = q[1];
                const float M = fmaxf(fmaxf(q0[0], q0[2]), fmaxf(q1[0], q1[2]));
                const float S = (q0[1] * __builtin_amdgcn_exp2f((q0[0] - M) * sc) + q0[3] * __builtin_amdgcn_exp2f((q0[2] - M) * sc)) + (q1[1] * __builtin_amdgcn_exp2f((q1[0] - M) * sc) + q1[3] * __builtin_amdgcn_exp2f((q1[2] - M) * sc));
                const float inv = 1.f / S; bf16_t* rowp = P + (size_t)(row0 + ai * HALF + m * 16) * 1024 + col0;
#pragma unroll
                for (int bj = 0; bj < 2; ++bj) { f32x4 p[2];
#pragma unroll
                    for (int n = 0; n < 2; ++n) { const f32x4 v = acc[ai][bj][m][n];
                        p[n] = (f32x4){__builtin_amdgcn_exp2f((v[0] - M) * sc) * inv, __builtin_amdgcn_exp2f((v[1] - M) * sc) * inv, __builtin_amdgcn_exp2f((v[2] - M) * sc) * inv, __builtin_amdgcn_exp2f((v[3] - M) * sc) * inv}; }
                    *(u32x4*)(rowp + bj * HALF) = pack8(p[0], p[1]); } }
        asm volatile("s_waitcnt lgkmcnt(0)" ::: "memory"); __builtin_amdgcn_s_barrier(); asm volatile("" ::: "memory");
    }
};
struct EpiGateUp {
    static constexpr bool PERM = true;
    bf16_t* Hs; const float* pair_gate;
    __device__ __forceinline__ void operator()(const f32x4 (&acc)[2][2][4][2], const Unit& u, int wr, int wc, int fr, int fq) const {
        const int row0 = u.pm * BM + wr * 64 + fr, cb = u.pn * 128 + wc * 32 + 8 * fq;
#pragma unroll
        for (int ai = 0; ai < 2; ++ai)
#pragma unroll
            for (int m = 0; m < 4; ++m) { const int row = row0 + ai * HALF + m * 16; const float pg = pair_gate[row]; f32x4 h[2];
#pragma unroll
                for (int n = 0; n < 2; ++n) { const f32x4 gt = acc[ai][0][m][n], up = acc[ai][1][m][n];
                    h[n] = (f32x4){gt[0] * sigm(gt[0]) * up[0] * pg, gt[1] * sigm(gt[1]) * up[1] * pg, gt[2] * sigm(gt[2]) * up[2] * pg, gt[3] * sigm(gt[3]) * up[3] * pg}; }
                if (pg == 0.f) { h[0] = (f32x4){0.f, 0.f, 0.f, 0.f}; h[1] = h[0]; }
                *(u32x4*)(Hs + (size_t)row * 512 + cb) = pack8(h[0], h[1]); }
    }
};
struct EpiDown {
    static constexpr bool PERM = false;
    float* out; const int* pair_tok;
    __device__ __forceinline__ void operator()(const f32x4 (&acc)[2][2][4][2], const Unit& u, int wr, int wc, int fr, int fq) const {
        const int row0 = u.pm * BM + wr * 64 + fr, col0 = u.pn * BM + wc * 32 + 4 * fq;
#pragma unroll
        for (int ai = 0; ai < 2; ++ai)
#pragma unroll
            for (int m = 0; m < 4; ++m) { const int tok = pair_tok[row0 + ai * HALF + m * 16];
                if (tok >= 0) { float* rp = out + (size_t)tok * 1024 + col0;
#pragma unroll
                    for (int bj = 0; bj < 2; ++bj)
#pragma unroll
                        for (int n = 0; n < 2; ++n)
#pragma unroll
                            for (int i = 0; i < 4; ++i) unsafeAtomicAdd(rp + bj * HALF + n * 16 + i, acc[ai][bj][m][n][i]); } }
    }
};
struct DenseSched {
    const char* A; const char* B; int nM, nN, G, c; size_t strideA, strideB;
    __device__ __forceinline__ bool next(int i, Unit& u) const { const int L = i * G + c; if (L >= nM * nN) return false; tile_of(L, nM, nN, u.pm, u.pn); u.A = A + (size_t)u.pm * strideA; u.B = B + (size_t)u.pn * strideB; u.kind = 0; u.aux = 0; return true; }
};
}


#define LAS __attribute__((address_space(3)))
__device__ __forceinline__ void transpose_item(const float* W, int N, bf16* WT, int Kd, int k0, int n0, int drow0, LAS float* scr, int lane) {
#pragma unroll 8
    for (int i = 0; i < 32; ++i) { const int kk = 2 * i + (lane >> 5); scr[kk * 33 + (lane & 31)] = W[(size_t)(k0 + kk) * N + n0 + (lane & 31)]; }
    asm volatile("s_waitcnt lgkmcnt(0)" ::: "memory");
    const int c = lane & 7;
#pragma unroll
    for (int j = 0; j < 4; ++j) { const int n = (lane >> 3) + 8 * j; const LAS float* sp = scr + (8 * c) * 33 + n;
        u32x4 o; o.x = pk2(sp[0 * 33], sp[1 * 33]); o.y = pk2(sp[2 * 33], sp[3 * 33]); o.z = pk2(sp[4 * 33], sp[5 * 33]); o.w = pk2(sp[6 * 33], sp[7 * 33]);
        *(u32x4*)(WT + (size_t)(drow0 + n) * Kd + k0 + 8 * c) = o; }
    asm volatile("s_waitcnt lgkmcnt(0)" ::: "memory");
}


typedef short bf16x8v __attribute__((ext_vector_type(8)));
__device__ __forceinline__ float bflo(unsigned v) { return __builtin_bit_cast(float, v << 16); }
__device__ __forceinline__ float bfhi(unsigned v) { return __builtin_bit_cast(float, v & 0xffff0000u); }

__device__ __forceinline__ void conv_unit(unsigned char* lds, const bf16* hglu, const float* w_dw, const float* b_dw, const float* g_cn, const float* b_cn, bf16* ycat, int cu) {
    int tid = threadIdx.x; asm volatile("" : "+v"(tid));
    const int lane = tid & 63, wave = tid >> 6;
    bf16* hin = (bf16*)lds; float* cout = (float*)(lds + 63488);
    const int t0 = cu * 32, s0 = t0 % SEQ;
    for (int c = tid; c < 62 * 64; c += 512) { const int row = c >> 6, part = c & 63; u32x4 v = (u32x4){0u, 0u, 0u, 0u};
        if (s0 - 30 + row >= 0) v = *(const u32x4*)(hglu + (size_t)(t0 - 30 + row) * 512 + part * 8);
        *(u32x4*)(hin + row * 512 + part * 8) = v; }
    __syncthreads();
    {
        const int cp = tid & 255, th = tid >> 8;
        float w0[CONV_W], w1[CONV_W];
#pragma unroll
        for (int j = 0; j < CONV_W; ++j) { const float2 ww = *(const float2*)(w_dw + j * CONV_CH + 2 * cp); w0[j] = ww.x; w1[j] = ww.y; }
        const float2 bb = *(const float2*)(b_dw + 2 * cp);
#pragma unroll 1
        for (int grp = 0; grp < 2; ++grp) { const int tt0 = th * 16 + grp * 8;
            float a0[8], a1[8];
#pragma unroll
            for (int o = 0; o < 8; ++o) { a0[o] = bb.x; a1[o] = bb.y; }
#pragma unroll
            for (int r = 0; r < 38; ++r) { const unsigned v = *(const unsigned*)(hin + (tt0 + r) * 512 + 2 * cp); const float lo = bflo(v), hi = bfhi(v);
#pragma unroll
                for (int o = 0; o < 8; ++o) { const int j = r - o; if (j >= 0 && j < CONV_W) { a0[o] += w0[j] * lo; a1[o] += w1[j] * hi; } } }
#pragma unroll
            for (int o = 0; o < 8; ++o) *(float2*)(cout + (tt0 + o) * 512 + 2 * cp) = make_float2(a0[o], a1[o]);
        }
    }
    __syncthreads();
    {
        const f32x4 g0 = *(const f32x4*)(g_cn + 8 * lane), g1 = *(const f32x4*)(g_cn + 8 * lane + 4), c0 = *(const f32x4*)(b_cn + 8 * lane), c1 = *(const f32x4*)(b_cn + 8 * lane + 4);
#pragma unroll 1
        for (int i = 0; i < 4; ++i) { const int tt = wave * 4 + i;
            f32x4 v0 = *(const f32x4*)(cout + tt * 512 + 8 * lane), v1 = *(const f32x4*)(cout + tt * 512 + 8 * lane + 4);
            const float mean = wave_sum((v0.x + v0.y) + (v0.z + v0.w) + (v1.x + v1.y) + (v1.z + v1.w)) * (1.f / 512.f);
            v0 = v0 - mean; v1 = v1 - mean;
            const float var = wave_sum((v0.x * v0.x + v0.y * v0.y) + (v0.z * v0.z + v0.w * v0.w) + (v1.x * v1.x + v1.y * v1.y) + (v1.z * v1.z + v1.w * v1.w)) * (1.f / 512.f);
            const float rstd = 1.f / sqrtf(var + LN_EPS);
            f32x4 y0 = v0 * rstd * g0 + c0, y1 = v1 * rstd * g1 + c1;
#pragma unroll
            for (int e = 0; e < 4; ++e) { y0[e] = y0[e] * pg8::sigm(y0[e]); y1[e] = y1[e] * pg8::sigm(y1[e]); }
            *(u32x4*)(ycat + (size_t)(t0 + tt) * 1024 + 8 * lane) = pg8::pack8(y0, y1); }
    }
    __syncthreads();
}

__device__ __forceinline__ void swa_unit(unsigned char* lds, const bf16* qkv, const float* sinks, bf16* ycat, int b, int kvh, int qb) {
    int tid = threadIdx.x; asm volatile("" : "+v"(tid));
    const int lane = tid & 63, wave = tid >> 6, q4 = lane >> 4, c16 = lane & 15;
    bf16* Ks = (bf16*)lds; bf16* VT = (bf16*)(lds + 36864);
    const long t0 = (long)b * SEQ + (long)qb * 128, tk0 = t0 - 128;
#pragma unroll
    for (int i = 0; i < 4; ++i) { const int c = tid + 512 * i, row = c >> 3, part = c & 7; const bool ok = (qb > 0) || (row >= 128);
        u32x4 kv = (u32x4){0u, 0u, 0u, 0u}, vv = kv;
        if (ok) { const bf16* rp = qkv + (tk0 + row) * 768 + 512 + kvh * 64 + part * 8; kv = *(const u32x4*)rp; vv = *(const u32x4*)(rp + 128); }
        *(u32x4*)(Ks + row * 72 + part * 8) = kv;
#pragma unroll
        for (int e = 0; e < 4; ++e) { VT[(part * 8 + 2 * e) * 264 + row] = (bf16)(vv[e] & 0xffffu); VT[(part * 8 + 2 * e + 1) * 264 + row] = (bf16)(vv[e] >> 16); } }
    __syncthreads();
    const int g = wave >> 1, hq = kvh * 4 + g, i0 = (wave & 1) * 64;
    const float L2E = 1.4426950408889634f, sc = 0.125f * L2E, sink2 = sinks[hq] * L2E;
#pragma unroll 1
    for (int qt = 0; qt < 4; ++qt) {
        const int iq = i0 + qt * 16, kt0 = iq >> 4, iqc = iq + c16;
        const bf16* qp = qkv + (t0 + iqc) * 768 + hq * 64 + 8 * q4;
        const bf16x8v Q0 = *(const bf16x8v*)qp, Q1 = *(const bf16x8v*)(qp + 32);
        f32x4 sv[9];
#pragma unroll
        for (int kt = 0; kt < 9; ++kt) { const bf16* kp = Ks + ((kt0 + kt) * 16 + c16) * 72 + 8 * q4;
            f32x4 a = (f32x4){0.f, 0.f, 0.f, 0.f};
            a = __builtin_amdgcn_mfma_f32_16x16x32_bf16(*(const bf16x8v*)kp, Q0, a, 0, 0, 0);
            a = __builtin_amdgcn_mfma_f32_16x16x32_bf16(*(const bf16x8v*)(kp + 32), Q1, a, 0, 0, 0);
            sv[kt] = a; }
        float mx = sink2;
#pragma unroll
        for (int kt = 0; kt < 9; ++kt)
#pragma unroll
            for (int r = 0; r < 4; ++r) { const int j = (kt0 + kt) * 16 + 4 * q4 + r; const bool ok = (j > iqc) && (j <= iqc + 128) && (qb > 0 || j >= 128);
                const float v = ok ? sv[kt][r] * sc : -INFINITY; sv[kt][r] = v; mx = fmaxf(mx, v); }
        mx = fmaxf(mx, __shfl_xor(mx, 16)); mx = fmaxf(mx, __shfl_xor(mx, 32));
        float sum = 0.f;
#pragma unroll
        for (int kt = 0; kt < 9; ++kt)
#pragma unroll
            for (int r = 0; r < 4; ++r) { const float pv = __builtin_amdgcn_exp2f(sv[kt][r] - mx); sv[kt][r] = pv; sum += pv; }
        sum += __shfl_xor(sum, 16); sum += __shfl_xor(sum, 32);
        sum += __builtin_amdgcn_exp2f(sink2 - mx);
        const float inv = 1.f / sum;
        f32x4 o[4];
#pragma unroll
        for (int dt = 0; dt < 4; ++dt) o[dt] = (f32x4){0.f, 0.f, 0.f, 0.f};
#pragma unroll
        for (int pp = 0; pp < 5; ++pp) { const int T0 = kt0 + 2 * pp, T1 = (pp < 4) ? T0 + 1 : T0;
            const f32x4 pa = sv[2 * pp], pb = (pp < 4) ? sv[2 * pp + 1] : (f32x4){0.f, 0.f, 0.f, 0.f};
            const u32x4 pw = pg8::pack8(pa, pb); const bf16x8v Bp = __builtin_bit_cast(bf16x8v, pw);
#pragma unroll
            for (int dt = 0; dt < 4; ++dt) { const bf16* vp = VT + (dt * 16 + c16) * 264 + 4 * q4;
                const u32x2 lo = *(const u32x2*)(vp + T0 * 16), hi = *(const u32x2*)(vp + T1 * 16);
                const u32x4 aw = (u32x4){lo.x, lo.y, hi.x, hi.y};
                o[dt] = __builtin_amdgcn_mfma_f32_16x16x32_bf16(__builtin_bit_cast(bf16x8v, aw), Bp, o[dt], 0, 0, 0); } }
        bf16* op = ycat + (t0 + iqc) * 1024 + 512 + hq * 64 + 4 * q4;
#pragma unroll
        for (int dt = 0; dt < 4; ++dt) { u32x2 w; w.x = pg8::cvt_pk_bf16(o[dt][0] * inv, o[dt][1] * inv); w.y = pg8::cvt_pk_bf16(o[dt][2] * inv, o[dt][3] * inv); *(u32x2*)(op + dt * 16) = w; }
    }
    __syncthreads();
}

struct SchedMoE { const char* A; const char* W; const int* seg; int nmt, nN, G, c; size_t strideA, strideE, strideN;
    __device__ __forceinline__ bool next(int i, pg8::Unit& u) const { const int L = i * G + c; if (L >= nmt * nN) return false; pg8::tile_of(L, nmt, nN, u.pm, u.pn); int e = 0;
#pragma unroll
        for (int j = 1; j < 16; ++j) if (u.pm * 256 >= seg[j]) e = j;
        u.kind = 0; u.aux = e; u.A = A + (size_t)u.pm * strideA; u.B = W + (size_t)e * strideE + (size_t)u.pn * strideN; return true; } };

__global__ void __launch_bounds__(512, 2) fwd_kernel(Params p) {
    extern __shared__ __attribute__((aligned(16))) unsigned char lds_raw[];
    float* ldsf = (float*)lds_raw;
    cg::grid_group grid = cg::this_grid();
    const int G = gridDim.x, bid = blockIdx.x, NGW = G * 8;
    unsigned char* ws = p.ws;
    const float *x = p.in[0], *mem = p.in[1], *w_in = p.in[2], *b_in = p.in[3], *w_dw = p.in[4], *b_dw = p.in[5], *g_cn = p.in[6], *b_cn = p.in[7], *sinks = p.in[8],
                *w_out = p.in[9], *g_ln1 = p.in[10], *b_ln1 = p.in[11], *w_mq = p.in[12], *w_mkv = p.in[13], *w_mo = p.in[14], *g_ln2 = p.in[15], *b_ln2 = p.in[16],
                *w_group = p.in[17], *b_group = p.in[18], *w_router = p.in[19], *b_router = p.in[20], *w_gate = p.in[21], *w_up = p.in[22], *w_down = p.in[23],
                *g_ln3 = p.in[24], *b_ln3 = p.in[25];
    float* out = p.out;
    bf16* xb = (bf16*)(ws + WS_A); bf16* ycat = (bf16*)(ws + WS_A); bf16* qm = (bf16*)(ws + WS_A); bf16* om = (bf16*)(ws + WS_A); bf16* Hs = (bf16*)(ws + WS_A);
    bf16* hglu = (bf16*)(ws + WS_B); bf16* qkv = (bf16*)(ws + WS_B + (size_t)T * 512 * 2); bf16* x1b = (bf16*)(ws + WS_B); bf16* Pb = (bf16*)(ws + WS_B); bf16* x2b = (bf16*)(ws + WS_B);
    float* Sbuf = (float*)(ws + WS_DD); bf16* Xs = (bf16*)(ws + WS_DD);
    bf16* kmem = (bf16*)(ws + WS_KMEM); bf16* vmemT = (bf16*)(ws + WS_VMEMT); bf16* memb = (bf16*)(ws + WS_MEMB);
    bf16* Wt_in = (bf16*)(ws + WS_WIN); bf16* Wt_out = (bf16*)(ws + WS_WOUT); bf16* Wt_mq = (bf16*)(ws + WS_WMQ); bf16* Wt_mkv = (bf16*)(ws + WS_WMKV); bf16* Wt_mo = (bf16*)(ws + WS_WMO);
    bf16* Wt_gu = (bf16*)(ws + WS_WGU); bf16* Wt_dn = (bf16*)(ws + WS_WDN);
    PG8_LAS unsigned char* ldsp = (PG8_LAS unsigned char*)lds_raw;
    int* route_e = (int*)(ws + WS_ROUTE); float* route_g = (float*)(ws + WS_ROUTE + (size_t)T * 8);
    int* blkcnt = (int*)(ws + WS_BLKCNT); int* segw = (int*)(ws + WS_SEG); int* rank = (int*)(ws + WS_RANK);
    int* pair_tok = (int*)(ws + WS_PTOK); float* pair_gate = (float*)(ws + WS_PGATE); int* tokpos = (int*)(ws + WS_TOKPOS); bf16* Yb = (bf16*)(ws + WS_DD);

    const int lo = p.ph_lo, hi = p.ph_hi;
    int ph = 0;
#define PHASE_BEGIN if (lo <= ph && ph < hi) { for (int rep_ = 0; rep_ < ((((unsigned)PROBE_MASK >> ph) & 1u) ? 2 : 1); ++rep_) { int tid = threadIdx.x; asm volatile("" : "+v"(tid)); const int lane = tid & 63, wave = tid >> 6, gw = bid * 8 + wave; (void)lane; (void)wave; (void)gw;
#define PHASE_END } } if (lo <= ph && ph + 1 < hi) grid.sync(); ++ph;

    PHASE_BEGIN
    for (size_t i = (size_t)bid * 512 + tid; i < (size_t)T * D / 4; i += (size_t)G * 512) { const f32x4 v = ((const f32x4*)x)[i]; u32x2 w; w.x = pk2(v.x, v.y); w.y = pk2(v.z, v.w); ((u32x2*)xb)[i] = w; }
    for (size_t i = (size_t)bid * 512 + tid; i < (size_t)NMEM * D / 4; i += (size_t)G * 512) { const f32x4 v = ((const f32x4*)mem)[i]; u32x2 w; w.x = pk2(v.x, v.y); w.y = pk2(v.z, v.w); ((u32x2*)memb)[i] = w; }
    {
        LAS float* scr = (LAS float*)(ldsp + wave * 16384);
        constexpr int I_IN = 16 * 56, I_SQ = 16 * 32, I_KV = 16 * 64, I_EX = 16 * 256;
        constexpr int NITEMS = I_IN + 3 * I_SQ + I_KV + 3 * I_EX;
        for (int it = gw; it < NITEMS; it += NGW) { int r = it;
            if (r < I_IN) { const int kb = r / 56, nb = r % 56, n0 = nb * 32; const int dr = n0 < 512 ? (n0 >> 7) * 256 + (n0 & 127) : (n0 < 1024 ? ((n0 - 512) >> 7) * 256 + 128 + (n0 & 127) : n0);
                transpose_item(w_in, D_IN, Wt_in, 1024, kb * 64, n0, dr, scr, lane); continue; } r -= I_IN;
            if (r < I_SQ) { transpose_item(w_out, 1024, Wt_out, 1024, (r / 32) * 64, (r % 32) * 32, (r % 32) * 32, scr, lane); continue; } r -= I_SQ;
            if (r < I_SQ) { transpose_item(w_mq, 1024, Wt_mq, 1024, (r / 32) * 64, (r % 32) * 32, (r % 32) * 32, scr, lane); continue; } r -= I_SQ;
            if (r < I_SQ) { transpose_item(w_mo, 1024, Wt_mo, 1024, (r / 32) * 64, (r % 32) * 32, (r % 32) * 32, scr, lane); continue; } r -= I_SQ;
            if (r < I_KV) { transpose_item(w_mkv, 2048, Wt_mkv, 1024, (r / 64) * 64, (r % 64) * 32, (r % 64) * 32, scr, lane); continue; } r -= I_KV;
            if (r < I_EX) { const int e = r / 256, q = r % 256, n0 = (q % 16) * 32; transpose_item(w_gate + (size_t)e * D * DE, DE, Wt_gu + (size_t)e * 1024 * 1024, 1024, (q / 16) * 64, n0, (n0 >> 7) * 256 + (n0 & 127), scr, lane); continue; } r -= I_EX;
            if (r < I_EX) { const int e = r / 256, q = r % 256, n0 = (q % 16) * 32; transpose_item(w_up + (size_t)e * D * DE, DE, Wt_gu + (size_t)e * 1024 * 1024, 1024, (q / 16) * 64, n0, (n0 >> 7) * 256 + 128 + (n0 & 127), scr, lane); continue; } r -= I_EX;
            { const int e = r / 256, q = r % 256; transpose_item(w_down + (size_t)e * DE * D, D, Wt_dn + (size_t)e * 1024 * 512, 512, (q / 32) * 64, (q % 32) * 32, (q % 32) * 32, scr, lane); }
        }
    }
    PHASE_END

    PHASE_BEGIN
#if FAST_P1
    {
        struct SchedP1 { const char *xb, *win, *memb, *wkv; int G, c;
            __device__ __forceinline__ bool next(int i, pg8::Unit& u) const { const int L = i * G + c; u.aux = 0;
                if (L < 448) { pg8::tile_of(L, 64, 7, u.pm, u.pn); u.A = xb + (size_t)u.pm * 256 * 2048; u.B = win + (size_t)u.pn * 256 * 2048; u.kind = u.pn < 4 ? 0 : 1; return true; }
                if (L < 456) { const int r = L - 448; u.pm = r >> 2; u.pn = r & 3; u.A = memb + (size_t)u.pm * 256 * 2048; u.B = wkv + (size_t)u.pn * 256 * 2048; u.kind = 2; return true; }
                if (L < 464) { const int r = L - 456; u.pm = r >> 1; u.pn = r & 1; u.A = wkv + (size_t)(4 + u.pm) * 256 * 2048; u.B = memb + (size_t)u.pn * 256 * 2048; u.kind = 3; return true; }
                return false; } };
        const SchedP1 S{(const char*)xb, (const char*)Wt_in, (const char*)memb, (const char*)Wt_mkv, G, bid};
        const pg8::EpiP1 E{hglu, qkv, kmem, vmemT, b_in};
        pg8::gemm_phase(ldsp, pg8::Gemm{1024, 1024, 1024}, S, E);
    }
#else
    constexpr int U_GLU = 128 * 8, U_QKV = 128 * 12, U_KVM = 4 * 32;
    for (int u = bid; u < U_GLU + U_QKV + U_KVM; u += G) {
        if (u < U_GLU) { const int mt = u / 8, nt = u % 8;
            ngemm_tile<2>(ldsf, D, mt * 128, nt * 64,
                [&](int m, int k) { return bf2f(xb[(size_t)m * D + k]); },
                [&](int b, int k, int n) { return w_in[(size_t)k * D_IN + n + b * 512]; },
                [&](int m, int n, float a, float g) { a += b_in[n]; g += b_in[512 + n]; hglu[(size_t)m * 512 + n] = (bf16)f2bf(a / (1.f + __expf(-g))); });
        } else if (u < U_GLU + U_QKV) { const int r = u - U_GLU, mt = r / 12, nt = r % 12;
            ngemm_tile<1>(ldsf, D, mt * 128, nt * 64,
                [&](int m, int k) { return bf2f(xb[(size_t)m * D + k]); },
                [&](int b, int k, int n) { return w_in[(size_t)k * D_IN + 1024 + n]; },
                [&](int m, int n, float a, float) { qkv[(size_t)m * 768 + n] = (bf16)f2bf(a + b_in[1024 + n]); });
        } else { const int r = u - U_GLU - U_QKV, mt = r / 32, nt = r % 32;
            ngemm_tile<1>(ldsf, D, mt * 128, nt * 64,
                [&](int m, int k) { return bf2f(memb[(size_t)m * D + k]); },
                [&](int b, int k, int n) { return w_mkv[(size_t)k * 2048 + n]; },
                [&](int m, int n, float a, float) { if (n < 1024) kmem[(size_t)m * 1024 + n] = (bf16)f2bf(a); else vmemT[(size_t)(n - 1024) * 512 + m] = (bf16)f2bf(a); });
        }
    }
#endif
    PHASE_END

    PHASE_BEGIN
#if FAST_P2
    for (int cu = bid; cu < T / 32; cu += G) conv_unit(lds_raw, hglu, w_dw, b_dw, g_cn, b_cn, ycat, cu);
    for (int u = bid; u < BATCH * NKV * (SEQ / 128); u += G) swa_unit(lds_raw, qkv, sinks, ycat, u >> 7, (u >> 6) & 1, u & 63);
#else
    {
        float wreg[CONV_W];
#pragma unroll
        for (int j = 0; j < CONV_W; ++j) wreg[j] = w_dw[j * CONV_CH + tid];
        const float bdw = b_dw[tid];
        float* cbuf = ldsf;
        for (int it = bid; it < T / 16; it += G) {
            const int t0 = it * 16, s0 = t0 % SEQ;
            for (int tt = 0; tt < 16; ++tt) {
                float acc = bdw;
#pragma unroll
                for (int j = 0; j < CONV_W; ++j) { const int sp = s0 + tt - (CONV_W - 1) + j; if (sp >= 0) acc += wreg[j] * bf2f(hglu[(size_t)(t0 + tt - (CONV_W - 1) + j) * 512 + tid]); }
                cbuf[tt * 512 + tid] = acc;
            }
            __syncthreads();
            for (int r = wave; r < 16; r += 8) {
                f32x4 v[2]; float s = 0.f;
#pragma unroll
                for (int j = 0; j < 2; ++j) { v[j] = ((const f32x4*)(cbuf + r * 512))[lane + 64 * j]; s += (v[j].x + v[j].y) + (v[j].z + v[j].w); }
                const float mean = wave_sum(s) * (1.f / 512.f); float s2 = 0.f;
#pragma unroll
                for (int j = 0; j < 2; ++j) { v[j] = v[j] - mean; s2 += (v[j].x * v[j].x + v[j].y * v[j].y) + (v[j].z * v[j].z + v[j].w * v[j].w); }
                const float rstd = 1.f / sqrtf(wave_sum(s2) * (1.f / 512.f) + LN_EPS);
#pragma unroll
                for (int j = 0; j < 2; ++j) { const f32x4 gg = ((const f32x4*)g_cn)[lane + 64 * j], bb = ((const f32x4*)b_cn)[lane + 64 * j]; f32x4 y = v[j] * rstd * gg + bb;
                    y.x = y.x / (1.f + __expf(-y.x)); y.y = y.y / (1.f + __expf(-y.y)); y.z = y.z / (1.f + __expf(-y.z)); y.w = y.w / (1.f + __expf(-y.w));
                    u32x2 w; w.x = pk2(y.x, y.y); w.y = pk2(y.z, y.w); ((u32x2*)(ycat + (size_t)(t0 + r) * 1024))[lane + 64 * j] = w; }
            }
            __syncthreads();
        }
    }
    {
        float* wq = ldsf + wave * 192; float* wp = wq + 64;
        for (int task = gw; task < T * NH; task += NGW) {
            const int t = task >> 3, hq = task & 7, kvh = hq >> 2, s = t % SEQ;
            wq[lane] = bf2f(qkv[(size_t)t * 768 + hq * 64 + lane]);
            __builtin_amdgcn_wave_barrier(); asm volatile("s_waitcnt lgkmcnt(0)" ::: "memory");
            float sc[2];
#pragma unroll
            for (int h2 = 0; h2 < 2; ++h2) { const int j = lane + 64 * h2, kp = s - (WINDOW - 1) + j;
                float a = -INFINITY;
                if (kp >= 0) { const u32x4* kr = (const u32x4*)(qkv + (size_t)(t - (WINDOW - 1) + j) * 768 + 512 + kvh * 64); a = 0.f;
#pragma unroll
                    for (int c = 0; c < 8; ++c) { const u32x4 kk = kr[c];
#pragma unroll
                        for (int i = 0; i < 4; ++i) { a += wq[c * 8 + 2 * i] * __builtin_bit_cast(float, kk[i] << 16); a += wq[c * 8 + 2 * i + 1] * __builtin_bit_cast(float, kk[i] & 0xffff0000u); } }
                    a *= 0.125f; }
                sc[h2] = a; }
            const float sk = sinks[hq];
            const float mx = fmaxf(wave_max(fmaxf(sc[0], sc[1])), sk);
            const float p0 = __expf(sc[0] - mx), p1 = __expf(sc[1] - mx);
            const float den = wave_sum(p0 + p1) + __expf(sk - mx);
            wp[lane] = p0; wp[lane + 64] = p1;
            __builtin_amdgcn_wave_barrier(); asm volatile("s_waitcnt lgkmcnt(0)" ::: "memory");
            float o = 0.f;
            for (int j = 0; j < WINDOW; ++j) { const int kp = s - (WINDOW - 1) + j; if (kp >= 0) o += wp[j] * bf2f(qkv[(size_t)(t - (WINDOW - 1) + j) * 768 + 640 + kvh * 64 + lane]); }
            ycat[(size_t)t * 1024 + 512 + hq * 64 + lane] = (bf16)f2bf(o / den);
            __builtin_amdgcn_wave_barrier(); asm volatile("s_waitcnt lgkmcnt(0)" ::: "memory");
        }
    }
#endif
    PHASE_END

    PHASE_BEGIN
#if FAST_DENSE
    { const pg8::DenseSched S{(const char*)ycat, (const char*)Wt_out, 64, 4, G, bid, (size_t)256 * 2048, (size_t)256 * 2048};
      const pg8::EpiResF32 E{x, out, ALPHA}; pg8::gemm_phase(ldsp, pg8::Gemm{1024, 1024, 1024}, S, E); }
#else
    for (int u = bid; u < 128 * 16; u += G) { const int mt = u / 16, nt = u % 16;
        ngemm_tile<1>(ldsf, D, mt * 128, nt * 64,
            [&](int m, int k) { return bf2f(ycat[(size_t)m * D + k]); },
            [&](int b, int k, int n) { return w_out[(size_t)k * D + n]; },
            [&](int m, int n, float a, float) { out[(size_t)m * D + n] = ALPHA * x[(size_t)m * D + n] + a; });
    }
#endif
    PHASE_END
    PHASE_BEGIN
    for (int m = gw; m < T; m += NGW) { f32x4 v[4]; ln_row(out + (size_t)m * D, g_ln1, b_ln1, v, lane); st_row_f32(out + (size_t)m * D, v, 1.f, lane); st_row_bf16(x1b + (size_t)m * D, v, lane); }
    PHASE_END
    PHASE_BEGIN
#if FAST_DENSE
    { const pg8::DenseSched S{(const char*)x1b, (const char*)Wt_mq, 64, 4, G, bid, (size_t)256 * 2048, (size_t)256 * 2048};
      const pg8::EpiBf16 E{qm, 1024, nullptr}; pg8::gemm_phase(ldsp, pg8::Gemm{1024, 1024, 1024}, S, E); }
#else
    for (int u = bid; u < 128 * 16; u += G) { const int mt = u / 16, nt = u % 16;
        ngemm_tile<1>(ldsf, D, mt * 128, nt * 64,
            [&](int m, int k) { return bf2f(x1b[(size_t)m * D + k]); },
            [&](int b, int k, int n) { return w_mq[(size_t)k * D + n]; },
            [&](int m, int n, float a, float) { qm[(size_t)m * D + n] = (bf16)f2bf(a); });
    }
#endif
    PHASE_END
    PHASE_BEGIN
#if FAST_XATT
    {
        struct SchedS { const char *qm, *kmem; int G, c;
            __device__ __forceinline__ bool next(int i, pg8::Unit& u) const { const int L = i * G + c; if (L >= 256) return false; pg8::tile_of(L, 64, 4, u.pm, u.pn); u.kind = 0; u.aux = 0;
                u.A = qm + ((size_t)u.pm * 256 * 1024 + u.pn * 256) * 2; u.B = kmem + ((size_t)(u.pm >> 5) * 256 * 1024 + u.pn * 256) * 2; return true; } };
        const SchedS S{(const char*)qm, (const char*)kmem, G, bid};
        const pg8::EpiSoftmax E{Pb, (PG8_LAS float*)(ldsp + 131072)};
        pg8::gemm_phase(ldsp, pg8::Gemm{1024, 1024, 256}, S, E);
    }
#else
    for (int u = bid; u < 128 * 16; u += G) { const int mt = u / 16, h = (u % 16) / 4, nt = u % 4; const int b = (mt * 128) / SEQ;
        ngemm_tile<1>(ldsf, MHD, mt * 128, nt * 64,
            [&](int m, int k) { return bf2f(qm[(size_t)m * D + h * MHD + k]); },
            [&](int bb, int k, int n) { return bf2f(kmem[(size_t)(b * MEM + n) * D + h * MHD + k]); },
            [&](int m, int n, float a, float) { Sbuf[(size_t)m * D + h * MHD + n] = a * 0.0625f; });
    }
#endif
    PHASE_END
#if !FAST_XATT
    PHASE_BEGIN
    for (int m = gw; m < T; m += NGW) {
#pragma unroll
        for (int h = 0; h < 4; ++h) { const f32x4 v = ((const f32x4*)(Sbuf + (size_t)m * D + h * MHD))[lane];
            const float mx = wave_max(fmaxf(fmaxf(v.x, v.y), fmaxf(v.z, v.w)));
            const float e0 = __expf(v.x - mx), e1 = __expf(v.y - mx), e2 = __expf(v.z - mx), e3 = __expf(v.w - mx);
            const float inv = 1.f / wave_sum((e0 + e1) + (e2 + e3));
            u32x2 w; w.x = pk2(e0 * inv, e1 * inv); w.y = pk2(e2 * inv, e3 * inv); ((u32x2*)(Pb + (size_t)m * D + h * MHD))[lane] = w; }
    }
    PHASE_END
#endif
    PHASE_BEGIN
#if FAST_XATT
    {
        struct SchedO { const char *P, *vT; int G, c;
            __device__ __forceinline__ bool next(int i, pg8::Unit& u) const { const int L = i * G + c; if (L >= 256) return false; pg8::tile_of(L, 64, 4, u.pm, u.pn); u.kind = 0; u.aux = 0;
                u.A = P + ((size_t)u.pm * 256 * 1024 + u.pn * 256) * 2; u.B = vT + ((size_t)u.pn * 256 * 512 + (u.pm >> 5) * 256) * 2; return true; } };
        const SchedO S{(const char*)Pb, (const char*)vmemT, G, bid};
        const pg8::EpiBf16 E{om, 1024, nullptr};
        pg8::gemm_phase(ldsp, pg8::Gemm{1024, 512, 256}, S, E);
    }
#else
    for (int u = bid; u < 128 * 16; u += G) { const int mt = u / 16, h = (u % 16) / 4, nt = u % 4; const int b = (mt * 128) / SEQ;
        ngemm_tile<1>(ldsf, MEM, mt * 128, nt * 64,
            [&](int m, int k) { return bf2f(Pb[(size_t)m * D + h * MHD + k]); },
            [&](int bb, int k, int n) { return bf2f(vmemT[(size_t)(h * MHD + n) * NMEM + b * MEM + k]); },
            [&](int m, int n, float a, float) { om[(size_t)m * D + h * MHD + n] = (bf16)f2bf(a); });
    }
#endif
    PHASE_END
    PHASE_BEGIN
#if FAST_DENSE
    { const pg8::DenseSched S{(const char*)om, (const char*)Wt_mo, 64, 4, G, bid, (size_t)256 * 2048, (size_t)256 * 2048};
      const pg8::EpiResF32 E{out, out, ALPHA}; pg8::gemm_phase(ldsp, pg8::Gemm{1024, 1024, 1024}, S, E); }
#else
    for (int u = bid; u < 128 * 16; u += G) { const int mt = u / 16, nt = u % 16;
        ngemm_tile<1>(ldsf, D, mt * 128, nt * 64,
            [&](int m, int k) { return bf2f(om[(size_t)m * D + k]); },
            [&](int b, int k, int n) { return w_mo[(size_t)k * D + n]; },
            [&](int m, int n, float a, float) { out[(size_t)m * D + n] = ALPHA * out[(size_t)m * D + n] + a; });
    }
#endif
    PHASE_END
    const int TPB = (T + G - 1) / G;
    PHASE_BEGIN
    { const int t0 = bid * TPB, t1 = (t0 + TPB < T) ? t0 + TPB : T;
      float* Wl = ldsf;
      int* le = (int*)(lds_raw + 81920);
      for (int k = tid; k < D; k += 512) { const f32x4 wg = *(const f32x4*)(w_group + (size_t)k * 4);
          Wl[0 * D + k] = wg.x; Wl[1 * D + k] = wg.y; Wl[2 * D + k] = wg.z; Wl[3 * D + k] = wg.w;
#pragma unroll
          for (int gq = 0; gq < 4; ++gq) { const f32x4 wr = *(const f32x4*)(w_router + ((size_t)gq * D + k) * 4);
              Wl[(4 + gq * 4 + 0) * D + k] = wr.x; Wl[(4 + gq * 4 + 1) * D + k] = wr.y; Wl[(4 + gq * 4 + 2) * D + k] = wr.z; Wl[(4 + gq * 4 + 3) * D + k] = wr.w; } }
      __syncthreads();
      const int TPW = (TPB + 7) / 8;
      for (int mb = t0 + wave * TPW; mb < t0 + (wave + 1) * TPW && mb < t1; mb += 2) {
        f32x4 v[2][4];
        const bool has1 = (mb + 1 < t1) && (mb + 1 < t0 + (wave + 1) * TPW);
        ln_row(out + (size_t)mb * D, g_ln2, b_ln2, v[0], lane);
        st_row_f32(out + (size_t)mb * D, v[0], ALPHA, lane); st_row_bf16(x2b + (size_t)mb * D, v[0], lane);
        __builtin_amdgcn_sched_barrier(0);
        ln_row(out + (size_t)(has1 ? mb + 1 : mb) * D, g_ln2, b_ln2, v[1], lane);
        if (has1) { st_row_f32(out + (size_t)(mb + 1) * D, v[1], ALPHA, lane); st_row_bf16(x2b + (size_t)(mb + 1) * D, v[1], lane); }
        __builtin_amdgcn_sched_barrier(0);
        float my[20];
#pragma unroll
        for (int c = 0; c < 20; ++c) {
            float a0 = 0.f, a1 = 0.f;
#pragma unroll
            for (int jj = 0; jj < 4; ++jj) { const f32x4 w4 = ((const f32x4*)(Wl + c * D))[lane + 64 * jj];
                a0 += (v[0][jj].x * w4.x + v[0][jj].y * w4.y) + (v[0][jj].z * w4.z + v[0][jj].w * w4.w);
                a1 += (v[1][jj].x * w4.x + v[1][jj].y * w4.y) + (v[1][jj].z * w4.z + v[1][jj].w * w4.w); }
            a0 = wave_sum(a0); a1 = wave_sum(a1);
            my[c] = (lane == 1) ? a1 : a0;
        }
        const int m = mb + lane;
        if (lane < 2 && m < t1 && m < t0 + (wave + 1) * TPW) {
            float gl[4]; int gi = 0; float gmx = -INFINITY;
#pragma unroll
            for (int i = 0; i < 4; ++i) { gl[i] = my[i] + b_group[i]; if (gl[i] > gmx) { gmx = gl[i]; gi = i; } }
            float gs = 0.f;
#pragma unroll
            for (int i = 0; i < 4; ++i) gs += __expf(gl[i] - gmx);
            const float gp = 1.f / gs;
            float el[4];
#pragma unroll
            for (int i = 0; i < 4; ++i) { float a = my[4 + i], bq = b_router[i];
                a = (gi == 1) ? my[8 + i] : a; a = (gi == 2) ? my[12 + i] : a; a = (gi == 3) ? my[16 + i] : a;
                bq = (gi == 1) ? b_router[4 + i] : bq; bq = (gi == 2) ? b_router[8 + i] : bq; bq = (gi == 3) ? b_router[12 + i] : bq;
                el[i] = a + bq; }
            int i0 = 0; float v0 = el[0];
#pragma unroll
            for (int i = 1; i < 4; ++i) if (el[i] > v0) { v0 = el[i]; i0 = i; }
            int i1 = -1; float v1 = -INFINITY;
#pragma unroll
            for (int i = 0; i < 4; ++i) if (i != i0 && el[i] > v1) { v1 = el[i]; i1 = i; }
            const float w0 = 1.f / (1.f + __expf(v1 - v0)), w1 = 1.f - w0;
            route_e[2 * m] = gi * 4 + i0; route_e[2 * m + 1] = gi * 4 + i1; route_g[2 * m] = gp * w0; route_g[2 * m + 1] = gp * w1;
            le[2 * (m - t0)] = gi * 4 + i0; le[2 * (m - t0) + 1] = gi * 4 + i1;
        }
      }
      __syncthreads();
      const int np = 2 * (t1 - t0);
      for (int i = tid; i < np; i += 512) { const int e = le[i]; int r = 0; for (int j2 = 0; j2 < i; ++j2) r += (le[j2] == e) ? 1 : 0; rank[2 * t0 + i] = r; }
      if (tid < 16) { int c = 0; for (int j2 = 0; j2 < np; ++j2) c += (le[j2] == tid) ? 1 : 0; blkcnt[bid * 16 + tid] = c; }
    }
    PHASE_END
    PHASE_BEGIN
    {
        int* sh = (int*)lds_raw;
        { const int e = tid & 15, part = tid >> 4; int tot = 0, base = 0;
          for (int b = part; b < G; b += 32) { const int c = blkcnt[b * 16 + e]; tot += c; if (b < bid) base += c; }
          sh[128 + part * 16 + e] = tot; sh[640 + part * 16 + e] = base; }
        __syncthreads();
        if (tid < 16) { int tot = 0, base = 0;
#pragma unroll 8
            for (int part = 0; part < 32; ++part) { tot += sh[128 + part * 16 + tid]; base += sh[640 + part * 16 + tid]; } sh[tid] = base; sh[64 + tid] = tot; }
        __syncthreads();
        if (tid == 0) { int sacc = 0; for (int e = 0; e < 16; ++e) { sh[16 + e] = sacc; sacc += (sh[64 + e] + 255) & ~255; } sh[32] = sacc; if (bid == 0) for (int e = 0; e <= 16; ++e) segw[e] = sh[16 + e]; }
        __syncthreads();
        if (bid == 0) { for (int e = 0; e < 16; ++e) for (int pos = sh[16 + e] + sh[64 + e] + tid; pos < sh[16 + e + 1]; pos += 512) { pair_tok[pos] = -1; pair_gate[pos] = 0.f; } }
        const int t0 = bid * TPB, t1 = (t0 + TPB < T) ? t0 + TPB : T, np = 2 * (t1 - t0);
        for (int i = tid; i < np; i += 512) { const int pi = 2 * t0 + i, e = route_e[pi], pos = sh[16 + e] + sh[e] + rank[pi]; pair_tok[pos] = pi >> 1; pair_gate[pos] = route_g[pi]; tokpos[pi] = pos; sh[2048 + i] = pos; }
        __syncthreads();
        for (int i = wave; i < np; i += 8) { const int pos = sh[2048 + i], tok = t0 + (i >> 1);
            const u32x4* src = (const u32x4*)(x2b + (size_t)tok * D); u32x4* dst = (u32x4*)(Xs + (size_t)pos * D);
            dst[lane] = src[lane]; dst[lane + 64] = src[lane + 64]; }
    }
    PHASE_END
    PHASE_BEGIN
#if FAST_MOE
    { const SchedMoE S{(const char*)Xs, (const char*)Wt_gu, segw, segw[16] / 256, 4, G, bid, (size_t)256 * 2048, (size_t)1024 * 2048, (size_t)256 * 2048};
      const pg8::EpiGateUp E{Hs, pair_gate}; pg8::gemm_phase(ldsp, pg8::Gemm{1024, 1024, 1024}, S, E); }
#else
    { const int nmt = segw[16] / 128;
      for (int u = bid; u < nmt * 8; u += G) { const int mt = u / 8, nt = u % 8; int e = 0;
#pragma unroll
        for (int i = 1; i < 16; ++i) if (mt * 128 >= segw[i]) e = i;
        const float* wg = w_gate + (size_t)e * D * DE; const float* wu = w_up + (size_t)e * D * DE;
        ngemm_tile<2>(ldsf, D, mt * 128, nt * 64,
            [&](int m, int k) { return bf2f(Xs[(size_t)m * D + k]); },
            [&](int b, int k, int n) { return (b == 0 ? wg : wu)[(size_t)k * DE + n]; },
            [&](int m, int n, float g, float uu) { const float pg = pair_gate[m]; const float hv = (pair_tok[m] >= 0) ? (g / (1.f + __expf(-g))) * uu * pg : 0.f; Hs[(size_t)m * DE + n] = (bf16)f2bf(hv); });
      } }
#endif
    PHASE_END
    PHASE_BEGIN
#if FAST_MOE
    { const SchedMoE S{(const char*)Hs, (const char*)Wt_dn, segw, segw[16] / 256, 4, G, bid, (size_t)256 * 1024, (size_t)1024 * 1024, (size_t)256 * 1024};
      const pg8::EpiBf16 E{Yb, 1024, nullptr}; pg8::gemm_phase(ldsp, pg8::Gemm{512, 512, 512}, S, E); }
#else
    { const int nmt = segw[16] / 128;
      for (int u = bid; u < nmt * 16; u += G) { const int mt = u / 16, nt = u % 16; int e = 0;
#pragma unroll
        for (int i = 1; i < 16; ++i) if (mt * 128 >= segw[i]) e = i;
        const float* wd = w_down + (size_t)e * DE * D;
        ngemm_tile<1>(ldsf, DE, mt * 128, nt * 64,
            [&](int m, int k) { return bf2f(Hs[(size_t)m * DE + k]); },
            [&](int b, int k, int n) { return wd[(size_t)k * D + n]; },
            [&](int m, int n, float a, float) { const int tok = pair_tok[m]; if (tok >= 0) atomicAdd(out + (size_t)tok * D + n, a); });
      } }
#endif
    PHASE_END
    PHASE_BEGIN
#if FAST_MOE
    for (int m = gw; m < T; m += NGW) { float* row = out + (size_t)m * D; const int p0 = tokpos[2 * m], p1 = tokpos[2 * m + 1];
        const u32x2* y0 = (const u32x2*)(Yb + (size_t)p0 * D); const u32x2* y1 = (const u32x2*)(Yb + (size_t)p1 * D);
        f32x4 v[4]; float sacc = 0.f;
#pragma unroll
        for (int jj = 0; jj < 4; ++jj) { const u32x2 a = y0[lane + 64 * jj], b = y1[lane + 64 * jj]; f32x4 z = ((const f32x4*)row)[lane + 64 * jj];
            z.x += bflo(a.x) + bflo(b.x); z.y += bfhi(a.x) + bfhi(b.x); z.z += bflo(a.y) + bflo(b.y); z.w += bfhi(a.y) + bfhi(b.y); v[jj] = z; sacc += (z.x + z.y) + (z.z + z.w); }
        const float mean = wave_sum(sacc) * (1.f / D); float s2 = 0.f;
#pragma unroll
        for (int jj = 0; jj < 4; ++jj) { v[jj] = v[jj] - mean; s2 += (v[jj].x * v[jj].x + v[jj].y * v[jj].y) + (v[jj].z * v[jj].z + v[jj].w * v[jj].w); }
        const float rstd = 1.f / sqrtf(wave_sum(s2) * (1.f / D) + LN_EPS);
#pragma unroll
        for (int jj = 0; jj < 4; ++jj) { const f32x4 gg = ((const f32x4*)g_ln3)[lane + 64 * jj], bb = ((const f32x4*)b_ln3)[lane + 64 * jj]; ((f32x4*)row)[lane + 64 * jj] = v[jj] * rstd * gg + bb; } }
#else
    for (int m = gw; m < T; m += NGW) { f32x4 v[4]; ln_row(out + (size_t)m * D, g_ln3, b_ln3, v, lane); st_row_f32(out + (size_t)m * D, v, 1.f, lane); }
#endif
    PHASE_END
}

constexpr int N_PHASES = 16;
constexpr int LDS_BYTES = 147456;

extern "C" void kernel_launch(void* const* d_in, const int* in_sizes, int n_in, void* d_out, int out_size, void* d_ws, size_t ws_size, hipStream_t stream) {
    static int grid = 0;
    if (grid == 0) {
        int dev = 0, cus = 0, per_cu = 0;
        hipGetDevice(&dev);
        hipDeviceGetAttribute(&cus, hipDeviceAttributeMultiprocessorCount, dev);
        hipFuncSetAttribute((const void*)fwd_kernel, hipFuncAttributeMaxDynamicSharedMemorySize, LDS_BYTES);
        hipOccupancyMaxActiveBlocksPerMultiprocessor(&per_cu, (const void*)fwd_kernel, 512, LDS_BYTES);
        if (per_cu < 1) { fprintf(stderr, "occupancy query returned %d\n", per_cu); per_cu = 1; }
        grid = cus * 1;
        if (ws_size < WS_END) { fprintf(stderr, "workspace too small\n"); grid = -1; }
    }
    if (grid < 0) return;
    Params p{};
    for (int i = 0; i < 26; ++i) p.in[i] = (const float*)d_in[i];
    p.out = (float*)d_out; p.ws = (unsigned char*)d_ws;
#if MK_N_LAUNCHES == 1
    p.ph_lo = 0; p.ph_hi = 64;
    void* args[] = {&p};
    hipError_t e = hipLaunchCooperativeKernel((const void*)fwd_kernel, dim3(grid), dim3(512), args, LDS_BYTES, stream);
    if (e != hipSuccess) fprintf(stderr, "cooperative launch failed: %s (grid %d)\n", hipGetErrorString(e), grid);
#else
    for (int ph = 0; ph < N_PHASES; ++ph) { p.ph_lo = ph; p.ph_hi = ph + 1; hipLaunchKernelGGL(fwd_kernel, dim3(grid), dim3(512), LDS_BYTES, stream, p); }
#endif
}
```

```cpp
#include <hip/hip_runtime.h>
#include <hip/hip_cooperative_groups.h>
#include <cstdio>
#include <cstdint>
namespace cg = cooperative_groups;

#ifndef FAST_P1
#define FAST_P1 1
#endif
#ifndef PROBE_MASK
#define PROBE_MASK 0
#endif
#ifndef FAST_P2
#define FAST_P2 1
#endif
#ifndef FAST_DENSE
#define FAST_DENSE 1
#endif
#ifndef FAST_XATT
#define FAST_XATT 1
#endif
#ifndef FAST_MOE
#define FAST_MOE 1
#endif
#ifndef MK_N_LAUNCHES
#define MK_N_LAUNCHES 1
#endif

typedef unsigned short bf16;
typedef float f32x4 __attribute__((ext_vector_type(4)));
typedef unsigned u32x4 __attribute__((ext_vector_type(4)));
typedef unsigned u32x2 __attribute__((ext_vector_type(2)));

constexpr int BATCH = 2, SEQ = 8192, D = 1024, T = BATCH * SEQ, MEM = 256, NMEM = BATCH * MEM;
constexpr int CONV_CH = 512, CONV_W = 31, NH = 8, NKV = 2, HD = 64, ATTN_W = 512, KV_W = 128, WINDOW = 128;
constexpr int D_IN = 1792, MH = 4, MHD = 256, NG = 4, EPG = 4, NE = 16, DE = 512;
constexpr float ALPHA = 1.189207115002721f, LN_EPS = 1e-5f;
constexpr int NPAIR = 2 * T, NPAIR_PAD = NPAIR + NE * 256;
constexpr int LDS_BYTES_K = 147456;

constexpr size_t MiB = 1u << 20;
constexpr size_t WS_CTL = 0;
constexpr size_t WS_ROUTE = 1 * MiB;
constexpr size_t WS_BLKCNT = 1 * MiB + 512 * 1024;
constexpr size_t WS_SEG = 1 * MiB + 640 * 1024;
constexpr size_t WS_RANK = 2 * MiB;
constexpr size_t WS_PTOK = 2 * MiB + 256 * 1024;
constexpr size_t WS_PGATE = 2 * MiB + 512 * 1024;
constexpr size_t WS_TOKPOS = 2 * MiB + 768 * 1024;
constexpr size_t WS_KMEM = 3 * MiB;
constexpr size_t WS_VMEMT = 4 * MiB;
constexpr size_t WS_MEMB = 5 * MiB;
constexpr size_t WS_A = 8 * MiB;
constexpr size_t WS_B = 48 * MiB;
constexpr size_t WS_DD = 88 * MiB;
constexpr size_t WS_WIN = 164 * MiB;
constexpr size_t WS_WOUT = 168 * MiB, WS_WMQ = 170 * MiB, WS_WMKV = 172 * MiB, WS_WMO = 176 * MiB;
constexpr size_t WS_WGU = 178 * MiB;
constexpr size_t WS_WDN = 210 * MiB;
constexpr size_t WS_END = 226 * MiB;

struct Params { const float* in[26]; float* out; unsigned char* ws; int ph_lo, ph_hi; };

__device__ __forceinline__ unsigned f2bf(float f) { unsigned u = __builtin_bit_cast(unsigned, f); return (u + 0x7fffu + ((u >> 16) & 1u)) >> 16; }
__device__ __forceinline__ float bf2f(bf16 b) { return __builtin_bit_cast(float, (unsigned)b << 16); }
__device__ __forceinline__ unsigned pk2(float lo, float hi) { return f2bf(lo) | (f2bf(hi) << 16); }
__device__ __forceinline__ float wave_sum(float v) {
#pragma unroll
    for (int o = 1; o < 64; o <<= 1) v += __shfl_xor(v, o);
    return v;
}
__device__ __forceinline__ float wave_max(float v) {
#pragma unroll
    for (int o = 1; o < 64; o <<= 1) v = fmaxf(v, __shfl_xor(v, o));
    return v;
}
__device__ __forceinline__ float ldA(const bf16* p) { return bf2f(*p); }
__device__ __forceinline__ float ldA(const float* p) { return *p; }

template <int NB, class FA, class FB, class FE>
__device__ __forceinline__ void ngemm_tile(float* lds, int K, int m0, int n0, FA fa, FB fb, FE fe) {
    float* As = lds;
    float* Bs = lds + 16 * 132;
    int tid = threadIdx.x; asm volatile("" : "+v"(tid));
    const int ty = tid >> 4, tx = tid & 15;
    float acc[NB][4][4];
#pragma unroll
    for (int b = 0; b < NB; ++b)
#pragma unroll
        for (int i = 0; i < 4; ++i)
#pragma unroll
            for (int j = 0; j < 4; ++j) acc[b][i][j] = 0.f;
    for (int k0 = 0; k0 < K; k0 += 16) {
        { const int r = tid >> 2, kk = (tid & 3) * 4;
#pragma unroll
            for (int i = 0; i < 4; ++i) As[(kk + i) * 132 + r] = fa(m0 + r, k0 + kk + i); }
#pragma unroll
        for (int b = 0; b < NB; ++b) { const int kk = tid >> 5, nn = (tid & 31) * 2;
            Bs[(b * 16 + kk) * 68 + nn] = fb(b, k0 + kk, n0 + nn); Bs[(b * 16 + kk) * 68 + nn + 1] = fb(b, k0 + kk, n0 + nn + 1); }
        __syncthreads();
#pragma unroll 4
        for (int k = 0; k < 16; ++k) {
            const f32x4 a = *(const f32x4*)&As[k * 132 + ty * 4];
#pragma unroll
            for (int b = 0; b < NB; ++b) { const f32x4 bb = *(const f32x4*)&Bs[(b * 16 + k) * 68 + tx * 4];
#pragma unroll
                for (int i = 0; i < 4; ++i)
#pragma unroll
                    for (int j = 0; j < 4; ++j) acc[b][i][j] += a[i] * bb[j]; }
        }
        __syncthreads();
    }
#pragma unroll
    for (int i = 0; i < 4; ++i)
#pragma unroll
        for (int j = 0; j < 4; ++j) fe(m0 + ty * 4 + i, n0 + tx * 4 + j, acc[0][i][j], acc[NB - 1][i][j]);
}

__device__ __forceinline__ void ln_row(const float* src, const float* g, const float* b, f32x4 (&v)[4], int lane) {
    const f32x4* xr = (const f32x4*)src + lane; float s = 0.f;
#pragma unroll
    for (int j = 0; j < 4; ++j) { v[j] = xr[64 * j]; s += (v[j].x + v[j].y) + (v[j].z + v[j].w); }
    const float mean = wave_sum(s) * (1.f / D); float s2 = 0.f;
#pragma unroll
    for (int j = 0; j < 4; ++j) { v[j] = v[j] - mean; s2 += (v[j].x * v[j].x + v[j].y * v[j].y) + (v[j].z * v[j].z + v[j].w * v[j].w); }
    const float rstd = 1.f / sqrtf(wave_sum(s2) * (1.f / D) + LN_EPS);
#pragma unroll
    for (int j = 0; j < 4; ++j) { const f32x4 gg = ((const f32x4*)g)[lane + 64 * j], bb = ((const f32x4*)b)[lane + 64 * j]; v[j] = v[j] * rstd * gg + bb; }
}
__device__ __forceinline__ void st_row_f32(float* dst, const f32x4 (&v)[4], float scale, int lane) {
#pragma unroll
    for (int j = 0; j < 4; ++j) ((f32x4*)dst)[lane + 64 * j] = v[j] * scale;
}
__device__ __forceinline__ void st_row_bf16(bf16* dst, const f32x4 (&v)[4], int lane) {
#pragma unroll
    for (int j = 0; j < 4; ++j) { u32x2 w; w.x = pk2(v[j].x, v[j].y); w.y = pk2(v[j].z, v[j].w); ((u32x2*)dst)[lane + 64 * j] = w; }
}


namespace pg8 {
#define PG8_LAS __attribute__((address_space(3)))
typedef unsigned short bf16_t;
typedef short bf16x8 __attribute__((ext_vector_type(8)));
constexpr int BM = 256, BK = 64, HALF = 128, HTB = HALF * BK * 2, STAGE_BYTES = 8 * HTB, NXCD = 8, WGM = 8;
__device__ __forceinline__ int lds_byte(int r, int c) { const int st = (r >> 4) * 2 + (c >> 5), rr = r & 15, cc = c & 31, ob = rr * 64 + cc * 2; return st * 1024 + (ob ^ (((ob >> 9) & 1) << 5)); }
__device__ __forceinline__ void stage_rc(int b, int& R, int& C) { const int st = b / 1024, sb = b % 1024, swz = sb ^ (((sb >> 9) & 1) << 5); R = (st >> 1) * 16 + swz / 64; C = (st & 1) * 32 + (swz % 64) / 2; }
__device__ __forceinline__ int perm32(int rho) { const int n = rho >> 4, i = rho & 15; return 8 * (i >> 2) + 4 * n + (i & 3); }
struct Unit { const char* A; const char* B; int pm, pn, kind, aux; };
struct Gemm { int lda, ldb, K; };
__device__ __forceinline__ void tile_of(int L, int nM, int nN, int& pm, int& pn) {
    const int nwg = nM * nN; int wgid = L; { const int q = nwg / NXCD, r = nwg % NXCD, xcd = wgid % NXCD, off = wgid / NXCD; wgid = (xcd < r ? xcd * (q + 1) : r * (q + 1) + (xcd - r) * q) + off; }
    const int nig = WGM * nN, gid = wgid / nig, fm = gid * WGM, gsz = (nM - fm) < WGM ? (nM - fm) : WGM;
    pm = fm + ((wgid % nig) % gsz); pn = (wgid % nig) / gsz;
}
__device__ __forceinline__ unsigned cvt_pk_bf16(float lo, float hi) { unsigned r; asm volatile("v_cvt_pk_bf16_f32 %0, %1, %2" : "=v"(r) : "v"(lo), "v"(hi)); return r; }

template <class Epi, class Sched>
__device__ __forceinline__ void gemm_phase(PG8_LAS unsigned char* lds, const Gemm g, const Sched& S, const Epi& E) {
    int tid = threadIdx.x; asm volatile("" : "+v"(tid));
    const int wid = __builtin_amdgcn_readfirstlane(tid >> 6), lane = tid & 63, wr = wid >> 2, wc = wid & 3, fr = lane & 15, fq = lane >> 4;
    const int K = g.K, nt = K / BK;
    unsigned voffA[2], voffB[2];
#pragma unroll
    for (int i = 0; i < 2; ++i) { int R, C; stage_rc(tid * 16 + i * 8192, R, C); const int Rb = Epi::PERM ? ((R & ~31) + perm32(R & 31)) : R;
        voffA[i] = (unsigned)(R * g.lda + C) * 2u; voffB[i] = (unsigned)(Rb * g.ldb + C) * 2u; }
    const size_t kstep = (size_t)(BK * 2);
    const size_t hstepA = (size_t)HALF * g.lda * 2, hstepB = (size_t)HALF * g.ldb * 2;
    const unsigned ldsw = (unsigned)wid * 1024u;
    const int aoff = lds_byte(wr * 64 + fr, fq * 8), boff = lds_byte(wc * 32 + fr, fq * 8);
#define PG8_SA(b, h) (((b) * 2 + (h)) * HTB)
#define PG8_SB(b, h) ((4 + (b) * 2 + (h)) * HTB)
#define PG8_STAGE(bufoff, gbase, voff) do { _Pragma("unroll") for (int _i = 0; _i < 2; ++_i) \
        __builtin_amdgcn_global_load_lds((const unsigned*)((const char*)(gbase) + (voff)[_i]), (PG8_LAS unsigned*)(lds + (bufoff) + ldsw + _i * 8192), 16, 0, 0); } while (0)
#define PG8_LDA(dst, b, h) do { _Pragma("unroll") for (int m = 0; m < 4; ++m) _Pragma("unroll") for (int k = 0; k < 2; ++k) dst[m][k] = *(const PG8_LAS bf16x8*)(lds + PG8_SA(b, h) + aoff + m * 2048 + k * 1024); } while (0)
#define PG8_LDB(dst, b, h) do { _Pragma("unroll") for (int n = 0; n < 2; ++n) _Pragma("unroll") for (int k = 0; k < 2; ++k) dst[n][k] = *(const PG8_LAS bf16x8*)(lds + PG8_SB(b, h) + boff + n * 2048 + k * 1024); } while (0)
#define PG8_MMA(ai, bj, At, Bt) do { __builtin_amdgcn_s_setprio(1); _Pragma("unroll") for (int m = 0; m < 4; ++m) _Pragma("unroll") for (int n = 0; n < 2; ++n) _Pragma("unroll") for (int k = 0; k < 2; ++k) \
        acc[ai][bj][m][n] = __builtin_amdgcn_mfma_f32_16x16x32_bf16(Bt[n][k], At[m][k], acc[ai][bj][m][n], 0, 0, 0); __builtin_amdgcn_s_setprio(0); } while (0)
#define PG8_WAIT_V(n) asm volatile("s_waitcnt vmcnt(" #n ")" ::: "memory")
#define PG8_WAIT_L(n) asm volatile("s_waitcnt lgkmcnt(" #n ")" ::: "memory")
#define PG8_BAR __builtin_amdgcn_s_barrier()
#define PG8_SCHED __builtin_amdgcn_sched_barrier(0)
    Unit cur, nxt; int ui = 0;
    if (!S.next(0, cur)) return;
    f32x4 acc[2][2][4][2];
#pragma unroll
    for (int a = 0; a < 2; ++a)
#pragma unroll
        for (int b = 0; b < 2; ++b)
#pragma unroll
            for (int m = 0; m < 4; ++m)
#pragma unroll
                for (int n = 0; n < 2; ++n) acc[a][b][m][n] = (f32x4){0.f, 0.f, 0.f, 0.f};
    bf16x8 At[4][2], B0[2][2], B1[2][2];
    const char* cA = cur.A; const char* cB = cur.B;
    PG8_STAGE(PG8_SB(0, 0), cB, voffB); PG8_STAGE(PG8_SB(0, 1), cB + hstepB, voffB); PG8_STAGE(PG8_SA(0, 0), cA, voffA); PG8_STAGE(PG8_SA(0, 1), cA + hstepA, voffA);
    if (wr == 1) PG8_BAR;
    PG8_WAIT_V(2); PG8_BAR;
    PG8_STAGE(PG8_SB(1, 0), cB + kstep, voffB); PG8_STAGE(PG8_SA(1, 0), cA + kstep, voffA); PG8_STAGE(PG8_SB(1, 1), cB + hstepB + kstep, voffB);
    PG8_WAIT_V(6); PG8_BAR;
    for (;;) {
        const bool has_next = S.next(ui + 1, nxt);
        const char* nA = has_next ? nxt.A : cA; const char* nB = has_next ? nxt.B : cB;
        for (int t = 0; t < nt; t += 2) {
            const bool last = (t == nt - 2);
            const char* a1 = cA + (size_t)(t + 1) * kstep;
            const char* a2 = last ? nA : cA + (size_t)(t + 2) * kstep; const char* b2 = last ? nB : cB + (size_t)(t + 2) * kstep;
            const char* a3 = a2 + kstep; const char* b3 = b2 + kstep;
            PG8_LDB(B0, 0, 0); PG8_LDB(B1, 0, 1); PG8_SCHED; PG8_LDA(At, 0, 0); PG8_STAGE(PG8_SA(1, 1), a1 + hstepA, voffA);
            PG8_WAIT_V(8); PG8_WAIT_L(0); PG8_BAR; PG8_MMA(0, 0, At, B0); PG8_MMA(0, 1, At, B1); PG8_BAR; PG8_SCHED;
            PG8_LDA(At, 0, 1); PG8_STAGE(PG8_SB(0, 0), b2, voffB); PG8_STAGE(PG8_SB(0, 1), b2 + hstepB, voffB); PG8_STAGE(PG8_SA(0, 0), a2, voffA);
            PG8_WAIT_V(8); PG8_WAIT_L(0); PG8_BAR; PG8_MMA(1, 0, At, B0); PG8_MMA(1, 1, At, B1); PG8_BAR; PG8_SCHED;
            PG8_LDB(B0, 1, 0); PG8_LDB(B1, 1, 1); PG8_SCHED; PG8_LDA(At, 1, 0); PG8_STAGE(PG8_SA(0, 1), a2 + hstepA, voffA);
            PG8_WAIT_V(8); PG8_WAIT_L(0); PG8_BAR; PG8_MMA(0, 0, At, B0); PG8_MMA(0, 1, At, B1); PG8_BAR; PG8_SCHED;
            PG8_LDA(At, 1, 1); PG8_STAGE(PG8_SB(1, 0), b3, voffB); PG8_STAGE(PG8_SB(1, 1), b3 + hstepB, voffB); PG8_STAGE(PG8_SA(1, 0), a3, voffA);
            PG8_WAIT_V(8); PG8_WAIT_L(0); PG8_BAR; PG8_MMA(1, 0, At, B0); PG8_MMA(1, 1, At, B1); PG8_BAR; PG8_SCHED;
        }
        if (wr == 0) PG8_BAR;
        E(acc, cur, wr, wc, fr, fq);
        if (!has_next) break;
#pragma unroll
        for (int a = 0; a < 2; ++a)
#pragma unroll
            for (int b = 0; b < 2; ++b)
#pragma unroll
                for (int m = 0; m < 4; ++m)
#pragma unroll
                    for (int n = 0; n < 2; ++n) acc[a][b][m][n] = (f32x4){0.f, 0.f, 0.f, 0.f};
        cur = nxt; cA = nA; cB = nB; ++ui;
        if (wr == 1) PG8_BAR;
    }
    PG8_WAIT_V(0);
    PG8_BAR;
#undef PG8_SA
#undef PG8_SB
#undef PG8_STAGE
#undef PG8_LDA
#undef PG8_LDB
#undef PG8_MMA
#undef PG8_WAIT_V
#undef PG8_WAIT_L
#undef PG8_BAR
#undef PG8_SCHED
}

__device__ __forceinline__ u32x4 pack8(const f32x4 v0, const f32x4 v1) { u32x4 w; w.x = cvt_pk_bf16(v0[0], v0[1]); w.y = cvt_pk_bf16(v0[2], v0[3]); w.z = cvt_pk_bf16(v1[0], v1[1]); w.w = cvt_pk_bf16(v1[2], v1[3]); return w; }
__device__ __forceinline__ float sigm(float g) { return __builtin_amdgcn_rcpf(1.f + __expf(-g)); }

struct EpiBf16 {
    static constexpr bool PERM = true;
    bf16_t* O; int ldc; const float* bias;
    __device__ __forceinline__ void operator()(const f32x4 (&acc)[2][2][4][2], const Unit& u, int wr, int wc, int fr, int fq) const {
        const int row0 = u.pm * BM + wr * 64 + fr, col0 = u.pn * BM + wc * 32 + 8 * fq;
        f32x4 bv[2][2];
#pragma unroll
        for (int bj = 0; bj < 2; ++bj)
#pragma unroll
            for (int n = 0; n < 2; ++n) bv[bj][n] = bias ? *(const f32x4*)(bias + col0 + bj * HALF + 4 * n) : (f32x4){0.f, 0.f, 0.f, 0.f};
#pragma unroll
        for (int ai = 0; ai < 2; ++ai)
#pragma unroll
            for (int m = 0; m < 4; ++m) { bf16_t* rowp = O + (size_t)(row0 + ai * HALF + m * 16) * ldc + col0;
#pragma unroll
                for (int bj = 0; bj < 2; ++bj) *(u32x4*)(rowp + bj * HALF) = pack8(acc[ai][bj][m][0] + bv[bj][0], acc[ai][bj][m][1] + bv[bj][1]); }
    }
};
struct EpiP1 {
    static constexpr bool PERM = true;
    bf16_t *hglu, *qkv, *kmem, *vmemT; const float* b_in;
    __device__ __forceinline__ void operator()(const f32x4 (&acc)[2][2][4][2], const Unit& u, int wr, int wc, int fr, int fq) const {
        if (u.kind == 0) {
            const int row0 = u.pm * BM + wr * 64 + fr, cb = u.pn * 128 + wc * 32 + 8 * fq;
            f32x4 ba[2], bg[2];
#pragma unroll
            for (int n = 0; n < 2; ++n) { ba[n] = *(const f32x4*)(b_in + cb + 4 * n); bg[n] = *(const f32x4*)(b_in + 512 + cb + 4 * n); }
#pragma unroll
            for (int ai = 0; ai < 2; ++ai)
#pragma unroll
                for (int m = 0; m < 4; ++m) { f32x4 h[2];
#pragma unroll
                    for (int n = 0; n < 2; ++n) { const f32x4 a = acc[ai][0][m][n] + ba[n], gt = acc[ai][1][m][n] + bg[n];
                        h[n] = (f32x4){a[0] * sigm(gt[0]), a[1] * sigm(gt[1]), a[2] * sigm(gt[2]), a[3] * sigm(gt[3])}; }
                    *(u32x4*)(hglu + (size_t)(row0 + ai * HALF + m * 16) * 512 + cb) = pack8(h[0], h[1]); }
        } else if (u.kind == 1) { EpiBf16 e{qkv - 1024, 768, b_in}; e(acc, u, wr, wc, fr, fq);
        } else if (u.kind == 2) { EpiBf16 e{kmem, 1024, nullptr}; e(acc, u, wr, wc, fr, fq);
        } else { EpiBf16 e{vmemT, 512, nullptr}; e(acc, u, wr, wc, fr, fq); }
    }
};
struct EpiResF32 {
    static constexpr bool PERM = false;
    const float* res; float* out; float alpha;
    __device__ __forceinline__ void operator()(const f32x4 (&acc)[2][2][4][2], const Unit& u, int wr, int wc, int fr, int fq) const {
        const int row0 = u.pm * BM + wr * 64 + fr, col0 = u.pn * BM + wc * 32 + 4 * fq;
#pragma unroll
        for (int ai = 0; ai < 2; ++ai)
#pragma unroll
            for (int m = 0; m < 4; ++m) { const size_t off = (size_t)(row0 + ai * HALF + m * 16) * 1024 + col0;
#pragma unroll
                for (int bj = 0; bj < 2; ++bj)
#pragma unroll
                    for (int n = 0; n < 2; ++n) { const f32x4 r = *(const f32x4*)(res + off + bj * HALF + n * 16); *(f32x4*)(out + off + bj * HALF + n * 16) = r * alpha + acc[ai][bj][m][n]; } }
    }
};
struct EpiSoftmax {
    static constexpr bool PERM = true;
    bf16_t* P; PG8_LAS float* xl;
    __device__ __forceinline__ void operator()(const f32x4 (&acc)[2][2][4][2], const Unit& u, int wr, int wc, int fr, int fq) const {
        const float sc = 0.0625f * 1.4426950408889634f;
#pragma unroll
        for (int ai = 0; ai < 2; ++ai)
#pragma unroll
            for (int m = 0; m < 4; ++m) { float mx = -INFINITY;
#pragma unroll
                for (int bj = 0; bj < 2; ++bj)
#pragma unroll
                    for (int n = 0; n < 2; ++n) { const f32x4 v = acc[ai][bj][m][n]; mx = fmaxf(mx, fmaxf(fmaxf(v[0], v[1]), fmaxf(v[2], v[3]))); }
                mx = fmaxf(mx, __shfl_xor(mx, 16)); mx = fmaxf(mx, __shfl_xor(mx, 32));
                float s = 0.f;
#pragma unroll
                for (int bj = 0; bj < 2; ++bj)
#pragma unroll
                    for (int n = 0; n < 2; ++n) { const f32x4 v = acc[ai][bj][m][n]; s += (__builtin_amdgcn_exp2f((v[0] - mx) * sc) + __builtin_amdgcn_exp2f((v[1] - mx) * sc)) + (__builtin_amdgcn_exp2f((v[2] - mx) * sc) + __builtin_amdgcn_exp2f((v[3] - mx) * sc)); }
                s += __shfl_xor(s, 16); s += __shfl_xor(s, 32);
                if (fq == 0) { PG8_LAS float* q = xl + ((ai * HALF + wr * 64 + m * 16 + fr) * 4 + wc) * 2; q[0] = mx; q[1] = s; } }
        asm volatile("s_waitcnt lgkmcnt(0)" ::: "memory"); __builtin_amdgcn_s_barrier(); asm volatile("" ::: "memory");
        const int row0 = u.pm * BM + wr * 64 + fr, col0 = u.pn * BM + wc * 32 + 8 * fq;
#pragma unroll
        for (int ai = 0; ai < 2; ++ai)
#pragma unroll
            for (int m = 0; m < 4; ++m) { const PG8_LAS f32x4* q = (const PG8_LAS f32x4*)(xl + (ai * HALF + wr * 64 + m * 16 + fr) * 8); const f32x4 q0 = q[0], q1 = q[1];
                const float M = fmaxf(fmaxf(q0[0], q0[2]), fmaxf(q1[0], q1[2]));
                const float S = (q0[1] * __builtin_amdgcn_exp2f((q0[0] - M) * sc) + q0[3] * __builtin_amdgcn_exp2f((q0[2] - M) * sc)) + (q1[1] * __builtin_amdgcn_exp2f((q1[0] - M) * sc) + q1[3] * __builtin_amdgcn_exp2f((q1[2] - M) * sc));
                const float inv = 1.f / S; bf16_t* rowp = P + (size_t)(row0 + ai * HALF + m * 16) * 1024 + col0;
#pragma unroll
                for (int bj = 0; bj < 2; ++bj) { f32x4 p[2];
#pragma unroll
                    for (int n = 0; n < 2; ++n) { const f32x4 v = acc[ai][bj][m][n];
                        p[n] = (f32x4){__builtin_amdgcn_exp2f((v[0] - M) * sc) * inv, __builtin_amdgcn_exp2f((v[1] - M) * sc) * inv, __builtin_amdgcn_exp2f((v[2] - M) * sc) * inv, __builtin_amdgcn_exp2f((v[3] - M) * sc) * inv}; }
                    *(u32x4*)(rowp + bj * HALF) = pack8(p[0], p[1]); } }
        asm volatile("s_waitcnt lgkmcnt(0)" ::: "memory"); __builtin_amdgcn_s_barrier(); asm volatile("" ::: "memory");
    }
};
struct EpiGateUp {
    static constexpr bool PERM = true;
    bf16_t* Hs; const float* pair_gate;
    __device__ __forceinline__ void operator()(const f32x4 (&acc)[2][2][4][2], const Unit& u, int wr, int wc, int fr, int fq) const {
        const int row0 = u.pm * BM + wr * 64 + fr, cb = u.pn * 128 + wc * 32 + 8 * fq;
#pragma unroll
        for (int ai = 0; ai < 2; ++ai)
#pragma unroll
            for (int m = 0; m < 4; ++m) { const int row = row0 + ai * HALF + m * 16; const float pg = pair_gate[row]; f32x4 h[2];
#pragma unroll
                for (int n = 0; n < 2; ++n) { const f32x4 gt = acc[ai][0][m][n], up = acc[ai][1][m][n];
                    h[n] = (f32x4){gt[0] * sigm(gt[0]) * up[0] * pg, gt[1] * sigm(gt[1]) * up[1] * pg, gt[2] * sigm(gt[2]) * up[2] * pg, gt[3] * sigm(gt[3]) * up[3] * pg}; }
                if (pg == 0.f) { h[0] = (f32x4){0.f, 0.f, 0.f, 0.f}; h[1] = h[0]; }
                *(u32x4*)(Hs + (size_t)row * 512 + cb) = pack8(h[0], h[1]); }
    }
};
struct EpiDown {
    static constexpr bool PERM = false;
    float* out; const int* pair_tok;
    __device__ __forceinline__ void operator()(const f32x4 (&acc)[2][2][4][2], const Unit& u, int wr, int wc, int fr, int fq) const {
        const int row0 = u.pm * BM + wr * 64 + fr, col0 = u.pn * BM + wc * 32 + 4 * fq;
#pragma unroll
        for (int ai = 0; ai < 2; ++ai)
#pragma unroll
            for (int m = 0; m < 4; ++m) { const int tok = pair_tok[row0 + ai * HALF + m * 16];
                if (tok >= 0) { float* rp = out + (size_t)tok * 1024 + col0;
#pragma unroll
                    for (int bj = 0; bj < 2; ++bj)
#pragma unroll
                        for (int n = 0; n < 2; ++n)
#pragma unroll
                            for (int i = 0; i < 4; ++i) unsafeAtomicAdd(rp + bj * HALF + n * 16 + i, acc[ai][bj][m][n][i]); } }
    }
};
struct DenseSched {
    const char* A; const char* B; int nM, nN, G, c; size_t strideA, strideB;
    __device__ __forceinline__ bool next(int i, Unit& u) const { const int L = i * G + c; if (L >= nM * nN) return false; tile_of(L, nM, nN, u.pm, u.pn); u.A = A + (size_t)u.pm * strideA; u.B = B + (size_t)u.pn * strideB; u.kind = 0; u.aux = 0; return true; }
};
}


#define LAS __attribute__((address_space(3)))
__device__ __forceinline__ void transpose_item(const float* W, int N, bf16* WT, int Kd, int k0, int n0, int drow0, LAS float* scr, int lane) {
#pragma unroll 8
    for (int i = 0; i < 32; ++i) { const int kk = 2 * i + (lane >> 5); scr[kk * 33 + (lane & 31)] = W[(size_t)(k0 + kk) * N + n0 + (lane & 31)]; }
    asm volatile("s_waitcnt lgkmcnt(0)" ::: "memory");
    const int c = lane & 7;
#pragma unroll
    for (int j = 0; j < 4; ++j) { const int n = (lane >> 3) + 8 * j; const LAS float* sp = scr + (8 * c) * 33 + n;
        u32x4 o; o.x = pk2(sp[0 * 33], sp[1 * 33]); o.y = pk2(sp[2 * 33], sp[3 * 33]); o.z = pk2(sp[4 * 33], sp[5 * 33]); o.w = pk2(sp[6 * 33], sp[7 * 33]);
        *(u32x4*)(WT + (size_t)(drow0 + n) * Kd + k0 + 8 * c) = o; }
    asm volatile("s_waitcnt lgkmcnt(0)" ::: "memory");
}


typedef short bf16x8v __attribute__((ext_vector_type(8)));
__device__ __forceinline__ float bflo(unsigned v) { return __builtin_bit_cast(float, v << 16); }
__device__ __forceinline__ float bfhi(unsigned v) { return __builtin_bit_cast(float, v & 0xffff0000u); }

__device__ __forceinline__ void conv_unit(unsigned char* lds, const bf16* hglu, const float* w_dw, const float* b_dw, const float* g_cn, const float* b_cn, bf16* ycat, int cu) {
    int tid = threadIdx.x; asm volatile("" : "+v"(tid));
    const int lane = tid & 63, wave = tid >> 6;
    bf16* hin = (bf16*)lds; float* cout = (float*)(lds + 63488);
    const int t0 = cu * 32, s0 = t0 % SEQ;
    for (int c = tid; c < 62 * 64; c += 512) { const int row = c >> 6, part = c & 63; u32x4 v = (u32x4){0u, 0u, 0u, 0u};
        if (s0 - 30 + row >= 0) v = *(const u32x4*)(hglu + (size_t)(t0 - 30 + row) * 512 + part * 8);
        *(u32x4*)(hin + row * 512 + part * 8) = v; }
    __syncthreads();
    {
        const int cp = tid & 255, th = tid >> 8;
        float w0[CONV_W], w1[CONV_W];
#pragma unroll
        for (int j = 0; j < CONV_W; ++j) { const float2 ww = *(const float2*)(w_dw + j * CONV_CH + 2 * cp); w0[j] = ww.x; w1[j] = ww.y; }
        const float2 bb = *(const float2*)(b_dw + 2 * cp);
#pragma unroll 1
        for (int grp = 0; grp < 2; ++grp) { const int tt0 = th * 16 + grp * 8;
            float a0[8], a1[8];
#pragma unroll
            for (int o = 0; o < 8; ++o) { a0[o] = bb.x; a1[o] = bb.y; }
#pragma unroll
            for (int r = 0; r < 38; ++r) { const unsigned v = *(const unsigned*)(hin + (tt0 + r) * 512 + 2 * cp); const float lo = bflo(v), hi = bfhi(v);
#pragma unroll
                for (int o = 0; o < 8; ++o) { const int j = r - o; if (j >= 0 && j < CONV_W) { a0[o] += w0[j] * lo; a1[o] += w1[j] * hi; } } }
#pragma unroll
            for (int o = 0; o < 8; ++o) *(float2*)(cout + (tt0 + o) * 512 + 2 * cp) = make_float2(a0[o], a1[o]);
        }
    }
    __syncthreads();
    {
        const f32x4 g0 = *(const f32x4*)(g_cn + 8 * lane), g1 = *(const f32x4*)(g_cn + 8 * lane + 4), c0 = *(const f32x4*)(b_cn + 8 * lane), c1 = *(const f32x4*)(b_cn + 8 * lane + 4);
#pragma unroll 1
        for (int i = 0; i < 4; ++i) { const int tt = wave * 4 + i;
            f32x4 v0 = *(const f32x4*)(cout + tt * 512 + 8 * lane), v1 = *(const f32x4*)(cout + tt * 512 + 8 * lane + 4);
            const float mean = wave_sum((v0.x + v0.y) + (v0.z + v0.w) + (v1.x + v1.y) + (v1.z + v1.w)) * (1.f / 512.f);
            v0 = v0 - mean; v1 = v1 - mean;
            const float var = wave_sum((v0.x * v0.x + v0.y * v0.y) + (v0.z * v0.z + v0.w * v0.w) + (v1.x * v1.x + v1.y * v1.y) + (v1.z * v1.z + v1.w * v1.w)) * (1.f / 512.f);
            const float rstd = 1.f / sqrtf(var + LN_EPS);
            f32x4 y0 = v0 * rstd * g0 + c0, y1 = v1 * rstd * g1 + c1;
#pragma unroll
            for (int e = 0; e < 4; ++e) { y0[e] = y0[e] * pg8::sigm(y0[e]); y1[e] = y1[e] * pg8::sigm(y1[e]); }
            *(u32x4*)(ycat + (size_t)(t0 + tt) * 1024 + 8 * lane) = pg8::pack8(y0, y1); }
    }
    __syncthreads();
}

__device__ __forceinline__ void swa_unit(unsigned char* lds, const bf16* qkv, const float* sinks, bf16* ycat, int b, int kvh, int qb) {
    int tid = threadIdx.x; asm volatile("" : "+v"(tid));
    const int lane = tid & 63, wave = tid >> 6, q4 = lane >> 4, c16 = lane & 15;
    bf16* Ks = (bf16*)lds; bf16* VT = (bf16*)(lds + 36864);
    const long t0 = (long)b * SEQ + (long)qb * 128, tk0 = t0 - 128;
#pragma unroll
    for (int i = 0; i < 4; ++i) { const int c = tid + 512 * i, row = c >> 3, part = c & 7; const bool ok = (qb > 0) || (row >= 128);
        u32x4 kv = (u32x4){0u, 0u, 0u, 0u}, vv = kv;
        if (ok) { const bf16* rp = qkv + (tk0 + row) * 768 + 512 + kvh * 64 + part * 8; kv = *(const u32x4*)rp; vv = *(const u32x4*)(rp + 128); }
        *(u32x4*)(Ks + row * 72 + part * 8) = kv;
#pragma unroll
        for (int e = 0; e < 4; ++e) { VT[(part * 8 + 2 * e) * 264 + row] = (bf16)(vv[e] & 0xffffu); VT[(part * 8 + 2 * e + 1) * 264 + row] = (bf16)(vv[e] >> 16); } }
    __syncthreads();
    const int g = wave >> 1, hq = kvh * 4 + g, i0 = (wave & 1) * 64;
    const float L2E = 1.4426950408889634f, sc = 0.125f * L2E, sink2 = sinks[hq] * L2E;
#pragma unroll 1
    for (int qt = 0; qt < 4; ++qt) {
        const int iq = i0 + qt * 16, kt0 = iq >> 4, iqc = iq + c16;
        const bf16* qp = qkv + (t0 + iqc) * 768 + hq * 64 + 8 * q4;
        const bf16x8v Q0 = *(const bf16x8v*)qp, Q1 = *(const bf16x8v*)(qp + 32);
        f32x4 sv[9];
#pragma unroll
        for (int kt = 0; kt < 9; ++kt) { const bf16* kp = Ks + ((kt0 + kt) * 16 + c16) * 72 + 8 * q4;
            f32x4 a = (f32x4){0.f, 0.f, 0.f, 0.f};
            a = __builtin_amdgcn_mfma_f32_16x16x32_bf16(*(const bf16x8v*)kp, Q0, a, 0, 0, 0);
            a = __builtin_amdgcn_mfma_f32_16x16x32_bf16(*(const bf16x8v*)(kp + 32), Q1, a, 0, 0, 0);
            sv[kt] = a; }
        float mx = sink2;
#pragma unroll
        for (int kt = 0; kt < 9; ++kt)
#pragma unroll
            for (int r = 0; r < 4; ++r) { const int j = (kt0 + kt) * 16 + 4 * q4 + r; const bool ok = (j > iqc) && (j <= iqc + 128) && (qb > 0 || j >= 128);
                const float v = ok ? sv[kt][r] * sc : -INFINITY; sv[kt][r] = v; mx = fmaxf(mx, v); }
        mx = fmaxf(mx, __shfl_xor(mx, 16)); mx = fmaxf(mx, __shfl_xor(mx, 32));
        float sum = 0.f;
#pragma unroll
        for (int kt = 0; kt < 9; ++kt)
#pragma unroll
            for (int r = 0; r < 4; ++r) { const float pv = __builtin_amdgcn_exp2f(sv[kt][r] - mx); sv[kt][r] = pv; sum += pv; }
        sum += __shfl_xor(sum, 16); sum += __shfl_xor(sum, 32);
        sum += __builtin_amdgcn_exp2f(sink2 - mx);
        const float inv = 1.f / sum;
        f32x4 o[4];
#pragma unroll
        for (int dt = 0; dt < 4; ++dt) o[dt] = (f32x4){0.f, 0.f, 0.f, 0.f};
#pragma unroll
        for (int pp = 0; pp < 5; ++pp) { const int T0 = kt0 + 2 * pp, T1 = (pp < 4) ? T0 + 1 : T0;
            const f32x4 pa = sv[2 * pp], pb = (pp < 4) ? sv[2 * pp + 1] : (f32x4){0.f, 0.f, 0.f, 0.f};
            const u32x4 pw = pg8::pack8(pa, pb); const bf16x8v Bp = __builtin_bit_cast(bf16x8v, pw);
#pragma unroll
            for (int dt = 0; dt < 4; ++dt) { const bf16* vp = VT + (dt * 16 + c16) * 264 + 4 * q4;
                const u32x2 lo = *(const u32x2*)(vp + T0 * 16), hi = *(const u32x2*)(vp + T1 * 16);
                const u32x4 aw = (u32x4){lo.x, lo.y, hi.x, hi.y};
                o[dt] = __builtin_amdgcn_mfma_f32_16x16x32_bf16(__builtin_bit_cast(bf16x8v, aw), Bp, o[dt], 0, 0, 0); } }
        bf16* op = ycat + (t0 + iqc) * 1024 + 512 + hq * 64 + 4 * q4;
#pragma unroll
        for (int dt = 0; dt < 4; ++dt) { u32x2 w; w.x = pg8::cvt_pk_bf16(o[dt][0] * inv, o[dt][1] * inv); w.y = pg8::cvt_pk_bf16(o[dt][2] * inv, o[dt][3] * inv); *(u32x2*)(op + dt * 16) = w; }
    }
    __syncthreads();
}


#define XB_TMO      128
#define XB_XCNT(j)  (256  + 64 * (j))
#define XB_XSUB(j)  (1280 + 64 * (j))
#define XB_XGEN(j)  (2304 + 64 * (j))
#define XB_TOP      3328
#define XB_TOPGEN   3392
#define XCD_BAR_WORDS 3456
#define XB_SPIN_CAP (1u << 20)
__device__ __forceinline__ unsigned xb_ld(unsigned* p)              { return __hip_atomic_load(p, __ATOMIC_RELAXED, __HIP_MEMORY_SCOPE_AGENT); }
__device__ __forceinline__ unsigned xb_add(unsigned* p, unsigned v) { return __hip_atomic_fetch_add(p, v, __ATOMIC_RELAXED, __HIP_MEMORY_SCOPE_AGENT); }
__device__ __forceinline__ unsigned xb_xcc_id() { return (unsigned)__builtin_amdgcn_s_getreg((3 << 11) | 20) & 0xFu; }
#define XB_SPIN(cond, bar) do { unsigned _sp = 0; while (cond) { __builtin_amdgcn_s_sleep(1); \
    if ((++_sp & 255u) == 0u) { if (xb_ld(&(bar)[XB_TMO])) break; if (_sp > XB_SPIN_CAP) { atomicAdd(&(bar)[XB_TMO], 1u); break; } } } } while (0)
struct XcdBarrier { unsigned* bar; unsigned x; volatile __attribute__((address_space(3))) unsigned* st; };
__device__ __forceinline__ XcdBarrier xcd_barrier_post(unsigned* bar, volatile __attribute__((address_space(3))) unsigned* st) {
    XcdBarrier b; b.bar = bar; b.x = xb_xcc_id(); b.st = st;
    if (threadIdx.x == 0) (void)xb_add(&bar[XB_XCNT(b.x)], 1u);
    return b;
}
__device__ __forceinline__ void xcd_barrier_complete(unsigned* bar, unsigned x, unsigned& nloc, unsigned& nx) {
    const unsigned G = gridDim.x * gridDim.y * gridDim.z;
    unsigned sum, cnt, mine, sp = 0u;
    for (;;) {
        sum = 0u; cnt = 0u; mine = 0u;
#pragma unroll
        for (unsigned j = 0; j < 16; ++j) { const unsigned c = xb_ld(&bar[XB_XCNT(j)]); sum += c; cnt += (c > 0u) ? 1u : 0u; mine = (j == x) ? c : mine; }
        if (sum == G) break;
        __builtin_amdgcn_s_sleep(1);
        if ((++sp & 255u) == 0u) { if (xb_ld(&bar[XB_TMO])) break; if (sp > XB_SPIN_CAP) { atomicAdd(&bar[XB_TMO], 1u); break; } }
    }
    nloc = mine > 0u ? mine : 1u; nx = cnt > 0u ? cnt : 1u;
}
__device__ __forceinline__ void xcd_barrier(const XcdBarrier& b) {
    asm volatile("s_waitcnt vmcnt(0)" ::: "memory");
    __syncthreads();
    if (threadIdx.x == 0) {
        unsigned* bar = b.bar;
        __builtin_amdgcn_s_waitcnt(0);
        unsigned nloc = b.st[0], nx = b.st[1];
        if (nloc == 0u) { xcd_barrier_complete(bar, b.x, nloc, nx); b.st[0] = nloc; b.st[1] = nx; }
        const unsigned old = xb_add(&bar[XB_XSUB(b.x)], 1u);
        const unsigned gen = old / nloc;
        if (old + 1u == (gen + 1u) * nloc) {
            __builtin_amdgcn_fence(__ATOMIC_RELEASE, "agent");
            asm volatile("s_waitcnt vmcnt(0)" ::: "memory");
            const unsigned og = xb_add(&bar[XB_TOP], 1u);
            const unsigned tg = og / nx;
            if (og + 1u == (tg + 1u) * nx) xb_add(&bar[XB_TOPGEN], 1u);
            else XB_SPIN(xb_ld(&bar[XB_TOPGEN]) == tg, bar);
            __builtin_amdgcn_fence(__ATOMIC_ACQUIRE, "agent");
            xb_add(&bar[XB_XGEN(b.x)], 1u);
            asm volatile("s_waitcnt vmcnt(0)" ::: "memory");
        } else {
            XB_SPIN(xb_ld(&bar[XB_XGEN(b.x)]) == gen, bar);
            __builtin_amdgcn_fence(__ATOMIC_ACQUIRE, "agent");
            asm volatile("s_waitcnt vmcnt(0)" ::: "memory");
        }
    }
    __syncthreads();
}

struct SchedMoE { const char* A; const char* W; const int* seg; int nmt, nN, G, c; size_t strideA, strideE, strideN;
    __device__ __forceinline__ bool next(int i, pg8::Unit& u) const { const int L = i * G + c; if (L >= nmt * nN) return false; pg8::tile_of(L, nmt, nN, u.pm, u.pn); int e = 0;
#pragma unroll
        for (int j = 1; j < 16; ++j) if (u.pm * 256 >= seg[j]) e = j;
        u.kind = 0; u.aux = e; u.A = A + (size_t)u.pm * strideA; u.B = W + (size_t)e * strideE + (size_t)u.pn * strideN; return true; } };

__global__ void __launch_bounds__(512, 2) fwd_kernel(Params p) {
    extern __shared__ __attribute__((aligned(16))) unsigned char lds_raw[];
    float* ldsf = (float*)lds_raw;
    cg::grid_group grid = cg::this_grid();
    const int G = gridDim.x, bid = blockIdx.x, NGW = G * 8;
    unsigned char* ws = p.ws;
    const float *x = p.in[0], *mem = p.in[1], *w_in = p.in[2], *b_in = p.in[3], *w_dw = p.in[4], *b_dw = p.in[5], *g_cn = p.in[6], *b_cn = p.in[7], *sinks = p.in[8],
                *w_out = p.in[9], *g_ln1 = p.in[10], *b_ln1 = p.in[11], *w_mq = p.in[12], *w_mkv = p.in[13], *w_mo = p.in[14], *g_ln2 = p.in[15], *b_ln2 = p.in[16],
                *w_group = p.in[17], *b_group = p.in[18], *w_router = p.in[19], *b_router = p.in[20], *w_gate = p.in[21], *w_up = p.in[22], *w_down = p.in[23],
                *g_ln3 = p.in[24], *b_ln3 = p.in[25];
    float* out = p.out;
    bf16* xb = (bf16*)(ws + WS_A); bf16* ycat = (bf16*)(ws + WS_A); bf16* qm = (bf16*)(ws + WS_A); bf16* om = (bf16*)(ws + WS_A); bf16* Hs = (bf16*)(ws + WS_A);
    bf16* hglu = (bf16*)(ws + WS_B); bf16* qkv = (bf16*)(ws + WS_B + (size_t)T * 512 * 2); bf16* x1b = (bf16*)(ws + WS_B); bf16* Pb = (bf16*)(ws + WS_B); bf16* x2b = (bf16*)(ws + WS_B);
    float* Sbuf = (float*)(ws + WS_DD); bf16* Xs = (bf16*)(ws + WS_DD);
    bf16* kmem = (bf16*)(ws + WS_KMEM); bf16* vmemT = (bf16*)(ws + WS_VMEMT); bf16* memb = (bf16*)(ws + WS_MEMB);
    bf16* Wt_in = (bf16*)(ws + WS_WIN); bf16* Wt_out = (bf16*)(ws + WS_WOUT); bf16* Wt_mq = (bf16*)(ws + WS_WMQ); bf16* Wt_mkv = (bf16*)(ws + WS_WMKV); bf16* Wt_mo = (bf16*)(ws + WS_WMO);
    bf16* Wt_gu = (bf16*)(ws + WS_WGU); bf16* Wt_dn = (bf16*)(ws + WS_WDN);
    PG8_LAS unsigned char* ldsp = (PG8_LAS unsigned char*)lds_raw;
    int* route_e = (int*)(ws + WS_ROUTE); float* route_g = (float*)(ws + WS_ROUTE + (size_t)T * 8);
    int* blkcnt = (int*)(ws + WS_BLKCNT); int* segw = (int*)(ws + WS_SEG); int* rank = (int*)(ws + WS_RANK);
    int* pair_tok = (int*)(ws + WS_PTOK); float* pair_gate = (float*)(ws + WS_PGATE); int* tokpos = (int*)(ws + WS_TOKPOS); bf16* Yb = (bf16*)(ws + WS_DD);

    const int lo = p.ph_lo, hi = p.ph_hi;
    int ph = 0;
    volatile __attribute__((address_space(3))) unsigned* bst = (volatile __attribute__((address_space(3))) unsigned*)(ldsp + LDS_BYTES_K - 64);
    if (threadIdx.x == 0) { bst[0] = 0u; bst[1] = 0u; }
    __syncthreads();
    const XcdBarrier xbar = xcd_barrier_post((unsigned*)(ws + WS_CTL), bst);
#define PHASE_BEGIN if (lo <= ph && ph < hi) { for (int rep_ = 0; rep_ < ((((unsigned)PROBE_MASK >> ph) & 1u) ? 2 : 1); ++rep_) { int tid = threadIdx.x; asm volatile("" : "+v"(tid)); const int lane = tid & 63, wave = tid >> 6, gw = bid * 8 + wave; (void)lane; (void)wave; (void)gw;
#define PHASE_END } } if (lo <= ph && ph + 1 < hi) { if (ph == 0) grid.sync(); else xcd_barrier(xbar); } ++ph;

    PHASE_BEGIN
    for (size_t i = (size_t)bid * 512 + tid; i < (size_t)T * D / 4; i += (size_t)G * 512) { const f32x4 v = ((const f32x4*)x)[i]; u32x2 w; w.x = pk2(v.x, v.y); w.y = pk2(v.z, v.w); ((u32x2*)xb)[i] = w; }
    for (size_t i = (size_t)bid * 512 + tid; i < (size_t)NMEM * D / 4; i += (size_t)G * 512) { const f32x4 v = ((const f32x4*)mem)[i]; u32x2 w; w.x = pk2(v.x, v.y); w.y = pk2(v.z, v.w); ((u32x2*)memb)[i] = w; }
    {
        LAS float* scr = (LAS float*)(ldsp + wave * 16384);
        constexpr int I_IN = 16 * 56, I_SQ = 16 * 32, I_KV = 16 * 64, I_EX = 16 * 256;
        constexpr int NITEMS = I_IN + 3 * I_SQ + I_KV + 3 * I_EX;
        for (int it = gw; it < NITEMS; it += NGW) { int r = it;
            if (r < I_IN) { const int kb = r / 56, nb = r % 56, n0 = nb * 32; const int dr = n0 < 512 ? (n0 >> 7) * 256 + (n0 & 127) : (n0 < 1024 ? ((n0 - 512) >> 7) * 256 + 128 + (n0 & 127) : n0);
                transpose_item(w_in, D_IN, Wt_in, 1024, kb * 64, n0, dr, scr, lane); continue; } r -= I_IN;
            if (r < I_SQ) { transpose_item(w_out, 1024, Wt_out, 1024, (r / 32) * 64, (r % 32) * 32, (r % 32) * 32, scr, lane); continue; } r -= I_SQ;
            if (r < I_SQ) { transpose_item(w_mq, 1024, Wt_mq, 1024, (r / 32) * 64, (r % 32) * 32, (r % 32) * 32, scr, lane); continue; } r -= I_SQ;
            if (r < I_SQ) { transpose_item(w_mo, 1024, Wt_mo, 1024, (r / 32) * 64, (r % 32) * 32, (r % 32) * 32, scr, lane); continue; } r -= I_SQ;
            if (r < I_KV) { transpose_item(w_mkv, 2048, Wt_mkv, 1024, (r / 64) * 64, (r % 64) * 32, (r % 64) * 32, scr, lane); continue; } r -= I_KV;
            if (r < I_EX) { const int e = r / 256, q = r % 256, n0 = (q % 16) * 32; transpose_item(w_gate + (size_t)e * D * DE, DE, Wt_gu + (size_t)e * 1024 * 1024, 1024, (q / 16) * 64, n0, (n0 >> 7) * 256 + (n0 & 127), scr, lane); continue; } r -= I_EX;
            if (r < I_EX) { const int e = r / 256, q = r % 256, n0 = (q % 16) * 32; transpose_item(w_up + (size_t)e * D * DE, DE, Wt_gu + (size_t)e * 1024 * 1024, 1024, (q / 16) * 64, n0, (n0 >> 7) * 256 + 128 + (n0 & 127), scr, lane); continue; } r -= I_EX;
            { const int e = r / 256, q = r % 256; transpose_item(w_down + (size_t)e * DE * D, D, Wt_dn + (size_t)e * 1024 * 512, 512, (q / 32) * 64, (q % 32) * 32, (q % 32) * 32, scr, lane); }
        }
    }
    PHASE_END

    PHASE_BEGIN
#if FAST_P1
    {
        struct SchedP1 { const char *xb, *win, *memb, *wkv; int G, c;
            __device__ __forceinline__ bool next(int i, pg8::Unit& u) const { const int L = i * G + c; u.aux = 0;
                if (L < 448) { pg8::tile_of(L, 64, 7, u.pm, u.pn); u.A = xb + (size_t)u.pm * 256 * 2048; u.B = win + (size_t)u.pn * 256 * 2048; u.kind = u.pn < 4 ? 0 : 1; return true; }
                if (L < 456) { const int r = L - 448; u.pm = r >> 2; u.pn = r & 3; u.A = memb + (size_t)u.pm * 256 * 2048; u.B = wkv + (size_t)u.pn * 256 * 2048; u.kind = 2; return true; }
                if (L < 464) { const int r = L - 456; u.pm = r >> 1; u.pn = r & 1; u.A = wkv + (size_t)(4 + u.pm) * 256 * 2048; u.B = memb + (size_t)u.pn * 256 * 2048; u.kind = 3; return true; }
                return false; } };
        const SchedP1 S{(const char*)xb, (const char*)Wt_in, (const char*)memb, (const char*)Wt_mkv, G, bid};
        const pg8::EpiP1 E{hglu, qkv, kmem, vmemT, b_in};
        pg8::gemm_phase(ldsp, pg8::Gemm{1024, 1024, 1024}, S, E);
    }
#else
    constexpr int U_GLU = 128 * 8, U_QKV = 128 * 12, U_KVM = 4 * 32;
    for (int u = bid; u < U_GLU + U_QKV + U_KVM; u += G) {
        if (u < U_GLU) { const int mt = u / 8, nt = u % 8;
            ngemm_tile<2>(ldsf, D, mt * 128, nt * 64,
                [&](int m, int k) { return bf2f(xb[(size_t)m * D + k]); },
                [&](int b, int k, int n) { return w_in[(size_t)k * D_IN + n + b * 512]; },
                [&](int m, int n, float a, float g) { a += b_in[n]; g += b_in[512 + n]; hglu[(size_t)m * 512 + n] = (bf16)f2bf(a / (1.f + __expf(-g))); });
        } else if (u < U_GLU + U_QKV) { const int r = u - U_GLU, mt = r / 12, nt = r % 12;
            ngemm_tile<1>(ldsf, D, mt * 128, nt * 64,
                [&](int m, int k) { return bf2f(xb[(size_t)m * D + k]); },
                [&](int b, int k, int n) { return w_in[(size_t)k * D_IN + 1024 + n]; },
                [&](int m, int n, float a, float) { qkv[(size_t)m * 768 + n] = (bf16)f2bf(a + b_in[1024 + n]); });
        } else { const int r = u - U_GLU - U_QKV, mt = r / 32, nt = r % 32;
            ngemm_tile<1>(ldsf, D, mt * 128, nt * 64,
                [&](int m, int k) { return bf2f(memb[(size_t)m * D + k]); },
                [&](int b, int k, int n) { return w_mkv[(size_t)k * 2048 + n]; },
                [&](int m, int n, float a, float) { if (n < 1024) kmem[(size_t)m * 1024 + n] = (bf16)f2bf(a); else vmemT[(size_t)(n - 1024) * 512 + m] = (bf16)f2bf(a); });
        }
    }
#endif
    PHASE_END

    PHASE_BEGIN
#if FAST_P2
    for (int cu = bid; cu < T / 32; cu += G) conv_unit(lds_raw, hglu, w_dw, b_dw, g_cn, b_cn, ycat, cu);
    for (int u = bid; u < BATCH * NKV * (SEQ / 128); u += G) swa_unit(lds_raw, qkv, sinks, ycat, u >> 7, (u >> 6) & 1, u & 63);
#else
    {
        float wreg[CONV_W];
#pragma unroll
        for (int j = 0; j < CONV_W; ++j) wreg[j] = w_dw[j * CONV_CH + tid];
        const float bdw = b_dw[tid];
        float* cbuf = ldsf;
        for (int it = bid; it < T / 16; it += G) {
            const int t0 = it * 16, s0 = t0 % SEQ;
            for (int tt = 0; tt < 16; ++tt) {
                float acc = bdw;
#pragma unroll
                for (int j = 0; j < CONV_W; ++j) { const int sp = s0 + tt - (CONV_W - 1) + j; if (sp >= 0) acc += wreg[j] * bf2f(hglu[(size_t)(t0 + tt - (CONV_W - 1) + j) * 512 + tid]); }
                cbuf[tt * 512 + tid] = acc;
            }
            __syncthreads();
            for (int r = wave; r < 16; r += 8) {
                f32x4 v[2]; float s = 0.f;
#pragma unroll
                for (int j = 0; j < 2; ++j) { v[j] = ((const f32x4*)(cbuf + r * 512))[lane + 64 * j]; s += (v[j].x + v[j].y) + (v[j].z + v[j].w); }
                const float mean = wave_sum(s) * (1.f / 512.f); float s2 = 0.f;
#pragma unroll
                for (int j = 0; j < 2; ++j) { v[j] = v[j] - mean; s2 += (v[j].x * v[j].x + v[j].y * v[j].y) + (v[j].z * v[j].z + v[j].w * v[j].w); }
                const float rstd = 1.f / sqrtf(wave_sum(s2) * (1.f / 512.f) + LN_EPS);
#pragma unroll
                for (int j = 0; j < 2; ++j) { const f32x4 gg = ((const f32x4*)g_cn)[lane + 64 * j], bb = ((const f32x4*)b_cn)[lane + 64 * j]; f32x4 y = v[j] * rstd * gg + bb;
                    y.x = y.x / (1.f + __expf(-y.x)); y.y = y.y / (1.f + __expf(-y.y)); y.z = y.z / (1.f + __expf(-y.z)); y.w = y.w / (1.f + __expf(-y.w));
                    u32x2 w; w.x = pk2(y.x, y.y); w.y = pk2(y.z, y.w); ((u32x2*)(ycat + (size_t)(t0 + r) * 1024))[lane + 64 * j] = w; }
            }
            __syncthreads();
        }
    }
    {
        float* wq = ldsf + wave * 192; float* wp = wq + 64;
        for (int task = gw; task < T * NH; task += NGW) {
            const int t = task >> 3, hq = task & 7, kvh = hq >> 2, s = t % SEQ;
            wq[lane] = bf2f(qkv[(size_t)t * 768 + hq * 64 + lane]);
            __builtin_amdgcn_wave_barrier(); asm volatile("s_waitcnt lgkmcnt(0)" ::: "memory");
            float sc[2];
#pragma unroll
            for (int h2 = 0; h2 < 2; ++h2) { const int j = lane + 64 * h2, kp = s - (WINDOW - 1) + j;
                float a = -INFINITY;
                if (kp >= 0) { const u32x4* kr = (const u32x4*)(qkv + (size_t)(t - (WINDOW - 1) + j) * 768 + 512 + kvh * 64); a = 0.f;
#pragma unroll
                    for (int c = 0; c < 8; ++c) { const u32x4 kk = kr[c];
#pragma unroll
                        for (int i = 0; i < 4; ++i) { a += wq[c * 8 + 2 * i] * __builtin_bit_cast(float, kk[i] << 16); a += wq[c * 8 + 2 * i + 1] * __builtin_bit_cast(float, kk[i] & 0xffff0000u); } }
                    a *= 0.125f; }
                sc[h2] = a; }
            const float sk = sinks[hq];
            const float mx = fmaxf(wave_max(fmaxf(sc[0], sc[1])), sk);
            const float p0 = __expf(sc[0] - mx), p1 = __expf(sc[1] - mx);
            const float den = wave_sum(p0 + p1) + __expf(sk - mx);
            wp[lane] = p0; wp[lane + 64] = p1;
            __builtin_amdgcn_wave_barrier(); asm volatile("s_waitcnt lgkmcnt(0)" ::: "memory");
            float o = 0.f;
            for (int j = 0; j < WINDOW; ++j) { const int kp = s - (WINDOW - 1) + j; if (kp >= 0) o += wp[j] * bf2f(qkv[(size_t)(t - (WINDOW - 1) + j) * 768 + 640 + kvh * 64 + lane]); }
            ycat[(size_t)t * 1024 + 512 + hq * 64 + lane] = (bf16)f2bf(o / den);
            __builtin_amdgcn_wave_barrier(); asm volatile("s_waitcnt lgkmcnt(0)" ::: "memory");
        }
    }
#endif
    PHASE_END

    PHASE_BEGIN
#if FAST_DENSE
    { const pg8::DenseSched S{(const char*)ycat, (const char*)Wt_out, 64, 4, G, bid, (size_t)256 * 2048, (size_t)256 * 2048};
      const pg8::EpiResF32 E{x, out, ALPHA}; pg8::gemm_phase(ldsp, pg8::Gemm{1024, 1024, 1024}, S, E); }
#else
    for (int u = bid; u < 128 * 16; u += G) { const int mt = u / 16, nt = u % 16;
        ngemm_tile<1>(ldsf, D, mt * 128, nt * 64,
            [&](int m, int k) { return bf2f(ycat[(size_t)m * D + k]); },
            [&](int b, int k, int n) { return w_out[(size_t)k * D + n]; },
            [&](int m, int n, float a, float) { out[(size_t)m * D + n] = ALPHA * x[(size_t)m * D + n] + a; });
    }
#endif
    PHASE_END
    PHASE_BEGIN
    for (int m = gw; m < T; m += NGW) { f32x4 v[4]; ln_row(out + (size_t)m * D, g_ln1, b_ln1, v, lane); st_row_f32(out + (size_t)m * D, v, 1.f, lane); st_row_bf16(x1b + (size_t)m * D, v, lane); }
    PHASE_END
    PHASE_BEGIN
#if FAST_DENSE
    { const pg8::DenseSched S{(const char*)x1b, (const char*)Wt_mq, 64, 4, G, bid, (size_t)256 * 2048, (size_t)256 * 2048};
      const pg8::EpiBf16 E{qm, 1024, nullptr}; pg8::gemm_phase(ldsp, pg8::Gemm{1024, 1024, 1024}, S, E); }
#else
    for (int u = bid; u < 128 * 16; u += G) { const int mt = u / 16, nt = u % 16;
        ngemm_tile<1>(ldsf, D, mt * 128, nt * 64,
            [&](int m, int k) { return bf2f(x1b[(size_t)m * D + k]); },
            [&](int b, int k, int n) { return w_mq[(size_t)k * D + n]; },
            [&](int m, int n, float a, float) { qm[(size_t)m * D + n] = (bf16)f2bf(a); });
    }
#endif
    PHASE_END
    PHASE_BEGIN
#if FAST_XATT
    {
        struct SchedS { const char *qm, *kmem; int G, c;
            __device__ __forceinline__ bool next(int i, pg8::Unit& u) const { const int L = i * G + c; if (L >= 256) return false; pg8::tile_of(L, 64, 4, u.pm, u.pn); u.kind = 0; u.aux = 0;
                u.A = qm + ((size_t)u.pm * 256 * 1024 + u.pn * 256) * 2; u.B = kmem + ((size_t)(u.pm >> 5) * 256 * 1024 + u.pn * 256) * 2; return true; } };
        const SchedS S{(const char*)qm, (const char*)kmem, G, bid};
        const pg8::EpiSoftmax E{Pb, (PG8_LAS float*)(ldsp + 131072)};
        pg8::gemm_phase(ldsp, pg8::Gemm{1024, 1024, 256}, S, E);
    }
#else
    for (int u = bid; u < 128 * 16; u += G) { const int mt = u / 16, h = (u % 16) / 4, nt = u % 4; const int b = (mt * 128) / SEQ;
        ngemm_tile<1>(ldsf, MHD, mt * 128, nt * 64,
            [&](int m, int k) { return bf2f(qm[(size_t)m * D + h * MHD + k]); },
            [&](int bb, int k, int n) { return bf2f(kmem[(size_t)(b * MEM + n) * D + h * MHD + k]); },
            [&](int m, int n, float a, float) { Sbuf[(size_t)m * D + h * MHD + n] = a * 0.0625f; });
    }
#endif
    PHASE_END
#if !FAST_XATT
    PHASE_BEGIN
    for (int m = gw; m < T; m += NGW) {
#pragma unroll
        for (int h = 0; h < 4; ++h) { const f32x4 v = ((const f32x4*)(Sbuf + (size_t)m * D + h * MHD))[lane];
            const float mx = wave_max(fmaxf(fmaxf(v.x, v.y), fmaxf(v.z, v.w)));
            const float e0 = __expf(v.x - mx), e1 = __expf(v.y - mx), e2 = __expf(v.z - mx), e3 = __expf(v.w - mx);
            const float inv = 1.f / wave_sum((e0 + e1) + (e2 + e3));
            u32x2 w; w.x = pk2(e0 * inv, e1 * inv); w.y = pk2(e2 * inv, e3 * inv); ((u32x2*)(Pb + (size_t)m * D + h * MHD))[lane] = w; }
    }
    PHASE_END
#endif
    PHASE_BEGIN
#if FAST_XATT
    {
        struct SchedO { const char *P, *vT; int G, c;
            __device__ __forceinline__ bool next(int i, pg8::Unit& u) const { const int L = i * G + c; if (L >= 256) return false; pg8::tile_of(L, 64, 4, u.pm, u.pn); u.kind = 0; u.aux = 0;
                u.A = P + ((size_t)u.pm * 256 * 1024 + u.pn * 256) * 2; u.B = vT + ((size_t)u.pn * 256 * 512 + (u.pm >> 5) * 256) * 2; return true; } };
        const SchedO S{(const char*)Pb, (const char*)vmemT, G, bid};
        const pg8::EpiBf16 E{om, 1024, nullptr};
        pg8::gemm_phase(ldsp, pg8::Gemm{1024, 512, 256}, S, E);
    }
#else
    for (int u = bid; u < 128 * 16; u += G) { const int mt = u / 16, h = (u % 16) / 4, nt = u % 4; const int b = (mt * 128) / SEQ;
        ngemm_tile<1>(ldsf, MEM, mt * 128, nt * 64,
            [&](int m, int k) { return bf2f(Pb[(size_t)m * D + h * MHD + k]); },
            [&](int bb, int k, int n) { return bf2f(vmemT[(size_t)(h * MHD + n) * NMEM + b * MEM + k]); },
            [&](int m, int n, float a, float) { om[(size_t)m * D + h * MHD + n] = (bf16)f2bf(a); });
    }
#endif
    PHASE_END
    PHASE_BEGIN
#if FAST_DENSE
    { const pg8::DenseSched S{(const char*)om, (const char*)Wt_mo, 64, 4, G, bid, (size_t)256 * 2048, (size_t)256 * 2048};
      const pg8::EpiResF32 E{out, out, ALPHA}; pg8::gemm_phase(ldsp, pg8::Gemm{1024, 1024, 1024}, S, E); }
#else
    for (int u = bid; u < 128 * 16; u += G) { const int mt = u / 16, nt = u % 16;
        ngemm_tile<1>(ldsf, D, mt * 128, nt * 64,
            [&](int m, int k) { return bf2f(om[(size_t)m * D + k]); },
            [&](int b, int k, int n) { return w_mo[(size_t)k * D + n]; },
            [&](int m, int n, float a, float) { out[(size_t)m * D + n] = ALPHA * out[(size_t)m * D + n] + a; });
    }
#endif
    PHASE_END
    const int TPB = (T + G - 1) / G;
    PHASE_BEGIN
    { const int t0 = bid * TPB, t1 = (t0 + TPB < T) ? t0 + TPB : T;
      float* Wl = ldsf;
      int* le = (int*)(lds_raw + 81920);
      for (int k = tid; k < D; k += 512) { const f32x4 wg = *(const f32x4*)(w_group + (size_t)k * 4);
          Wl[0 * D + k] = wg.x; Wl[1 * D + k] = wg.y; Wl[2 * D + k] = wg.z; Wl[3 * D + k] = wg.w;
#pragma unroll
          for (int gq = 0; gq < 4; ++gq) { const f32x4 wr = *(const f32x4*)(w_router + ((size_t)gq * D + k) * 4);
              Wl[(4 + gq * 4 + 0) * D + k] = wr.x; Wl[(4 + gq * 4 + 1) * D + k] = wr.y; Wl[(4 + gq * 4 + 2) * D + k] = wr.z; Wl[(4 + gq * 4 + 3) * D + k] = wr.w; } }
      __syncthreads();
      const int TPW = (TPB + 7) / 8;
      for (int mb = t0 + wave * TPW; mb < t0 + (wave + 1) * TPW && mb < t1; mb += 2) {
        f32x4 v[2][4];
        const bool has1 = (mb + 1 < t1) && (mb + 1 < t0 + (wave + 1) * TPW);
        ln_row(out + (size_t)mb * D, g_ln2, b_ln2, v[0], lane);
        st_row_f32(out + (size_t)mb * D, v[0], ALPHA, lane); st_row_bf16(x2b + (size_t)mb * D, v[0], lane);
        __builtin_amdgcn_sched_barrier(0);
        ln_row(out + (size_t)(has1 ? mb + 1 : mb) * D, g_ln2, b_ln2, v[1], lane);
        if (has1) { st_row_f32(out + (size_t)(mb + 1) * D, v[1], ALPHA, lane); st_row_bf16(x2b + (size_t)(mb + 1) * D, v[1], lane); }
        __builtin_amdgcn_sched_barrier(0);
        float my[20];
#pragma unroll
        for (int c = 0; c < 20; ++c) {
            float a0 = 0.f, a1 = 0.f;
#pragma unroll
            for (int jj = 0; jj < 4; ++jj) { const f32x4 w4 = ((const f32x4*)(Wl + c * D))[lane + 64 * jj];
                a0 += (v[0][jj].x * w4.x + v[0][jj].y * w4.y) + (v[0][jj].z * w4.z + v[0][jj].w * w4.w);
                a1 += (v[1][jj].x * w4.x + v[1][jj].y * w4.y) + (v[1][jj].z * w4.z + v[1][jj].w * w4.w); }
            a0 = wave_sum(a0); a1 = wave_sum(a1);
            my[c] = (lane == 1) ? a1 : a0;
        }
        const int m = mb + lane;
        if (lane < 2 && m < t1 && m < t0 + (wave + 1) * TPW) {
            float gl[4]; int gi = 0; float gmx = -INFINITY;
#pragma unroll
            for (int i = 0; i < 4; ++i) { gl[i] = my[i] + b_group[i]; if (gl[i] > gmx) { gmx = gl[i]; gi = i; } }
            float gs = 0.f;
#pragma unroll
            for (int i = 0; i < 4; ++i) gs += __expf(gl[i] - gmx);
            const float gp = 1.f / gs;
            float el[4];
#pragma unroll
            for (int i = 0; i < 4; ++i) { float a = my[4 + i], bq = b_router[i];
                a = (gi == 1) ? my[8 + i] : a; a = (gi == 2) ? my[12 + i] : a; a = (gi == 3) ? my[16 + i] : a;
                bq = (gi == 1) ? b_router[4 + i] : bq; bq = (gi == 2) ? b_router[8 + i] : bq; bq = (gi == 3) ? b_router[12 + i] : bq;
                el[i] = a + bq; }
            int i0 = 0; float v0 = el[0];
#pragma unroll
            for (int i = 1; i < 4; ++i) if (el[i] > v0) { v0 = el[i]; i0 = i; }
            int i1 = -1; float v1 = -INFINITY;
#pragma unroll
            for (int i = 0; i < 4; ++i) if (i != i0 && el[i] > v1) { v1 = el[i]; i1 = i; }
            const float w0 = 1.f / (1.f + __expf(v1 - v0)), w1 = 1.f - w0;
            route_e[2 * m] = gi * 4 + i0; route_e[2 * m + 1] = gi * 4 + i1; route_g[2 * m] = gp * w0; route_g[2 * m + 1] = gp * w1;
            le[2 * (m - t0)] = gi * 4 + i0; le[2 * (m - t0) + 1] = gi * 4 + i1;
        }
      }
      __syncthreads();
      const int np = 2 * (t1 - t0);
      for (int i = tid; i < np; i += 512) { const int e = le[i]; int r = 0; for (int j2 = 0; j2 < i; ++j2) r += (le[j2] == e) ? 1 : 0; rank[2 * t0 + i] = r; }
      if (tid < 16) { int c = 0; for (int j2 = 0; j2 < np; ++j2) c += (le[j2] == tid) ? 1 : 0; blkcnt[bid * 16 + tid] = c; }
    }
    PHASE_END
    PHASE_BEGIN
    {
        int* sh = (int*)lds_raw;
        { const int e = tid & 15, part = tid >> 4; int tot = 0, base = 0;
          for (int b = part; b < G; b += 32) { const int c = blkcnt[b * 16 + e]; tot += c; if (b < bid) base += c; }
          sh[128 + part * 16 + e] = tot; sh[640 + part * 16 + e] = base; }
        __syncthreads();
        if (tid < 16) { int tot = 0, base = 0;
#pragma unroll 8
            for (int part = 0; part < 32; ++part) { tot += sh[128 + part * 16 + tid]; base += sh[640 + part * 16 + tid]; } sh[tid] = base; sh[64 + tid] = tot; }
        __syncthreads();
        if (tid == 0) { int sacc = 0; for (int e = 0; e < 16; ++e) { sh[16 + e] = sacc; sacc += (sh[64 + e] + 255) & ~255; } sh[32] = sacc; if (bid == 0) for (int e = 0; e <= 16; ++e) segw[e] = sh[16 + e]; }
        __syncthreads();
        if (bid == 0) { for (int e = 0; e < 16; ++e) for (int pos = sh[16 + e] + sh[64 + e] + tid; pos < sh[16 + e + 1]; pos += 512) { pair_tok[pos] = -1; pair_gate[pos] = 0.f; } }
        const int t0 = bid * TPB, t1 = (t0 + TPB < T) ? t0 + TPB : T, np = 2 * (t1 - t0);
        for (int i = tid; i < np; i += 512) { const int pi = 2 * t0 + i, e = route_e[pi], pos = sh[16 + e] + sh[e] + rank[pi]; pair_tok[pos] = pi >> 1; pair_gate[pos] = route_g[pi]; tokpos[pi] = pos; sh[2048 + i] = pos; }
        __syncthreads();
        for (int i = wave; i < np; i += 8) { const int pos = sh[2048 + i], tok = t0 + (i >> 1);
            const u32x4* src = (const u32x4*)(x2b + (size_t)tok * D); u32x4* dst = (u32x4*)(Xs + (size_t)pos * D);
            dst[lane] = src[lane]; dst[lane + 64] = src[lane + 64]; }
    }
    PHASE_END
    PHASE_BEGIN
#if FAST_MOE
    { const SchedMoE S{(const char*)Xs, (const char*)Wt_gu, segw, segw[16] / 256, 4, G, bid, (size_t)256 * 2048, (size_t)1024 * 2048, (size_t)256 * 2048};
      const pg8::EpiGateUp E{Hs, pair_gate}; pg8::gemm_phase(ldsp, pg8::Gemm{1024, 1024, 1024}, S, E); }
#else
    { const int nmt = segw[16] / 128;
      for (int u = bid; u < nmt * 8; u += G) { const int mt = u / 8, nt = u % 8; int e = 0;
#pragma unroll
        for (int i = 1; i < 16; ++i) if (mt * 128 >= segw[i]) e = i;
        const float* wg = w_gate + (size_t)e * D * DE; const float* wu = w_up + (size_t)e * D * DE;
        ngemm_tile<2>(ldsf, D, mt * 128, nt * 64,
            [&](int m, int k) { return bf2f(Xs[(size_t)m * D + k]); },
            [&](int b, int k, int n) { return (b == 0 ? wg : wu)[(size_t)k * DE + n]; },
            [&](int m, int n, float g, float uu) { const float pg = pair_gate[m]; const float hv = (pair_tok[m] >= 0) ? (g / (1.f + __expf(-g))) * uu * pg : 0.f; Hs[(size_t)m * DE + n] = (bf16)f2bf(hv); });
      } }
#endif
    PHASE_END
    PHASE_BEGIN
#if FAST_MOE
    { const SchedMoE S{(const char*)Hs, (const char*)Wt_dn, segw, segw[16] / 256, 4, G, bid, (size_t)256 * 1024, (size_t)1024 * 1024, (size_t)256 * 1024};
      const pg8::EpiBf16 E{Yb, 1024, nullptr}; pg8::gemm_phase(ldsp, pg8::Gemm{512, 512, 512}, S, E); }
#else
    { const int nmt = segw[16] / 128;
      for (int u = bid; u < nmt * 16; u += G) { const int mt = u / 16, nt = u % 16; int e = 0;
#pragma unroll
        for (int i = 1; i < 16; ++i) if (mt * 128 >= segw[i]) e = i;
        const float* wd = w_down + (size_t)e * DE * D;
        ngemm_tile<1>(ldsf, DE, mt * 128, nt * 64,
            [&](int m, int k) { return bf2f(Hs[(size_t)m * DE + k]); },
            [&](int b, int k, int n) { return wd[(size_t)k * D + n]; },
            [&](int m, int n, float a, float) { const int tok = pair_tok[m]; if (tok >= 0) atomicAdd(out + (size_t)tok * D + n, a); });
      } }
#endif
    PHASE_END
    PHASE_BEGIN
#if FAST_MOE
    for (int m = gw; m < T; m += NGW) { float* row = out + (size_t)m * D; const int p0 = tokpos[2 * m], p1 = tokpos[2 * m + 1];
        const u32x2* y0 = (const u32x2*)(Yb + (size_t)p0 * D); const u32x2* y1 = (const u32x2*)(Yb + (size_t)p1 * D);
        f32x4 v[4]; float sacc = 0.f;
#pragma unroll
        for (int jj = 0; jj < 4; ++jj) { const u32x2 a = y0[lane + 64 * jj], b = y1[lane + 64 * jj]; f32x4 z = ((const f32x4*)row)[lane + 64 * jj];
            z.x += bflo(a.x) + bflo(b.x); z.y += bfhi(a.x) + bfhi(b.x); z.z += bflo(a.y) + bflo(b.y); z.w += bfhi(a.y) + bfhi(b.y); v[jj] = z; sacc += (z.x + z.y) + (z.z + z.w); }
        const float mean = wave_sum(sacc) * (1.f / D); float s2 = 0.f;
#pragma unroll
        for (int jj = 0; jj < 4; ++jj) { v[jj] = v[jj] - mean; s2 += (v[jj].x * v[jj].x + v[jj].y * v[jj].y) + (v[jj].z * v[jj].z + v[jj].w * v[jj].w); }
        const float rstd = 1.f / sqrtf(wave_sum(s2) * (1.f / D) + LN_EPS);
#pragma unroll
        for (int jj = 0; jj < 4; ++jj) { const f32x4 gg = ((const f32x4*)g_ln3)[lane + 64 * jj], bb = ((const f32x4*)b_ln3)[lane + 64 * jj]; ((f32x4*)row)[lane + 64 * jj] = v[jj] * rstd * gg + bb; } }
#else
    for (int m = gw; m < T; m += NGW) { f32x4 v[4]; ln_row(out + (size_t)m * D, g_ln3, b_ln3, v, lane); st_row_f32(out + (size_t)m * D, v, 1.f, lane); }
#endif
    PHASE_END
}

constexpr int N_PHASES = 16;
constexpr int LDS_BYTES = 147456;

extern "C" void kernel_launch(void* const* d_in, const int* in_sizes, int n_in, void* d_out, int out_size, void* d_ws, size_t ws_size, hipStream_t stream) {
    static int grid = 0;
    if (grid == 0) {
        int dev = 0, cus = 0, per_cu = 0;
        hipGetDevice(&dev);
        hipDeviceGetAttribute(&cus, hipDeviceAttributeMultiprocessorCount, dev);
        hipFuncSetAttribute((const void*)fwd_kernel, hipFuncAttributeMaxDynamicSharedMemorySize, LDS_BYTES);
        hipOccupancyMaxActiveBlocksPerMultiprocessor(&per_cu, (const void*)fwd_kernel, 512, LDS_BYTES);
        if (per_cu < 1) { fprintf(stderr, "occupancy query returned %d\n", per_cu); per_cu = 1; }
        grid = cus * 1;
        if (ws_size < WS_END) { fprintf(stderr, "workspace too small\n"); grid = -1; }
    }
    if (grid < 0) return;
    if (hipMemsetAsync((char*)d_ws + WS_CTL, 0, 65536, stream) != hipSuccess) { fprintf(stderr, "memset failed\n"); return; }
    Params p{};
    for (int i = 0; i < 26; ++i) p.in[i] = (const float*)d_in[i];
    p.out = (float*)d_out; p.ws = (unsigned char*)d_ws;
#if MK_N_LAUNCHES == 1
    p.ph_lo = 0; p.ph_hi = 64;
    void* args[] = {&p};
    hipError_t e = hipLaunchCooperativeKernel((const void*)fwd_kernel, dim3(grid), dim3(512), args, LDS_BYTES, stream);
    if (e != hipSuccess) fprintf(stderr, "cooperative launch failed: %s (grid %d)\n", hipGetErrorString(e), grid);
#else
    for (int ph = 0; ph < N_PHASES; ++ph) { p.ph_lo = ph; p.ph_hi = ph + 1; hipLaunchKernelGGL(fwd_kernel, dim3(grid), dim3(512), LDS_BYTES, stream, p); }
#endif
}
```

```cpp
#include <hip/hip_runtime.h>
#include <hip/hip_cooperative_groups.h>
#include <cstdio>
#include <cstdint>
namespace cg = cooperative_groups;

#ifndef FAST_P1
#define FAST_P1 1
#endif
#ifndef PROBE_MASK
#define PROBE_MASK 0
#endif
#ifndef FAST_P2
#define FAST_P2 1
#endif
#ifndef FAST_DENSE
#define FAST_DENSE 1
#endif
#ifndef FAST_XATT
#define FAST_XATT 1
#endif
#ifndef FAST_MOE
#define FAST_MOE 1
#endif
#ifndef MK_N_LAUNCHES
#define MK_N_LAUNCHES 1
#endif

typedef unsigned short bf16;
typedef float f32x4 __attribute__((ext_vector_type(4)));
typedef unsigned u32x4 __attribute__((ext_vector_type(4)));
typedef unsigned u32x2 __attribute__((ext_vector_type(2)));

constexpr int BATCH = 2, SEQ = 8192, D = 1024, T = BATCH * SEQ, MEM = 256, NMEM = BATCH * MEM;
constexpr int CONV_CH = 512, CONV_W = 31, NH = 8, NKV = 2, HD = 64, ATTN_W = 512, KV_W = 128, WINDOW = 128;
constexpr int D_IN = 1792, MH = 4, MHD = 256, NG = 4, EPG = 4, NE = 16, DE = 512;
constexpr float ALPHA = 1.189207115002721f, LN_EPS = 1e-5f;
constexpr int NPAIR = 2 * T, NPAIR_PAD = NPAIR + NE * 256;
constexpr int LDS_BYTES_K = 147456;

constexpr size_t MiB = 1u << 20;
constexpr size_t WS_CTL = 0;
constexpr size_t WS_ROUTE = 1 * MiB;
constexpr size_t WS_BLKCNT = 1 * MiB + 512 * 1024;
constexpr size_t WS_SEG = 1 * MiB + 640 * 1024;
constexpr size_t WS_RANK = 2 * MiB;
constexpr size_t WS_PTOK = 2 * MiB + 256 * 1024;
constexpr size_t WS_PGATE = 2 * MiB + 512 * 1024;
constexpr size_t WS_TOKPOS = 2 * MiB + 768 * 1024;
constexpr size_t WS_KMEM = 3 * MiB;
constexpr size_t WS_VMEMT = 4 * MiB;
constexpr size_t WS_MEMB = 5 * MiB;
constexpr size_t WS_A = 8 * MiB;
constexpr size_t WS_B = 48 * MiB;
constexpr size_t WS_DD = 88 * MiB;
constexpr size_t WS_WIN = 164 * MiB;
constexpr size_t WS_WOUT = 168 * MiB, WS_WMQ = 170 * MiB, WS_WMKV = 172 * MiB, WS_WMO = 176 * MiB;
constexpr size_t WS_WGU = 178 * MiB;
constexpr size_t WS_WDN = 210 * MiB;
constexpr size_t WS_END = 226 * MiB;

struct Params { const float* in[26]; float* out; unsigned char* ws; int ph_lo, ph_hi; };

__device__ __forceinline__ unsigned f2bf(float f) { unsigned u = __builtin_bit_cast(unsigned, f); return (u + 0x7fffu + ((u >> 16) & 1u)) >> 16; }
__device__ __forceinline__ float bf2f(bf16 b) { return __builtin_bit_cast(float, (unsigned)b << 16); }
__device__ __forceinline__ unsigned pk2(float lo, float hi) { return f2bf(lo) | (f2bf(hi) << 16); }
__device__ __forceinline__ float wave_sum(float v) {
#pragma unroll
    for (int o = 1; o < 64; o <<= 1) v += __shfl_xor(v, o);
    return v;
}
__device__ __forceinline__ float wave_max(float v) {
#pragma unroll
    for (int o = 1; o < 64; o <<= 1) v = fmaxf(v, __shfl_xor(v, o));
    return v;
}
__device__ __forceinline__ float ldA(const bf16* p) { return bf2f(*p); }
__device__ __forceinline__ float ldA(const float* p) { return *p; }

template <int NB, class FA, class FB, class FE>
__device__ __forceinline__ void ngemm_tile(float* lds, int K, int m0, int n0, FA fa, FB fb, FE fe) {
    float* As = lds;
    float* Bs = lds + 16 * 132;
    int tid = threadIdx.x; asm volatile("" : "+v"(tid));
    const int ty = tid >> 4, tx = tid & 15;
    float acc[NB][4][4];
#pragma unroll
    for (int b = 0; b < NB; ++b)
#pragma unroll
        for (int i = 0; i < 4; ++i)
#pragma unroll
            for (int j = 0; j < 4; ++j) acc[b][i][j] = 0.f;
    for (int k0 = 0; k0 < K; k0 += 16) {
        { const int r = tid >> 2, kk = (tid & 3) * 4;
#pragma unroll
            for (int i = 0; i < 4; ++i) As[(kk + i) * 132 + r] = fa(m0 + r, k0 + kk + i); }
#pragma unroll
        for (int b = 0; b < NB; ++b) { const int kk = tid >> 5, nn = (tid & 31) * 2;
            Bs[(b * 16 + kk) * 68 + nn] = fb(b, k0 + kk, n0 + nn); Bs[(b * 16 + kk) * 68 + nn + 1] = fb(b, k0 + kk, n0 + nn + 1); }
        __syncthreads();
#pragma unroll 4
        for (int k = 0; k < 16; ++k) {
            const f32x4 a = *(const f32x4*)&As[k * 132 + ty * 4];
#pragma unroll
            for (int b = 0; b < NB; ++b) { const f32x4 bb = *(const f32x4*)&Bs[(b * 16 + k) * 68 + tx * 4];
#pragma unroll
                for (int i = 0; i < 4; ++i)
#pragma unroll
                    for (int j = 0; j < 4; ++j) acc[b][i][j] += a[i] * bb[j]; }
        }
        __syncthreads();
    }
#pragma unroll
    for (int i = 0; i < 4; ++i)
#pragma unroll
        for (int j = 0; j < 4; ++j) fe(m0 + ty * 4 + i, n0 + tx * 4 + j, acc[0][i][j], acc[NB - 1][i][j]);
}

__device__ __forceinline__ void ln_row(const float* src, const float* g, const float* b, f32x4 (&v)[4], int lane) {
    const f32x4* xr = (const f32x4*)src + lane; float s = 0.f;
#pragma unroll
    for (int j = 0; j < 4; ++j) { v[j] = xr[64 * j]; s += (v[j].x + v[j].y) + (v[j].z + v[j].w); }
    const float mean = wave_sum(s) * (1.f / D); float s2 = 0.f;
#pragma unroll
    for (int j = 0; j < 4; ++j) { v[j] = v[j] - mean; s2 += (v[j].x * v[j].x + v[j].y * v[j].y) + (v[j].z * v[j].z + v[j].w * v[j].w); }
    const float rstd = 1.f / sqrtf(wave_sum(s2) * (1.f / D) + LN_EPS);
#pragma unroll
    for (int j = 0; j < 4; ++j) { const f32x4 gg = ((const f32x4*)g)[lane + 64 * j], bb = ((const f32x4*)b)[lane + 64 * j]; v[j] = v[j] * rstd * gg + bb; }
}
__device__ __forceinline__ void st_row_f32(float* dst, const f32x4 (&v)[4], float scale, int lane) {
#pragma unroll
    for (int j = 0; j < 4; ++j) ((f32x4*)dst)[lane + 64 * j] = v[j] * scale;
}
__device__ __forceinline__ void st_row_bf16(bf16* dst, const f32x4 (&v)[4], int lane) {
#pragma unroll
    for (int j = 0; j < 4; ++j) { u32x2 w; w.x = pk2(v[j].x, v[j].y); w.y = pk2(v[j].z, v[j].w); ((u32x2*)dst)[lane + 64 * j] = w; }
}


namespace pg8 {
#define PG8_LAS __attribute__((address_space(3)))
typedef unsigned short bf16_t;
typedef short bf16x8 __attribute__((ext_vector_type(8)));
constexpr int BM = 256, BK = 64, HALF = 128, HTB = HALF * BK * 2, STAGE_BYTES = 8 * HTB, NXCD = 8, WGM = 8;
__device__ __forceinline__ int lds_byte(int r, int c) { const int st = (r >> 4) * 2 + (c >> 5), rr = r & 15, cc = c & 31, ob = rr * 64 + cc * 2; return st * 1024 + (ob ^ (((ob >> 9) & 1) << 5)); }
__device__ __forceinline__ void stage_rc(int b, int& R, int& C) { const int st = b / 1024, sb = b % 1024, swz = sb ^ (((sb >> 9) & 1) << 5); R = (st >> 1) * 16 + swz / 64; C = (st & 1) * 32 + (swz % 64) / 2; }
__device__ __forceinline__ int perm32(int rho) { const int n = rho >> 4, i = rho & 15; return 8 * (i >> 2) + 4 * n + (i & 3); }
struct Unit { const char* A; const char* B; int pm, pn, kind, aux; };
struct Gemm { int lda, ldb, K; };
__device__ __forceinline__ void tile_of(int L, int nM, int nN, int& pm, int& pn) {
    const int nwg = nM * nN; int wgid = L; { const int q = nwg / NXCD, r = nwg % NXCD, xcd = wgid % NXCD, off = wgid / NXCD; wgid = (xcd < r ? xcd * (q + 1) : r * (q + 1) + (xcd - r) * q) + off; }
    const int nig = WGM * nN, gid = wgid / nig, fm = gid * WGM, gsz = (nM - fm) < WGM ? (nM - fm) : WGM;
    pm = fm + ((wgid % nig) % gsz); pn = (wgid % nig) / gsz;
}
__device__ __forceinline__ unsigned cvt_pk_bf16(float lo, float hi) { unsigned r; asm volatile("v_cvt_pk_bf16_f32 %0, %1, %2" : "=v"(r) : "v"(lo), "v"(hi)); return r; }

template <class Epi, class Sched>
__device__ __forceinline__ void gemm_phase(PG8_LAS unsigned char* lds, const Gemm g, const Sched& S, const Epi& E) {
    int tid = threadIdx.x; asm volatile("" : "+v"(tid));
    const int wid = __builtin_amdgcn_readfirstlane(tid >> 6), lane = tid & 63, wr = wid >> 2, wc = wid & 3, fr = lane & 15, fq = lane >> 4;
    const int K = g.K, nt = K / BK;
    unsigned voffA[2], voffB[2];
#pragma unroll
    for (int i = 0; i < 2; ++i) { int R, C; stage_rc(tid * 16 + i * 8192, R, C); const int Rb = Epi::PERM ? ((R & ~31) + perm32(R & 31)) : R;
        voffA[i] = (unsigned)(R * g.lda + C) * 2u; voffB[i] = (unsigned)(Rb * g.ldb + C) * 2u; }
    const size_t kstep = (size_t)(BK * 2);
    const size_t hstepA = (size_t)HALF * g.lda * 2, hstepB = (size_t)HALF * g.ldb * 2;
    const unsigned ldsw = (unsigned)wid * 1024u;
    const int aoff = lds_byte(wr * 64 + fr, fq * 8), boff = lds_byte(wc * 32 + fr, fq * 8);
#define PG8_SA(b, h) (((b) * 2 + (h)) * HTB)
#define PG8_SB(b, h) ((4 + (b) * 2 + (h)) * HTB)
#define PG8_STAGE(bufoff, gbase, voff) do { _Pragma("unroll") for (int _i = 0; _i < 2; ++_i) \
        __builtin_amdgcn_global_load_lds((const unsigned*)((const char*)(gbase) + (voff)[_i]), (PG8_LAS unsigned*)(lds + (bufoff) + ldsw + _i * 8192), 16, 0, 0); } while (0)
#define PG8_LDA(dst, b, h) do { _Pragma("unroll") for (int m = 0; m < 4; ++m) _Pragma("unroll") for (int k = 0; k < 2; ++k) dst[m][k] = *(const PG8_LAS bf16x8*)(lds + PG8_SA(b, h) + aoff + m * 2048 + k * 1024); } while (0)
#define PG8_LDB(dst, b, h) do { _Pragma("unroll") for (int n = 0; n < 2; ++n) _Pragma("unroll") for (int k = 0; k < 2; ++k) dst[n][k] = *(const PG8_LAS bf16x8*)(lds + PG8_SB(b, h) + boff + n * 2048 + k * 1024); } while (0)
#define PG8_MMA(ai, bj, At, Bt) do { __builtin_amdgcn_s_setprio(1); _Pragma("unroll") for (int m = 0; m < 4; ++m) _Pragma("unroll") for (int n = 0; n < 2; ++n) _Pragma("unroll") for (int k = 0; k < 2; ++k) \
        acc[ai][bj][m][n] = __builtin_amdgcn_mfma_f32_16x16x32_bf16(Bt[n][k], At[m][k], acc[ai][bj][m][n], 0, 0, 0); __builtin_amdgcn_s_setprio(0); } while (0)
#define PG8_WAIT_V(n) asm volatile("s_waitcnt vmcnt(" #n ")" ::: "memory")
#define PG8_WAIT_L(n) asm volatile("s_waitcnt lgkmcnt(" #n ")" ::: "memory")
#define PG8_BAR __builtin_amdgcn_s_barrier()
#define PG8_SCHED __builtin_amdgcn_sched_barrier(0)
    Unit cur, nxt; int ui = 0;
    if (!S.next(0, cur)) return;
    f32x4 acc[2][2][4][2];
#pragma unroll
    for (int a = 0; a < 2; ++a)
#pragma unroll
        for (int b = 0; b < 2; ++b)
#pragma unroll
            for (int m = 0; m < 4; ++m)
#pragma unroll
                for (int n = 0; n < 2; ++n) acc[a][b][m][n] = (f32x4){0.f, 0.f, 0.f, 0.f};
    bf16x8 At[4][2], B0[2][2], B1[2][2];
    const char* cA = cur.A; const char* cB = cur.B;
    PG8_STAGE(PG8_SB(0, 0), cB, voffB); PG8_STAGE(PG8_SB(0, 1), cB + hstepB, voffB); PG8_STAGE(PG8_SA(0, 0), cA, voffA); PG8_STAGE(PG8_SA(0, 1), cA + hstepA, voffA);
    if (wr == 1) PG8_BAR;
    PG8_WAIT_V(2); PG8_BAR;
    PG8_STAGE(PG8_SB(1, 0), cB + kstep, voffB); PG8_STAGE(PG8_SA(1, 0), cA + kstep, voffA); PG8_STAGE(PG8_SB(1, 1), cB + hstepB + kstep, voffB);
    PG8_WAIT_V(6); PG8_BAR;
    for (;;) {
        const bool has_next = S.next(ui + 1, nxt);
        const char* nA = has_next ? nxt.A : cA; const char* nB = has_next ? nxt.B : cB;
        for (int t = 0; t < nt; t += 2) {
            const bool last = (t == nt - 2);
            const char* a1 = cA + (size_t)(t + 1) * kstep;
            const char* a2 = last ? nA : cA + (size_t)(t + 2) * kstep; const char* b2 = last ? nB : cB + (size_t)(t + 2) * kstep;
            const char* a3 = a2 + kstep; const char* b3 = b2 + kstep;
            PG8_LDB(B0, 0, 0); PG8_LDB(B1, 0, 1); PG8_SCHED; PG8_LDA(At, 0, 0); PG8_STAGE(PG8_SA(1, 1), a1 + hstepA, voffA);
            PG8_WAIT_V(8); PG8_WAIT_L(0); PG8_BAR; PG8_MMA(0, 0, At, B0); PG8_MMA(0, 1, At, B1); PG8_BAR; PG8_SCHED;
            PG8_LDA(At, 0, 1); PG8_STAGE(PG8_SB(0, 0), b2, voffB); PG8_STAGE(PG8_SB(0, 1), b2 + hstepB, voffB); PG8_STAGE(PG8_SA(0, 0), a2, voffA);
            PG8_WAIT_V(8); PG8_WAIT_L(0); PG8_BAR; PG8_MMA(1, 0, At, B0); PG8_MMA(1, 1, At, B1); PG8_BAR; PG8_SCHED;
            PG8_LDB(B0, 1, 0); PG8_LDB(B1, 1, 1); PG8_SCHED; PG8_LDA(At, 1, 0); PG8_STAGE(PG8_SA(0, 1), a2 + hstepA, voffA);
            PG8_WAIT_V(8); PG8_WAIT_L(0); PG8_BAR; PG8_MMA(0, 0, At, B0); PG8_MMA(0, 1, At, B1); PG8_BAR; PG8_SCHED;
            PG8_LDA(At, 1, 1); PG8_STAGE(PG8_SB(1, 0), b3, voffB); PG8_STAGE(PG8_SB(1, 1), b3 + hstepB, voffB); PG8_STAGE(PG8_SA(1, 0), a3, voffA);
            PG8_WAIT_V(8); PG8_WAIT_L(0); PG8_BAR; PG8_MMA(1, 0, At, B0); PG8_MMA(1, 1, At, B1); PG8_BAR; PG8_SCHED;
        }
        if (wr == 0) PG8_BAR;
        E(acc, cur, wr, wc, fr, fq);
        if (!has_next) break;
#pragma unroll
        for (int a = 0; a < 2; ++a)
#pragma unroll
            for (int b = 0; b < 2; ++b)
#pragma unroll
                for (int m = 0; m < 4; ++m)
#pragma unroll
                    for (int n = 0; n < 2; ++n) acc[a][b][m][n] = (f32x4){0.f, 0.f, 0.f, 0.f};
        cur = nxt; cA = nA; cB = nB; ++ui;
        if (wr == 1) PG8_BAR;
    }
    PG8_WAIT_V(0);
    PG8_BAR;
#undef PG8_SA
#undef PG8_SB
#undef PG8_STAGE
#undef PG8_LDA
#undef PG8_LDB
#undef PG8_MMA
#undef PG8_WAIT_V
#undef PG8_WAIT_L
#undef PG8_BAR
#undef PG8_SCHED
}

__device__ __forceinline__ u32x4 pack8(const f32x4 v0, const f32x4 v1) { u32x4 w; w.x = cvt_pk_bf16(v0[0], v0[1]); w.y = cvt_pk_bf16(v0[2], v0[3]); w.z = cvt_pk_bf16(v1[0], v1[1]); w.w = cvt_pk_bf16(v1[2], v1[3]); return w; }
__device__ __forceinline__ float sigm(float g) { return __builtin_amdgcn_rcpf(1.f + __expf(-g)); }

struct EpiBf16 {
    static constexpr bool PERM = true;
    bf16_t* O; int ldc; const float* bias;
    __device__ __forceinline__ void operator()(const f32x4 (&acc)[2][2][4][2], const Unit& u, int wr, int wc, int fr, int fq) const {
        const int row0 = u.pm * BM + wr * 64 + fr, col0 = u.pn * BM + wc * 32 + 8 * fq;
        f32x4 bv[2][2];
#pragma unroll
        for (int bj = 0; bj < 2; ++bj)
#pragma unroll
            for (int n = 0; n < 2; ++n) bv[bj][n] = bias ? *(const f32x4*)(bias + col0 + bj * HALF + 4 * n) : (f32x4){0.f, 0.f, 0.f, 0.f};
#pragma unroll
        for (int ai = 0; ai < 2; ++ai)
#pragma unroll
            for (int m = 0; m < 4; ++m) { bf16_t* rowp = O + (size_t)(row0 + ai * HALF + m * 16) * ldc + col0;
#pragma unroll
                for (int bj = 0; bj < 2; ++bj) *(u32x4*)(rowp + bj * HALF) = pack8(acc[ai][bj][m][0] + bv[bj][0], acc[ai][bj][m][1] + bv[bj][1]); }
    }
};
struct EpiP1 {
    static constexpr bool PERM = true;
    bf16_t *hglu, *qkv, *kmem, *vmemT; const float* b_in;
    __device__ __forceinline__ void operator()(const f32x4 (&acc)[2][2][4][2], const Unit& u, int wr, int wc, int fr, int fq) const {
        if (u.kind == 0) {
            const int row0 = u.pm * BM + wr * 64 + fr, cb = u.pn * 128 + wc * 32 + 8 * fq;
            f32x4 ba[2], bg[2];
#pragma unroll
            for (int n = 0; n < 2; ++n) { ba[n] = *(const f32x4*)(b_in + cb + 4 * n); bg[n] = *(const f32x4*)(b_in + 512 + cb + 4 * n); }
#pragma unroll
            for (int ai = 0; ai < 2; ++ai)
#pragma unroll
                for (int m = 0; m < 4; ++m) { f32x4 h[2];
#pragma unroll
                    for (int n = 0; n < 2; ++n) { const f32x4 a = acc[ai][0][m][n] + ba[n], gt = acc[ai][1][m][n] + bg[n];
                        h[n] = (f32x4){a[0] * sigm(gt[0]), a[1] * sigm(gt[1]), a[2] * sigm(gt[2]), a[3] * sigm(gt[3])}; }
                    *(u32x4*)(hglu + (size_t)(row0 + ai * HALF + m * 16) * 512 + cb) = pack8(h[0], h[1]); }
        } else if (u.kind == 1) { EpiBf16 e{qkv - 1024, 768, b_in}; e(acc, u, wr, wc, fr, fq);
        } else if (u.kind == 2) { EpiBf16 e{kmem, 1024, nullptr}; e(acc, u, wr, wc, fr, fq);
        } else { EpiBf16 e{vmemT, 512, nullptr}; e(acc, u, wr, wc, fr, fq); }
    }
};
struct EpiResF32 {
    static constexpr bool PERM = false;
    const float* res; float* out; float alpha;
    __device__ __forceinline__ void operator()(const f32x4 (&acc)[2][2][4][2], const Unit& u, int wr, int wc, int fr, int fq) const {
        const int row0 = u.pm * BM + wr * 64 + fr, col0 = u.pn * BM + wc * 32 + 4 * fq;
#pragma unroll
        for (int ai = 0; ai < 2; ++ai)
#pragma unroll
            for (int m = 0; m < 4; ++m) { const size_t off = (size_t)(row0 + ai * HALF + m * 16) * 1024 + col0;
#pragma unroll
                for (int bj = 0; bj < 2; ++bj)
#pragma unroll
                    for (int n = 0; n < 2; ++n) { const f32x4 r = *(const f32x4*)(res + off + bj * HALF + n * 16); *(f32x4*)(out + off + bj * HALF + n * 16) = r * alpha + acc[ai][bj][m][n]; } }
    }
};
struct EpiSoftmax {
    static constexpr bool PERM = true;
    bf16_t* P; PG8_LAS float* xl;
    __device__ __forceinline__ void operator()(const f32x4 (&acc)[2][2][4][2], const Unit& u, int wr, int wc, int fr, int fq) const {
        const float sc = 0.0625f * 1.4426950408889634f;
#pragma unroll
        for (int ai = 0; ai < 2; ++ai)
#pragma unroll
            for (int m = 0; m < 4; ++m) { float mx = -INFINITY;
#pragma unroll
                for (int bj = 0; bj < 2; ++bj)
#pragma unroll
                    for (int n = 0; n < 2; ++n) { const f32x4 v = acc[ai][bj][m][n]; mx = fmaxf(mx, fmaxf(fmaxf(v[0], v[1]), fmaxf(v[2], v[3]))); }
                mx = fmaxf(mx, __shfl_xor(mx, 16)); mx = fmaxf(mx, __shfl_xor(mx, 32));
                float s = 0.f;
#pragma unroll
                for (int bj = 0; bj < 2; ++bj)
#pragma unroll
                    for (int n = 0; n < 2; ++n) { const f32x4 v = acc[ai][bj][m][n]; s += (__builtin_amdgcn_exp2f((v[0] - mx) * sc) + __builtin_amdgcn_exp2f((v[1] - mx) * sc)) + (__builtin_amdgcn_exp2f((v[2] - mx) * sc) + __builtin_amdgcn_exp2f((v[3] - mx) * sc)); }
                s += __shfl_xor(s, 16); s += __shfl_xor(s, 32);
                if (fq == 0) { PG8_LAS float* q = xl + ((ai * HALF + wr * 64 + m * 16 + fr) * 4 + wc) * 2; q[0] = mx; q[1] = s; } }
        asm volatile("s_waitcnt lgkmcnt(0)" ::: "memory"); __builtin_amdgcn_s_barrier(); asm volatile("" ::: "memory");
        const int row0 = u.pm * BM + wr * 64 + fr, col0 = u.pn * BM + wc * 32 + 8 * fq;
#pragma unroll
        for (int ai = 0; ai < 2; ++ai)
#pragma unroll
            for (int m = 0; m < 4; ++m) { const PG8_LAS f32x4* q = (const PG8_LAS f32x4*)(xl + (ai * HALF + wr * 64 + m * 16 + fr) * 8); const f32x4 q0 = q[0], q1 = q[1];
                const float M = fmaxf(fmaxf(q0[0], q0[2]), fmaxf(q1[0], q1[2]));
                const float S = (q0[1] * __builtin_amdgcn_exp2f((q0[0] - M) * sc) + q0[3] * __builtin_amdgcn_exp2f((q0[2] - M) * sc)) + (q1[1] * __builtin_amdgcn_exp2f((q1[0] - M) * sc) + q1[3] * __builtin_amdgcn_exp2f((q1[2] - M) * sc));
                const float inv = 1.f / S; bf16_t* rowp = P + (size_t)(row0 + ai * HALF + m * 16) * 1024 + col0;
#pragma unroll
                for (int bj = 0; bj < 2; ++bj) { f32x4 p[2];
#pragma unroll
                    for (int n = 0; n < 2; ++n) { const f32x4 v = acc[ai][bj][m][n];
                        p[n] = (f32x4){__builtin_amdgcn_exp2f((v[0] - M) * sc) * inv, __builtin_amdgcn_exp2f((v[1] - M) * sc) * inv, __builtin_amdgcn_exp2f((v[2] - M) * sc) * inv, __builtin_amdgcn_exp2f((v[3] - M) * sc) * inv}; }
                    *(u32x4*)(rowp + bj * HALF) = pack8(p[0], p[1]); } }
        asm volatile("s_waitcnt lgkmcnt(0)" ::: "memory"); __builtin_amdgcn_s_barrier(); asm volatile("" ::: "memory");
    }
};
struct EpiGateUp {
    static constexpr bool PERM = true;
    bf16_t* Hs; const float* pair_gate;
    __device__ __forceinline__ void operator()(const f32x4 (&acc)[2][2][4][2], const Unit& u, int wr, int wc, int fr, int fq) const {
        const int row0 = u.pm * BM + wr * 64 + fr, cb = u.pn * 128 + wc * 32 + 8 * fq;
#pragma unroll
        for (int ai = 0; ai < 2; ++ai)
#pragma unroll
            for (int m = 0; m < 4; ++m) { const int row = row0 + ai * HALF + m * 16; const float pg = pair_gate[row]; f32x4 h[2];
#pragma unroll
                for (int n = 0; n < 2; ++n) { const f32x4 gt = acc[ai][0][m][n], up = acc[ai][1][m][n];
                    h[n] = (f32x4){gt[0] * sigm(gt[0]) * up[0] * pg, gt[1] * sigm(gt[1]) * up[1] * pg, gt[2] * sigm(gt[2]) * up[2] * pg, gt[3] * sigm(gt[3]) * up[3] * pg}; }
                if (pg == 0.f) { h[0] = (f32x4){0.f, 0.f, 0.f, 0.f}; h[1] = h[0]; }
                *(u32x4*)(Hs + (size_t)row * 512 + cb) = pack8(h[0], h[1]); }
    }
};
struct EpiDown {
    static constexpr bool PERM = false;
    float* out; const int* pair_tok;
    __device__ __forceinline__ void operator()(const f32x4 (&acc)[2][2][4][2], const Unit& u, int wr, int wc, int fr, int fq) const {
        const int row0 = u.pm * BM + wr * 64 + fr, col0 = u.pn * BM + wc * 32 + 4 * fq;
#pragma unroll
        for (int ai = 0; ai < 2; ++ai)
#pragma unroll
            for (int m = 0; m < 4; ++m) { const int tok = pair_tok[row0 + ai * HALF + m * 16];
                if (tok >= 0) { float* rp = out + (size_t)tok * 1024 + col0;
#pragma unroll
                    for (int bj = 0; bj < 2; ++bj)
#pragma unroll
                        for (int n = 0; n < 2; ++n)
#pragma unroll
                            for (int i = 0; i < 4; ++i) unsafeAtomicAdd(rp + bj * HALF + n * 16 + i, acc[ai][bj][m][n][i]); } }
    }
};
struct DenseSched {
    const char* A; const char* B; int nM, nN, G, c; size_t strideA, strideB;
    __device__ __forceinline__ bool next(int i, Unit& u) const { const int L = i * G + c; if (L >= nM * nN) return false; tile_of(L, nM, nN, u.pm, u.pn); u.A = A + (size_t)u.pm * strideA; u.B = B + (size_t)u.pn * strideB; u.kind = 0; u.aux = 0; return true; }
};
}


#define LAS __attribute__((address_space(3)))
__device__ __forceinline__ void transpose_item(const float* W, int N, bf16* WT, int Kd, int k0, int n0, int drow0, LAS float* scr, int lane) {
#pragma unroll 8
    for (int i = 0; i < 32; ++i) { const int kk = 2 * i + (lane >> 5); scr[kk * 33 + (lane & 31)] = W[(size_t)(k0 + kk) * N + n0 + (lane & 31)]; }
    asm volatile("s_waitcnt lgkmcnt(0)" ::: "memory");
    const int c = lane & 7;
#pragma unroll
    for (int j = 0; j < 4; ++j) { const int n = (lane >> 3) + 8 * j; const LAS float* sp = scr + (8 * c) * 33 + n;
        u32x4 o; o.x = pk2(sp[0 * 33], sp[1 * 33]); o.y = pk2(sp[2 * 33], sp[3 * 33]); o.z = pk2(sp[4 * 33], sp[5 * 33]); o.w = pk2(sp[6 * 33], sp[7 * 33]);
        *(u32x4*)(WT + (size_t)(drow0 + n) * Kd + k0 + 8 * c) = o; }
    asm volatile("s_waitcnt lgkmcnt(0)" ::: "memory");
}


typedef short bf16x8v __attribute__((ext_vector_type(8)));
__device__ __forceinline__ float bflo(unsigned v) { return __builtin_bit_cast(float, v << 16); }
__device__ __forceinline__ float bfhi(unsigned v) { return __builtin_bit_cast(float, v & 0xffff0000u); }

__device__ __forceinline__ void conv_unit(unsigned char* lds, const bf16* hglu, const float* w_dw, const float* b_dw, const float* g_cn, const float* b_cn, bf16* ycat, int cu) {
    int tid = threadIdx.x; asm volatile("" : "+v"(tid));
    const int lane = tid & 63, wave = tid >> 6;
    bf16* hin = (bf16*)lds; float* cout = (float*)(lds + 63488);
    const int t0 = cu * 32, s0 = t0 % SEQ;
    for (int c = tid; c < 62 * 64; c += 512) { const int row = c >> 6, part = c & 63; u32x4 v = (u32x4){0u, 0u, 0u, 0u};
        if (s0 - 30 + row >= 0) v = *(const u32x4*)(hglu + (size_t)(t0 - 30 + row) * 512 + part * 8);
        *(u32x4*)(hin + row * 512 + part * 8) = v; }
    __syncthreads();
    {
        const int cp = tid & 255, th = tid >> 8;
        float w0[CONV_W], w1[CONV_W];
#pragma unroll
        for (int j = 0; j < CONV_W; ++j) { const float2 ww = *(const float2*)(w_dw + j * CONV_CH + 2 * cp); w0[j] = ww.x; w1[j] = ww.y; }
        const float2 bb = *(const float2*)(b_dw + 2 * cp);
#pragma unroll 1
        for (int grp = 0; grp < 2; ++grp) { const int tt0 = th * 16 + grp * 8;
            float a0[8], a1[8];
#pragma unroll
            for (int o = 0; o < 8; ++o) { a0[o] = bb.x; a1[o] = bb.y; }
#pragma unroll
            for (int r = 0; r < 38; ++r) { const unsigned v = *(const unsigned*)(hin + (tt0 + r) * 512 + 2 * cp); const float lo = bflo(v), hi = bfhi(v);
#pragma unroll
                for (int o = 0; o < 8; ++o) { const int j = r - o; if (j >= 0 && j < CONV_W) { a0[o] += w0[j] * lo; a1[o] += w1[j] * hi; } } }
#pragma unroll
            for (int o = 0; o < 8; ++o) *(float2*)(cout + (tt0 + o) * 512 + 2 * cp) = make_float2(a0[o], a1[o]);
        }
    }
    __syncthreads();
    {
        const f32x4 g0 = *(const f32x4*)(g_cn + 8 * lane), g1 = *(const f32x4*)(g_cn + 8 * lane + 4), c0 = *(const f32x4*)(b_cn + 8 * lane), c1 = *(const f32x4*)(b_cn + 8 * lane + 4);
#pragma unroll 1
        for (int i = 0; i < 4; ++i) { const int tt = wave * 4 + i;
            f32x4 v0 = *(const f32x4*)(cout + tt * 512 + 8 * lane), v1 = *(const f32x4*)(cout + tt * 512 + 8 * lane + 4);
            const float mean = wave_sum((v0.x + v0.y) + (v0.z + v0.w) + (v1.x + v1.y) + (v1.z + v1.w)) * (1.f / 512.f);
            v0 = v0 - mean; v1 = v1 - mean;
            const float var = wave_sum((v0.x * v0.x + v0.y * v0.y) + (v0.z * v0.z + v0.w * v0.w) + (v1.x * v1.x + v1.y * v1.y) + (v1.z * v1.z + v1.w * v1.w)) * (1.f / 512.f);
            const float rstd = 1.f / sqrtf(var + LN_EPS);
            f32x4 y0 = v0 * rstd * g0 + c0, y1 = v1 * rstd * g1 + c1;
#pragma unroll
            for (int e = 0; e < 4; ++e) { y0[e] = y0[e] * pg8::sigm(y0[e]); y1[e] = y1[e] * pg8::sigm(y1[e]); }
            *(u32x4*)(ycat + (size_t)(t0 + tt) * 1024 + 8 * lane) = pg8::pack8(y0, y1); }
    }
    __syncthreads();
}

__device__ __forceinline__ void swa_unit(unsigned char* lds, const bf16* qkv, const float* sinks, bf16* ycat, int b, int kvh, int qb) {
    int tid = threadIdx.x; asm volatile("" : "+v"(tid));
    const int lane = tid & 63, wave = tid >> 6, q4 = lane >> 4, c16 = lane & 15;
    bf16* Ks = (bf16*)lds; bf16* VT = (bf16*)(lds + 36864);
    const long t0 = (long)b * SEQ + (long)qb * 128, tk0 = t0 - 128;
#pragma unroll
    for (int i = 0; i < 4; ++i) { const int c = tid + 512 * i, row = c >> 3, part = c & 7; const bool ok = (qb > 0) || (row >= 128);
        u32x4 kv = (u32x4){0u, 0u, 0u, 0u}, vv = kv;
        if (ok) { const bf16* rp = qkv + (tk0 + row) * 768 + 512 + kvh * 64 + part * 8; kv = *(const u32x4*)rp; vv = *(const u32x4*)(rp + 128); }
        *(u32x4*)(Ks + row * 72 + part * 8) = kv;
#pragma unroll
        for (int e = 0; e < 4; ++e) { VT[(part * 8 + 2 * e) * 264 + row] = (bf16)(vv[e] & 0xffffu); VT[(part * 8 + 2 * e + 1) * 264 + row] = (bf16)(vv[e] >> 16); } }
    __syncthreads();
    const int g = wave >> 1, hq = kvh * 4 + g, i0 = (wave & 1) * 64;
    const float L2E = 1.4426950408889634f, sc = 0.125f * L2E, sink2 = sinks[hq] * L2E;
#pragma unroll 1
    for (int qt = 0; qt < 4; ++qt) {
        const int iq = i0 + qt * 16, kt0 = iq >> 4, iqc = iq + c16;
        const bf16* qp = qkv + (t0 + iqc) * 768 + hq * 64 + 8 * q4;
        const bf16x8v Q0 = *(const bf16x8v*)qp, Q1 = *(const bf16x8v*)(qp + 32);
        f32x4 sv[9];
#pragma unroll
        for (int kt = 0; kt < 9; ++kt) { const bf16* kp = Ks + ((kt0 + kt) * 16 + c16) * 72 + 8 * q4;
            f32x4 a = (f32x4){0.f, 0.f, 0.f, 0.f};
            a = __builtin_amdgcn_mfma_f32_16x16x32_bf16(*(const bf16x8v*)kp, Q0, a, 0, 0, 0);
            a = __builtin_amdgcn_mfma_f32_16x16x32_bf16(*(const bf16x8v*)(kp + 32), Q1, a, 0, 0, 0);
            sv[kt] = a; }
        float mx = sink2;
#pragma unroll
        for (int kt = 0; kt < 9; ++kt)
#pragma unroll
            for (int r = 0; r < 4; ++r) { const int j = (kt0 + kt) * 16 + 4 * q4 + r; const bool ok = (j > iqc) && (j <= iqc + 128) && (qb > 0 || j >= 128);
                const float v = ok ? sv[kt][r] * sc : -INFINITY; sv[kt][r] = v; mx = fmaxf(mx, v); }
        mx = fmaxf(mx, __shfl_xor(mx, 16)); mx = fmaxf(mx, __shfl_xor(mx, 32));
        float sum = 0.f;
#pragma unroll
        for (int kt = 0; kt < 9; ++kt)
#pragma unroll
            for (int r = 0; r < 4; ++r) { const float pv = __builtin_amdgcn_exp2f(sv[kt][r] - mx); sv[kt][r] = pv; sum += pv; }
        sum += __shfl_xor(sum, 16); sum += __shfl_xor(sum, 32);
        sum += __builtin_amdgcn_exp2f(sink2 - mx);
        const float inv = 1.f / sum;
        f32x4 o[4];
#pragma unroll
        for (int dt = 0; dt < 4; ++dt) o[dt] = (f32x4){0.f, 0.f, 0.f, 0.f};
#pragma unroll
        for (int pp = 0; pp < 5; ++pp) { const int T0 = kt0 + 2 * pp, T1 = (pp < 4) ? T0 + 1 : T0;
            const f32x4 pa = sv[2 * pp], pb = (pp < 4) ? sv[2 * pp + 1] : (f32x4){0.f, 0.f, 0.f, 0.f};
            const u32x4 pw = pg8::pack8(pa, pb); const bf16x8v Bp = __builtin_bit_cast(bf16x8v, pw);
#pragma unroll
            for (int dt = 0; dt < 4; ++dt) { const bf16* vp = VT + (dt * 16 + c16) * 264 + 4 * q4;
                const u32x2 lo = *(const u32x2*)(vp + T0 * 16), hi = *(const u32x2*)(vp + T1 * 16);
                const u32x4 aw = (u32x4){lo.x, lo.y, hi.x, hi.y};
                o[dt] = __builtin_amdgcn_mfma_f32_16x16x32_bf16(__builtin_bit_cast(bf16x8v, aw), Bp, o[dt], 0, 0, 0); } }
        bf16* op = ycat + (t0 + iqc) * 1024 + 512 + hq * 64 + 4 * q4;
#pragma unroll
        for (int dt = 0; dt < 4; ++dt) { u32x2 w; w.x = pg8::cvt_pk_bf16(o[dt][0] * inv, o[dt][1] * inv); w.y = pg8::cvt_pk_bf16(o[dt][2] * inv, o[dt][3] * inv); *(u32x2*)(op + dt * 16) = w; }
    }
    __syncthreads();
}


#define XB_TMO      128
#define XB_XCNT(j)  (256  + 64 * (j))
#define XB_XSUB(j)  (1280 + 64 * (j))
#define XB_XGEN(j)  (2304 + 64 * (j))
#define XB_TOP      3328
#define XB_TOPGEN   3392
#define XCD_BAR_WORDS 3456
#define XB_SPIN_CAP (1u << 20)
__device__ __forceinline__ unsigned xb_ld(unsigned* p)              { return __hip_atomic_load(p, __ATOMIC_RELAXED, __HIP_MEMORY_SCOPE_AGENT); }
__device__ __forceinline__ unsigned xb_add(unsigned* p, unsigned v) { return __hip_atomic_fetch_add(p, v, __ATOMIC_RELAXED, __HIP_MEMORY_SCOPE_AGENT); }
__device__ __forceinline__ unsigned xb_xcc_id() { return (unsigned)__builtin_amdgcn_s_getreg((3 << 11) | 20) & 0xFu; }
#define XB_SPIN(cond, bar) do { unsigned _sp = 0; while (cond) { __builtin_amdgcn_s_sleep(1); \
    if ((++_sp & 255u) == 0u) { if (xb_ld(&(bar)[XB_TMO])) break; if (_sp > XB_SPIN_CAP) { atomicAdd(&(bar)[XB_TMO], 1u); break; } } } } while (0)
struct XcdBarrier { unsigned* bar; unsigned x; volatile __attribute__((address_space(3))) unsigned* st; };
__device__ __forceinline__ XcdBarrier xcd_barrier_post(unsigned* bar, volatile __attribute__((address_space(3))) unsigned* st) {
    XcdBarrier b; b.bar = bar; b.x = xb_xcc_id(); b.st = st;
    if (threadIdx.x == 0) (void)xb_add(&bar[XB_XCNT(b.x)], 1u);
    return b;
}
__device__ __forceinline__ void xcd_barrier_complete(unsigned* bar, unsigned x, unsigned& nloc, unsigned& nx) {
    const unsigned G = gridDim.x * gridDim.y * gridDim.z;
    unsigned sum, cnt, mine, sp = 0u;
    for (;;) {
        sum = 0u; cnt = 0u; mine = 0u;
#pragma unroll
        for (unsigned j = 0; j < 16; ++j) { const unsigned c = xb_ld(&bar[XB_XCNT(j)]); sum += c; cnt += (c > 0u) ? 1u : 0u; mine = (j == x) ? c : mine; }
        if (sum == G) break;
        __builtin_amdgcn_s_sleep(1);
        if ((++sp & 255u) == 0u) { if (xb_ld(&bar[XB_TMO])) break; if (sp > XB_SPIN_CAP) { atomicAdd(&bar[XB_TMO], 1u); break; } }
    }
    nloc = mine > 0u ? mine : 1u; nx = cnt > 0u ? cnt : 1u;
}
__device__ __forceinline__ void xcd_barrier(const XcdBarrier& b) {
    asm volatile("s_waitcnt vmcnt(0)" ::: "memory");
    __syncthreads();
    if (threadIdx.x == 0) {
        unsigned* bar = b.bar;
        __builtin_amdgcn_s_waitcnt(0);
        unsigned nloc = b.st[0], nx = b.st[1];
        if (nloc == 0u) { xcd_barrier_complete(bar, b.x, nloc, nx); b.st[0] = nloc; b.st[1] = nx; }
        const unsigned old = xb_add(&bar[XB_XSUB(b.x)], 1u);
        const unsigned gen = old / nloc;
        if (old + 1u == (gen + 1u) * nloc) {
            __builtin_amdgcn_fence(__ATOMIC_RELEASE, "agent");
            asm volatile("s_waitcnt vmcnt(0)" ::: "memory");
            const unsigned og = xb_add(&bar[XB_TOP], 1u);
            const unsigned tg = og / nx;
            if (og + 1u == (tg + 1u) * nx) xb_add(&bar[XB_TOPGEN], 1u);
            else XB_SPIN(xb_ld(&bar[XB_TOPGEN]) == tg, bar);
            __builtin_amdgcn_fence(__ATOMIC_ACQUIRE, "agent");
            xb_add(&bar[XB_XGEN(b.x)], 1u);
            asm volatile("s_waitcnt vmcnt(0)" ::: "memory");
        } else {
            XB_SPIN(xb_ld(&bar[XB_XGEN(b.x)]) == gen, bar);
            __builtin_amdgcn_fence(__ATOMIC_ACQUIRE, "agent");
            asm volatile("s_waitcnt vmcnt(0)" ::: "memory");
        }
    }
    __syncthreads();
}

struct SchedMoE { const char* A; const char* W; const int* seg; int nmt, nN, G, c; size_t strideA, strideE, strideN;
    __device__ __forceinline__ bool next(int i, pg8::Unit& u) const { const int L = i * G + c; if (L >= nmt * nN) return false; pg8::tile_of(L, nmt, nN, u.pm, u.pn); int e = 0;
#pragma unroll
        for (int j = 1; j < 16; ++j) if (u.pm * 256 >= seg[j]) e = j;
        u.kind = 0; u.aux = e; u.A = A + (size_t)u.pm * strideA; u.B = W + (size_t)e * strideE + (size_t)u.pn * strideN; return true; } };

__global__ void __launch_bounds__(512, 2) fwd_kernel(Params p) {
    extern __shared__ __attribute__((aligned(16))) unsigned char lds_raw[];
    float* ldsf = (float*)lds_raw;
    cg::grid_group grid = cg::this_grid();
    const int G = gridDim.x, bid = blockIdx.x, NGW = G * 8;
    unsigned char* ws = p.ws;
    const float *x = p.in[0], *mem = p.in[1], *w_in = p.in[2], *b_in = p.in[3], *w_dw = p.in[4], *b_dw = p.in[5], *g_cn = p.in[6], *b_cn = p.in[7], *sinks = p.in[8],
                *w_out = p.in[9], *g_ln1 = p.in[10], *b_ln1 = p.in[11], *w_mq = p.in[12], *w_mkv = p.in[13], *w_mo = p.in[14], *g_ln2 = p.in[15], *b_ln2 = p.in[16],
                *w_group = p.in[17], *b_group = p.in[18], *w_router = p.in[19], *b_router = p.in[20], *w_gate = p.in[21], *w_up = p.in[22], *w_down = p.in[23],
                *g_ln3 = p.in[24], *b_ln3 = p.in[25];
    float* out = p.out;
    bf16* xb = (bf16*)(ws + WS_A); bf16* ycat = (bf16*)(ws + WS_A); bf16* qm = (bf16*)(ws + WS_A); bf16* om = (bf16*)(ws + WS_A); bf16* Hs = (bf16*)(ws + WS_A);
    bf16* hglu = (bf16*)(ws + WS_B); bf16* qkv = (bf16*)(ws + WS_B + (size_t)T * 512 * 2); bf16* x1b = (bf16*)(ws + WS_B); bf16* Pb = (bf16*)(ws + WS_B); bf16* x2b = (bf16*)(ws + WS_B);
    float* Sbuf = (float*)(ws + WS_DD); bf16* Xs = (bf16*)(ws + WS_DD);
    bf16* kmem = (bf16*)(ws + WS_KMEM); bf16* vmemT = (bf16*)(ws + WS_VMEMT); bf16* memb = (bf16*)(ws + WS_MEMB);
    bf16* Wt_in = (bf16*)(ws + WS_WIN); bf16* Wt_out = (bf16*)(ws + WS_WOUT); bf16* Wt_mq = (bf16*)(ws + WS_WMQ); bf16* Wt_mkv = (bf16*)(ws + WS_WMKV); bf16* Wt_mo = (bf16*)(ws + WS_WMO);
    bf16* Wt_gu = (bf16*)(ws + WS_WGU); bf16* Wt_dn = (bf16*)(ws + WS_WDN);
    PG8_LAS unsigned char* ldsp = (PG8_LAS unsigned char*)lds_raw;
    int* route_e = (int*)(ws + WS_ROUTE); float* route_g = (float*)(ws + WS_ROUTE + (size_t)T * 8);
    int* blkcnt = (int*)(ws + WS_BLKCNT); int* segw = (int*)(ws + WS_SEG); int* rank = (int*)(ws + WS_RANK);
    int* pair_tok = (int*)(ws + WS_PTOK); float* pair_gate = (float*)(ws + WS_PGATE); int* tokpos = (int*)(ws + WS_TOKPOS); bf16* Yb = (bf16*)(ws + WS_DD);

    const int lo = p.ph_lo, hi = p.ph_hi;
    int ph = 0;
    volatile __attribute__((address_space(3))) unsigned* bst = (volatile __attribute__((address_space(3))) unsigned*)(ldsp + LDS_BYTES_K - 64);
    if (threadIdx.x == 0) { bst[0] = 0u; bst[1] = 0u; }
    __syncthreads();
    const XcdBarrier xbar = xcd_barrier_post((unsigned*)(ws + WS_CTL), bst);
    if (lo > hi) grid.sync();
#define PHASE_BEGIN if (lo <= ph && ph < hi) { for (int rep_ = 0; rep_ < ((((unsigned)PROBE_MASK >> ph) & 1u) ? 2 : 1); ++rep_) { int tid = threadIdx.x; asm volatile("" : "+v"(tid)); const int lane = tid & 63, wave = tid >> 6, gw = bid * 8 + wave; (void)lane; (void)wave; (void)gw;
#define PHASE_END } } if (lo <= ph && ph + 1 < hi) xcd_barrier(xbar); ++ph;

    PHASE_BEGIN
    for (size_t i = (size_t)bid * 512 + tid; i < (size_t)T * D / 4; i += (size_t)G * 512) { const f32x4 v = ((const f32x4*)x)[i]; u32x2 w; w.x = pk2(v.x, v.y); w.y = pk2(v.z, v.w); ((u32x2*)xb)[i] = w; }
    for (size_t i = (size_t)bid * 512 + tid; i < (size_t)NMEM * D / 4; i += (size_t)G * 512) { const f32x4 v = ((const f32x4*)mem)[i]; u32x2 w; w.x = pk2(v.x, v.y); w.y = pk2(v.z, v.w); ((u32x2*)memb)[i] = w; }
    {
        LAS float* scr = (LAS float*)(ldsp + wave * 16384);
        constexpr int I_IN = 16 * 56, I_SQ = 16 * 32, I_KV = 16 * 64, I_EX = 16 * 256;
        constexpr int NITEMS = I_IN + 3 * I_SQ + I_KV + 3 * I_EX;
        for (int it = gw; it < NITEMS; it += NGW) { int r = it;
            if (r < I_IN) { const int kb = r / 56, nb = r % 56, n0 = nb * 32; const int dr = n0 < 512 ? (n0 >> 7) * 256 + (n0 & 127) : (n0 < 1024 ? ((n0 - 512) >> 7) * 256 + 128 + (n0 & 127) : n0);
                transpose_item(w_in, D_IN, Wt_in, 1024, kb * 64, n0, dr, scr, lane); continue; } r -= I_IN;
            if (r < I_SQ) { transpose_item(w_out, 1024, Wt_out, 1024, (r / 32) * 64, (r % 32) * 32, (r % 32) * 32, scr, lane); continue; } r -= I_SQ;
            if (r < I_SQ) { transpose_item(w_mq, 1024, Wt_mq, 1024, (r / 32) * 64, (r % 32) * 32, (r % 32) * 32, scr, lane); continue; } r -= I_SQ;
            if (r < I_SQ) { transpose_item(w_mo, 1024, Wt_mo, 1024, (r / 32) * 64, (r % 32) * 32, (r % 32) * 32, scr, lane); continue; } r -= I_SQ;
            if (r < I_KV) { transpose_item(w_mkv, 2048, Wt_mkv, 1024, (r / 64) * 64, (r % 64) * 32, (r % 64) * 32, scr, lane); continue; } r -= I_KV;
            if (r < I_EX) { const int e = r / 256, q = r % 256, n0 = (q % 16) * 32; transpose_item(w_gate + (size_t)e * D * DE, DE, Wt_gu + (size_t)e * 1024 * 1024, 1024, (q / 16) * 64, n0, (n0 >> 7) * 256 + (n0 & 127), scr, lane); continue; } r -= I_EX;
            if (r < I_EX) { const int e = r / 256, q = r % 256, n0 = (q % 16) * 32; transpose_item(w_up + (size_t)e * D * DE, DE, Wt_gu + (size_t)e * 1024 * 1024, 1024, (q / 16) * 64, n0, (n0 >> 7) * 256 + 128 + (n0 & 127), scr, lane); continue; } r -= I_EX;
            { const int e = r / 256, q = r % 256; transpose_item(w_down + (size_t)e * DE * D, D, Wt_dn + (size_t)e * 1024 * 512, 512, (q / 32) * 64, (q % 32) * 32, (q % 32) * 32, scr, lane); }
        }
    }
    PHASE_END

    PHASE_BEGIN
#if FAST_P1
    {
        struct SchedP1 { const char *xb, *win, *memb, *wkv; int G, c;
            __device__ __forceinline__ bool next(int i, pg8::Unit& u) const { const int L = i * G + c; u.aux = 0;
                if (L < 448) { pg8::tile_of(L, 64, 7, u.pm, u.pn); u.A = xb + (size_t)u.pm * 256 * 2048; u.B = win + (size_t)u.pn * 256 * 2048; u.kind = u.pn < 4 ? 0 : 1; return true; }
                if (L < 456) { const int r = L - 448; u.pm = r >> 2; u.pn = r & 3; u.A = memb + (size_t)u.pm * 256 * 2048; u.B = wkv + (size_t)u.pn * 256 * 2048; u.kind = 2; return true; }
                if (L < 464) { const int r = L - 456; u.pm = r >> 1; u.pn = r & 1; u.A = wkv + (size_t)(4 + u.pm) * 256 * 2048; u.B = memb + (size_t)u.pn * 256 * 2048; u.kind = 3; return true; }
                return false; } };
        const SchedP1 S{(const char*)xb, (const char*)Wt_in, (const char*)memb, (const char*)Wt_mkv, G, bid};
        const pg8::EpiP1 E{hglu, qkv, kmem, vmemT, b_in};
        pg8::gemm_phase(ldsp, pg8::Gemm{1024, 1024, 1024}, S, E);
    }
#else
    constexpr int U_GLU = 128 * 8, U_QKV = 128 * 12, U_KVM = 4 * 32;
    for (int u = bid; u < U_GLU + U_QKV + U_KVM; u += G) {
        if (u < U_GLU) { const int mt = u / 8, nt = u % 8;
            ngemm_tile<2>(ldsf, D, mt * 128, nt * 64,
                [&](int m, int k) { return bf2f(xb[(size_t)m * D + k]); },
                [&](int b, int k, int n) { return w_in[(size_t)k * D_IN + n + b * 512]; },
                [&](int m, int n, float a, float g) { a += b_in[n]; g += b_in[512 + n]; hglu[(size_t)m * 512 + n] = (bf16)f2bf(a / (1.f + __expf(-g))); });
        } else if (u < U_GLU + U_QKV) { const int r = u - U_GLU, mt = r / 12, nt = r % 12;
            ngemm_tile<1>(ldsf, D, mt * 128, nt * 64,
                [&](int m, int k) { return bf2f(xb[(size_t)m * D + k]); },
                [&](int b, int k, int n) { return w_in[(size_t)k * D_IN + 1024 + n]; },
                [&](int m, int n, float a, float) { qkv[(size_t)m * 768 + n] = (bf16)f2bf(a + b_in[1024 + n]); });
        } else { const int r = u - U_GLU - U_QKV, mt = r / 32, nt = r % 32;
            ngemm_tile<1>(ldsf, D, mt * 128, nt * 64,
                [&](int m, int k) { return bf2f(memb[(size_t)m * D + k]); },
                [&](int b, int k, int n) { return w_mkv[(size_t)k * 2048 + n]; },
                [&](int m, int n, float a, float) { if (n < 1024) kmem[(size_t)m * 1024 + n] = (bf16)f2bf(a); else vmemT[(size_t)(n - 1024) * 512 + m] = (bf16)f2bf(a); });
        }
    }
#endif
    PHASE_END

    PHASE_BEGIN
#if FAST_P2
    for (int cu = bid; cu < T / 32; cu += G) conv_unit(lds_raw, hglu, w_dw, b_dw, g_cn, b_cn, ycat, cu);
    for (int u = bid; u < BATCH * NKV * (SEQ / 128); u += G) swa_unit(lds_raw, qkv, sinks, ycat, u >> 7, (u >> 6) & 1, u & 63);
#else
    {
        float wreg[CONV_W];
#pragma unroll
        for (int j = 0; j < CONV_W; ++j) wreg[j] = w_dw[j * CONV_CH + tid];
        const float bdw = b_dw[tid];
        float* cbuf = ldsf;
        for (int it = bid; it < T / 16; it += G) {
            const int t0 = it * 16, s0 = t0 % SEQ;
            for (int tt = 0; tt < 16; ++tt) {
                float acc = bdw;
#pragma unroll
                for (int j = 0; j < CONV_W; ++j) { const int sp = s0 + tt - (CONV_W - 1) + j; if (sp >= 0) acc += wreg[j] * bf2f(hglu[(size_t)(t0 + tt - (CONV_W - 1) + j) * 512 + tid]); }
                cbuf[tt * 512 + tid] = acc;
            }
            __syncthreads();
            for (int r = wave; r < 16; r += 8) {
                f32x4 v[2]; float s = 0.f;
#pragma unroll
                for (int j = 0; j < 2; ++j) { v[j] = ((const f32x4*)(cbuf + r * 512))[lane + 64 * j]; s += (v[j].x + v[j].y) + (v[j].z + v[j].w); }
                const float mean = wave_sum(s) * (1.f / 512.f); float s2 = 0.f;
#pragma unroll
                for (int j = 0; j < 2; ++j) { v[j] = v[j] - mean; s2 += (v[j].x * v[j].x + v[j].y * v[j].y) + (v[j].z * v[j].z + v[j].w * v[j].w); }
                const float rstd = 1.f / sqrtf(wave_sum(s2) * (1.f / 512.f) + LN_EPS);
#pragma unroll
                for (int j = 0; j < 2; ++j) { const f32x4 gg = ((const f32x4*)g_cn)[lane + 64 * j], bb = ((const f32x4*)b_cn)[lane + 64 * j]; f32x4 y = v[j] * rstd * gg + bb;
                    y.x = y.x / (1.f + __expf(-y.x)); y.y = y.y / (1.f + __expf(-y.y)); y.z = y.z / (1.f + __expf(-y.z)); y.w = y.w / (1.f + __expf(-y.w));
                    u32x2 w; w.x = pk2(y.x, y.y); w.y = pk2(y.z, y.w); ((u32x2*)(ycat + (size_t)(t0 + r) * 1024))[lane + 64 * j] = w; }
            }
            __syncthreads();
        }
    }
    {
        float* wq = ldsf + wave * 192; float* wp = wq + 64;
        for (int task = gw; task < T * NH; task += NGW) {
            const int t = task >> 3, hq = task & 7, kvh = hq >> 2, s = t % SEQ;
            wq[lane] = bf2f(qkv[(size_t)t * 768 + hq * 64 + lane]);
            __builtin_amdgcn_wave_barrier(); asm volatile("s_waitcnt lgkmcnt(0)" ::: "memory");
            float sc[2];
#pragma unroll
            for (int h2 = 0; h2 < 2; ++h2) { const int j = lane + 64 * h2, kp = s - (WINDOW - 1) + j;
                float a = -INFINITY;
                if (kp >= 0) { const u32x4* kr = (const u32x4*)(qkv + (size_t)(t - (WINDOW - 1) + j) * 768 + 512 + kvh * 64); a = 0.f;
#pragma unroll
                    for (int c = 0; c < 8; ++c) { const u32x4 kk = kr[c];
#pragma unroll
                        for (int i = 0; i < 4; ++i) { a += wq[c * 8 + 2 * i] * __builtin_bit_cast(float, kk[i] << 16); a += wq[c * 8 + 2 * i + 1] * __builtin_bit_cast(float, kk[i] & 0xffff0000u); } }
                    a *= 0.125f; }
                sc[h2] = a; }
            const float sk = sinks[hq];
            const float mx = fmaxf(wave_max(fmaxf(sc[0], sc[1])), sk);
            const float p0 = __expf(sc[0] - mx), p1 = __expf(sc[1] - mx);
            const float den = wave_sum(p0 + p1) + __expf(sk - mx);
            wp[lane] = p0; wp[lane + 64] = p1;
            __builtin_amdgcn_wave_barrier(); asm volatile("s_waitcnt lgkmcnt(0)" ::: "memory");
            float o = 0.f;
            for (int j = 0; j < WINDOW; ++j) { const int kp = s - (WINDOW - 1) + j; if (kp >= 0) o += wp[j] * bf2f(qkv[(size_t)(t - (WINDOW - 1) + j) * 768 + 640 + kvh * 64 + lane]); }
            ycat[(size_t)t * 1024 + 512 + hq * 64 + lane] = (bf16)f2bf(o / den);
            __builtin_amdgcn_wave_barrier(); asm volatile("s_waitcnt lgkmcnt(0)" ::: "memory");
        }
    }
#endif
    PHASE_END

    PHASE_BEGIN
#if FAST_DENSE
    { const pg8::DenseSched S{(const char*)ycat, (const char*)Wt_out, 64, 4, G, bid, (size_t)256 * 2048, (size_t)256 * 2048};
      const pg8::EpiResF32 E{x, out, ALPHA}; pg8::gemm_phase(ldsp, pg8::Gemm{1024, 1024, 1024}, S, E); }
#else
    for (int u = bid; u < 128 * 16; u += G) { const int mt = u / 16, nt = u % 16;
        ngemm_tile<1>(ldsf, D, mt * 128, nt * 64,
            [&](int m, int k) { return bf2f(ycat[(size_t)m * D + k]); },
            [&](int b, int k, int n) { return w_out[(size_t)k * D + n]; },
            [&](int m, int n, float a, float) { out[(size_t)m * D + n] = ALPHA * x[(size_t)m * D + n] + a; });
    }
#endif
    PHASE_END
    PHASE_BEGIN
    for (int m = gw; m < T; m += NGW) { f32x4 v[4]; ln_row(out + (size_t)m * D, g_ln1, b_ln1, v, lane); st_row_f32(out + (size_t)m * D, v, 1.f, lane); st_row_bf16(x1b + (size_t)m * D, v, lane); }
    PHASE_END
    PHASE_BEGIN
#if FAST_DENSE
    { const pg8::DenseSched S{(const char*)x1b, (const char*)Wt_mq, 64, 4, G, bid, (size_t)256 * 2048, (size_t)256 * 2048};
      const pg8::EpiBf16 E{qm, 1024, nullptr}; pg8::gemm_phase(ldsp, pg8::Gemm{1024, 1024, 1024}, S, E); }
#else
    for (int u = bid; u < 128 * 16; u += G) { const int mt = u / 16, nt = u % 16;
        ngemm_tile<1>(ldsf, D, mt * 128, nt * 64,
            [&](int m, int k) { return bf2f(x1b[(size_t)m * D + k]); },
            [&](int b, int k, int n) { return w_mq[(size_t)k * D + n]; },
            [&](int m, int n, float a, float) { qm[(size_t)m * D + n] = (bf16)f2bf(a); });
    }
#endif
    PHASE_END
    PHASE_BEGIN
#if FAST_XATT
    {
        struct SchedS { const char *qm, *kmem; int G, c;
            __device__ __forceinline__ bool next(int i, pg8::Unit& u) const { const int L = i * G + c; if (L >= 256) return false; pg8::tile_of(L, 64, 4, u.pm, u.pn); u.kind = 0; u.aux = 0;
                u.A = qm + ((size_t)u.pm * 256 * 1024 + u.pn * 256) * 2; u.B = kmem + ((size_t)(u.pm >> 5) * 256 * 1024 + u.pn * 256) * 2; return true; } };
        const SchedS S{(const char*)qm, (const char*)kmem, G, bid};
        const pg8::EpiSoftmax E{Pb, (PG8_LAS float*)(ldsp + 131072)};
        pg8::gemm_phase(ldsp, pg8::Gemm{1024, 1024, 256}, S, E);
    }
#else
    for (int u = bid; u < 128 * 16; u += G) { const int mt = u / 16, h = (u % 16) / 4, nt = u % 4; const int b = (mt * 128) / SEQ;
        ngemm_tile<1>(ldsf, MHD, mt * 128, nt * 64,
            [&](int m, int k) { return bf2f(qm[(size_t)m * D + h * MHD + k]); },
            [&](int bb, int k, int n) { return bf2f(kmem[(size_t)(b * MEM + n) * D + h * MHD + k]); },
            [&](int m, int n, float a, float) { Sbuf[(size_t)m * D + h * MHD + n] = a * 0.0625f; });
    }
#endif
    PHASE_END
#if !FAST_XATT
    PHASE_BEGIN
    for (int m = gw; m < T; m += NGW) {
#pragma unroll
        for (int h = 0; h < 4; ++h) { const f32x4 v = ((const f32x4*)(Sbuf + (size_t)m * D + h * MHD))[lane];
            const float mx = wave_max(fmaxf(fmaxf(v.x, v.y), fmaxf(v.z, v.w)));
            const float e0 = __expf(v.x - mx), e1 = __expf(v.y - mx), e2 = __expf(v.z - mx), e3 = __expf(v.w - mx);
            const float inv = 1.f / wave_sum((e0 + e1) + (e2 + e3));
            u32x2 w; w.x = pk2(e0 * inv, e1 * inv); w.y = pk2(e2 * inv, e3 * inv); ((u32x2*)(Pb + (size_t)m * D + h * MHD))[lane] = w; }
    }
    PHASE_END
#endif
    PHASE_BEGIN
#if FAST_XATT
    {
        struct SchedO { const char *P, *vT; int G, c;
            __device__ __forceinline__ bool next(int i, pg8::Unit& u) const { const int L = i * G + c; if (L >= 256) return false; pg8::tile_of(L, 64, 4, u.pm, u.pn); u.kind = 0; u.aux = 0;
                u.A = P + ((size_t)u.pm * 256 * 1024 + u.pn * 256) * 2; u.B = vT + ((size_t)u.pn * 256 * 512 + (u.pm >> 5) * 256) * 2; return true; } };
        const SchedO S{(const char*)Pb, (const char*)vmemT, G, bid};
        const pg8::EpiBf16 E{om, 1024, nullptr};
        pg8::gemm_phase(ldsp, pg8::Gemm{1024, 512, 256}, S, E);
    }
#else
    for (int u = bid; u < 128 * 16; u += G) { const int mt = u / 16, h = (u % 16) / 4, nt = u % 4; const int b = (mt * 128) / SEQ;
        ngemm_tile<1>(ldsf, MEM, mt * 128, nt * 64,
            [&](int m, int k) { return bf2f(Pb[(size_t)m * D + h * MHD + k]); },
            [&](int bb, int k, int n) { return bf2f(vmemT[(size_t)(h * MHD + n) * NMEM + b * MEM + k]); },
            [&](int m, int n, float a, float) { om[(size_t)m * D + h * MHD + n] = (bf16)f2bf(a); });
    }
#endif
    PHASE_END
    PHASE_BEGIN
#if FAST_DENSE
    { const pg8::DenseSched S{(const char*)om, (const char*)Wt_mo, 64, 4, G, bid, (size_t)256 * 2048, (size_t)256 * 2048};
      const pg8::EpiResF32 E{out, out, ALPHA}; pg8::gemm_phase(ldsp, pg8::Gemm{1024, 1024, 1024}, S, E); }
#else
    for (int u = bid; u < 128 * 16; u += G) { const int mt = u / 16, nt = u % 16;
        ngemm_tile<1>(ldsf, D, mt * 128, nt * 64,
            [&](int m, int k) { return bf2f(om[(size_t)m * D + k]); },
            [&](int b, int k, int n) { return w_mo[(size_t)k * D + n]; },
            [&](int m, int n, float a, float) { out[(size_t)m * D + n] = ALPHA * out[(size_t)m * D + n] + a; });
    }
#endif
    PHASE_END
    const int TPB = (T + G - 1) / G;
    PHASE_BEGIN
    { const int t0 = bid * TPB, t1 = (t0 + TPB < T) ? t0 + TPB : T;
      float* Wl = ldsf;
      int* le = (int*)(lds_raw + 81920);
      for (int k = tid; k < D; k += 512) { const f32x4 wg = *(const f32x4*)(w_group + (size_t)k * 4);
          Wl[0 * D + k] = wg.x; Wl[1 * D + k] = wg.y; Wl[2 * D + k] = wg.z; Wl[3 * D + k] = wg.w;
#pragma unroll
          for (int gq = 0; gq < 4; ++gq) { const f32x4 wr = *(const f32x4*)(w_router + ((size_t)gq * D + k) * 4);
              Wl[(4 + gq * 4 + 0) * D + k] = wr.x; Wl[(4 + gq * 4 + 1) * D + k] = wr.y; Wl[(4 + gq * 4 + 2) * D + k] = wr.z; Wl[(4 + gq * 4 + 3) * D + k] = wr.w; } }
      __syncthreads();
      const int TPW = (TPB + 7) / 8;
      for (int mb = t0 + wave * TPW; mb < t0 + (wave + 1) * TPW && mb < t1; mb += 2) {
        f32x4 v[2][4];
        const bool has1 = (mb + 1 < t1) && (mb + 1 < t0 + (wave + 1) * TPW);
        ln_row(out + (size_t)mb * D, g_ln2, b_ln2, v[0], lane);
        st_row_f32(out + (size_t)mb * D, v[0], ALPHA, lane); st_row_bf16(x2b + (size_t)mb * D, v[0], lane);
        __builtin_amdgcn_sched_barrier(0);
        ln_row(out + (size_t)(has1 ? mb + 1 : mb) * D, g_ln2, b_ln2, v[1], lane);
        if (has1) { st_row_f32(out + (size_t)(mb + 1) * D, v[1], ALPHA, lane); st_row_bf16(x2b + (size_t)(mb + 1) * D, v[1], lane); }
        __builtin_amdgcn_sched_barrier(0);
        float my[20];
#pragma unroll
        for (int c = 0; c < 20; ++c) {
            float a0 = 0.f, a1 = 0.f;
#pragma unroll
            for (int jj = 0; jj < 4; ++jj) { const f32x4 w4 = ((const f32x4*)(Wl + c * D))[lane + 64 * jj];
                a0 += (v[0][jj].x * w4.x + v[0][jj].y * w4.y) + (v[0][jj].z * w4.z + v[0][jj].w * w4.w);
                a1 += (v[1][jj].x * w4.x + v[1][jj].y * w4.y) + (v[1][jj].z * w4.z + v[1][jj].w * w4.w); }
            a0 = wave_sum(a0); a1 = wave_sum(a1);
            my[c] = (lane == 1) ? a1 : a0;
        }
        const int m = mb + lane;
        if (lane < 2 && m < t1 && m < t0 + (wave + 1) * TPW) {
            float gl[4]; int gi = 0; float gmx = -INFINITY;
#pragma unroll
            for (int i = 0; i < 4; ++i) { gl[i] = my[i] + b_group[i]; if (gl[i] > gmx) { gmx = gl[i]; gi = i; } }
            float gs = 0.f;
#pragma unroll
            for (int i = 0; i < 4; ++i) gs += __expf(gl[i] - gmx);
            const float gp = 1.f / gs;
            float el[4];
#pragma unroll
            for (int i = 0; i < 4; ++i) { float a = my[4 + i], bq = b_router[i];
                a = (gi == 1) ? my[8 + i] : a; a = (gi == 2) ? my[12 + i] : a; a = (gi == 3) ? my[16 + i] : a;
                bq = (gi == 1) ? b_router[4 + i] : bq; bq = (gi == 2) ? b_router[8 + i] : bq; bq = (gi == 3) ? b_router[12 + i] : bq;
                el[i] = a + bq; }
            int i0 = 0; float v0 = el[0];
#pragma unroll
            for (int i = 1; i < 4; ++i) if (el[i] > v0) { v0 = el[i]; i0 = i; }
            int i1 = -1; float v1 = -INFINITY;
#pragma unroll
            for (int i = 0; i < 4; ++i) if (i != i0 && el[i] > v1) { v1 = el[i]; i1 = i; }
            const float w0 = 1.f / (1.f + __expf(v1 - v0)), w1 = 1.f - w0;
            route_e[2 * m] = gi * 4 + i0; route_e[2 * m + 1] = gi * 4 + i1; route_g[2 * m] = gp * w0; route_g[2 * m + 1] = gp * w1;
            le[2 * (m - t0)] = gi * 4 + i0; le[2 * (m - t0) + 1] = gi * 4 + i1;
        }
      }
      __syncthreads();
      const int np = 2 * (t1 - t0);
      for (int i = tid; i < np; i += 512) { const int e = le[i]; int r = 0; for (int j2 = 0; j2 < i; ++j2) r += (le[j2] == e) ? 1 : 0; rank[2 * t0 + i] = r; }
      if (tid < 16) { int c = 0; for (int j2 = 0; j2 < np; ++j2) c += (le[j2] == tid) ? 1 : 0; blkcnt[bid * 16 + tid] = c; }
    }
    PHASE_END
    PHASE_BEGIN
    {
        int* sh = (int*)lds_raw;
        { const int e = tid & 15, part = tid >> 4; int tot = 0, base = 0;
          for (int b = part; b < G; b += 32) { const int c = blkcnt[b * 16 + e]; tot += c; if (b < bid) base += c; }
          sh[128 + part * 16 + e] = tot; sh[640 + part * 16 + e] = base; }
        __syncthreads();
        if (tid < 16) { int tot = 0, base = 0;
#pragma unroll 8
            for (int part = 0; part < 32; ++part) { tot += sh[128 + part * 16 + tid]; base += sh[640 + part * 16 + tid]; } sh[tid] = base; sh[64 + tid] = tot; }
        __syncthreads();
        if (tid == 0) { int sacc = 0; for (int e = 0; e < 16; ++e) { sh[16 + e] = sacc; sacc += (sh[64 + e] + 255) & ~255; } sh[32] = sacc; if (bid == 0) for (int e = 0; e <= 16; ++e) segw[e] = sh[16 + e]; }
        __syncthreads();
        if (bid == 0) { for (int e = 0; e < 16; ++e) for (int pos = sh[16 + e] + sh[64 + e] + tid; pos < sh[16 + e + 1]; pos += 512) { pair_tok[pos] = -1; pair_gate[pos] = 0.f; } }
        const int t0 = bid * TPB, t1 = (t0 + TPB < T) ? t0 + TPB : T, np = 2 * (t1 - t0);
        for (int i = tid; i < np; i += 512) { const int pi = 2 * t0 + i, e = route_e[pi], pos = sh[16 + e] + sh[e] + rank[pi]; pair_tok[pos] = pi >> 1; pair_gate[pos] = route_g[pi]; tokpos[pi] = pos; sh[2048 + i] = pos; }
        __syncthreads();
        for (int i = wave; i < np; i += 8) { const int pos = sh[2048 + i], tok = t0 + (i >> 1);
            const u32x4* src = (const u32x4*)(x2b + (size_t)tok * D); u32x4* dst = (u32x4*)(Xs + (size_t)pos * D);
            dst[lane] = src[lane]; dst[lane + 64] = src[lane + 64]; }
    }
    PHASE_END
    PHASE_BEGIN
#if FAST_MOE
    { const SchedMoE S{(const char*)Xs, (const char*)Wt_gu, segw, segw[16] / 256, 4, G, bid, (size_t)256 * 2048, (size_t)1024 * 2048, (size_t)256 * 2048};
      const pg8::EpiGateUp E{Hs, pair_gate}; pg8::gemm_phase(ldsp, pg8::Gemm{1024, 1024, 1024}, S, E); }
#else
    { const int nmt = segw[16] / 128;
      for (int u = bid; u < nmt * 8; u += G) { const int mt = u / 8, nt = u % 8; int e = 0;
#pragma unroll
        for (int i = 1; i < 16; ++i) if (mt * 128 >= segw[i]) e = i;
        const float* wg = w_gate + (size_t)e * D * DE; const float* wu = w_up + (size_t)e * D * DE;
        ngemm_tile<2>(ldsf, D, mt * 128, nt * 64,
            [&](int m, int k) { return bf2f(Xs[(size_t)m * D + k]); },
            [&](int b, int k, int n) { return (b == 0 ? wg : wu)[(size_t)k * DE + n]; },
            [&](int m, int n, float g, float uu) { const float pg = pair_gate[m]; const float hv = (pair_tok[m] >= 0) ? (g / (1.f + __expf(-g))) * uu * pg : 0.f; Hs[(size_t)m * DE + n] = (bf16)f2bf(hv); });
      } }
#endif
    PHASE_END
    PHASE_BEGIN
#if FAST_MOE
    { const SchedMoE S{(const char*)Hs, (const char*)Wt_dn, segw, segw[16] / 256, 4, G, bid, (size_t)256 * 1024, (size_t)1024 * 1024, (size_t)256 * 1024};
      const pg8::EpiBf16 E{Yb, 1024, nullptr}; pg8::gemm_phase(ldsp, pg8::Gemm{512, 512, 512}, S, E); }
#else
    { const int nmt = segw[16] / 128;
      for (int u = bid; u < nmt * 16; u += G) { const int mt = u / 16, nt = u % 16; int e = 0;
#pragma unroll
        for (int i = 1; i < 16; ++i) if (mt * 128 >= segw[i]) e = i;
        const float* wd = w_down + (size_t)e * DE * D;
        ngemm_tile<1>(ldsf, DE, mt * 128, nt * 64,
            [&](int m, int k) { return bf2f(Hs[(size_t)m * DE + k]); },
            [&](int b, int k, int n) { return wd[(size_t)k * D + n]; },
            [&](int m, int n, float a, float) { const int tok = pair_tok[m]; if (tok >= 0) atomicAdd(out + (size_t)tok * D + n, a); });
      } }
#endif
    PHASE_END
    PHASE_BEGIN
#if FAST_MOE
    for (int m = gw; m < T; m += NGW) { float* row = out + (size_t)m * D; const int p0 = tokpos[2 * m], p1 = tokpos[2 * m + 1];
        const u32x2* y0 = (const u32x2*)(Yb + (size_t)p0 * D); const u32x2* y1 = (const u32x2*)(Yb + (size_t)p1 * D);
        f32x4 v[4]; float sacc = 0.f;
#pragma unroll
        for (int jj = 0; jj < 4; ++jj) { const u32x2 a = y0[lane + 64 * jj], b = y1[lane + 64 * jj]; f32x4 z = ((const f32x4*)row)[lane + 64 * jj];
            z.x += bflo(a.x) + bflo(b.x); z.y += bfhi(a.x) + bfhi(b.x); z.z += bflo(a.y) + bflo(b.y); z.w += bfhi(a.y) + bfhi(b.y); v[jj] = z; sacc += (z.x + z.y) + (z.z + z.w); }
        const float mean = wave_sum(sacc) * (1.f / D); float s2 = 0.f;
#pragma unroll
        for (int jj = 0; jj < 4; ++jj) { v[jj] = v[jj] - mean; s2 += (v[jj].x * v[jj].x + v[jj].y * v[jj].y) + (v[jj].z * v[jj].z + v[jj].w * v[jj].w); }
        const float rstd = 1.f / sqrtf(wave_sum(s2) * (1.f / D) + LN_EPS);
#pragma unroll
        for (int jj = 0; jj < 4; ++jj) { const f32x4 gg = ((const f32x4*)g_ln3)[lane + 64 * jj], bb = ((const f32x4*)b_ln3)[lane + 64 * jj]; ((f32x4*)row)[lane + 64 * jj] = v[jj] * rstd * gg + bb; } }
#else
    for (int m = gw; m < T; m += NGW) { f32x4 v[4]; ln_row(out + (size_t)m * D, g_ln3, b_ln3, v, lane); st_row_f32(out + (size_t)m * D, v, 1.f, lane); }
#endif
    PHASE_END
}

constexpr int N_PHASES = 16;
constexpr int LDS_BYTES = 147456;

extern "C" void kernel_launch(void* const* d_in, const int* in_sizes, int n_in, void* d_out, int out_size, void* d_ws, size_t ws_size, hipStream_t stream) {
    static int grid = 0;
    if (grid == 0) {
        int dev = 0, cus = 0, per_cu = 0;
        hipGetDevice(&dev);
        hipDeviceGetAttribute(&cus, hipDeviceAttributeMultiprocessorCount, dev);
        hipFuncSetAttribute((const void*)fwd_kernel, hipFuncAttributeMaxDynamicSharedMemorySize, LDS_BYTES);
        hipOccupancyMaxActiveBlocksPerMultiprocessor(&per_cu, (const void*)fwd_kernel, 512, LDS_BYTES);
        if (per_cu < 1) { fprintf(stderr, "occupancy query returned %d\n", per_cu); per_cu = 1; }
        grid = cus * 1;
        if (ws_size < WS_END) { fprintf(stderr, "workspace too small\n"); grid = -1; }
    }
    if (grid < 0) return;
    if (hipMemsetAsync((char*)d_ws + WS_CTL, 0, 65536, stream) != hipSuccess) { fprintf(stderr, "memset failed\n"); return; }
    Params p{};
    for (int i = 0; i < 26; ++i) p.in[i] = (const float*)d_in[i];
    p.out = (float*)d_out; p.ws = (unsigned char*)d_ws;
#if MK_N_LAUNCHES == 1
    p.ph_lo = 0; p.ph_hi = 64;
    void* args[] = {&p};
    hipError_t e = hipLaunchCooperativeKernel((const void*)fwd_kernel, dim3(grid), dim3(512), args, LDS_BYTES, stream);
    if (e != hipSuccess) fprintf(stderr, "cooperative launch failed: %s (grid %d)\n", hipGetErrorString(e), grid);
#else
    for (int ph = 0; ph < N_PHASES; ++ph) { p.ph_lo = ph; p.ph_hi = ph + 1; hipLaunchKernelGGL(fwd_kernel, dim3(grid), dim3(512), LDS_BYTES, stream, p); }
#endif
}
```

```cpp
#include <hip/hip_runtime.h>
#include <hip/hip_cooperative_groups.h>
#include <cstdio>
#include <cstdint>
namespace cg = cooperative_groups;

#ifndef PROBE_MASK
#define PROBE_MASK 0
#endif
#ifndef MK_N_LAUNCHES
#define MK_N_LAUNCHES 1
#endif

typedef unsigned short bf16;
typedef float f32x4 __attribute__((ext_vector_type(4)));
typedef unsigned u32x4 __attribute__((ext_vector_type(4)));
typedef unsigned u32x2 __attribute__((ext_vector_type(2)));

constexpr int BATCH = 2, SEQ = 8192, D = 1024, T = BATCH * SEQ, MEM = 256, NMEM = BATCH * MEM;
constexpr int CONV_CH = 512, CONV_W = 31, NH = 8, NKV = 2, HD = 64, ATTN_W = 512, KV_W = 128, WINDOW = 128;
constexpr int D_IN = 1792, MH = 4, MHD = 256, NG = 4, EPG = 4, NE = 16, DE = 512;
constexpr float ALPHA = 1.189207115002721f, LN_EPS = 1e-5f;
constexpr int NPAIR = 2 * T, NPAIR_PAD = NPAIR + NE * 256;
constexpr int LDS_BYTES_K = 147456;

constexpr size_t MiB = 1u << 20;
constexpr size_t WS_CTL = 0;
constexpr size_t WS_ROUTE = 1 * MiB;
constexpr size_t WS_BLKCNT = 1 * MiB + 512 * 1024;
constexpr size_t WS_SEG = 1 * MiB + 640 * 1024;
constexpr size_t WS_RANK = 2 * MiB;
constexpr size_t WS_PTOK = 2 * MiB + 256 * 1024;
constexpr size_t WS_PGATE = 2 * MiB + 512 * 1024;
constexpr size_t WS_TOKPOS = 2 * MiB + 768 * 1024;
constexpr size_t WS_KVM = 3 * MiB;
constexpr size_t WS_MEMB = 5 * MiB;
constexpr size_t WS_A = 8 * MiB;
constexpr size_t WS_B = 48 * MiB;
constexpr size_t WS_DD = 88 * MiB;
constexpr size_t WS_WIN = 164 * MiB;
constexpr size_t WS_WOUT = 168 * MiB, WS_WMQ = 170 * MiB, WS_WMKV = 172 * MiB, WS_WMO = 176 * MiB;
constexpr size_t WS_WGU = 178 * MiB;
constexpr size_t WS_WDN = 210 * MiB;
constexpr size_t WS_ST1 = 226 * MiB;
constexpr size_t WS_CS1 = 128 * 1024;
constexpr size_t WS_MT = 228 * MiB;
constexpr size_t WS_NT = 232 * MiB;
constexpr size_t WS_CSS = 192 * 1024;
constexpr size_t WS_CSP = 256 * 1024;
constexpr size_t WS_END = 236 * MiB;

struct Params { const float* in[26]; float* out; unsigned char* ws; int ph_lo, ph_hi; };

__device__ __forceinline__ unsigned f2bf(float f) { unsigned u = __builtin_bit_cast(unsigned, f); return (u + 0x7fffu + ((u >> 16) & 1u)) >> 16; }
__device__ __forceinline__ float bf2f(bf16 b) { return __builtin_bit_cast(float, (unsigned)b << 16); }
__device__ __forceinline__ unsigned pk2(float lo, float hi) { return f2bf(lo) | (f2bf(hi) << 16); }
template <int CTRL, int ROWMASK> __device__ __forceinline__ float dpp_f(float v) { return __builtin_bit_cast(float, __builtin_amdgcn_update_dpp(0, __builtin_bit_cast(int, v), CTRL, ROWMASK, 0xF, false)); }
__device__ __forceinline__ float wave_sum(float v) {
    v += dpp_f<0xB1, 0xF>(v);
    v += dpp_f<0x4E, 0xF>(v);
    v += dpp_f<0x141, 0xF>(v);
    v += dpp_f<0x140, 0xF>(v);
    v += dpp_f<0x142, 0xA>(v);
    v += dpp_f<0x143, 0xC>(v);
    return __builtin_bit_cast(float, __builtin_amdgcn_readlane(__builtin_bit_cast(int, v), 63));
}
__device__ __forceinline__ float wave_max(float v) {
    v = fmaxf(v, __builtin_bit_cast(float, __builtin_amdgcn_update_dpp(__builtin_bit_cast(int, v), __builtin_bit_cast(int, v), 0xB1, 0xF, 0xF, false)));
    v = fmaxf(v, __builtin_bit_cast(float, __builtin_amdgcn_update_dpp(__builtin_bit_cast(int, v), __builtin_bit_cast(int, v), 0x4E, 0xF, 0xF, false)));
    v = fmaxf(v, __builtin_bit_cast(float, __builtin_amdgcn_update_dpp(__builtin_bit_cast(int, v), __builtin_bit_cast(int, v), 0x141, 0xF, 0xF, false)));
    v = fmaxf(v, __builtin_bit_cast(float, __builtin_amdgcn_update_dpp(__builtin_bit_cast(int, v), __builtin_bit_cast(int, v), 0x140, 0xF, 0xF, false)));
    v = fmaxf(v, __builtin_bit_cast(float, __builtin_amdgcn_update_dpp(__builtin_bit_cast(int, v), __builtin_bit_cast(int, v), 0x142, 0xA, 0xF, false)));
    v = fmaxf(v, __builtin_bit_cast(float, __builtin_amdgcn_update_dpp(__builtin_bit_cast(int, v), __builtin_bit_cast(int, v), 0x143, 0xC, 0xF, false)));
    return __builtin_bit_cast(float, __builtin_amdgcn_readlane(__builtin_bit_cast(int, v), 63));
}
__device__ __forceinline__ int lane_fresh() { int l; asm volatile("v_mbcnt_lo_u32_b32 %0, -1, 0\n\tv_mbcnt_hi_u32_b32 %0, -1, %0" : "=v"(l)); return l; }
__device__ __forceinline__ float ldA(const bf16* p) { return bf2f(*p); }
__device__ __forceinline__ float ldA(const float* p) { return *p; }

template <int NB, class FA, class FB, class FE>
__device__ __forceinline__ void ngemm_tile(int tid, float* lds, int K, int m0, int n0, FA fa, FB fb, FE fe) {
    float* As = lds;
    float* Bs = lds + 16 * 132;
    const int ty = tid >> 4, tx = tid & 15;
    float acc[NB][4][4];
#pragma unroll
    for (int b = 0; b < NB; ++b)
#pragma unroll
        for (int i = 0; i < 4; ++i)
#pragma unroll
            for (int j = 0; j < 4; ++j) acc[b][i][j] = 0.f;
    for (int k0 = 0; k0 < K; k0 += 16) {
        { const int r = tid >> 2, kk = (tid & 3) * 4;
#pragma unroll
            for (int i = 0; i < 4; ++i) As[(kk + i) * 132 + r] = fa(m0 + r, k0 + kk + i); }
#pragma unroll
        for (int b = 0; b < NB; ++b) { const int kk = tid >> 5, nn = (tid & 31) * 2;
            Bs[(b * 16 + kk) * 68 + nn] = fb(b, k0 + kk, n0 + nn); Bs[(b * 16 + kk) * 68 + nn + 1] = fb(b, k0 + kk, n0 + nn + 1); }
        __syncthreads();
#pragma unroll 4
        for (int k = 0; k < 16; ++k) {
            const f32x4 a = *(const f32x4*)&As[k * 132 + ty * 4];
#pragma unroll
            for (int b = 0; b < NB; ++b) { const f32x4 bb = *(const f32x4*)&Bs[(b * 16 + k) * 68 + tx * 4];
#pragma unroll
                for (int i = 0; i < 4; ++i)
#pragma unroll
                    for (int j = 0; j < 4; ++j) acc[b][i][j] += a[i] * bb[j]; }
        }
        __syncthreads();
    }
#pragma unroll
    for (int i = 0; i < 4; ++i)
#pragma unroll
        for (int j = 0; j < 4; ++j) fe(m0 + ty * 4 + i, n0 + tx * 4 + j, acc[0][i][j], acc[NB - 1][i][j]);
}

__device__ __forceinline__ void ln_row(const float* src, const float* g, const float* b, f32x4 (&v)[4], int lane) {
    const f32x4* xr = (const f32x4*)src + lane; float s = 0.f;
#pragma unroll
    for (int j = 0; j < 4; ++j) { v[j] = xr[64 * j]; s += (v[j].x + v[j].y) + (v[j].z + v[j].w); }
    const float mean = wave_sum(s) * (1.f / D); float s2 = 0.f;
#pragma unroll
    for (int j = 0; j < 4; ++j) { v[j] = v[j] - mean; s2 += (v[j].x * v[j].x + v[j].y * v[j].y) + (v[j].z * v[j].z + v[j].w * v[j].w); }
    const float rstd = 1.f / sqrtf(wave_sum(s2) * (1.f / D) + LN_EPS);
#pragma unroll
    for (int j = 0; j < 4; ++j) { const f32x4 gg = ((const f32x4*)g)[lane + 64 * j], bb = ((const f32x4*)b)[lane + 64 * j]; v[j] = v[j] * rstd * gg + bb; }
}
__device__ __forceinline__ void st_row_f32(float* dst, const f32x4 (&v)[4], float scale, int lane) {
#pragma unroll
    for (int j = 0; j < 4; ++j) ((f32x4*)dst)[lane + 64 * j] = v[j] * scale;
}
__device__ __forceinline__ void st_row_bf16(bf16* dst, const f32x4 (&v)[4], int lane) {
#pragma unroll
    for (int j = 0; j < 4; ++j) { u32x2 w; w.x = pk2(v[j].x, v[j].y); w.y = pk2(v[j].z, v[j].w); ((u32x2*)dst)[lane + 64 * j] = w; }
}


namespace pg8 {
#define PG8_LAS __attribute__((address_space(3)))
typedef unsigned short bf16_t;
typedef short bf16x8 __attribute__((ext_vector_type(8)));
constexpr int BM = 256, BK = 64, HALF = 128, HTB = HALF * BK * 2, STAGE_BYTES = 8 * HTB, NXCD = 8, WGM = 8;
__device__ __forceinline__ int lds_byte(int r, int c) { const int st = (r >> 4) * 2 + (c >> 5), rr = r & 15, cc = c & 31, ob = rr * 64 + cc * 2; return st * 1024 + (ob ^ (((ob >> 9) & 1) << 5)); }
__device__ __forceinline__ void stage_rc(int b, int& R, int& C) { const int st = b / 1024, sb = b % 1024, swz = sb ^ (((sb >> 9) & 1) << 5); R = (st >> 1) * 16 + swz / 64; C = (st & 1) * 32 + (swz % 64) / 2; }
__device__ __forceinline__ int perm32(int rho) { const int n = rho >> 4, i = rho & 15; return 8 * (i >> 2) + 4 * n + (i & 3); }
struct Unit { const char* A; const char* B; int pm, pn, kind, aux; };
struct Gemm { int lda, ldb, K; };
__device__ __forceinline__ void tile_of(int L, int nM, int nN, int& pm, int& pn) {
    const int nwg = nM * nN; int wgid = L; { const int q = nwg / NXCD, r = nwg % NXCD, xcd = wgid % NXCD, off = wgid / NXCD; wgid = (xcd < r ? xcd * (q + 1) : r * (q + 1) + (xcd - r) * q) + off; }
    const int nig = WGM * nN, gid = wgid / nig, fm = gid * WGM, gsz = (nM - fm) < WGM ? (nM - fm) : WGM;
    pm = fm + ((wgid % nig) % gsz); pn = (wgid % nig) / gsz;
}
__device__ __forceinline__ unsigned cvt_pk_bf16(float lo, float hi) { unsigned r; asm volatile("v_cvt_pk_bf16_f32 %0, %1, %2" : "=v"(r) : "v"(lo), "v"(hi)); return r; }

template <class Epi, class Sched>
__device__ __forceinline__ void gemm_phase(int tid, PG8_LAS unsigned char* lds, const Gemm g, const Sched& S, const Epi& E) {
    const int wid = __builtin_amdgcn_readfirstlane(tid >> 6), lane = tid & 63, wr = wid >> 2, wc = wid & 3, fr = lane & 15, fq = lane >> 4;
    const int K = g.K, nt = K / BK;
    unsigned voffA[2], voffB[2];
#pragma unroll
    for (int i = 0; i < 2; ++i) { int R, C; stage_rc(tid * 16 + i * 8192, R, C); const int Rb = Epi::PERM ? ((R & ~31) + perm32(R & 31)) : R;
        voffA[i] = (unsigned)(R * g.lda + C) * 2u; voffB[i] = (unsigned)(Rb * g.ldb + C) * 2u; }
    const size_t kstep = (size_t)(BK * 2);
    const size_t hstepA = (size_t)HALF * g.lda * 2, hstepB = (size_t)HALF * g.ldb * 2;
    const unsigned ldsw = (unsigned)wid * 1024u;
    const int aoff = lds_byte(wr * 64 + fr, fq * 8), boff = lds_byte(wc * 32 + fr, fq * 8);
#define PG8_SA(b, h) (((b) * 2 + (h)) * HTB)
#define PG8_SB(b, h) ((4 + (b) * 2 + (h)) * HTB)
#define PG8_STAGE(bufoff, gbase, voff) do { _Pragma("unroll") for (int _i = 0; _i < 2; ++_i) \
        __builtin_amdgcn_global_load_lds((const unsigned*)((const char*)(gbase) + (voff)[_i]), (PG8_LAS unsigned*)(lds + (bufoff) + ldsw + _i * 8192), 16, 0, 0); } while (0)
#define PG8_LDA(dst, b, h) do { _Pragma("unroll") for (int m = 0; m < 4; ++m) _Pragma("unroll") for (int k = 0; k < 2; ++k) dst[m][k] = *(const PG8_LAS bf16x8*)(lds + PG8_SA(b, h) + aoff + m * 2048 + k * 1024); } while (0)
#define PG8_LDB(dst, b, h) do { _Pragma("unroll") for (int n = 0; n < 2; ++n) _Pragma("unroll") for (int k = 0; k < 2; ++k) dst[n][k] = *(const PG8_LAS bf16x8*)(lds + PG8_SB(b, h) + boff + n * 2048 + k * 1024); } while (0)
#define PG8_MMA(ai, bj, At, Bt) do { __builtin_amdgcn_s_setprio(1); _Pragma("unroll") for (int m = 0; m < 4; ++m) _Pragma("unroll") for (int n = 0; n < 2; ++n) _Pragma("unroll") for (int k = 0; k < 2; ++k) \
        acc[ai][bj][m][n] = __builtin_amdgcn_mfma_f32_16x16x32_bf16(Bt[n][k], At[m][k], acc[ai][bj][m][n], 0, 0, 0); __builtin_amdgcn_s_setprio(0); } while (0)
#define PG8_WAIT_V(n) asm volatile("s_waitcnt vmcnt(" #n ")" ::: "memory")
#define PG8_WAIT_L(n) asm volatile("s_waitcnt lgkmcnt(" #n ")" ::: "memory")
#define PG8_BAR __builtin_amdgcn_s_barrier()
#define PG8_SCHED __builtin_amdgcn_sched_barrier(0)
    Unit cur, nxt; int ui = 0;
    if (!S.next(0, cur)) return;
    f32x4 acc[2][2][4][2];
#pragma unroll
    for (int a = 0; a < 2; ++a)
#pragma unroll
        for (int b = 0; b < 2; ++b)
#pragma unroll
            for (int m = 0; m < 4; ++m)
#pragma unroll
                for (int n = 0; n < 2; ++n) acc[a][b][m][n] = (f32x4){0.f, 0.f, 0.f, 0.f};
    bf16x8 At[4][2], B0[2][2], B1[2][2];
    const char* cA = cur.A; const char* cB = cur.B;
    PG8_STAGE(PG8_SB(0, 0), cB, voffB); PG8_STAGE(PG8_SB(0, 1), cB + hstepB, voffB); PG8_STAGE(PG8_SA(0, 0), cA, voffA); PG8_STAGE(PG8_SA(0, 1), cA + hstepA, voffA);
    if (wr == 1) PG8_BAR;
    PG8_WAIT_V(2); PG8_BAR;
    PG8_STAGE(PG8_SB(1, 0), cB + kstep, voffB); PG8_STAGE(PG8_SA(1, 0), cA + kstep, voffA); PG8_STAGE(PG8_SB(1, 1), cB + hstepB + kstep, voffB);
    PG8_WAIT_V(6); PG8_BAR;
    for (;;) {
        const bool has_next = S.next(ui + 1, nxt);
        const char* nA = has_next ? nxt.A : cA; const char* nB = has_next ? nxt.B : cB;
        for (int t = 0; t < nt; t += 2) {
            const bool last = (t == nt - 2);
            const char* a1 = cA + (size_t)(t + 1) * kstep;
            const char* a2 = last ? nA : cA + (size_t)(t + 2) * kstep; const char* b2 = last ? nB : cB + (size_t)(t + 2) * kstep;
            const char* a3 = a2 + kstep; const char* b3 = b2 + kstep;
            PG8_LDB(B0, 0, 0); PG8_LDB(B1, 0, 1); PG8_SCHED; PG8_LDA(At, 0, 0); PG8_STAGE(PG8_SA(1, 1), a1 + hstepA, voffA);
            PG8_WAIT_V(8); PG8_WAIT_L(0); PG8_BAR; PG8_MMA(0, 0, At, B0); PG8_MMA(0, 1, At, B1); PG8_BAR; PG8_SCHED;
            PG8_LDA(At, 0, 1); PG8_STAGE(PG8_SB(0, 0), b2, voffB); PG8_STAGE(PG8_SB(0, 1), b2 + hstepB, voffB); PG8_STAGE(PG8_SA(0, 0), a2, voffA);
            PG8_WAIT_V(8); PG8_WAIT_L(0); PG8_BAR; PG8_MMA(1, 0, At, B0); PG8_MMA(1, 1, At, B1); PG8_BAR; PG8_SCHED;
            PG8_LDB(B0, 1, 0); PG8_LDB(B1, 1, 1); PG8_SCHED; PG8_LDA(At, 1, 0); PG8_STAGE(PG8_SA(0, 1), a2 + hstepA, voffA);
            PG8_WAIT_V(8); PG8_WAIT_L(0); PG8_BAR; PG8_MMA(0, 0, At, B0); PG8_MMA(0, 1, At, B1); PG8_BAR; PG8_SCHED;
            PG8_LDA(At, 1, 1); PG8_STAGE(PG8_SB(1, 0), b3, voffB); PG8_STAGE(PG8_SB(1, 1), b3 + hstepB, voffB); PG8_STAGE(PG8_SA(1, 0), a3, voffA);
            PG8_WAIT_V(8); PG8_WAIT_L(0); PG8_BAR; PG8_MMA(1, 0, At, B0); PG8_MMA(1, 1, At, B1); PG8_BAR; PG8_SCHED;
        }
        if (wr == 0) PG8_BAR;
        E(acc, cur, wr, wc, fr, fq);
        if (!has_next) break;
#pragma unroll
        for (int a = 0; a < 2; ++a)
#pragma unroll
            for (int b = 0; b < 2; ++b)
#pragma unroll
                for (int m = 0; m < 4; ++m)
#pragma unroll
                    for (int n = 0; n < 2; ++n) acc[a][b][m][n] = (f32x4){0.f, 0.f, 0.f, 0.f};
        cur = nxt; cA = nA; cB = nB; ++ui;
        if (wr == 1) PG8_BAR;
    }
    PG8_WAIT_V(0);
    PG8_BAR;
#undef PG8_SA
#undef PG8_SB
#undef PG8_STAGE
#undef PG8_LDA
#undef PG8_LDB
#undef PG8_MMA
#undef PG8_WAIT_V
#undef PG8_WAIT_L
#undef PG8_BAR
#undef PG8_SCHED
}

__device__ __forceinline__ u32x4 pack8(const f32x4 v0, const f32x4 v1) { u32x4 w; w.x = cvt_pk_bf16(v0[0], v0[1]); w.y = cvt_pk_bf16(v0[2], v0[3]); w.z = cvt_pk_bf16(v1[0], v1[1]); w.w = cvt_pk_bf16(v1[2], v1[3]); return w; }
__device__ __forceinline__ float sigm(float g) { return __builtin_amdgcn_rcpf(1.f + __expf(-g)); }

struct EpiBf16 {
    static constexpr bool PERM = true;
    bf16_t* O; int ldc; const float* bias;
    __device__ __forceinline__ void operator()(const f32x4 (&acc)[2][2][4][2], const Unit& u, int wr, int wc, int fr, int fq) const {
        const int row0 = u.pm * BM + wr * 64 + fr, col0 = u.pn * BM + wc * 32 + 8 * fq;
        f32x4 bv[2][2];
#pragma unroll
        for (int bj = 0; bj < 2; ++bj)
#pragma unroll
            for (int n = 0; n < 2; ++n) bv[bj][n] = bias ? *(const f32x4*)(bias + col0 + bj * HALF + 4 * n) : (f32x4){0.f, 0.f, 0.f, 0.f};
#pragma unroll
        for (int ai = 0; ai < 2; ++ai)
#pragma unroll
            for (int m = 0; m < 4; ++m) { bf16_t* rowp = O + (size_t)(row0 + ai * HALF + m * 16) * ldc + col0;
#pragma unroll
                for (int bj = 0; bj < 2; ++bj) *(u32x4*)(rowp + bj * HALF) = pack8(acc[ai][bj][m][0] + bv[bj][0], acc[ai][bj][m][1] + bv[bj][1]); }
    }
};
struct EpiP1 {
    static constexpr bool PERM = true;
    bf16_t *hglu, *qkv, *kvm; const float* b_in;
    __device__ __forceinline__ void operator()(const f32x4 (&acc)[2][2][4][2], const Unit& u, int wr, int wc, int fr, int fq) const {
        if (u.kind == 0) {
            const int row0 = u.pm * BM + wr * 64 + fr, cb = u.pn * 128 + wc * 32 + 8 * fq;
            f32x4 ba[2], bg[2];
#pragma unroll
            for (int n = 0; n < 2; ++n) { ba[n] = *(const f32x4*)(b_in + cb + 4 * n); bg[n] = *(const f32x4*)(b_in + 512 + cb + 4 * n); }
#pragma unroll
            for (int ai = 0; ai < 2; ++ai)
#pragma unroll
                for (int m = 0; m < 4; ++m) { f32x4 h[2];
#pragma unroll
                    for (int n = 0; n < 2; ++n) { const f32x4 a = acc[ai][0][m][n] + ba[n], gt = acc[ai][1][m][n] + bg[n];
                        h[n] = (f32x4){a[0] * sigm(gt[0]), a[1] * sigm(gt[1]), a[2] * sigm(gt[2]), a[3] * sigm(gt[3])}; }
                    *(u32x4*)(hglu + (size_t)(row0 + ai * HALF + m * 16) * 512 + cb) = pack8(h[0], h[1]); }
        } else if (u.kind == 1) { EpiBf16 e{qkv - 1024, 768, b_in}; e(acc, u, wr, wc, fr, fq);
        } else { EpiBf16 e{kvm, 2048, nullptr}; e(acc, u, wr, wc, fr, fq); }
    }
};
struct EpiResF32 {
    static constexpr bool PERM = false;
    const float* res; float* out; float alpha;
    __device__ __forceinline__ void operator()(const f32x4 (&acc)[2][2][4][2], const Unit& u, int wr, int wc, int fr, int fq) const {
        const int row0 = u.pm * BM + wr * 64 + fr, col0 = u.pn * BM + wc * 32 + 4 * fq;
#pragma unroll
        for (int ai = 0; ai < 2; ++ai)
#pragma unroll
            for (int m = 0; m < 4; ++m) { const size_t off = (size_t)(row0 + ai * HALF + m * 16) * 1024 + col0;
#pragma unroll
                for (int bj = 0; bj < 2; ++bj)
#pragma unroll
                    for (int n = 0; n < 2; ++n) { const f32x4 r = *(const f32x4*)(res + off + bj * HALF + n * 16); *(f32x4*)(out + off + bj * HALF + n * 16) = r * alpha + acc[ai][bj][m][n]; } }
    }
};
struct EpiSoftmax {
    static constexpr bool PERM = true;
    bf16_t* P; PG8_LAS float* xl;
    __device__ __forceinline__ void operator()(const f32x4 (&acc)[2][2][4][2], const Unit& u, int wr, int wc, int fr, int fq) const {
        const float sc = 0.0625f * 1.4426950408889634f;
#pragma unroll
        for (int ai = 0; ai < 2; ++ai)
#pragma unroll
            for (int m = 0; m < 4; ++m) { float mx = -INFINITY;
#pragma unroll
                for (int bj = 0; bj < 2; ++bj)
#pragma unroll
                    for (int n = 0; n < 2; ++n) { const f32x4 v = acc[ai][bj][m][n]; mx = fmaxf(mx, fmaxf(fmaxf(v[0], v[1]), fmaxf(v[2], v[3]))); }
                mx = fmaxf(mx, __shfl_xor(mx, 16)); mx = fmaxf(mx, __shfl_xor(mx, 32));
                float s = 0.f;
#pragma unroll
                for (int bj = 0; bj < 2; ++bj)
#pragma unroll
                    for (int n = 0; n < 2; ++n) { const f32x4 v = acc[ai][bj][m][n]; s += (__builtin_amdgcn_exp2f((v[0] - mx) * sc) + __builtin_amdgcn_exp2f((v[1] - mx) * sc)) + (__builtin_amdgcn_exp2f((v[2] - mx) * sc) + __builtin_amdgcn_exp2f((v[3] - mx) * sc)); }
                s += __shfl_xor(s, 16); s += __shfl_xor(s, 32);
                if (fq == 0) { PG8_LAS float* q = xl + ((ai * HALF + wr * 64 + m * 16 + fr) * 4 + wc) * 2; q[0] = mx; q[1] = s; } }
        asm volatile("s_waitcnt lgkmcnt(0)" ::: "memory"); __builtin_amdgcn_s_barrier(); asm volatile("" ::: "memory");
        const int row0 = u.pm * BM + wr * 64 + fr, col0 = u.pn * BM + wc * 32 + 8 * fq;
#pragma unroll
        for (int ai = 0; ai < 2; ++ai)
#pragma unroll
            for (int m = 0; m < 4; ++m) { const PG8_LAS f32x4* q = (const PG8_LAS f32x4*)(xl + (ai * HALF + wr * 64 + m * 16 + fr) * 8); const f32x4 q0 = q[0], q1 = q[1];
                const float M = fmaxf(fmaxf(q0[0], q0[2]), fmaxf(q1[0], q1[2]));
                const float S = (q0[1] * __builtin_amdgcn_exp2f((q0[0] - M) * sc) + q0[3] * __builtin_amdgcn_exp2f((q0[2] - M) * sc)) + (q1[1] * __builtin_amdgcn_exp2f((q1[0] - M) * sc) + q1[3] * __builtin_amdgcn_exp2f((q1[2] - M) * sc));
                const float inv = 1.f / S; bf16_t* rowp = P + (size_t)(row0 + ai * HALF + m * 16) * 1024 + col0;
#pragma unroll
                for (int bj = 0; bj < 2; ++bj) { f32x4 p[2];
#pragma unroll
                    for (int n = 0; n < 2; ++n) { const f32x4 v = acc[ai][bj][m][n];
                        p[n] = (f32x4){__builtin_amdgcn_exp2f((v[0] - M) * sc) * inv, __builtin_amdgcn_exp2f((v[1] - M) * sc) * inv, __builtin_amdgcn_exp2f((v[2] - M) * sc) * inv, __builtin_amdgcn_exp2f((v[3] - M) * sc) * inv}; }
                    *(u32x4*)(rowp + bj * HALF) = pack8(p[0], p[1]); } }
        asm volatile("s_waitcnt lgkmcnt(0)" ::: "memory"); __builtin_amdgcn_s_barrier(); asm volatile("" ::: "memory");
    }
};
struct EpiGateUp {
    static constexpr bool PERM = true;
    bf16_t* Hs; const float* pair_gate;
    __device__ __forceinline__ void operator()(const f32x4 (&acc)[2][2][4][2], const Unit& u, int wr, int wc, int fr, int fq) const {
        const int row0 = u.pm * BM + wr * 64 + fr, cb = u.pn * 128 + wc * 32 + 8 * fq;
#pragma unroll
        for (int ai = 0; ai < 2; ++ai)
#pragma unroll
            for (int m = 0; m < 4; ++m) { const int row = row0 + ai * HALF + m * 16; const float pg = pair_gate[row]; f32x4 h[2];
#pragma unroll
                for (int n = 0; n < 2; ++n) { const f32x4 gt = acc[ai][0][m][n], up = acc[ai][1][m][n];
                    h[n] = (f32x4){gt[0] * sigm(gt[0]) * up[0] * pg, gt[1] * sigm(gt[1]) * up[1] * pg, gt[2] * sigm(gt[2]) * up[2] * pg, gt[3] * sigm(gt[3]) * up[3] * pg}; }
                if (pg == 0.f) { h[0] = (f32x4){0.f, 0.f, 0.f, 0.f}; h[1] = h[0]; }
                *(u32x4*)(Hs + (size_t)row * 512 + cb) = pack8(h[0], h[1]); }
    }
};
struct EpiDown {
    static constexpr bool PERM = false;
    float* out; const int* pair_tok;
    __device__ __forceinline__ void operator()(const f32x4 (&acc)[2][2][4][2], const Unit& u, int wr, int wc, int fr, int fq) const {
        const int row0 = u.pm * BM + wr * 64 + fr, col0 = u.pn * BM + wc * 32 + 4 * fq;
#pragma unroll
        for (int ai = 0; ai < 2; ++ai)
#pragma unroll
            for (int m = 0; m < 4; ++m) { const int tok = pair_tok[row0 + ai * HALF + m * 16];
                if (tok >= 0) { float* rp = out + (size_t)tok * 1024 + col0;
#pragma unroll
                    for (int bj = 0; bj < 2; ++bj)
#pragma unroll
                        for (int n = 0; n < 2; ++n)
#pragma unroll
                            for (int i = 0; i < 4; ++i) unsafeAtomicAdd(rp + bj * HALF + n * 16 + i, acc[ai][bj][m][n][i]); } }
    }
};

__device__ __forceinline__ void row_stats16(const float* stats, int row, int fq, float& mu, float& rstd) {
    const f32x4* sp = (const f32x4*)(stats + (size_t)row * 32 + fq * 8); const f32x4 a = sp[0], b = sp[1];
    float s = (a[0] + a[2]) + (b[0] + b[2]), ss = (a[1] + a[3]) + (b[1] + b[3]);
    s += __shfl_xor(s, 16); s += __shfl_xor(s, 32); ss += __shfl_xor(ss, 16); ss += __shfl_xor(ss, 32);
    mu = s * (1.f / 1024.f); const float var = ss * (1.f / 1024.f) - mu * mu; rstd = 1.f / sqrtf(var + 1e-5f);
}
struct EpiResStats {
    static constexpr bool PERM = false;
    const float* res; float* out; bf16_t* zb; float* stats; float alpha;
    __device__ __forceinline__ void operator()(const f32x4 (&acc)[2][2][4][2], const Unit& u, int wr, int wc, int fr, int fq) const {
        const int row0 = u.pm * BM + wr * 64 + fr, col0 = u.pn * BM + wc * 32 + 4 * fq;
#pragma unroll
        for (int ai = 0; ai < 2; ++ai)
#pragma unroll
            for (int m = 0; m < 4; ++m) { const int row = row0 + ai * HALF + m * 16; const size_t off = (size_t)row * 1024 + col0; float sm = 0.f, ss = 0.f;
#pragma unroll
                for (int bj = 0; bj < 2; ++bj)
#pragma unroll
                    for (int n = 0; n < 2; ++n) { const f32x4 r = *(const f32x4*)(res + off + bj * HALF + n * 16); const f32x4 z = r * alpha + acc[ai][bj][m][n];
                        *(f32x4*)(out + off + bj * HALF + n * 16) = z; u32x2 w; w.x = cvt_pk_bf16(z[0], z[1]); w.y = cvt_pk_bf16(z[2], z[3]); *(u32x2*)(zb + off + bj * HALF + n * 16) = w;
                        sm += (z[0] + z[1]) + (z[2] + z[3]); ss += (z[0] * z[0] + z[1] * z[1]) + (z[2] * z[2] + z[3] * z[3]); }
                sm += __shfl_xor(sm, 16); sm += __shfl_xor(sm, 32); ss += __shfl_xor(ss, 16); ss += __shfl_xor(ss, 32);
                if (fq == 0) *(float2*)(stats + (size_t)row * 32 + (u.pn * 4 + wc) * 2) = make_float2(sm, ss); }
    }
};
struct EpiResLn {
    static constexpr bool PERM = false;
    float* out; const float* stats; const float* g; const float* b; float alpha;
    __device__ __forceinline__ void operator()(const f32x4 (&acc)[2][2][4][2], const Unit& u, int wr, int wc, int fr, int fq) const {
        const int row0 = u.pm * BM + wr * 64 + fr, col0 = u.pn * BM + wc * 32 + 4 * fq;
        f32x4 gv[2][2], bv[2][2];
#pragma unroll
        for (int bj = 0; bj < 2; ++bj)
#pragma unroll
            for (int n = 0; n < 2; ++n) { gv[bj][n] = *(const f32x4*)(g + col0 + bj * HALF + n * 16); bv[bj][n] = *(const f32x4*)(b + col0 + bj * HALF + n * 16); }
#pragma unroll
        for (int ai = 0; ai < 2; ++ai)
#pragma unroll
            for (int m = 0; m < 4; ++m) { const int row = row0 + ai * HALF + m * 16; const size_t off = (size_t)row * 1024 + col0; float mu, rstd; row_stats16(stats, row, fq, mu, rstd);
#pragma unroll
                for (int bj = 0; bj < 2; ++bj)
#pragma unroll
                    for (int n = 0; n < 2; ++n) { const f32x4 z = *(const f32x4*)(out + off + bj * HALF + n * 16); const f32x4 x1 = (z - mu) * rstd * gv[bj][n] + bv[bj][n];
                        *(f32x4*)(out + off + bj * HALF + n * 16) = x1 * alpha + acc[ai][bj][m][n]; } }
    }
};
struct EpiRank1 {
    static constexpr bool PERM = true;
    bf16_t* O; const float* stats; const float* cs; const float* bw;
    __device__ __forceinline__ void operator()(const f32x4 (&acc)[2][2][4][2], const Unit& u, int wr, int wc, int fr, int fq) const {
        const int row0 = u.pm * BM + wr * 64 + fr, col0 = u.pn * BM + wc * 32 + 8 * fq;
        f32x4 cv[2][2], wv[2][2];
#pragma unroll
        for (int bj = 0; bj < 2; ++bj)
#pragma unroll
            for (int n = 0; n < 2; ++n) { cv[bj][n] = *(const f32x4*)(cs + col0 + bj * HALF + 4 * n); wv[bj][n] = *(const f32x4*)(bw + col0 + bj * HALF + 4 * n); }
#pragma unroll
        for (int ai = 0; ai < 2; ++ai)
#pragma unroll
            for (int m = 0; m < 4; ++m) { const int row = row0 + ai * HALF + m * 16; float mu, rstd; row_stats16(stats, row, fq, mu, rstd); bf16_t* rowp = O + (size_t)row * 1024 + col0;
#pragma unroll
                for (int bj = 0; bj < 2; ++bj) *(u32x4*)(rowp + bj * HALF) = pack8((acc[ai][bj][m][0] - cv[bj][0] * mu) * rstd + wv[bj][0], (acc[ai][bj][m][1] - cv[bj][1] * mu) * rstd + wv[bj][1]); }
    }
};

struct EpiPre {
    static constexpr bool PERM = true;
    bf16_t* O; float* csp;
    __device__ __forceinline__ void operator()(const f32x4 (&acc)[2][2][4][2], const Unit& u, int wr, int wc, int fr, int fq) const {
        const int row0 = u.pm * BM + wr * 64 + fr, col0 = u.pn * BM + wc * 32 + 8 * fq;
#pragma unroll
        for (int ai = 0; ai < 2; ++ai)
#pragma unroll
            for (int m = 0; m < 4; ++m) { const int row = row0 + ai * HALF + m * 16; bf16_t* rowp = O + ((size_t)u.aux * 1024 + row) * 1024 + col0; float sm = 0.f;
#pragma unroll
                for (int bj = 0; bj < 2; ++bj) { const u32x4 w = pack8(acc[ai][bj][m][0], acc[ai][bj][m][1]); *(u32x4*)(rowp + bj * HALF) = w;
#pragma unroll
                    for (int e = 0; e < 4; ++e) sm += __builtin_bit_cast(float, w[e] << 16) + __builtin_bit_cast(float, w[e] & 0xffff0000u); }
                if (csp) { sm += __shfl_xor(sm, 16); sm += __shfl_xor(sm, 32); if (fq == 0) csp[((size_t)u.aux * 1024 + row) * 16 + u.pn * 4 + wc] = sm; } }
    }
};
struct EpiSoftmaxLn {
    static constexpr bool PERM = true;
    bf16_t* P; PG8_LAS float* xl; const float* stats; const float* cs; const float* bw;
    __device__ __forceinline__ void operator()(f32x4 (&acc)[2][2][4][2], const Unit& u, int wr, int wc, int fr, int fq) const {
        const float sc = 0.0625f * 1.4426950408889634f;
        const int row0 = u.pm * BM + wr * 64 + fr, col0 = u.pn * BM + wc * 32 + 8 * fq;
        { f32x4 cv[2][2], wv[2][2];
#pragma unroll
          for (int bj = 0; bj < 2; ++bj)
#pragma unroll
            for (int n = 0; n < 2; ++n) { cv[bj][n] = *(const f32x4*)(cs + u.aux * 1024 + col0 + bj * HALF + 4 * n); wv[bj][n] = *(const f32x4*)(bw + u.aux * 1024 + col0 + bj * HALF + 4 * n); }
#pragma unroll
          for (int ai = 0; ai < 2; ++ai)
#pragma unroll
            for (int m = 0; m < 4; ++m) { float mu, rstd; row_stats16(stats, row0 + ai * HALF + m * 16, fq, mu, rstd);
#pragma unroll
                for (int bj = 0; bj < 2; ++bj)
#pragma unroll
                    for (int n = 0; n < 2; ++n) acc[ai][bj][m][n] = (acc[ai][bj][m][n] - cv[bj][n] * mu) * rstd + wv[bj][n]; } }
#pragma unroll
        for (int ai = 0; ai < 2; ++ai)
#pragma unroll
            for (int m = 0; m < 4; ++m) { float mx = -INFINITY;
#pragma unroll
                for (int bj = 0; bj < 2; ++bj)
#pragma unroll
                    for (int n = 0; n < 2; ++n) { const f32x4 v = acc[ai][bj][m][n]; mx = fmaxf(mx, fmaxf(fmaxf(v[0], v[1]), fmaxf(v[2], v[3]))); }
                mx = fmaxf(mx, __shfl_xor(mx, 16)); mx = fmaxf(mx, __shfl_xor(mx, 32));
                float sm = 0.f;
#pragma unroll
                for (int bj = 0; bj < 2; ++bj)
#pragma unroll
                    for (int n = 0; n < 2; ++n) { const f32x4 v = acc[ai][bj][m][n]; sm += (__builtin_amdgcn_exp2f((v[0] - mx) * sc) + __builtin_amdgcn_exp2f((v[1] - mx) * sc)) + (__builtin_amdgcn_exp2f((v[2] - mx) * sc) + __builtin_amdgcn_exp2f((v[3] - mx) * sc)); }
                sm += __shfl_xor(sm, 16); sm += __shfl_xor(sm, 32);
                if (fq == 0) { PG8_LAS float* q = xl + ((ai * HALF + wr * 64 + m * 16 + fr) * 4 + wc) * 2; q[0] = mx; q[1] = sm; } }
        asm volatile("s_waitcnt lgkmcnt(0)" ::: "memory"); __builtin_amdgcn_s_barrier(); asm volatile("" ::: "memory");
#pragma unroll
        for (int ai = 0; ai < 2; ++ai)
#pragma unroll
            for (int m = 0; m < 4; ++m) { const PG8_LAS f32x4* q = (const PG8_LAS f32x4*)(xl + (ai * HALF + wr * 64 + m * 16 + fr) * 8); const f32x4 q0 = q[0], q1 = q[1];
                const float M = fmaxf(fmaxf(q0[0], q0[2]), fmaxf(q1[0], q1[2]));
                const float S = (q0[1] * __builtin_amdgcn_exp2f((q0[0] - M) * sc) + q0[3] * __builtin_amdgcn_exp2f((q0[2] - M) * sc)) + (q1[1] * __builtin_amdgcn_exp2f((q1[0] - M) * sc) + q1[3] * __builtin_amdgcn_exp2f((q1[2] - M) * sc));
                const float inv = 1.f / S; bf16_t* rowp = P + (size_t)(row0 + ai * HALF + m * 16) * 1024 + col0;
#pragma unroll
                for (int bj = 0; bj < 2; ++bj) { f32x4 pq[2];
#pragma unroll
                    for (int n = 0; n < 2; ++n) { const f32x4 v = acc[ai][bj][m][n];
                        pq[n] = (f32x4){__builtin_amdgcn_exp2f((v[0] - M) * sc) * inv, __builtin_amdgcn_exp2f((v[1] - M) * sc) * inv, __builtin_amdgcn_exp2f((v[2] - M) * sc) * inv, __builtin_amdgcn_exp2f((v[3] - M) * sc) * inv}; }
                    *(u32x4*)(rowp + bj * HALF) = pack8(pq[0], pq[1]); } }
        asm volatile("s_waitcnt lgkmcnt(0)" ::: "memory"); __builtin_amdgcn_s_barrier(); asm volatile("" ::: "memory");
    }
};
struct DenseSched {
    const char* A; const char* B; int nM, nN, G, c; size_t strideA, strideB;
    __device__ __forceinline__ bool next(int i, Unit& u) const { const int L = i * G + c; if (L >= nM * nN) return false; tile_of(L, nM, nN, u.pm, u.pn); u.A = A + (size_t)u.pm * strideA; u.B = B + (size_t)u.pn * strideB; u.kind = 0; u.aux = 0; return true; }
};
}


#define LAS __attribute__((address_space(3)))
__device__ __forceinline__ void transpose_item(const float* W, int N, bf16* WT, int Kd, int k0, int n0, int drow0, LAS float* scr, int lane, const float* gk = nullptr) {
#pragma unroll 8
    for (int i = 0; i < 32; ++i) { const int kk = 2 * i + (lane >> 5); float wv = W[(size_t)(k0 + kk) * N + n0 + (lane & 31)]; if (gk) wv *= gk[k0 + kk]; scr[kk * 33 + (lane & 31)] = wv; }
    asm volatile("s_waitcnt lgkmcnt(0)" ::: "memory");
    const int c = lane & 7;
#pragma unroll
    for (int j = 0; j < 4; ++j) { const int n = (lane >> 3) + 8 * j; const LAS float* sp = scr + (8 * c) * 33 + n;
        u32x4 o; o.x = pk2(sp[0 * 33], sp[1 * 33]); o.y = pk2(sp[2 * 33], sp[3 * 33]); o.z = pk2(sp[4 * 33], sp[5 * 33]); o.w = pk2(sp[6 * 33], sp[7 * 33]);
        *(u32x4*)(WT + (size_t)(drow0 + n) * Kd + k0 + 8 * c) = o; }
    asm volatile("s_waitcnt lgkmcnt(0)" ::: "memory");
}


typedef short bf16x8v __attribute__((ext_vector_type(8)));
__device__ __forceinline__ float bflo(unsigned v) { return __builtin_bit_cast(float, v << 16); }
__device__ __forceinline__ float bfhi(unsigned v) { return __builtin_bit_cast(float, v & 0xffff0000u); }

__device__ __forceinline__ void conv_unit(unsigned char* lds, const bf16* hglu, const float* w_dw, const float* b_dw, const float* g_cn, const float* b_cn, bf16* ycat, int cu, int tid) {
    const int lane = tid & 63, wave = tid >> 6;
    bf16* hin = (bf16*)lds; float* cout = (float*)(lds + 63488);
    const int t0 = cu * 32, s0 = t0 % SEQ;
    for (int c = tid; c < 62 * 64; c += 512) { const int row = c >> 6, part = c & 63; u32x4 v = (u32x4){0u, 0u, 0u, 0u};
        if (s0 - 30 + row >= 0) v = *(const u32x4*)(hglu + (size_t)(t0 - 30 + row) * 512 + part * 8);
        *(u32x4*)(hin + row * 512 + part * 8) = v; }
    __syncthreads();
    {
        const int cp = tid & 255, th = tid >> 8;
        float w0[CONV_W], w1[CONV_W];
#pragma unroll
        for (int j = 0; j < CONV_W; ++j) { const float2 ww = *(const float2*)(w_dw + j * CONV_CH + 2 * cp); w0[j] = ww.x; w1[j] = ww.y; }
        const float2 bb = *(const float2*)(b_dw + 2 * cp);
#pragma unroll 1
        for (int grp = 0; grp < 2; ++grp) { const int tt0 = th * 16 + grp * 8;
            float a0[8], a1[8];
#pragma unroll
            for (int o = 0; o < 8; ++o) { a0[o] = bb.x; a1[o] = bb.y; }
#pragma unroll
            for (int r = 0; r < 38; ++r) { const unsigned v = *(const unsigned*)(hin + (tt0 + r) * 512 + 2 * cp); const float lo = bflo(v), hi = bfhi(v);
#pragma unroll
                for (int o = 0; o < 8; ++o) { const int j = r - o; if (j >= 0 && j < CONV_W) { a0[o] += w0[j] * lo; a1[o] += w1[j] * hi; } } }
#pragma unroll
            for (int o = 0; o < 8; ++o) *(float2*)(cout + (tt0 + o) * 512 + 2 * cp) = make_float2(a0[o], a1[o]);
        }
    }
    __syncthreads();
    {
        const f32x4 g0 = *(const f32x4*)(g_cn + 8 * lane), g1 = *(const f32x4*)(g_cn + 8 * lane + 4), c0 = *(const f32x4*)(b_cn + 8 * lane), c1 = *(const f32x4*)(b_cn + 8 * lane + 4);
#pragma unroll 1
        for (int i = 0; i < 4; ++i) { const int tt = wave * 4 + i;
            f32x4 v0 = *(const f32x4*)(cout + tt * 512 + 8 * lane), v1 = *(const f32x4*)(cout + tt * 512 + 8 * lane + 4);
            const float mean = wave_sum((v0.x + v0.y) + (v0.z + v0.w) + (v1.x + v1.y) + (v1.z + v1.w)) * (1.f / 512.f);
            v0 = v0 - mean; v1 = v1 - mean;
            const float var = wave_sum((v0.x * v0.x + v0.y * v0.y) + (v0.z * v0.z + v0.w * v0.w) + (v1.x * v1.x + v1.y * v1.y) + (v1.z * v1.z + v1.w * v1.w)) * (1.f / 512.f);
            const float rstd = 1.f / sqrtf(var + LN_EPS);
            f32x4 y0 = v0 * rstd * g0 + c0, y1 = v1 * rstd * g1 + c1;
#pragma unroll
            for (int e = 0; e < 4; ++e) { y0[e] = y0[e] * pg8::sigm(y0[e]); y1[e] = y1[e] * pg8::sigm(y1[e]); }
            *(u32x4*)(ycat + (size_t)(t0 + tt) * 1024 + 8 * lane) = pg8::pack8(y0, y1); }
    }
    __syncthreads();
}

__device__ __forceinline__ void swa_unit(unsigned char* lds, const bf16* qkv, const float* sinks, bf16* ycat, int b, int kvh, int qb, int tid) {
    const int lane = tid & 63, wave = tid >> 6, q4 = lane >> 4, c16 = lane & 15;
    bf16* Ks = (bf16*)lds; bf16* VT = (bf16*)(lds + 36864);
    const long t0 = (long)b * SEQ + (long)qb * 128, tk0 = t0 - 128;
#pragma unroll
    for (int i = 0; i < 4; ++i) { const int c = tid + 512 * i, row = c >> 3, part = c & 7; const bool ok = (qb > 0) || (row >= 128);
        u32x4 kv = (u32x4){0u, 0u, 0u, 0u}, vv = kv;
        if (ok) { const bf16* rp = qkv + (tk0 + row) * 768 + 512 + kvh * 64 + part * 8; kv = *(const u32x4*)rp; vv = *(const u32x4*)(rp + 128); }
        *(u32x4*)(Ks + row * 72 + part * 8) = kv;
#pragma unroll
        for (int e = 0; e < 4; ++e) { VT[(part * 8 + 2 * e) * 264 + row] = (bf16)(vv[e] & 0xffffu); VT[(part * 8 + 2 * e + 1) * 264 + row] = (bf16)(vv[e] >> 16); } }
    __syncthreads();
    const int g = wave >> 1, hq = kvh * 4 + g, i0 = (wave & 1) * 64;
    const float L2E = 1.4426950408889634f, sc = 0.125f * L2E, sink2 = sinks[hq] * L2E;
#pragma unroll 1
    for (int qt = 0; qt < 4; ++qt) {
        const int iq = i0 + qt * 16, kt0 = iq >> 4, iqc = iq + c16;
        const bf16* qp = qkv + (t0 + iqc) * 768 + hq * 64 + 8 * q4;
        const bf16x8v Q0 = *(const bf16x8v*)qp, Q1 = *(const bf16x8v*)(qp + 32);
        f32x4 sv[9];
#pragma unroll
        for (int kt = 0; kt < 9; ++kt) { const bf16* kp = Ks + ((kt0 + kt) * 16 + c16) * 72 + 8 * q4;
            f32x4 a = (f32x4){0.f, 0.f, 0.f, 0.f};
            a = __builtin_amdgcn_mfma_f32_16x16x32_bf16(*(const bf16x8v*)kp, Q0, a, 0, 0, 0);
            a = __builtin_amdgcn_mfma_f32_16x16x32_bf16(*(const bf16x8v*)(kp + 32), Q1, a, 0, 0, 0);
            sv[kt] = a; }
        float mx = sink2;
#pragma unroll
        for (int kt = 0; kt < 9; ++kt)
#pragma unroll
            for (int r = 0; r < 4; ++r) { const int j = (kt0 + kt) * 16 + 4 * q4 + r; const bool ok = (j > iqc) && (j <= iqc + 128) && (qb > 0 || j >= 128);
                const float v = ok ? sv[kt][r] * sc : -INFINITY; sv[kt][r] = v; mx = fmaxf(mx, v); }
        mx = fmaxf(mx, __shfl_xor(mx, 16)); mx = fmaxf(mx, __shfl_xor(mx, 32));
        float sum = 0.f;
#pragma unroll
        for (int kt = 0; kt < 9; ++kt)
#pragma unroll
            for (int r = 0; r < 4; ++r) { const float pv = __builtin_amdgcn_exp2f(sv[kt][r] - mx); sv[kt][r] = pv; sum += pv; }
        sum += __shfl_xor(sum, 16); sum += __shfl_xor(sum, 32);
        sum += __builtin_amdgcn_exp2f(sink2 - mx);
        const float inv = 1.f / sum;
        f32x4 o[4];
#pragma unroll
        for (int dt = 0; dt < 4; ++dt) o[dt] = (f32x4){0.f, 0.f, 0.f, 0.f};
#pragma unroll
        for (int pp = 0; pp < 5; ++pp) { const int T0 = kt0 + 2 * pp, T1 = (pp < 4) ? T0 + 1 : T0;
            const f32x4 pa = sv[2 * pp], pb = (pp < 4) ? sv[2 * pp + 1] : (f32x4){0.f, 0.f, 0.f, 0.f};
            const u32x4 pw = pg8::pack8(pa, pb); const bf16x8v Bp = __builtin_bit_cast(bf16x8v, pw);
#pragma unroll
            for (int dt = 0; dt < 4; ++dt) { const bf16* vp = VT + (dt * 16 + c16) * 264 + 4 * q4;
                const u32x2 lo = *(const u32x2*)(vp + T0 * 16), hi = *(const u32x2*)(vp + T1 * 16);
                const u32x4 aw = (u32x4){lo.x, lo.y, hi.x, hi.y};
                o[dt] = __builtin_amdgcn_mfma_f32_16x16x32_bf16(__builtin_bit_cast(bf16x8v, aw), Bp, o[dt], 0, 0, 0); } }
        bf16* op = ycat + (t0 + iqc) * 1024 + 512 + hq * 64 + 4 * q4;
#pragma unroll
        for (int dt = 0; dt < 4; ++dt) { u32x2 w; w.x = pg8::cvt_pk_bf16(o[dt][0] * inv, o[dt][1] * inv); w.y = pg8::cvt_pk_bf16(o[dt][2] * inv, o[dt][3] * inv); *(u32x2*)(op + dt * 16) = w; }
    }
    __syncthreads();
}


#define XB_TMO      128
#define XB_XCNT(j)  (256  + 64 * (j))
#define XB_XSUB(j)  (1280 + 64 * (j))
#define XB_XGEN(j)  (2304 + 64 * (j))
#define XB_TOP      3328
#define XB_TOPGEN   3392
#define XCD_BAR_WORDS 3456
#define XB_SPIN_CAP (1u << 20)
__device__ __forceinline__ unsigned xb_ld(unsigned* p)              { return __hip_atomic_load(p, __ATOMIC_RELAXED, __HIP_MEMORY_SCOPE_AGENT); }
__device__ __forceinline__ unsigned xb_add(unsigned* p, unsigned v) { return __hip_atomic_fetch_add(p, v, __ATOMIC_RELAXED, __HIP_MEMORY_SCOPE_AGENT); }
__device__ __forceinline__ unsigned xb_xcc_id() { return (unsigned)__builtin_amdgcn_s_getreg((3 << 11) | 20) & 0xFu; }
#define XB_SPIN(cond, bar) do { unsigned _sp = 0; while (cond) { __builtin_amdgcn_s_sleep(1); \
    if ((++_sp & 255u) == 0u) { if (xb_ld(&(bar)[XB_TMO])) break; if (_sp > XB_SPIN_CAP) { atomicAdd(&(bar)[XB_TMO], 1u); break; } } } } while (0)
struct XcdBarrier { unsigned* bar; unsigned x; volatile __attribute__((address_space(3))) unsigned* st; };
__device__ __forceinline__ XcdBarrier xcd_barrier_post(unsigned* bar, volatile __attribute__((address_space(3))) unsigned* st) {
    XcdBarrier b; b.bar = bar; b.x = xb_xcc_id(); b.st = st;
    if (threadIdx.x == 0) (void)xb_add(&bar[XB_XCNT(b.x)], 1u);
    return b;
}
__device__ __forceinline__ void xcd_barrier_complete(unsigned* bar, unsigned x, unsigned& nloc, unsigned& nx) {
    const unsigned G = gridDim.x * gridDim.y * gridDim.z;
    unsigned sum, cnt, mine, sp = 0u;
    for (;;) {
        sum = 0u; cnt = 0u; mine = 0u;
#pragma unroll
        for (unsigned j = 0; j < 16; ++j) { const unsigned c = xb_ld(&bar[XB_XCNT(j)]); sum += c; cnt += (c > 0u) ? 1u : 0u; mine = (j == x) ? c : mine; }
        if (sum == G) break;
        __builtin_amdgcn_s_sleep(1);
        if ((++sp & 255u) == 0u) { if (xb_ld(&bar[XB_TMO])) break; if (sp > XB_SPIN_CAP) { atomicAdd(&bar[XB_TMO], 1u); break; } }
    }
    nloc = mine > 0u ? mine : 1u; nx = cnt > 0u ? cnt : 1u;
}
__device__ __forceinline__ void xcd_barrier(const XcdBarrier& b, int tid) {
    asm volatile("s_waitcnt vmcnt(0)" ::: "memory");
    __syncthreads();
    if (tid == 0) {
        unsigned* bar = b.bar;
        __builtin_amdgcn_s_waitcnt(0);
        unsigned nloc = b.st[0], nx = b.st[1];
        if (nloc == 0u) { xcd_barrier_complete(bar, b.x, nloc, nx); b.st[0] = nloc; b.st[1] = nx; }
        const unsigned old = xb_add(&bar[XB_XSUB(b.x)], 1u);
        const unsigned gen = old / nloc;
        if (old + 1u == (gen + 1u) * nloc) {
            __builtin_amdgcn_fence(__ATOMIC_RELEASE, "agent");
            asm volatile("s_waitcnt vmcnt(0)" ::: "memory");
            const unsigned og = xb_add(&bar[XB_TOP], 1u);
            const unsigned tg = og / nx;
            if (og + 1u == (tg + 1u) * nx) xb_add(&bar[XB_TOPGEN], 1u);
            else XB_SPIN(xb_ld(&bar[XB_TOPGEN]) == tg, bar);
            __builtin_amdgcn_fence(__ATOMIC_ACQUIRE, "agent");
            xb_add(&bar[XB_XGEN(b.x)], 1u);
            asm volatile("s_waitcnt vmcnt(0)" ::: "memory");
        } else {
            XB_SPIN(xb_ld(&bar[XB_XGEN(b.x)]) == gen, bar);
            __builtin_amdgcn_fence(__ATOMIC_ACQUIRE, "agent");
            asm volatile("s_waitcnt vmcnt(0)" ::: "memory");
        }
    }
    __syncthreads();
}

struct SchedMoE { const char* A; const char* W; const int* seg; int nmt, nN, G, c; size_t strideA, strideE, strideN;
    __device__ __forceinline__ bool next(int i, pg8::Unit& u) const { const int L = i * G + c; if (L >= nmt * nN) return false; pg8::tile_of(L, nmt, nN, u.pm, u.pn); int e = 0;
#pragma unroll
        for (int j = 1; j < 16; ++j) if (u.pm * 256 >= seg[j]) e = j;
        u.kind = 0; u.aux = e; u.A = A + (size_t)u.pm * strideA; u.B = W + (size_t)e * strideE + (size_t)u.pn * strideN; return true; } };

__global__ void __launch_bounds__(512, 2) fwd_kernel(Params p) {
    extern __shared__ __attribute__((aligned(16))) unsigned char lds_raw[];
    float* ldsf = (float*)lds_raw;
    cg::grid_group grid = cg::this_grid();
    const int G = gridDim.x, bid = blockIdx.x, NGW = G * 8;
    const int wid_s = __builtin_amdgcn_readfirstlane((int)threadIdx.x >> 6);
    unsigned char* ws = p.ws;
    const float *x = p.in[0], *mem = p.in[1], *w_in = p.in[2], *b_in = p.in[3], *w_dw = p.in[4], *b_dw = p.in[5], *g_cn = p.in[6], *b_cn = p.in[7], *sinks = p.in[8],
                *w_out = p.in[9], *g_ln1 = p.in[10], *b_ln1 = p.in[11], *w_mq = p.in[12], *w_mkv = p.in[13], *w_mo = p.in[14], *g_ln2 = p.in[15], *b_ln2 = p.in[16],
                *w_group = p.in[17], *b_group = p.in[18], *w_router = p.in[19], *b_router = p.in[20], *w_gate = p.in[21], *w_up = p.in[22], *w_down = p.in[23],
                *g_ln3 = p.in[24], *b_ln3 = p.in[25];
    float* out = p.out;
    bf16* xb = (bf16*)(ws + WS_A); bf16* ycat = (bf16*)(ws + WS_A); bf16* qm = (bf16*)(ws + WS_A); bf16* om = (bf16*)(ws + WS_A); bf16* Hs = (bf16*)(ws + WS_A);
    bf16* hglu = (bf16*)(ws + WS_B); bf16* qkv = (bf16*)(ws + WS_B + (size_t)T * 512 * 2); bf16* x1b = (bf16*)(ws + WS_B); bf16* Pb2 = (bf16*)(ws + WS_A); bf16* x2b = (bf16*)(ws + WS_B);
    float* Sbuf = (float*)(ws + WS_DD); bf16* Xs = (bf16*)(ws + WS_DD);
    bf16* kvm = (bf16*)(ws + WS_KVM); bf16* memb = (bf16*)(ws + WS_MEMB); bf16* MT = (bf16*)(ws + WS_MT); bf16* NT = (bf16*)(ws + WS_NT);
    float* csS = (float*)(ws + WS_CSS); float* bwS = csS + 2048; float* csp = (float*)(ws + WS_CSP);
    bf16* Wt_in = (bf16*)(ws + WS_WIN); bf16* Wt_out = (bf16*)(ws + WS_WOUT); bf16* Wqb = (bf16*)(ws + WS_WMQ); bf16* Wt_mkv = (bf16*)(ws + WS_WMKV); bf16* Wt_mo = (bf16*)(ws + WS_WMO);
    bf16* Wt_gu = (bf16*)(ws + WS_WGU); bf16* Wt_dn = (bf16*)(ws + WS_WDN);
    PG8_LAS unsigned char* ldsp = (PG8_LAS unsigned char*)lds_raw;
    float* stats1 = (float*)(ws + WS_ST1); float* cs1 = (float*)(ws + WS_CS1); float* bw1 = cs1 + 1024;
    int* route_e = (int*)(ws + WS_ROUTE); float* route_g = (float*)(ws + WS_ROUTE + (size_t)T * 8);
    int* blkcnt = (int*)(ws + WS_BLKCNT); int* segw = (int*)(ws + WS_SEG); int* rank = (int*)(ws + WS_RANK);
    int* pair_tok = (int*)(ws + WS_PTOK); float* pair_gate = (float*)(ws + WS_PGATE); int* tokpos = (int*)(ws + WS_TOKPOS); bf16* Yb = (bf16*)(ws + WS_DD);

    const int lo = p.ph_lo, hi = p.ph_hi;
    int ph = 0;
    volatile __attribute__((address_space(3))) unsigned* bst = (volatile __attribute__((address_space(3))) unsigned*)(ldsp + LDS_BYTES_K - 64);
    if (threadIdx.x == 0) { bst[0] = 0u; bst[1] = 0u; }
    __syncthreads();
    const XcdBarrier xbar = xcd_barrier_post((unsigned*)(ws + WS_CTL), bst);
    if (lo > hi) grid.sync();
#define PHASE_BEGIN if (lo <= ph && ph < hi) { for (int rep_ = 0; rep_ < ((((unsigned)PROBE_MASK >> ph) & 1u) ? 2 : 1); ++rep_) { const int tid = wid_s * 64 + lane_fresh(); const int lane = tid & 63, wave = tid >> 6, gw = bid * 8 + wave; (void)lane; (void)wave; (void)gw;
#define PHASE_END } } if (lo <= ph && ph + 1 < hi) xcd_barrier(xbar, wid_s * 64 + lane_fresh()); ++ph;

    PHASE_BEGIN
    for (size_t i = (size_t)bid * 512 + tid; i < (size_t)T * D / 4; i += (size_t)G * 512) { const f32x4 v = ((const f32x4*)x)[i]; u32x2 w; w.x = pk2(v.x, v.y); w.y = pk2(v.z, v.w); ((u32x2*)xb)[i] = w; }
    for (size_t i = (size_t)bid * 512 + tid; i < (size_t)NMEM * D / 4; i += (size_t)G * 512) { const f32x4 v = ((const f32x4*)mem)[i]; u32x2 w; w.x = pk2(v.x, v.y); w.y = pk2(v.z, v.w); ((u32x2*)memb)[i] = w; }
    {
        LAS float* scr = (LAS float*)(ldsp + wave * 16384);
        constexpr int I_IN = 16 * 56, I_SQ = 16 * 32, I_KV = 16 * 64, I_EX = 16 * 256;
        constexpr int NITEMS = I_IN + 2 * I_SQ + I_KV + 3 * I_EX;
        for (int it = gw; it < NITEMS; it += NGW) { int r = it;
            if (r < I_IN) { const int kb = r / 56, nb = r % 56, n0 = nb * 32; const int dr = n0 < 512 ? (n0 >> 7) * 256 + (n0 & 127) : (n0 < 1024 ? ((n0 - 512) >> 7) * 256 + 128 + (n0 & 127) : n0);
                transpose_item(w_in, D_IN, Wt_in, 1024, kb * 64, n0, dr, scr, lane); continue; } r -= I_IN;
            if (r < I_SQ) { transpose_item(w_out, 1024, Wt_out, 1024, (r / 32) * 64, (r % 32) * 32, (r % 32) * 32, scr, lane); continue; } r -= I_SQ;
            if (r < I_SQ) { transpose_item(w_mo, 1024, Wt_mo, 1024, (r / 32) * 64, (r % 32) * 32, (r % 32) * 32, scr, lane); continue; } r -= I_SQ;
            if (r < I_KV) { transpose_item(w_mkv, 2048, Wt_mkv, 1024, (r / 64) * 64, (r % 64) * 32, (r % 64) * 32, scr, lane); continue; } r -= I_KV;
            if (r < I_EX) { const int e = r / 256, q = r % 256, n0 = (q % 16) * 32; transpose_item(w_gate + (size_t)e * D * DE, DE, Wt_gu + (size_t)e * 1024 * 1024, 1024, (q / 16) * 64, n0, (n0 >> 7) * 256 + (n0 & 127), scr, lane); continue; } r -= I_EX;
            if (r < I_EX) { const int e = r / 256, q = r % 256, n0 = (q % 16) * 32; transpose_item(w_up + (size_t)e * D * DE, DE, Wt_gu + (size_t)e * 1024 * 1024, 1024, (q / 16) * 64, n0, (n0 >> 7) * 256 + 128 + (n0 & 127), scr, lane); continue; } r -= I_EX;
            { const int e = r / 256, q = r % 256; transpose_item(w_down + (size_t)e * DE * D, D, Wt_dn + (size_t)e * 1024 * 512, 512, (q / 32) * 64, (q % 32) * 32, (q % 32) * 32, scr, lane); }
        }
        for (int it = gw; it < 256; it += NGW) {
            f32x4 b4 = (f32x4){0.f, 0.f, 0.f, 0.f};
#pragma unroll 4
            for (int i = 0; i < 16; ++i) { const int k = lane + 64 * i; const f32x4 w = *(const f32x4*)(w_mq + (size_t)k * 1024 + 4 * it); b4 += w * b_ln1[k]; }
#pragma unroll
            for (int e = 0; e < 4; ++e) b4[e] = wave_sum(b4[e]);
            if (lane == 0) *(f32x4*)(bw1 + 4 * it) = b4; }
    }
    for (size_t i = (size_t)bid * 512 + tid; i < (size_t)D * D / 4; i += (size_t)G * 512) { const float gk = g_ln1[i >> 8]; const f32x4 v = ((const f32x4*)w_mq)[i] * gk; u32x2 w; w.x = pk2(v.x, v.y); w.y = pk2(v.z, v.w); ((u32x2*)Wqb)[i] = w; }
    PHASE_END

    PHASE_BEGIN
    {
        struct SchedP1 { const char *xb, *win, *memb, *wkv; int G, c;
            __device__ __forceinline__ bool next(int i, pg8::Unit& u) const { const int L = i * G + c; u.aux = 0;
                if (L < 448) { pg8::tile_of(L, 64, 7, u.pm, u.pn); u.A = xb + (size_t)u.pm * 256 * 2048; u.B = win + (size_t)u.pn * 256 * 2048; u.kind = u.pn < 4 ? 0 : 1; return true; }
                if (L < 464) { const int r = L - 448; u.pm = r >> 3; u.pn = r & 7; u.A = memb + (size_t)u.pm * 256 * 2048; u.B = wkv + (size_t)u.pn * 256 * 2048; u.kind = 2; return true; }
                return false; } };
        const SchedP1 S{(const char*)xb, (const char*)Wt_in, (const char*)memb, (const char*)Wt_mkv, G, bid};
        const pg8::EpiP1 E{hglu, qkv, kvm, b_in};
        pg8::gemm_phase(tid, ldsp, pg8::Gemm{1024, 1024, 1024}, S, E);
    }
    PHASE_END

    PHASE_BEGIN
    for (int cu = bid; cu < T / 32; cu += G) conv_unit(lds_raw, hglu, w_dw, b_dw, g_cn, b_cn, ycat, cu, tid);
    for (int u = bid; u < BATCH * NKV * (SEQ / 128); u += G) swa_unit(lds_raw, qkv, sinks, ycat, u >> 7, (u >> 6) & 1, u & 63, tid);
    {
        struct SchedMT { const char *kvm, *wq; int c;
            __device__ __forceinline__ bool next(int i, pg8::Unit& u) const { if (i > 0 || c < 0 || c >= 32) return false; const int b = c >> 4, h = (c >> 2) & 3, pn = c & 3; u.pm = h; u.pn = pn; u.aux = b; u.kind = 0;
                u.A = kvm + ((size_t)(b * 256) * 2048 + h * 256) * 2; u.B = wq + ((size_t)(pn * 256) * 1024 + h * 256) * 2; return true; } };
        struct SchedNT { const char *wo, *kvm; int c;
            __device__ __forceinline__ bool next(int i, pg8::Unit& u) const { if (i > 0 || c < 0 || c >= 32) return false; const int b = c >> 4, h = (c >> 2) & 3, pm = c & 3; u.pm = pm; u.pn = h; u.aux = b; u.kind = 0;
                u.A = wo + ((size_t)(pm * 256) * 1024 + h * 256) * 2; u.B = kvm + ((size_t)(b * 256) * 2048 + 1024 + h * 256) * 2; return true; } };
        const SchedMT S1{(const char*)kvm, (const char*)Wqb, bid}; const pg8::EpiPre E1{MT, csp};
        pg8::gemm_phase(wid_s * 64 + lane_fresh(), ldsp, pg8::Gemm{2048, 1024, 256}, S1, E1);
        const SchedNT S2{(const char*)Wt_mo, (const char*)kvm, bid - 32}; const pg8::EpiPre E2{NT, nullptr};
        pg8::gemm_phase(wid_s * 64 + lane_fresh(), ldsp, pg8::Gemm{1024, 2048, 256}, S2, E2);
    }
    PHASE_END

    PHASE_BEGIN
    for (int r = gw; r < 2048; r += NGW) { const int b = r >> 10, hk = r & 1023, h = hk >> 8, key = hk & 255;
        const float c = wave_sum(lane < 16 ? csp[(size_t)r * 16 + lane] : 0.f);
        const u32x2 kk = *(const u32x2*)(kvm + (size_t)(b * 256 + key) * 2048 + h * 256 + 4 * lane); const f32x4 bq = *(const f32x4*)(bw1 + h * 256 + 4 * lane);
        const float w = wave_sum((bflo(kk.x) * bq[0] + bfhi(kk.x) * bq[1]) + (bflo(kk.y) * bq[2] + bfhi(kk.y) * bq[3]));
        if (lane == 0) { csS[r] = c; bwS[r] = w; } }
    { const pg8::DenseSched S{(const char*)ycat, (const char*)Wt_out, 64, 4, G, bid, (size_t)256 * 2048, (size_t)256 * 2048};
      const pg8::EpiResStats E{x, out, x1b, stats1, ALPHA}; pg8::gemm_phase(tid, ldsp, pg8::Gemm{1024, 1024, 1024}, S, E); }
    PHASE_END
    PHASE_BEGIN
    {   struct SchedS { const char *z, *mt; int G, c;
            __device__ __forceinline__ bool next(int i, pg8::Unit& u) const { const int L = i * G + c; if (L >= 256) return false; pg8::tile_of(L, 64, 4, u.pm, u.pn); u.kind = 0; u.aux = u.pm >> 5;
                u.A = z + (size_t)u.pm * 256 * 2048; u.B = mt + ((size_t)u.aux * 1024 * 1024 + (size_t)u.pn * 256 * 1024) * 2; return true; } };
        const SchedS S{(const char*)x1b, (const char*)MT, G, bid};
        const pg8::EpiSoftmaxLn E{Pb2, (PG8_LAS float*)(ldsp + 131072), stats1, csS, bwS};
        pg8::gemm_phase(tid, ldsp, pg8::Gemm{1024, 1024, 1024}, S, E);
    }
    PHASE_END
    PHASE_BEGIN
    {   struct SchedN { const char *P, *nt; int G, c;
            __device__ __forceinline__ bool next(int i, pg8::Unit& u) const { const int L = i * G + c; if (L >= 256) return false; pg8::tile_of(L, 64, 4, u.pm, u.pn); u.kind = 0; u.aux = u.pm >> 5;
                u.A = P + (size_t)u.pm * 256 * 2048; u.B = nt + ((size_t)u.aux * 1024 * 1024 + (size_t)u.pn * 256 * 1024) * 2; return true; } };
        const SchedN S{(const char*)Pb2, (const char*)NT, G, bid};
        const pg8::EpiResLn E{out, stats1, g_ln1, b_ln1, ALPHA}; pg8::gemm_phase(tid, ldsp, pg8::Gemm{1024, 1024, 1024}, S, E);
    }
    PHASE_END
    const int TPB = (T + G - 1) / G;
    PHASE_BEGIN
    { const int t0 = bid * TPB, t1 = (t0 + TPB < T) ? t0 + TPB : T;
      float* Wl = ldsf;
      int* le = (int*)(lds_raw + 81920);
      for (int k = tid; k < D; k += 512) { const f32x4 wg = *(const f32x4*)(w_group + (size_t)k * 4);
          Wl[0 * D + k] = wg.x; Wl[1 * D + k] = wg.y; Wl[2 * D + k] = wg.z; Wl[3 * D + k] = wg.w;
#pragma unroll
          for (int gq = 0; gq < 4; ++gq) { const f32x4 wr = *(const f32x4*)(w_router + ((size_t)gq * D + k) * 4);
              Wl[(4 + gq * 4 + 0) * D + k] = wr.x; Wl[(4 + gq * 4 + 1) * D + k] = wr.y; Wl[(4 + gq * 4 + 2) * D + k] = wr.z; Wl[(4 + gq * 4 + 3) * D + k] = wr.w; } }
      __syncthreads();
      const int TPW = (TPB + 7) / 8;
      for (int mb = t0 + wave * TPW; mb < t0 + (wave + 1) * TPW && mb < t1; mb += 2) {
        f32x4 v[2][4];
        const bool has1 = (mb + 1 < t1) && (mb + 1 < t0 + (wave + 1) * TPW);
        ln_row(out + (size_t)mb * D, g_ln2, b_ln2, v[0], lane);
        st_row_bf16(x2b + (size_t)mb * D, v[0], lane);
        __builtin_amdgcn_sched_barrier(0);
        ln_row(out + (size_t)(has1 ? mb + 1 : mb) * D, g_ln2, b_ln2, v[1], lane);
        if (has1) st_row_bf16(x2b + (size_t)(mb + 1) * D, v[1], lane);
        __builtin_amdgcn_sched_barrier(0);
        float my[20];
#pragma unroll
        for (int c = 0; c < 20; ++c) {
            float a0 = 0.f, a1 = 0.f;
#pragma unroll
            for (int jj = 0; jj < 4; ++jj) { const f32x4 w4 = ((const f32x4*)(Wl + c * D))[lane + 64 * jj];
                a0 += (v[0][jj].x * w4.x + v[0][jj].y * w4.y) + (v[0][jj].z * w4.z + v[0][jj].w * w4.w);
                a1 += (v[1][jj].x * w4.x + v[1][jj].y * w4.y) + (v[1][jj].z * w4.z + v[1][jj].w * w4.w); }
            a0 = wave_sum(a0); a1 = wave_sum(a1);
            my[c] = (lane == 1) ? a1 : a0;
        }
        const int m = mb + lane;
        if (lane < 2 && m < t1 && m < t0 + (wave + 1) * TPW) {
            float gl[4]; int gi = 0; float gmx = -INFINITY;
#pragma unroll
            for (int i = 0; i < 4; ++i) { gl[i] = my[i] + b_group[i]; if (gl[i] > gmx) { gmx = gl[i]; gi = i; } }
            float gs = 0.f;
#pragma unroll
            for (int i = 0; i < 4; ++i) gs += __expf(gl[i] - gmx);
            const float gp = 1.f / gs;
            float el[4];
#pragma unroll
            for (int i = 0; i < 4; ++i) { float a = my[4 + i], bq = b_router[i];
                a = (gi == 1) ? my[8 + i] : a; a = (gi == 2) ? my[12 + i] : a; a = (gi == 3) ? my[16 + i] : a;
                bq = (gi == 1) ? b_router[4 + i] : bq; bq = (gi == 2) ? b_router[8 + i] : bq; bq = (gi == 3) ? b_router[12 + i] : bq;
                el[i] = a + bq; }
            int i0 = 0; float v0 = el[0];
#pragma unroll
            for (int i = 1; i < 4; ++i) if (el[i] > v0) { v0 = el[i]; i0 = i; }
            int i1 = -1; float v1 = -INFINITY;
#pragma unroll
            for (int i = 0; i < 4; ++i) if (i != i0 && el[i] > v1) { v1 = el[i]; i1 = i; }
            const float w0 = 1.f / (1.f + __expf(v1 - v0)), w1 = 1.f - w0;
            route_e[2 * m] = gi * 4 + i0; route_e[2 * m + 1] = gi * 4 + i1; route_g[2 * m] = gp * w0; route_g[2 * m + 1] = gp * w1;
            le[2 * (m - t0)] = gi * 4 + i0; le[2 * (m - t0) + 1] = gi * 4 + i1;
        }
      }
      __syncthreads();
      const int np = 2 * (t1 - t0);
      for (int i = tid; i < np; i += 512) { const int e = le[i]; int r = 0; for (int j2 = 0; j2 < i; ++j2) r += (le[j2] == e) ? 1 : 0; rank[2 * t0 + i] = r; }
      if (tid < 16) { int c = 0; for (int j2 = 0; j2 < np; ++j2) c += (le[j2] == tid) ? 1 : 0; blkcnt[bid * 16 + tid] = c; }
    }
    PHASE_END
    PHASE_BEGIN
    {
        int* sh = (int*)lds_raw;
        { const int e = tid & 15, part = tid >> 4; int tot = 0, base = 0;
          for (int b = part; b < G; b += 32) { const int c = blkcnt[b * 16 + e]; tot += c; if (b < bid) base += c; }
          sh[128 + part * 16 + e] = tot; sh[640 + part * 16 + e] = base; }
        __syncthreads();
        if (tid < 16) { int tot = 0, base = 0;
#pragma unroll 8
            for (int part = 0; part < 32; ++part) { tot += sh[128 + part * 16 + tid]; base += sh[640 + part * 16 + tid]; } sh[tid] = base; sh[64 + tid] = tot; }
        __syncthreads();
        if (tid == 0) { int sacc = 0; for (int e = 0; e < 16; ++e) { sh[16 + e] = sacc; sacc += (sh[64 + e] + 255) & ~255; } sh[32] = sacc; if (bid == 0) for (int e = 0; e <= 16; ++e) segw[e] = sh[16 + e]; }
        __syncthreads();
        if (bid == 0) { for (int e = 0; e < 16; ++e) for (int pos = sh[16 + e] + sh[64 + e] + tid; pos < sh[16 + e + 1]; pos += 512) { pair_tok[pos] = -1; pair_gate[pos] = 0.f; } }
        const int t0 = bid * TPB, t1 = (t0 + TPB < T) ? t0 + TPB : T, np = 2 * (t1 - t0);
        for (int i = tid; i < np; i += 512) { const int pi = 2 * t0 + i, e = route_e[pi], pos = sh[16 + e] + sh[e] + rank[pi]; pair_tok[pos] = pi >> 1; pair_gate[pos] = route_g[pi]; tokpos[pi] = pos; sh[2048 + i] = pos; }
        __syncthreads();
        for (int i = wave; i < np; i += 8) { const int pos = sh[2048 + i], tok = t0 + (i >> 1);
            const u32x4* src = (const u32x4*)(x2b + (size_t)tok * D); u32x4* dst = (u32x4*)(Xs + (size_t)pos * D);
            dst[lane] = src[lane]; dst[lane + 64] = src[lane + 64]; }
    }
    PHASE_END
    PHASE_BEGIN
    { const SchedMoE S{(const char*)Xs, (const char*)Wt_gu, segw, segw[16] / 256, 4, G, bid, (size_t)256 * 2048, (size_t)1024 * 2048, (size_t)256 * 2048};
      const pg8::EpiGateUp E{Hs, pair_gate}; pg8::gemm_phase(tid, ldsp, pg8::Gemm{1024, 1024, 1024}, S, E); }
    PHASE_END
    PHASE_BEGIN
    { const SchedMoE S{(const char*)Hs, (const char*)Wt_dn, segw, segw[16] / 256, 4, G, bid, (size_t)256 * 1024, (size_t)1024 * 1024, (size_t)256 * 1024};
      const pg8::EpiBf16 E{Yb, 1024, nullptr}; pg8::gemm_phase(tid, ldsp, pg8::Gemm{512, 512, 512}, S, E); }
    PHASE_END
    PHASE_BEGIN
    for (int m = gw; m < T; m += NGW) { float* row = out + (size_t)m * D; const int p0 = tokpos[2 * m], p1 = tokpos[2 * m + 1];
        const u32x2* y0 = (const u32x2*)(Yb + (size_t)p0 * D); const u32x2* y1 = (const u32x2*)(Yb + (size_t)p1 * D);
        f32x4 v[4]; float sacc = 0.f;
        ln_row(row, g_ln2, b_ln2, v, lane);
#pragma unroll
        for (int jj = 0; jj < 4; ++jj) { const u32x2 a = y0[lane + 64 * jj], b = y1[lane + 64 * jj]; f32x4 z = v[jj] * ALPHA;
            z.x += bflo(a.x) + bflo(b.x); z.y += bfhi(a.x) + bfhi(b.x); z.z += bflo(a.y) + bflo(b.y); z.w += bfhi(a.y) + bfhi(b.y); v[jj] = z; sacc += (z.x + z.y) + (z.z + z.w); }
        const float mean = wave_sum(sacc) * (1.f / D); float s2 = 0.f;
#pragma unroll
        for (int jj = 0; jj < 4; ++jj) { v[jj] = v[jj] - mean; s2 += (v[jj].x * v[jj].x + v[jj].y * v[jj].y) + (v[jj].z * v[jj].z + v[jj].w * v[jj].w); }
        const float rstd = 1.f / sqrtf(wave_sum(s2) * (1.f / D) + LN_EPS);
#pragma unroll
        for (int jj = 0; jj < 4; ++jj) { const f32x4 gg = ((const f32x4*)g_ln3)[lane + 64 * jj], bb = ((const f32x4*)b_ln3)[lane + 64 * jj]; ((f32x4*)row)[lane + 64 * jj] = v[jj] * rstd * gg + bb; } }
    PHASE_END
}

constexpr int N_PHASES = 16;
constexpr int LDS_BYTES = 147456;

extern "C" void kernel_launch(void* const* d_in, const int* in_sizes, int n_in, void* d_out, int out_size, void* d_ws, size_t ws_size, hipStream_t stream) {
    static int grid = 0;
    if (grid == 0) {
        int dev = 0, cus = 0, per_cu = 0;
        hipGetDevice(&dev);
        hipDeviceGetAttribute(&cus, hipDeviceAttributeMultiprocessorCount, dev);
        hipFuncSetAttribute((const void*)fwd_kernel, hipFuncAttributeMaxDynamicSharedMemorySize, LDS_BYTES);
        hipOccupancyMaxActiveBlocksPerMultiprocessor(&per_cu, (const void*)fwd_kernel, 512, LDS_BYTES);
        if (per_cu < 1) { fprintf(stderr, "occupancy query returned %d\n", per_cu); per_cu = 1; }
        grid = cus * 1;
        if (ws_size < WS_END) { fprintf(stderr, "workspace too small\n"); grid = -1; }
    }
    if (grid < 0) return;
    if (hipMemsetAsync((char*)d_ws + WS_CTL, 0, 65536, stream) != hipSuccess) { fprintf(stderr, "memset failed\n"); return; }
    Params p{};
    for (int i = 0; i < 26; ++i) p.in[i] = (const float*)d_in[i];
    p.out = (float*)d_out; p.ws = (unsigned char*)d_ws;
#if MK_N_LAUNCHES == 1
    p.ph_lo = 0; p.ph_hi = 64;
    void* args[] = {&p};
    hipError_t e = hipLaunchCooperativeKernel((const void*)fwd_kernel, dim3(grid), dim3(512), args, LDS_BYTES, stream);
    if (e != hipSuccess) fprintf(stderr, "cooperative launch failed: %s (grid %d)\n", hipGetErrorString(e), grid);
#else
    for (int ph = 0; ph < N_PHASES; ++ph) { p.ph_lo = ph; p.ph_hi = ph + 1; hipLaunchKernelGGL(fwd_kernel, dim3(grid), dim3(512), LDS_BYTES, stream, p); }
#endif
}
```

```cpp
#include <hip/hip_runtime.h>
#include <hip/hip_cooperative_groups.h>
#include <cstdio>
#include <cstdint>
namespace cg = cooperative_groups;

#ifndef PROBE_MASK
#define PROBE_MASK 0
#endif
#ifndef MK_N_LAUNCHES
#define MK_N_LAUNCHES 1
#endif

typedef unsigned short bf16;
typedef float f32x4 __attribute__((ext_vector_type(4)));
typedef unsigned u32x4 __attribute__((ext_vector_type(4)));
typedef unsigned u32x2 __attribute__((ext_vector_type(2)));

constexpr int BATCH = 2, SEQ = 8192, D = 1024, T = BATCH * SEQ, MEM = 256, NMEM = BATCH * MEM;
constexpr int CONV_CH = 512, CONV_W = 31, NH = 8, NKV = 2, HD = 64, ATTN_W = 512, KV_W = 128, WINDOW = 128;
constexpr int D_IN = 1792, MH = 4, MHD = 256, NG = 4, EPG = 4, NE = 16, DE = 512;
constexpr float ALPHA = 1.189207115002721f, LN_EPS = 1e-5f;
constexpr int NPAIR = 2 * T, NPAIR_PAD = NPAIR + NE * 256;
constexpr int LDS_BYTES_K = 147456;

constexpr size_t MiB = 1u << 20;
constexpr size_t WS_CTL = 0;
constexpr size_t WS_ROUTE = 1 * MiB;
constexpr size_t WS_BLKCNT = 1 * MiB + 512 * 1024;
constexpr size_t WS_SEG = 1 * MiB + 640 * 1024;
constexpr size_t WS_RANK = 2 * MiB;
constexpr size_t WS_PTOK = 2 * MiB + 256 * 1024;
constexpr size_t WS_PGATE = 2 * MiB + 512 * 1024;
constexpr size_t WS_TOKPOS = 2 * MiB + 768 * 1024;
constexpr size_t WS_KVM = 3 * MiB;
constexpr size_t WS_MEMB = 5 * MiB;
constexpr size_t WS_A = 8 * MiB;
constexpr size_t WS_B = 48 * MiB;
constexpr size_t WS_DD = 88 * MiB;
constexpr size_t WS_WIN = 164 * MiB;
constexpr size_t WS_WOUT = 168 * MiB, WS_WMQ = 170 * MiB, WS_WMKV = 172 * MiB, WS_WMO = 176 * MiB;
constexpr size_t WS_WGU = 178 * MiB;
constexpr size_t WS_WDN = 210 * MiB;
constexpr size_t WS_ST1 = 226 * MiB;
constexpr size_t WS_CS1 = 128 * 1024;
constexpr size_t WS_MT = 228 * MiB;
constexpr size_t WS_NT = 232 * MiB;
constexpr size_t WS_CSS = 192 * 1024;
constexpr size_t WS_CSP = 256 * 1024;
constexpr size_t WS_END = 236 * MiB;

struct Params { const float* in[26]; float* out; unsigned char* ws; int ph_lo, ph_hi; };

__device__ __forceinline__ unsigned f2bf(float f) { unsigned u = __builtin_bit_cast(unsigned, f); return (u + 0x7fffu + ((u >> 16) & 1u)) >> 16; }
__device__ __forceinline__ float bf2f(bf16 b) { return __builtin_bit_cast(float, (unsigned)b << 16); }
__device__ __forceinline__ unsigned pk2(float lo, float hi) { return f2bf(lo) | (f2bf(hi) << 16); }
template <int CTRL, int ROWMASK> __device__ __forceinline__ float dpp_f(float v) { return __builtin_bit_cast(float, __builtin_amdgcn_update_dpp(0, __builtin_bit_cast(int, v), CTRL, ROWMASK, 0xF, false)); }
__device__ __forceinline__ float wave_sum(float v) {
    v += dpp_f<0xB1, 0xF>(v);
    v += dpp_f<0x4E, 0xF>(v);
    v += dpp_f<0x141, 0xF>(v);
    v += dpp_f<0x140, 0xF>(v);
    v += dpp_f<0x142, 0xA>(v);
    v += dpp_f<0x143, 0xC>(v);
    return __builtin_bit_cast(float, __builtin_amdgcn_readlane(__builtin_bit_cast(int, v), 63));
}
__device__ __forceinline__ float wave_max(float v) {
    v = fmaxf(v, __builtin_bit_cast(float, __builtin_amdgcn_update_dpp(__builtin_bit_cast(int, v), __builtin_bit_cast(int, v), 0xB1, 0xF, 0xF, false)));
    v = fmaxf(v, __builtin_bit_cast(float, __builtin_amdgcn_update_dpp(__builtin_bit_cast(int, v), __builtin_bit_cast(int, v), 0x4E, 0xF, 0xF, false)));
    v = fmaxf(v, __builtin_bit_cast(float, __builtin_amdgcn_update_dpp(__builtin_bit_cast(int, v), __builtin_bit_cast(int, v), 0x141, 0xF, 0xF, false)));
    v = fmaxf(v, __builtin_bit_cast(float, __builtin_amdgcn_update_dpp(__builtin_bit_cast(int, v), __builtin_bit_cast(int, v), 0x140, 0xF, 0xF, false)));
    v = fmaxf(v, __builtin_bit_cast(float, __builtin_amdgcn_update_dpp(__builtin_bit_cast(int, v), __builtin_bit_cast(int, v), 0x142, 0xA, 0xF, false)));
    v = fmaxf(v, __builtin_bit_cast(float, __builtin_amdgcn_update_dpp(__builtin_bit_cast(int, v), __builtin_bit_cast(int, v), 0x143, 0xC, 0xF, false)));
    return __builtin_bit_cast(float, __builtin_amdgcn_readlane(__builtin_bit_cast(int, v), 63));
}
__device__ __forceinline__ int lane_fresh() { int l; asm volatile("v_mbcnt_lo_u32_b32 %0, -1, 0\n\tv_mbcnt_hi_u32_b32 %0, -1, %0" : "=v"(l)); return l; }
__device__ __forceinline__ float ldA(const bf16* p) { return bf2f(*p); }
__device__ __forceinline__ float ldA(const float* p) { return *p; }

template <int NB, class FA, class FB, class FE>
__device__ __forceinline__ void ngemm_tile(int tid, float* lds, int K, int m0, int n0, FA fa, FB fb, FE fe) {
    float* As = lds;
    float* Bs = lds + 16 * 132;
    const int ty = tid >> 4, tx = tid & 15;
    float acc[NB][4][4];
#pragma unroll
    for (int b = 0; b < NB; ++b)
#pragma unroll
        for (int i = 0; i < 4; ++i)
#pragma unroll
            for (int j = 0; j < 4; ++j) acc[b][i][j] = 0.f;
    for (int k0 = 0; k0 < K; k0 += 16) {
        { const int r = tid >> 2, kk = (tid & 3) * 4;
#pragma unroll
            for (int i = 0; i < 4; ++i) As[(kk + i) * 132 + r] = fa(m0 + r, k0 + kk + i); }
#pragma unroll
        for (int b = 0; b < NB; ++b) { const int kk = tid >> 5, nn = (tid & 31) * 2;
            Bs[(b * 16 + kk) * 68 + nn] = fb(b, k0 + kk, n0 + nn); Bs[(b * 16 + kk) * 68 + nn + 1] = fb(b, k0 + kk, n0 + nn + 1); }
        __syncthreads();
#pragma unroll 4
        for (int k = 0; k < 16; ++k) {
            const f32x4 a = *(const f32x4*)&As[k * 132 + ty * 4];
#pragma unroll
            for (int b = 0; b < NB; ++b) { const f32x4 bb = *(const f32x4*)&Bs[(b * 16 + k) * 68 + tx * 4];
#pragma unroll
                for (int i = 0; i < 4; ++i)
#pragma unroll
                    for (int j = 0; j < 4; ++j) acc[b][i][j] += a[i] * bb[j]; }
        }
        __syncthreads();
    }
#pragma unroll
    for (int i = 0; i < 4; ++i)
#pragma unroll
        for (int j = 0; j < 4; ++j) fe(m0 + ty * 4 + i, n0 + tx * 4 + j, acc[0][i][j], acc[NB - 1][i][j]);
}

__device__ __forceinline__ void ln_row(const float* src, const float* g, const float* b, f32x4 (&v)[4], int lane) {
    const f32x4* xr = (const f32x4*)src + lane; float s = 0.f;
#pragma unroll
    for (int j = 0; j < 4; ++j) { v[j] = xr[64 * j]; s += (v[j].x + v[j].y) + (v[j].z + v[j].w); }
    const float mean = wave_sum(s) * (1.f / D); float s2 = 0.f;
#pragma unroll
    for (int j = 0; j < 4; ++j) { v[j] = v[j] - mean; s2 += (v[j].x * v[j].x + v[j].y * v[j].y) + (v[j].z * v[j].z + v[j].w * v[j].w); }
    const float rstd = 1.f / sqrtf(wave_sum(s2) * (1.f / D) + LN_EPS);
#pragma unroll
    for (int j = 0; j < 4; ++j) { const f32x4 gg = ((const f32x4*)g)[lane + 64 * j], bb = ((const f32x4*)b)[lane + 64 * j]; v[j] = v[j] * rstd * gg + bb; }
}
__device__ __forceinline__ void st_row_f32(float* dst, const f32x4 (&v)[4], float scale, int lane) {
#pragma unroll
    for (int j = 0; j < 4; ++j) ((f32x4*)dst)[lane + 64 * j] = v[j] * scale;
}
__device__ __forceinline__ void st_row_bf16(bf16* dst, const f32x4 (&v)[4], int lane) {
#pragma unroll
    for (int j = 0; j < 4; ++j) { u32x2 w; w.x = pk2(v[j].x, v[j].y); w.y = pk2(v[j].z, v[j].w); ((u32x2*)dst)[lane + 64 * j] = w; }
}


namespace pg8 {
#define PG8_LAS __attribute__((address_space(3)))
typedef unsigned short bf16_t;
typedef short bf16x8 __attribute__((ext_vector_type(8)));
constexpr int BM = 256, BK = 64, HALF = 128, HTB = HALF * BK * 2, STAGE_BYTES = 8 * HTB, NXCD = 8, WGM = 8;
__device__ __forceinline__ int lds_byte(int r, int c) { const int st = (r >> 4) * 2 + (c >> 5), rr = r & 15, cc = c & 31, ob = rr * 64 + cc * 2; return st * 1024 + (ob ^ (((ob >> 9) & 1) << 5)); }
__device__ __forceinline__ void stage_rc(int b, int& R, int& C) { const int st = b / 1024, sb = b % 1024, swz = sb ^ (((sb >> 9) & 1) << 5); R = (st >> 1) * 16 + swz / 64; C = (st & 1) * 32 + (swz % 64) / 2; }
__device__ __forceinline__ int perm32(int rho) { const int n = rho >> 4, i = rho & 15; return 8 * (i >> 2) + 4 * n + (i & 3); }
struct Unit { const char* A; const char* B; const int* rows; int pm, pn, kind, aux; };
struct Gemm { int lda, ldb, K; };
__device__ __forceinline__ void tile_of(int L, int nM, int nN, int& pm, int& pn) {
    const int nwg = nM * nN; int wgid = L; { const int q = nwg / NXCD, r = nwg % NXCD, xcd = wgid % NXCD, off = wgid / NXCD; wgid = (xcd < r ? xcd * (q + 1) : r * (q + 1) + (xcd - r) * q) + off; }
    const int nig = WGM * nN, gid = wgid / nig, fm = gid * WGM, gsz = (nM - fm) < WGM ? (nM - fm) : WGM;
    pm = fm + ((wgid % nig) % gsz); pn = (wgid % nig) / gsz;
}
__device__ __forceinline__ unsigned cvt_pk_bf16(float lo, float hi) { unsigned r; asm volatile("v_cvt_pk_bf16_f32 %0, %1, %2" : "=v"(r) : "v"(lo), "v"(hi)); return r; }

template <bool GATHER = false, class Epi, class Sched>
__device__ __forceinline__ void gemm_phase(int tid, PG8_LAS unsigned char* lds, const Gemm g, const Sched& S, const Epi& E) {
    const int wid = __builtin_amdgcn_readfirstlane(tid >> 6), lane = tid & 63, wr = wid >> 2, wc = wid & 3, fr = lane & 15, fq = lane >> 4;
    const int K = g.K, nt = K / BK;
    unsigned voffA[2], voffB[2]; int gR[2]; unsigned gC[2];
#pragma unroll
    for (int i = 0; i < 2; ++i) { int R, C; stage_rc(tid * 16 + i * 8192, R, C); const int Rb = Epi::PERM ? ((R & ~31) + perm32(R & 31)) : R;
        voffA[i] = (unsigned)(R * g.lda + C) * 2u; voffB[i] = (unsigned)(Rb * g.ldb + C) * 2u; gR[i] = R; gC[i] = (unsigned)C * 2u; }
    unsigned vgc[2][2], vgn[2][2];
    const size_t kstep = (size_t)(BK * 2);
    const size_t hstepA = (size_t)HALF * g.lda * 2, hstepB = (size_t)HALF * g.ldb * 2;
    const unsigned ldsw = (unsigned)wid * 1024u;
    const int aoff = lds_byte(wr * 64 + fr, fq * 8), boff = lds_byte(wc * 32 + fr, fq * 8);
#define PG8_SA(b, h) (((b) * 2 + (h)) * HTB)
#define PG8_SB(b, h) ((4 + (b) * 2 + (h)) * HTB)
#define PG8_STAGE(bufoff, gbase, voff) do { _Pragma("unroll") for (int _i = 0; _i < 2; ++_i) \
        __builtin_amdgcn_global_load_lds((const unsigned*)((const char*)(gbase) + (voff)[_i]), (PG8_LAS unsigned*)(lds + (bufoff) + ldsw + _i * 8192), 16, 0, 0); } while (0)
#define PG8_GOFF(dst, rows) do { _Pragma("unroll") for (int _h = 0; _h < 2; ++_h) _Pragma("unroll") for (int _i = 0; _i < 2; ++_i) { int _t = (rows)[_h * HALF + gR[_i]]; _t = _t < 0 ? 0 : _t; dst[_h][_i] = (unsigned)_t * (unsigned)(g.lda * 2) + gC[_i]; } } while (0)
#define PG8_STAGE_A(bufoff, h, kptr, useNext) do { if constexpr (GATHER) { unsigned _v[2]; _v[0] = (useNext) ? vgn[h][0] : vgc[h][0]; _v[1] = (useNext) ? vgn[h][1] : vgc[h][1]; PG8_STAGE(bufoff, kptr, _v); } \
        else { PG8_STAGE(bufoff, (kptr) + (h) * hstepA, voffA); } } while (0)
#define PG8_LDA(dst, b, h) do { _Pragma("unroll") for (int m = 0; m < 4; ++m) _Pragma("unroll") for (int k = 0; k < 2; ++k) dst[m][k] = *(const PG8_LAS bf16x8*)(lds + PG8_SA(b, h) + aoff + m * 2048 + k * 1024); } while (0)
#define PG8_LDB(dst, b, h) do { _Pragma("unroll") for (int n = 0; n < 2; ++n) _Pragma("unroll") for (int k = 0; k < 2; ++k) dst[n][k] = *(const PG8_LAS bf16x8*)(lds + PG8_SB(b, h) + boff + n * 2048 + k * 1024); } while (0)
#define PG8_MMA(ai, bj, At, Bt) do { __builtin_amdgcn_s_setprio(1); _Pragma("unroll") for (int m = 0; m < 4; ++m) _Pragma("unroll") for (int n = 0; n < 2; ++n) _Pragma("unroll") for (int k = 0; k < 2; ++k) \
        acc[ai][bj][m][n] = __builtin_amdgcn_mfma_f32_16x16x32_bf16(Bt[n][k], At[m][k], acc[ai][bj][m][n], 0, 0, 0); __builtin_amdgcn_s_setprio(0); } while (0)
#define PG8_WAIT_V(n) asm volatile("s_waitcnt vmcnt(" #n ")" ::: "memory")
#define PG8_WAIT_L(n) asm volatile("s_waitcnt lgkmcnt(" #n ")" ::: "memory")
#define PG8_BAR __builtin_amdgcn_s_barrier()
#define PG8_SCHED __builtin_amdgcn_sched_barrier(0)
    Unit cur, nxt; int ui = 0;
    if (!S.next(0, cur)) return;
    f32x4 acc[2][2][4][2];
#pragma unroll
    for (int a = 0; a < 2; ++a)
#pragma unroll
        for (int b = 0; b < 2; ++b)
#pragma unroll
            for (int m = 0; m < 4; ++m)
#pragma unroll
                for (int n = 0; n < 2; ++n) acc[a][b][m][n] = (f32x4){0.f, 0.f, 0.f, 0.f};
    bf16x8 At[4][2], B0[2][2], B1[2][2];
    const char* cA = cur.A; const char* cB = cur.B;
    if constexpr (GATHER) { PG8_GOFF(vgc, cur.rows); }
    PG8_STAGE(PG8_SB(0, 0), cB, voffB); PG8_STAGE(PG8_SB(0, 1), cB + hstepB, voffB); PG8_STAGE_A(PG8_SA(0, 0), 0, cA, false); PG8_STAGE_A(PG8_SA(0, 1), 1, cA, false);
    if (wr == 1) PG8_BAR;
    PG8_WAIT_V(2); PG8_BAR;
    PG8_STAGE(PG8_SB(1, 0), cB + kstep, voffB); PG8_STAGE_A(PG8_SA(1, 0), 0, cA + kstep, false); PG8_STAGE(PG8_SB(1, 1), cB + hstepB + kstep, voffB);
    PG8_WAIT_V(6); PG8_BAR;
    for (;;) {
        const bool has_next = S.next(ui + 1, nxt);
        const char* nA = has_next ? nxt.A : cA; const char* nB = has_next ? nxt.B : cB;
        if constexpr (GATHER) { if (has_next) { PG8_GOFF(vgn, nxt.rows); asm volatile("" : "+v"(vgn[0][0]), "+v"(vgn[0][1]), "+v"(vgn[1][0]), "+v"(vgn[1][1]));   } else { _Pragma("unroll") for (int _h = 0; _h < 2; ++_h) { vgn[_h][0] = vgc[_h][0]; vgn[_h][1] = vgc[_h][1]; } } }
        for (int t = 0; t < nt; t += 2) {
            const bool last = (t == nt - 2);
            const char* a1 = cA + (size_t)(t + 1) * kstep;
            const char* a2 = last ? nA : cA + (size_t)(t + 2) * kstep; const char* b2 = last ? nB : cB + (size_t)(t + 2) * kstep;
            const char* a3 = a2 + kstep; const char* b3 = b2 + kstep;
            PG8_LDB(B0, 0, 0); PG8_LDB(B1, 0, 1); PG8_SCHED; PG8_LDA(At, 0, 0); PG8_STAGE_A(PG8_SA(1, 1), 1, a1, false);
            PG8_WAIT_V(8); PG8_WAIT_L(0); PG8_BAR; PG8_MMA(0, 0, At, B0); PG8_MMA(0, 1, At, B1); PG8_BAR; PG8_SCHED;
            PG8_LDA(At, 0, 1); PG8_STAGE(PG8_SB(0, 0), b2, voffB); PG8_STAGE(PG8_SB(0, 1), b2 + hstepB, voffB); PG8_STAGE_A(PG8_SA(0, 0), 0, a2, last);
            PG8_WAIT_V(8); PG8_WAIT_L(0); PG8_BAR; PG8_MMA(1, 0, At, B0); PG8_MMA(1, 1, At, B1); PG8_BAR; PG8_SCHED;
            PG8_LDB(B0, 1, 0); PG8_LDB(B1, 1, 1); PG8_SCHED; PG8_LDA(At, 1, 0); PG8_STAGE_A(PG8_SA(0, 1), 1, a2, last);
            PG8_WAIT_V(8); PG8_WAIT_L(0); PG8_BAR; PG8_MMA(0, 0, At, B0); PG8_MMA(0, 1, At, B1); PG8_BAR; PG8_SCHED;
            PG8_LDA(At, 1, 1); PG8_STAGE(PG8_SB(1, 0), b3, voffB); PG8_STAGE(PG8_SB(1, 1), b3 + hstepB, voffB); PG8_STAGE_A(PG8_SA(1, 0), 0, a3, last);
            PG8_WAIT_V(8); PG8_WAIT_L(0); PG8_BAR; PG8_MMA(1, 0, At, B0); PG8_MMA(1, 1, At, B1); PG8_BAR; PG8_SCHED;
        }
        if (wr == 0) PG8_BAR;
        E(acc, cur, wr, wc, fr, fq);
        if (!has_next) break;
#pragma unroll
        for (int a = 0; a < 2; ++a)
#pragma unroll
            for (int b = 0; b < 2; ++b)
#pragma unroll
                for (int m = 0; m < 4; ++m)
#pragma unroll
                    for (int n = 0; n < 2; ++n) acc[a][b][m][n] = (f32x4){0.f, 0.f, 0.f, 0.f};
        cur = nxt; cA = nA; cB = nB; ++ui;
        if constexpr (GATHER) { _Pragma("unroll") for (int _h = 0; _h < 2; ++_h) { vgc[_h][0] = vgn[_h][0]; vgc[_h][1] = vgn[_h][1]; } }
        if (wr == 1) PG8_BAR;
    }
    PG8_WAIT_V(0);
    PG8_BAR;
#undef PG8_SA
#undef PG8_SB
#undef PG8_STAGE
#undef PG8_LDA
#undef PG8_GOFF
#undef PG8_STAGE_A
#undef PG8_LDB
#undef PG8_MMA
#undef PG8_WAIT_V
#undef PG8_WAIT_L
#undef PG8_BAR
#undef PG8_SCHED
}

__device__ __forceinline__ u32x4 pack8(const f32x4 v0, const f32x4 v1) { u32x4 w; w.x = cvt_pk_bf16(v0[0], v0[1]); w.y = cvt_pk_bf16(v0[2], v0[3]); w.z = cvt_pk_bf16(v1[0], v1[1]); w.w = cvt_pk_bf16(v1[2], v1[3]); return w; }
__device__ __forceinline__ float sigm(float g) { return __builtin_amdgcn_rcpf(1.f + __expf(-g)); }

struct EpiBf16 {
    static constexpr bool PERM = true;
    bf16_t* O; int ldc; const float* bias;
    __device__ __forceinline__ void operator()(const f32x4 (&acc)[2][2][4][2], const Unit& u, int wr, int wc, int fr, int fq) const {
        const int row0 = u.pm * BM + wr * 64 + fr, col0 = u.pn * BM + wc * 32 + 8 * fq;
        f32x4 bv[2][2];
#pragma unroll
        for (int bj = 0; bj < 2; ++bj)
#pragma unroll
            for (int n = 0; n < 2; ++n) bv[bj][n] = bias ? *(const f32x4*)(bias + col0 + bj * HALF + 4 * n) : (f32x4){0.f, 0.f, 0.f, 0.f};
#pragma unroll
        for (int ai = 0; ai < 2; ++ai)
#pragma unroll
            for (int m = 0; m < 4; ++m) { bf16_t* rowp = O + (size_t)(row0 + ai * HALF + m * 16) * ldc + col0;
#pragma unroll
                for (int bj = 0; bj < 2; ++bj) *(u32x4*)(rowp + bj * HALF) = pack8(acc[ai][bj][m][0] + bv[bj][0], acc[ai][bj][m][1] + bv[bj][1]); }
    }
};
struct EpiP1 {
    static constexpr bool PERM = true;
    bf16_t *hglu, *qkv, *kvm; const float* b_in;
    __device__ __forceinline__ void operator()(const f32x4 (&acc)[2][2][4][2], const Unit& u, int wr, int wc, int fr, int fq) const {
        if (u.kind == 0) {
            const int row0 = u.pm * BM + wr * 64 + fr, cb = u.pn * 128 + wc * 32 + 8 * fq;
            f32x4 ba[2], bg[2];
#pragma unroll
            for (int n = 0; n < 2; ++n) { ba[n] = *(const f32x4*)(b_in + cb + 4 * n); bg[n] = *(const f32x4*)(b_in + 512 + cb + 4 * n); }
#pragma unroll
            for (int ai = 0; ai < 2; ++ai)
#pragma unroll
                for (int m = 0; m < 4; ++m) { f32x4 h[2];
#pragma unroll
                    for (int n = 0; n < 2; ++n) { const f32x4 a = acc[ai][0][m][n] + ba[n], gt = acc[ai][1][m][n] + bg[n];
                        h[n] = (f32x4){a[0] * sigm(gt[0]), a[1] * sigm(gt[1]), a[2] * sigm(gt[2]), a[3] * sigm(gt[3])}; }
                    *(u32x4*)(hglu + (size_t)(row0 + ai * HALF + m * 16) * 512 + cb) = pack8(h[0], h[1]); }
        } else if (u.kind == 1) { EpiBf16 e{qkv - 1024, 768, b_in}; e(acc, u, wr, wc, fr, fq);
        } else { EpiBf16 e{kvm, 2048, nullptr}; e(acc, u, wr, wc, fr, fq); }
    }
};
struct EpiResF32 {
    static constexpr bool PERM = false;
    const float* res; float* out; float alpha;
    __device__ __forceinline__ void operator()(const f32x4 (&acc)[2][2][4][2], const Unit& u, int wr, int wc, int fr, int fq) const {
        const int row0 = u.pm * BM + wr * 64 + fr, col0 = u.pn * BM + wc * 32 + 4 * fq;
#pragma unroll
        for (int ai = 0; ai < 2; ++ai)
#pragma unroll
            for (int m = 0; m < 4; ++m) { const size_t off = (size_t)(row0 + ai * HALF + m * 16) * 1024 + col0;
#pragma unroll
                for (int bj = 0; bj < 2; ++bj)
#pragma unroll
                    for (int n = 0; n < 2; ++n) { const f32x4 r = *(const f32x4*)(res + off + bj * HALF + n * 16); *(f32x4*)(out + off + bj * HALF + n * 16) = r * alpha + acc[ai][bj][m][n]; } }
    }
};
struct EpiSoftmax {
    static constexpr bool PERM = true;
    bf16_t* P; PG8_LAS float* xl;
    __device__ __forceinline__ void operator()(const f32x4 (&acc)[2][2][4][2], const Unit& u, int wr, int wc, int fr, int fq) const {
        const float sc = 0.0625f * 1.4426950408889634f;
#pragma unroll
        for (int ai = 0; ai < 2; ++ai)
#pragma unroll
            for (int m = 0; m < 4; ++m) { float mx = -INFINITY;
#pragma unroll
                for (int bj = 0; bj < 2; ++bj)
#pragma unroll
                    for (int n = 0; n < 2; ++n) { const f32x4 v = acc[ai][bj][m][n]; mx = fmaxf(mx, fmaxf(fmaxf(v[0], v[1]), fmaxf(v[2], v[3]))); }
                mx = fmaxf(mx, __shfl_xor(mx, 16)); mx = fmaxf(mx, __shfl_xor(mx, 32));
                float s = 0.f;
#pragma unroll
                for (int bj = 0; bj < 2; ++bj)
#pragma unroll
                    for (int n = 0; n < 2; ++n) { const f32x4 v = acc[ai][bj][m][n]; s += (__builtin_amdgcn_exp2f((v[0] - mx) * sc) + __builtin_amdgcn_exp2f((v[1] - mx) * sc)) + (__builtin_amdgcn_exp2f((v[2] - mx) * sc) + __builtin_amdgcn_exp2f((v[3] - mx) * sc)); }
                s += __shfl_xor(s, 16); s += __shfl_xor(s, 32);
                if (fq == 0) { PG8_LAS float* q = xl + ((ai * HALF + wr * 64 + m * 16 + fr) * 4 + wc) * 2; q[0] = mx; q[1] = s; } }
        asm volatile("s_waitcnt lgkmcnt(0)" ::: "memory"); __builtin_amdgcn_s_barrier(); asm volatile("" ::: "memory");
        const int row0 = u.pm * BM + wr * 64 + fr, col0 = u.pn * BM + wc * 32 + 8 * fq;
#pragma unroll
        for (int ai = 0; ai < 2; ++ai)
#pragma unroll
            for (int m = 0; m < 4; ++m) { const PG8_LAS f32x4* q = (const PG8_LAS f32x4*)(xl + (ai * HALF + wr * 64 + m * 16 + fr) * 8); const f32x4 q0 = q[0], q1 = q[1];
                const float M = fmaxf(fmaxf(q0[0], q0[2]), fmaxf(q1[0], q1[2]));
                const float S = (q0[1] * __builtin_amdgcn_exp2f((q0[0] - M) * sc) + q0[3] * __builtin_amdgcn_exp2f((q0[2] - M) * sc)) + (q1[1] * __builtin_amdgcn_exp2f((q1[0] - M) * sc) + q1[3] * __builtin_amdgcn_exp2f((q1[2] - M) * sc));
                const float inv = 1.f / S; bf16_t* rowp = P + (size_t)(row0 + ai * HALF + m * 16) * 1024 + col0;
#pragma unroll
                for (int bj = 0; bj < 2; ++bj) { f32x4 p[2];
#pragma unroll
                    for (int n = 0; n < 2; ++n) { const f32x4 v = acc[ai][bj][m][n];
                        p[n] = (f32x4){__builtin_amdgcn_exp2f((v[0] - M) * sc) * inv, __builtin_amdgcn_exp2f((v[1] - M) * sc) * inv, __builtin_amdgcn_exp2f((v[2] - M) * sc) * inv, __builtin_amdgcn_exp2f((v[3] - M) * sc) * inv}; }
                    *(u32x4*)(rowp + bj * HALF) = pack8(p[0], p[1]); } }
        asm volatile("s_waitcnt lgkmcnt(0)" ::: "memory"); __builtin_amdgcn_s_barrier(); asm volatile("" ::: "memory");
    }
};
struct EpiGateUp {
    static constexpr bool PERM = true;
    bf16_t* Hs; const float* pair_gate;
    __device__ __forceinline__ void operator()(const f32x4 (&acc)[2][2][4][2], const Unit& u, int wr, int wc, int fr, int fq) const {
        const int row0 = u.pm * BM + wr * 64 + fr, cb = u.pn * 128 + wc * 32 + 8 * fq;
        float pgv[2][4];
#pragma unroll
        for (int ai = 0; ai < 2; ++ai)
#pragma unroll
            for (int m = 0; m < 4; ++m) pgv[ai][m] = pair_gate[row0 + ai * HALF + m * 16];
#pragma unroll
        for (int ai = 0; ai < 2; ++ai)
#pragma unroll
            for (int m = 0; m < 4; ++m) { const int row = row0 + ai * HALF + m * 16; const float pg = pgv[ai][m]; f32x4 h[2];
#pragma unroll
                for (int n = 0; n < 2; ++n) { const f32x4 gt = acc[ai][0][m][n], up = acc[ai][1][m][n];
                    h[n] = (f32x4){gt[0] * sigm(gt[0]) * up[0] * pg, gt[1] * sigm(gt[1]) * up[1] * pg, gt[2] * sigm(gt[2]) * up[2] * pg, gt[3] * sigm(gt[3]) * up[3] * pg}; }
                if (pg == 0.f) { h[0] = (f32x4){0.f, 0.f, 0.f, 0.f}; h[1] = h[0]; }
                *(u32x4*)(Hs + (size_t)row * 512 + cb) = pack8(h[0], h[1]); }
    }
};
struct EpiDown {
    static constexpr bool PERM = false;
    float* out; const int* pair_tok;
    __device__ __forceinline__ void operator()(const f32x4 (&acc)[2][2][4][2], const Unit& u, int wr, int wc, int fr, int fq) const {
        const int row0 = u.pm * BM + wr * 64 + fr, col0 = u.pn * BM + wc * 32 + 4 * fq;
#pragma unroll
        for (int ai = 0; ai < 2; ++ai)
#pragma unroll
            for (int m = 0; m < 4; ++m) { const int tok = pair_tok[row0 + ai * HALF + m * 16];
                if (tok >= 0) { float* rp = out + (size_t)tok * 1024 + col0;
#pragma unroll
                    for (int bj = 0; bj < 2; ++bj)
#pragma unroll
                        for (int n = 0; n < 2; ++n)
#pragma unroll
                            for (int i = 0; i < 4; ++i) unsafeAtomicAdd(rp + bj * HALF + n * 16 + i, acc[ai][bj][m][n][i]); } }
    }
};

__device__ __forceinline__ void row_stats16(const float* stats, int row, int fq, float& mu, float& rstd) {
    const f32x4* sp = (const f32x4*)(stats + (size_t)row * 32 + fq * 8); const f32x4 a = sp[0], b = sp[1];
    float s = (a[0] + a[2]) + (b[0] + b[2]), ss = (a[1] + a[3]) + (b[1] + b[3]);
    s += __shfl_xor(s, 16); s += __shfl_xor(s, 32); ss += __shfl_xor(ss, 16); ss += __shfl_xor(ss, 32);
    mu = s * (1.f / 1024.f); const float var = ss * (1.f / 1024.f) - mu * mu; rstd = 1.f / sqrtf(var + 1e-5f);
}
struct EpiResStats {
    static constexpr bool PERM = false;
    const float* res; float* out; bf16_t* zb; float* stats; float alpha;
    __device__ __forceinline__ void operator()(const f32x4 (&acc)[2][2][4][2], const Unit& u, int wr, int wc, int fr, int fq) const {
        const int row0 = u.pm * BM + wr * 64 + fr, col0 = u.pn * BM + wc * 32 + 4 * fq;
#pragma unroll
        for (int ai = 0; ai < 2; ++ai)
#pragma unroll
            for (int m = 0; m < 4; ++m) { const int row = row0 + ai * HALF + m * 16; const size_t off = (size_t)row * 1024 + col0; float sm = 0.f, ss = 0.f;
#pragma unroll
                for (int bj = 0; bj < 2; ++bj)
#pragma unroll
                    for (int n = 0; n < 2; ++n) { const f32x4 r = *(const f32x4*)(res + off + bj * HALF + n * 16); const f32x4 z = r * alpha + acc[ai][bj][m][n];
                        u32x2 w; w.x = cvt_pk_bf16(z[0], z[1]); w.y = cvt_pk_bf16(z[2], z[3]); *(u32x2*)(zb + off + bj * HALF + n * 16) = w;
                        sm += (z[0] + z[1]) + (z[2] + z[3]); ss += (z[0] * z[0] + z[1] * z[1]) + (z[2] * z[2] + z[3] * z[3]); }
                sm += __shfl_xor(sm, 16); sm += __shfl_xor(sm, 32); ss += __shfl_xor(ss, 16); ss += __shfl_xor(ss, 32);
                if (fq == 0) *(float2*)(stats + (size_t)row * 32 + (u.pn * 4 + wc) * 2) = make_float2(sm, ss); }
    }
};
struct EpiResLn {
    static constexpr bool PERM = false;
    float* out; const bf16_t* zb; const float* stats; const float* g; const float* b; float alpha;
    __device__ __forceinline__ void operator()(const f32x4 (&acc)[2][2][4][2], const Unit& u, int wr, int wc, int fr, int fq) const {
        const int row0 = u.pm * BM + wr * 64 + fr, col0 = u.pn * BM + wc * 32 + 4 * fq;
        f32x4 gv[2][2], bv[2][2];
#pragma unroll
        for (int bj = 0; bj < 2; ++bj)
#pragma unroll
            for (int n = 0; n < 2; ++n) { gv[bj][n] = *(const f32x4*)(g + col0 + bj * HALF + n * 16); bv[bj][n] = *(const f32x4*)(b + col0 + bj * HALF + n * 16); }
#pragma unroll
        for (int ai = 0; ai < 2; ++ai)
#pragma unroll
            for (int m = 0; m < 4; ++m) { const int row = row0 + ai * HALF + m * 16; const size_t off = (size_t)row * 1024 + col0; float mu, rstd; row_stats16(stats, row, fq, mu, rstd);
#pragma unroll
                for (int bj = 0; bj < 2; ++bj)
#pragma unroll
                    for (int n = 0; n < 2; ++n) { const u32x2 zw = *(const u32x2*)(zb + off + bj * HALF + n * 16);
                        const f32x4 z = (f32x4){__builtin_bit_cast(float, zw.x << 16), __builtin_bit_cast(float, zw.x & 0xffff0000u), __builtin_bit_cast(float, zw.y << 16), __builtin_bit_cast(float, zw.y & 0xffff0000u)};
                        const f32x4 x1 = (z - mu) * rstd * gv[bj][n] + bv[bj][n];
                        *(f32x4*)(out + off + bj * HALF + n * 16) = x1 * alpha + acc[ai][bj][m][n]; } }
    }
};
struct EpiRank1 {
    static constexpr bool PERM = true;
    bf16_t* O; const float* stats; const float* cs; const float* bw;
    __device__ __forceinline__ void operator()(const f32x4 (&acc)[2][2][4][2], const Unit& u, int wr, int wc, int fr, int fq) const {
        const int row0 = u.pm * BM + wr * 64 + fr, col0 = u.pn * BM + wc * 32 + 8 * fq;
        f32x4 cv[2][2], wv[2][2];
#pragma unroll
        for (int bj = 0; bj < 2; ++bj)
#pragma unroll
            for (int n = 0; n < 2; ++n) { cv[bj][n] = *(const f32x4*)(cs + col0 + bj * HALF + 4 * n); wv[bj][n] = *(const f32x4*)(bw + col0 + bj * HALF + 4 * n); }
#pragma unroll
        for (int ai = 0; ai < 2; ++ai)
#pragma unroll
            for (int m = 0; m < 4; ++m) { const int row = row0 + ai * HALF + m * 16; float mu, rstd; row_stats16(stats, row, fq, mu, rstd); bf16_t* rowp = O + (size_t)row * 1024 + col0;
#pragma unroll
                for (int bj = 0; bj < 2; ++bj) *(u32x4*)(rowp + bj * HALF) = pack8((acc[ai][bj][m][0] - cv[bj][0] * mu) * rstd + wv[bj][0], (acc[ai][bj][m][1] - cv[bj][1] * mu) * rstd + wv[bj][1]); }
    }
};

struct EpiPre {
    static constexpr bool PERM = true;
    bf16_t* O; float* csp;
    __device__ __forceinline__ void operator()(const f32x4 (&acc)[2][2][4][2], const Unit& u, int wr, int wc, int fr, int fq) const {
        const int row0 = u.pm * BM + wr * 64 + fr, col0 = u.pn * BM + wc * 32 + 8 * fq;
#pragma unroll
        for (int ai = 0; ai < 2; ++ai)
#pragma unroll
            for (int m = 0; m < 4; ++m) { const int row = row0 + ai * HALF + m * 16; bf16_t* rowp = O + ((size_t)u.aux * 1024 + row) * 1024 + col0; float sm = 0.f;
#pragma unroll
                for (int bj = 0; bj < 2; ++bj) { const u32x4 w = pack8(acc[ai][bj][m][0], acc[ai][bj][m][1]); *(u32x4*)(rowp + bj * HALF) = w;
#pragma unroll
                    for (int e = 0; e < 4; ++e) sm += __builtin_bit_cast(float, w[e] << 16) + __builtin_bit_cast(float, w[e] & 0xffff0000u); }
                if (csp) { sm += __shfl_xor(sm, 16); sm += __shfl_xor(sm, 32); if (fq == 0) csp[((size_t)u.aux * 1024 + row) * 16 + u.pn * 4 + wc] = sm; } }
    }
};
struct EpiSoftmaxLn {
    static constexpr bool PERM = true;
    bf16_t* P; PG8_LAS float* xl; const float* stats; const float* cs; const float* bw;
    __device__ __forceinline__ void operator()(f32x4 (&acc)[2][2][4][2], const Unit& u, int wr, int wc, int fr, int fq) const {
        const float sc = 0.0625f * 1.4426950408889634f;
        const int row0 = u.pm * BM + wr * 64 + fr, col0 = u.pn * BM + wc * 32 + 8 * fq;
        { f32x4 cv[2][2], wv[2][2];
#pragma unroll
          for (int bj = 0; bj < 2; ++bj)
#pragma unroll
            for (int n = 0; n < 2; ++n) { cv[bj][n] = *(const f32x4*)(cs + u.aux * 1024 + col0 + bj * HALF + 4 * n); wv[bj][n] = *(const f32x4*)(bw + u.aux * 1024 + col0 + bj * HALF + 4 * n); }
#pragma unroll
          for (int ai = 0; ai < 2; ++ai)
#pragma unroll
            for (int m = 0; m < 4; ++m) { float mu, rstd; row_stats16(stats, row0 + ai * HALF + m * 16, fq, mu, rstd);
#pragma unroll
                for (int bj = 0; bj < 2; ++bj)
#pragma unroll
                    for (int n = 0; n < 2; ++n) acc[ai][bj][m][n] = (acc[ai][bj][m][n] - cv[bj][n] * mu) * rstd + wv[bj][n]; } }
#pragma unroll
        for (int ai = 0; ai < 2; ++ai)
#pragma unroll
            for (int m = 0; m < 4; ++m) { float mx = -INFINITY;
#pragma unroll
                for (int bj = 0; bj < 2; ++bj)
#pragma unroll
                    for (int n = 0; n < 2; ++n) { const f32x4 v = acc[ai][bj][m][n]; mx = fmaxf(mx, fmaxf(fmaxf(v[0], v[1]), fmaxf(v[2], v[3]))); }
                mx = fmaxf(mx, __shfl_xor(mx, 16)); mx = fmaxf(mx, __shfl_xor(mx, 32));
                float sm = 0.f;
#pragma unroll
                for (int bj = 0; bj < 2; ++bj)
#pragma unroll
                    for (int n = 0; n < 2; ++n) { const f32x4 v = acc[ai][bj][m][n]; sm += (__builtin_amdgcn_exp2f((v[0] - mx) * sc) + __builtin_amdgcn_exp2f((v[1] - mx) * sc)) + (__builtin_amdgcn_exp2f((v[2] - mx) * sc) + __builtin_amdgcn_exp2f((v[3] - mx) * sc)); }
                sm += __shfl_xor(sm, 16); sm += __shfl_xor(sm, 32);
                if (fq == 0) { PG8_LAS float* q = xl + ((ai * HALF + wr * 64 + m * 16 + fr) * 4 + wc) * 2; q[0] = mx; q[1] = sm; } }
        asm volatile("s_waitcnt lgkmcnt(0)" ::: "memory"); __builtin_amdgcn_s_barrier(); asm volatile("" ::: "memory");
#pragma unroll
        for (int ai = 0; ai < 2; ++ai)
#pragma unroll
            for (int m = 0; m < 4; ++m) { const PG8_LAS f32x4* q = (const PG8_LAS f32x4*)(xl + (ai * HALF + wr * 64 + m * 16 + fr) * 8); const f32x4 q0 = q[0], q1 = q[1];
                const float M = fmaxf(fmaxf(q0[0], q0[2]), fmaxf(q1[0], q1[2]));
                const float S = (q0[1] * __builtin_amdgcn_exp2f((q0[0] - M) * sc) + q0[3] * __builtin_amdgcn_exp2f((q0[2] - M) * sc)) + (q1[1] * __builtin_amdgcn_exp2f((q1[0] - M) * sc) + q1[3] * __builtin_amdgcn_exp2f((q1[2] - M) * sc));
                const float inv = 1.f / S; bf16_t* rowp = P + (size_t)(row0 + ai * HALF + m * 16) * 1024 + col0;
#pragma unroll
                for (int bj = 0; bj < 2; ++bj) { f32x4 pq[2];
#pragma unroll
                    for (int n = 0; n < 2; ++n) { const f32x4 v = acc[ai][bj][m][n];
                        pq[n] = (f32x4){__builtin_amdgcn_exp2f((v[0] - M) * sc) * inv, __builtin_amdgcn_exp2f((v[1] - M) * sc) * inv, __builtin_amdgcn_exp2f((v[2] - M) * sc) * inv, __builtin_amdgcn_exp2f((v[3] - M) * sc) * inv}; }
                    *(u32x4*)(rowp + bj * HALF) = pack8(pq[0], pq[1]); } }
        asm volatile("s_waitcnt lgkmcnt(0)" ::: "memory"); __builtin_amdgcn_s_barrier(); asm volatile("" ::: "memory");
    }
};
struct DenseSched {
    const char* A; const char* B; int nM, nN, G, c; size_t strideA, strideB;
    __device__ __forceinline__ bool next(int i, Unit& u) const { const int L = i * G + c; if (L >= nM * nN) return false; tile_of(L, nM, nN, u.pm, u.pn); u.A = A + (size_t)u.pm * strideA; u.B = B + (size_t)u.pn * strideB; u.kind = 0; u.aux = 0; u.rows = nullptr; return true; }
};
}


#define LAS __attribute__((address_space(3)))
__device__ __forceinline__ void transpose_item(const float* W, int N, bf16* WT, int Kd, int k0, int n0, int drow0, LAS float* scr, int lane, const float* gk = nullptr) {
#pragma unroll 8
    for (int i = 0; i < 32; ++i) { const int kk = 2 * i + (lane >> 5); float wv = W[(size_t)(k0 + kk) * N + n0 + (lane & 31)]; if (gk) wv *= gk[k0 + kk]; scr[kk * 33 + (lane & 31)] = wv; }
    asm volatile("s_waitcnt lgkmcnt(0)" ::: "memory");
    const int c = lane & 7;
#pragma unroll
    for (int j = 0; j < 4; ++j) { const int n = (lane >> 3) + 8 * j; const LAS float* sp = scr + (8 * c) * 33 + n;
        u32x4 o; o.x = pk2(sp[0 * 33], sp[1 * 33]); o.y = pk2(sp[2 * 33], sp[3 * 33]); o.z = pk2(sp[4 * 33], sp[5 * 33]); o.w = pk2(sp[6 * 33], sp[7 * 33]);
        *(u32x4*)(WT + (size_t)(drow0 + n) * Kd + k0 + 8 * c) = o; }
    asm volatile("s_waitcnt lgkmcnt(0)" ::: "memory");
}


typedef short bf16x8v __attribute__((ext_vector_type(8)));
__device__ __forceinline__ float bflo(unsigned v) { return __builtin_bit_cast(float, v << 16); }
__device__ __forceinline__ float bfhi(unsigned v) { return __builtin_bit_cast(float, v & 0xffff0000u); }

__device__ __forceinline__ void conv_unit(unsigned char* lds, const bf16* hglu, const float* w_dw, const float* b_dw, const float* g_cn, const float* b_cn, bf16* ycat, int cu, int tid) {
    const int lane = tid & 63, wave = tid >> 6;
    bf16* hin = (bf16*)lds; float* cout = (float*)(lds + 63488);
    const int t0 = cu * 32, s0 = t0 % SEQ;
    for (int c = tid; c < 62 * 64; c += 512) { const int row = c >> 6, part = c & 63; u32x4 v = (u32x4){0u, 0u, 0u, 0u};
        if (s0 - 30 + row >= 0) v = *(const u32x4*)(hglu + (size_t)(t0 - 30 + row) * 512 + part * 8);
        *(u32x4*)(hin + row * 512 + part * 8) = v; }
    __syncthreads();
    {
        const int cp = tid & 255, th = tid >> 8;
        float w0[CONV_W], w1[CONV_W];
#pragma unroll
        for (int j = 0; j < CONV_W; ++j) { const float2 ww = *(const float2*)(w_dw + j * CONV_CH + 2 * cp); w0[j] = ww.x; w1[j] = ww.y; }
        const float2 bb = *(const float2*)(b_dw + 2 * cp);
#pragma unroll 1
        for (int grp = 0; grp < 2; ++grp) { const int tt0 = th * 16 + grp * 8;
            float a0[8], a1[8];
#pragma unroll
            for (int o = 0; o < 8; ++o) { a0[o] = bb.x; a1[o] = bb.y; }
#pragma unroll
            for (int r = 0; r < 38; ++r) { const unsigned v = *(const unsigned*)(hin + (tt0 + r) * 512 + 2 * cp); const float lo = bflo(v), hi = bfhi(v);
#pragma unroll
                for (int o = 0; o < 8; ++o) { const int j = r - o; if (j >= 0 && j < CONV_W) { a0[o] += w0[j] * lo; a1[o] += w1[j] * hi; } } }
#pragma unroll
            for (int o = 0; o < 8; ++o) *(float2*)(cout + (tt0 + o) * 512 + 2 * cp) = make_float2(a0[o], a1[o]);
        }
    }
    __syncthreads();
    {
        const f32x4 g0 = *(const f32x4*)(g_cn + 8 * lane), g1 = *(const f32x4*)(g_cn + 8 * lane + 4), c0 = *(const f32x4*)(b_cn + 8 * lane), c1 = *(const f32x4*)(b_cn + 8 * lane + 4);
#pragma unroll 1
        for (int i = 0; i < 4; ++i) { const int tt = wave * 4 + i;
            f32x4 v0 = *(const f32x4*)(cout + tt * 512 + 8 * lane), v1 = *(const f32x4*)(cout + tt * 512 + 8 * lane + 4);
            const float mean = wave_sum((v0.x + v0.y) + (v0.z + v0.w) + (v1.x + v1.y) + (v1.z + v1.w)) * (1.f / 512.f);
            v0 = v0 - mean; v1 = v1 - mean;
            const float var = wave_sum((v0.x * v0.x + v0.y * v0.y) + (v0.z * v0.z + v0.w * v0.w) + (v1.x * v1.x + v1.y * v1.y) + (v1.z * v1.z + v1.w * v1.w)) * (1.f / 512.f);
            const float rstd = 1.f / sqrtf(var + LN_EPS);
            f32x4 y0 = v0 * rstd * g0 + c0, y1 = v1 * rstd * g1 + c1;
#pragma unroll
            for (int e = 0; e < 4; ++e) { y0[e] = y0[e] * pg8::sigm(y0[e]); y1[e] = y1[e] * pg8::sigm(y1[e]); }
            *(u32x4*)(ycat + (size_t)(t0 + tt) * 1024 + 8 * lane) = pg8::pack8(y0, y1); }
    }
    __syncthreads();
}

__device__ __forceinline__ void swa_unit(unsigned char* lds, const bf16* qkv, const float* sinks, bf16* ycat, int b, int kvh, int qb, int tid) {
    const int lane = tid & 63, wave = tid >> 6, q4 = lane >> 4, c16 = lane & 15;
    bf16* Ks = (bf16*)lds; bf16* VT = (bf16*)(lds + 36864);
    const long t0 = (long)b * SEQ + (long)qb * 128, tk0 = t0 - 128;
#pragma unroll
    for (int i = 0; i < 4; ++i) { const int c = tid + 512 * i, row = c >> 3, part = c & 7; const bool ok = (qb > 0) || (row >= 128);
        u32x4 kv = (u32x4){0u, 0u, 0u, 0u}, vv = kv;
        if (ok) { const bf16* rp = qkv + (tk0 + row) * 768 + 512 + kvh * 64 + part * 8; kv = *(const u32x4*)rp; vv = *(const u32x4*)(rp + 128); }
        *(u32x4*)(Ks + row * 72 + part * 8) = kv;
#pragma unroll
        for (int e = 0; e < 4; ++e) { VT[(part * 8 + 2 * e) * 264 + row] = (bf16)(vv[e] & 0xffffu); VT[(part * 8 + 2 * e + 1) * 264 + row] = (bf16)(vv[e] >> 16); } }
    __syncthreads();
    const int g = wave >> 1, hq = kvh * 4 + g, i0 = (wave & 1) * 64;
    const float L2E = 1.4426950408889634f, sc = 0.125f * L2E, sink2 = sinks[hq] * L2E;
#pragma unroll 1
    for (int qt = 0; qt < 4; ++qt) {
        const int iq = i0 + qt * 16, kt0 = iq >> 4, iqc = iq + c16;
        const bf16* qp = qkv + (t0 + iqc) * 768 + hq * 64 + 8 * q4;
        const bf16x8v Q0 = *(const bf16x8v*)qp, Q1 = *(const bf16x8v*)(qp + 32);
        f32x4 sv[9];
#pragma unroll
        for (int kt = 0; kt < 9; ++kt) { const bf16* kp = Ks + ((kt0 + kt) * 16 + c16) * 72 + 8 * q4;
            f32x4 a = (f32x4){0.f, 0.f, 0.f, 0.f};
            a = __builtin_amdgcn_mfma_f32_16x16x32_bf16(*(const bf16x8v*)kp, Q0, a, 0, 0, 0);
            a = __builtin_amdgcn_mfma_f32_16x16x32_bf16(*(const bf16x8v*)(kp + 32), Q1, a, 0, 0, 0);
            sv[kt] = a; }
        float mx = sink2;
#pragma unroll
        for (int kt = 0; kt < 9; ++kt)
#pragma unroll
            for (int r = 0; r < 4; ++r) { const int j = (kt0 + kt) * 16 + 4 * q4 + r; const bool ok = (j > iqc) && (j <= iqc + 128) && (qb > 0 || j >= 128);
                const float v = ok ? sv[kt][r] * sc : -INFINITY; sv[kt][r] = v; mx = fmaxf(mx, v); }
        mx = fmaxf(mx, __shfl_xor(mx, 16)); mx = fmaxf(mx, __shfl_xor(mx, 32));
        float sum = 0.f;
#pragma unroll
        for (int kt = 0; kt < 9; ++kt)
#pragma unroll
            for (int r = 0; r < 4; ++r) { const float pv = __builtin_amdgcn_exp2f(sv[kt][r] - mx); sv[kt][r] = pv; sum += pv; }
        sum += __shfl_xor(sum, 16); sum += __shfl_xor(sum, 32);
        sum += __builtin_amdgcn_exp2f(sink2 - mx);
        const float inv = 1.f / sum;
        f32x4 o[4];
#pragma unroll
        for (int dt = 0; dt < 4; ++dt) o[dt] = (f32x4){0.f, 0.f, 0.f, 0.f};
#pragma unroll
        for (int pp = 0; pp < 5; ++pp) { const int T0 = kt0 + 2 * pp, T1 = (pp < 4) ? T0 + 1 : T0;
            const f32x4 pa = sv[2 * pp], pb = (pp < 4) ? sv[2 * pp + 1] : (f32x4){0.f, 0.f, 0.f, 0.f};
            const u32x4 pw = pg8::pack8(pa, pb); const bf16x8v Bp = __builtin_bit_cast(bf16x8v, pw);
#pragma unroll
            for (int dt = 0; dt < 4; ++dt) { const bf16* vp = VT + (dt * 16 + c16) * 264 + 4 * q4;
                const u32x2 lo = *(const u32x2*)(vp + T0 * 16), hi = *(const u32x2*)(vp + T1 * 16);
                const u32x4 aw = (u32x4){lo.x, lo.y, hi.x, hi.y};
                o[dt] = __builtin_amdgcn_mfma_f32_16x16x32_bf16(__builtin_bit_cast(bf16x8v, aw), Bp, o[dt], 0, 0, 0); } }
        bf16* op = ycat + (t0 + iqc) * 1024 + 512 + hq * 64 + 4 * q4;
#pragma unroll
        for (int dt = 0; dt < 4; ++dt) { u32x2 w; w.x = pg8::cvt_pk_bf16(o[dt][0] * inv, o[dt][1] * inv); w.y = pg8::cvt_pk_bf16(o[dt][2] * inv, o[dt][3] * inv); *(u32x2*)(op + dt * 16) = w; }
    }
    __syncthreads();
}


#define XB_TMO      128
#define XB_XCNT(j)  (256  + 64 * (j))
#define XB_XSUB(j)  (1280 + 64 * (j))
#define XB_XGEN(j)  (2304 + 64 * (j))
#define XB_TOP      3328
#define XB_TOPGEN   3392
#define XCD_BAR_WORDS 3456
#define XB_SPIN_CAP (1u << 20)
__device__ __forceinline__ unsigned xb_ld(unsigned* p)              { return __hip_atomic_load(p, __ATOMIC_RELAXED, __HIP_MEMORY_SCOPE_AGENT); }
__device__ __forceinline__ unsigned xb_add(unsigned* p, unsigned v) { return __hip_atomic_fetch_add(p, v, __ATOMIC_RELAXED, __HIP_MEMORY_SCOPE_AGENT); }
__device__ __forceinline__ unsigned xb_xcc_id() { return (unsigned)__builtin_amdgcn_s_getreg((3 << 11) | 20) & 0xFu; }
#define XB_SPIN(cond, bar) do { unsigned _sp = 0; while (cond) { __builtin_amdgcn_s_sleep(1); \
    if ((++_sp & 255u) == 0u) { if (xb_ld(&(bar)[XB_TMO])) break; if (_sp > XB_SPIN_CAP) { atomicAdd(&(bar)[XB_TMO], 1u); break; } } } } while (0)
struct XcdBarrier { unsigned* bar; unsigned x; volatile __attribute__((address_space(3))) unsigned* st; };
__device__ __forceinline__ XcdBarrier xcd_barrier_post(unsigned* bar, volatile __attribute__((address_space(3))) unsigned* st) {
    XcdBarrier b; b.bar = bar; b.x = xb_xcc_id(); b.st = st;
    if (threadIdx.x == 0) (void)xb_add(&bar[XB_XCNT(b.x)], 1u);
    return b;
}
__device__ __forceinline__ void xcd_barrier_complete(unsigned* bar, unsigned x, unsigned& nloc, unsigned& nx) {
    const unsigned G = gridDim.x * gridDim.y * gridDim.z;
    unsigned sum, cnt, mine, sp = 0u;
    for (;;) {
        sum = 0u; cnt = 0u; mine = 0u;
#pragma unroll
        for (unsigned j = 0; j < 16; ++j) { const unsigned c = xb_ld(&bar[XB_XCNT(j)]); sum += c; cnt += (c > 0u) ? 1u : 0u; mine = (j == x) ? c : mine; }
        if (sum == G) break;
        __builtin_amdgcn_s_sleep(1);
        if ((++sp & 255u) == 0u) { if (xb_ld(&bar[XB_TMO])) break; if (sp > XB_SPIN_CAP) { atomicAdd(&bar[XB_TMO], 1u); break; } }
    }
    nloc = mine > 0u ? mine : 1u; nx = cnt > 0u ? cnt : 1u;
}
__device__ __forceinline__ void xcd_barrier(const XcdBarrier& b, int tid) {
    asm volatile("s_waitcnt vmcnt(0)" ::: "memory");
    __syncthreads();
    if (tid == 0) {
        unsigned* bar = b.bar;
        __builtin_amdgcn_s_waitcnt(0);
        unsigned nloc = b.st[0], nx = b.st[1];
        if (nloc == 0u) { xcd_barrier_complete(bar, b.x, nloc, nx); b.st[0] = nloc; b.st[1] = nx; }
        const unsigned old = xb_add(&bar[XB_XSUB(b.x)], 1u);
        const unsigned gen = old / nloc;
        if (old + 1u == (gen + 1u) * nloc) {
            __builtin_amdgcn_fence(__ATOMIC_RELEASE, "agent");
            asm volatile("s_waitcnt vmcnt(0)" ::: "memory");
            const unsigned og = xb_add(&bar[XB_TOP], 1u);
            const unsigned tg = og / nx;
            if (og + 1u == (tg + 1u) * nx) xb_add(&bar[XB_TOPGEN], 1u);
            else XB_SPIN(xb_ld(&bar[XB_TOPGEN]) == tg, bar);
            __builtin_amdgcn_fence(__ATOMIC_ACQUIRE, "agent");
            xb_add(&bar[XB_XGEN(b.x)], 1u);
            asm volatile("s_waitcnt vmcnt(0)" ::: "memory");
        } else {
            XB_SPIN(xb_ld(&bar[XB_XGEN(b.x)]) == gen, bar);
            __builtin_amdgcn_fence(__ATOMIC_ACQUIRE, "agent");
            asm volatile("s_waitcnt vmcnt(0)" ::: "memory");
        }
    }
    __syncthreads();
}

struct SchedMoE { const char* A; const char* W; const int* seg; const int* rows; int nmt, nN, G, c; size_t strideA, strideE, strideN;
    __device__ __forceinline__ bool next(int i, pg8::Unit& u) const { const int L = i * G + c; if (L >= nmt * nN) return false; pg8::tile_of(L, nmt, nN, u.pm, u.pn); int e = 0;
#pragma unroll
        for (int j = 1; j < 16; ++j) if (u.pm * 256 >= seg[j]) e = j;
        u.kind = 0; u.aux = e; u.rows = rows ? rows + u.pm * 256 : nullptr; u.A = rows ? A : A + (size_t)u.pm * strideA; u.B = W + (size_t)e * strideE + (size_t)u.pn * strideN; return true; } };

__global__ void __launch_bounds__(512, 2) fwd_kernel(Params p) {
    extern __shared__ __attribute__((aligned(16))) unsigned char lds_raw[];
    float* ldsf = (float*)lds_raw;
    cg::grid_group grid = cg::this_grid();
    const int G = gridDim.x, bid = blockIdx.x, NGW = G * 8;
    const int wid_s = __builtin_amdgcn_readfirstlane((int)threadIdx.x >> 6);
    unsigned char* ws = p.ws;
    const float *x = p.in[0], *mem = p.in[1], *w_in = p.in[2], *b_in = p.in[3], *w_dw = p.in[4], *b_dw = p.in[5], *g_cn = p.in[6], *b_cn = p.in[7], *sinks = p.in[8],
                *w_out = p.in[9], *g_ln1 = p.in[10], *b_ln1 = p.in[11], *w_mq = p.in[12], *w_mkv = p.in[13], *w_mo = p.in[14], *g_ln2 = p.in[15], *b_ln2 = p.in[16],
                *w_group = p.in[17], *b_group = p.in[18], *w_router = p.in[19], *b_router = p.in[20], *w_gate = p.in[21], *w_up = p.in[22], *w_down = p.in[23],
                *g_ln3 = p.in[24], *b_ln3 = p.in[25];
    float* out = p.out;
    bf16* xb = (bf16*)(ws + WS_A); bf16* ycat = (bf16*)(ws + WS_A); bf16* qm = (bf16*)(ws + WS_A); bf16* om = (bf16*)(ws + WS_A); bf16* Hs = (bf16*)(ws + WS_A);
    bf16* hglu = (bf16*)(ws + WS_B); bf16* qkv = (bf16*)(ws + WS_B + (size_t)T * 512 * 2); bf16* x1b = (bf16*)(ws + WS_B); bf16* Pb2 = (bf16*)(ws + WS_A); bf16* x2b = (bf16*)(ws + WS_B);
    float* Sbuf = (float*)(ws + WS_DD); bf16* Xs = (bf16*)(ws + WS_DD);
    bf16* kvm = (bf16*)(ws + WS_KVM); bf16* memb = (bf16*)(ws + WS_MEMB); bf16* MT = (bf16*)(ws + WS_MT); bf16* NT = (bf16*)(ws + WS_NT);
    float* csS = (float*)(ws + WS_CSS); float* bwS = csS + 2048; float* csp = (float*)(ws + WS_CSP);
    bf16* Wt_in = (bf16*)(ws + WS_WIN); bf16* Wt_out = (bf16*)(ws + WS_WOUT); bf16* Wqb = (bf16*)(ws + WS_WMQ); bf16* Wt_mkv = (bf16*)(ws + WS_WMKV); bf16* Wt_mo = (bf16*)(ws + WS_WMO);
    bf16* Wt_gu = (bf16*)(ws + WS_WGU); bf16* Wt_dn = (bf16*)(ws + WS_WDN);
    PG8_LAS unsigned char* ldsp = (PG8_LAS unsigned char*)lds_raw;
    float* stats1 = (float*)(ws + WS_ST1); float* cs1 = (float*)(ws + WS_CS1); float* bw1 = cs1 + 1024;
    int* route_e = (int*)(ws + WS_ROUTE); float* route_g = (float*)(ws + WS_ROUTE + (size_t)T * 8);
    int* blkcnt = (int*)(ws + WS_BLKCNT); int* segw = (int*)(ws + WS_SEG); int* rank = (int*)(ws + WS_RANK);
    int* pair_tok = (int*)(ws + WS_PTOK); float* pair_gate = (float*)(ws + WS_PGATE); int* tokpos = (int*)(ws + WS_TOKPOS); bf16* Yb = (bf16*)(ws + WS_DD);

    const int lo = p.ph_lo, hi = p.ph_hi;
    int ph = 0;
    volatile __attribute__((address_space(3))) unsigned* bst = (volatile __attribute__((address_space(3))) unsigned*)(ldsp + LDS_BYTES_K - 64);
    if (threadIdx.x == 0) { bst[0] = 0u; bst[1] = 0u; }
    __syncthreads();
    const XcdBarrier xbar = xcd_barrier_post((unsigned*)(ws + WS_CTL), bst);
    if (lo > hi) grid.sync();
#define PHASE_BEGIN if (lo <= ph && ph < hi) { for (int rep_ = 0; rep_ < ((((unsigned)PROBE_MASK >> ph) & 1u) ? 2 : 1); ++rep_) { const int tid = wid_s * 64 + lane_fresh(); const int lane = tid & 63, wave = tid >> 6, gw = bid * 8 + wave; (void)lane; (void)wave; (void)gw;
#define PHASE_END } } if (lo <= ph && ph + 1 < hi) xcd_barrier(xbar, wid_s * 64 + lane_fresh()); ++ph;

    PHASE_BEGIN
    for (size_t i = (size_t)bid * 512 + tid; i < (size_t)T * D / 4; i += (size_t)G * 512) { const f32x4 v = ((const f32x4*)x)[i]; u32x2 w; w.x = pk2(v.x, v.y); w.y = pk2(v.z, v.w); ((u32x2*)xb)[i] = w; }
    for (size_t i = (size_t)bid * 512 + tid; i < (size_t)NMEM * D / 4; i += (size_t)G * 512) { const f32x4 v = ((const f32x4*)mem)[i]; u32x2 w; w.x = pk2(v.x, v.y); w.y = pk2(v.z, v.w); ((u32x2*)memb)[i] = w; }
    {
        LAS float* scr = (LAS float*)(ldsp + wave * 16384);
        constexpr int I_IN = 16 * 56, I_SQ = 16 * 32, I_KV = 16 * 64, I_EX = 16 * 256;
        constexpr int NITEMS = I_IN + 2 * I_SQ + I_KV + 3 * I_EX;
        for (int it = gw; it < NITEMS; it += NGW) { int r = it;
            if (r < I_IN) { const int kb = r / 56, nb = r % 56, n0 = nb * 32; const int dr = n0 < 512 ? (n0 >> 7) * 256 + (n0 & 127) : (n0 < 1024 ? ((n0 - 512) >> 7) * 256 + 128 + (n0 & 127) : n0);
                transpose_item(w_in, D_IN, Wt_in, 1024, kb * 64, n0, dr, scr, lane); continue; } r -= I_IN;
            if (r < I_SQ) { transpose_item(w_out, 1024, Wt_out, 1024, (r / 32) * 64, (r % 32) * 32, (r % 32) * 32, scr, lane); continue; } r -= I_SQ;
            if (r < I_SQ) { transpose_item(w_mo, 1024, Wt_mo, 1024, (r / 32) * 64, (r % 32) * 32, (r % 32) * 32, scr, lane); continue; } r -= I_SQ;
            if (r < I_KV) { transpose_item(w_mkv, 2048, Wt_mkv, 1024, (r / 64) * 64, (r % 64) * 32, (r % 64) * 32, scr, lane); continue; } r -= I_KV;
            if (r < I_EX) { const int e = r / 256, q = r % 256, n0 = (q % 16) * 32; transpose_item(w_gate + (size_t)e * D * DE, DE, Wt_gu + (size_t)e * 1024 * 1024, 1024, (q / 16) * 64, n0, (n0 >> 7) * 256 + (n0 & 127), scr, lane); continue; } r -= I_EX;
            if (r < I_EX) { const int e = r / 256, q = r % 256, n0 = (q % 16) * 32; transpose_item(w_up + (size_t)e * D * DE, DE, Wt_gu + (size_t)e * 1024 * 1024, 1024, (q / 16) * 64, n0, (n0 >> 7) * 256 + 128 + (n0 & 127), scr, lane); continue; } r -= I_EX;
            { const int e = r / 256, q = r % 256; transpose_item(w_down + (size_t)e * DE * D, D, Wt_dn + (size_t)e * 1024 * 512, 512, (q / 32) * 64, (q % 32) * 32, (q % 32) * 32, scr, lane); }
        }
        for (int it = gw; it < 256; it += NGW) {
            f32x4 b4 = (f32x4){0.f, 0.f, 0.f, 0.f};
#pragma unroll 4
            for (int i = 0; i < 16; ++i) { const int k = lane + 64 * i; const f32x4 w = *(const f32x4*)(w_mq + (size_t)k * 1024 + 4 * it); b4 += w * b_ln1[k]; }
#pragma unroll
            for (int e = 0; e < 4; ++e) b4[e] = wave_sum(b4[e]);
            if (lane == 0) *(f32x4*)(bw1 + 4 * it) = b4; }
    }
    for (size_t i = (size_t)bid * 512 + tid; i < (size_t)D * D / 4; i += (size_t)G * 512) { const float gk = g_ln1[i >> 8]; const f32x4 v = ((const f32x4*)w_mq)[i] * gk; u32x2 w; w.x = pk2(v.x, v.y); w.y = pk2(v.z, v.w); ((u32x2*)Wqb)[i] = w; }
    PHASE_END

    PHASE_BEGIN
    {
        struct SchedP1 { const char *xb, *win, *memb, *wkv; int G, c;
            __device__ __forceinline__ bool next(int i, pg8::Unit& u) const { const int L = i * G + c; u.aux = 0;
                if (L < 448) { pg8::tile_of(L, 64, 7, u.pm, u.pn); u.A = xb + (size_t)u.pm * 256 * 2048; u.B = win + (size_t)u.pn * 256 * 2048; u.kind = u.pn < 4 ? 0 : 1; return true; }
                if (L < 464) { const int r = L - 448; u.pm = r >> 3; u.pn = r & 7; u.A = memb + (size_t)u.pm * 256 * 2048; u.B = wkv + (size_t)u.pn * 256 * 2048; u.kind = 2; return true; }
                return false; } };
        const SchedP1 S{(const char*)xb, (const char*)Wt_in, (const char*)memb, (const char*)Wt_mkv, G, bid};
        const pg8::EpiP1 E{hglu, qkv, kvm, b_in};
        pg8::gemm_phase(tid, ldsp, pg8::Gemm{1024, 1024, 1024}, S, E);
    }
    PHASE_END

    PHASE_BEGIN
    for (int cu = bid; cu < T / 32; cu += G) conv_unit(lds_raw, hglu, w_dw, b_dw, g_cn, b_cn, ycat, cu, tid);
    for (int u = bid; u < BATCH * NKV * (SEQ / 128); u += G) swa_unit(lds_raw, qkv, sinks, ycat, u >> 7, (u >> 6) & 1, u & 63, tid);
    {
        struct SchedMT { const char *kvm, *wq; int c;
            __device__ __forceinline__ bool next(int i, pg8::Unit& u) const { if (i > 0 || c < 0 || c >= 32) return false; const int b = c >> 4, h = (c >> 2) & 3, pn = c & 3; u.pm = h; u.pn = pn; u.aux = b; u.kind = 0;
                u.A = kvm + ((size_t)(b * 256) * 2048 + h * 256) * 2; u.B = wq + ((size_t)(pn * 256) * 1024 + h * 256) * 2; return true; } };
        struct SchedNT { const char *wo, *kvm; int c;
            __device__ __forceinline__ bool next(int i, pg8::Unit& u) const { if (i > 0 || c < 0 || c >= 32) return false; const int b = c >> 4, h = (c >> 2) & 3, pm = c & 3; u.pm = pm; u.pn = h; u.aux = b; u.kind = 0;
                u.A = wo + ((size_t)(pm * 256) * 1024 + h * 256) * 2; u.B = kvm + ((size_t)(b * 256) * 2048 + 1024 + h * 256) * 2; return true; } };
        const SchedMT S1{(const char*)kvm, (const char*)Wqb, bid}; const pg8::EpiPre E1{MT, csp};
        pg8::gemm_phase(wid_s * 64 + lane_fresh(), ldsp, pg8::Gemm{2048, 1024, 256}, S1, E1);
        const SchedNT S2{(const char*)Wt_mo, (const char*)kvm, bid - 32}; const pg8::EpiPre E2{NT, nullptr};
        pg8::gemm_phase(wid_s * 64 + lane_fresh(), ldsp, pg8::Gemm{1024, 2048, 256}, S2, E2);
    }
    PHASE_END

    PHASE_BEGIN
    for (int r = gw; r < 2048; r += NGW) { const int b = r >> 10, hk = r & 1023, h = hk >> 8, key = hk & 255;
        const float c = wave_sum(lane < 16 ? csp[(size_t)r * 16 + lane] : 0.f);
        const u32x2 kk = *(const u32x2*)(kvm + (size_t)(b * 256 + key) * 2048 + h * 256 + 4 * lane); const f32x4 bq = *(const f32x4*)(bw1 + h * 256 + 4 * lane);
        const float w = wave_sum((bflo(kk.x) * bq[0] + bfhi(kk.x) * bq[1]) + (bflo(kk.y) * bq[2] + bfhi(kk.y) * bq[3]));
        if (lane == 0) { csS[r] = c; bwS[r] = w; } }
    { const pg8::DenseSched S{(const char*)ycat, (const char*)Wt_out, 64, 4, G, bid, (size_t)256 * 2048, (size_t)256 * 2048};
      const pg8::EpiResStats E{x, out, x1b, stats1, ALPHA}; pg8::gemm_phase(tid, ldsp, pg8::Gemm{1024, 1024, 1024}, S, E); }
    PHASE_END
    PHASE_BEGIN
    {   struct SchedS { const char *z, *mt; int G, c;
            __device__ __forceinline__ bool next(int i, pg8::Unit& u) const { const int L = i * G + c; if (L >= 256) return false; pg8::tile_of(L, 64, 4, u.pm, u.pn); u.kind = 0; u.aux = u.pm >> 5;
                u.A = z + (size_t)u.pm * 256 * 2048; u.B = mt + ((size_t)u.aux * 1024 * 1024 + (size_t)u.pn * 256 * 1024) * 2; return true; } };
        const SchedS S{(const char*)x1b, (const char*)MT, G, bid};
        const pg8::EpiSoftmaxLn E{Pb2, (PG8_LAS float*)(ldsp + 131072), stats1, csS, bwS};
        pg8::gemm_phase(tid, ldsp, pg8::Gemm{1024, 1024, 1024}, S, E);
    }
    PHASE_END
    PHASE_BEGIN
    {   struct SchedN { const char *P, *nt; int G, c;
            __device__ __forceinline__ bool next(int i, pg8::Unit& u) const { const int L = i * G + c; if (L >= 256) return false; pg8::tile_of(L, 64, 4, u.pm, u.pn); u.kind = 0; u.aux = u.pm >> 5;
                u.A = P + (size_t)u.pm * 256 * 2048; u.B = nt + ((size_t)u.aux * 1024 * 1024 + (size_t)u.pn * 256 * 1024) * 2; return true; } };
        const SchedN S{(const char*)Pb2, (const char*)NT, G, bid};
        const pg8::EpiResLn E{out, x1b, stats1, g_ln1, b_ln1, ALPHA}; pg8::gemm_phase(tid, ldsp, pg8::Gemm{1024, 1024, 1024}, S, E);
    }
    PHASE_END
    const int TPB = (T + G - 1) / G;
    PHASE_BEGIN
    { const int t0 = bid * TPB, t1 = (t0 + TPB < T) ? t0 + TPB : T;
      float* Wl = ldsf;
      int* le = (int*)(lds_raw + 81920);
      for (int k = tid; k < D; k += 512) { const f32x4 wg = *(const f32x4*)(w_group + (size_t)k * 4);
          Wl[0 * D + k] = wg.x; Wl[1 * D + k] = wg.y; Wl[2 * D + k] = wg.z; Wl[3 * D + k] = wg.w;
#pragma unroll
          for (int gq = 0; gq < 4; ++gq) { const f32x4 wr = *(const f32x4*)(w_router + ((size_t)gq * D + k) * 4);
              Wl[(4 + gq * 4 + 0) * D + k] = wr.x; Wl[(4 + gq * 4 + 1) * D + k] = wr.y; Wl[(4 + gq * 4 + 2) * D + k] = wr.z; Wl[(4 + gq * 4 + 3) * D + k] = wr.w; } }
      __syncthreads();
      const int TPW = (TPB + 7) / 8;
      for (int mb = t0 + wave * TPW; mb < t0 + (wave + 1) * TPW && mb < t1; mb += 2) {
        f32x4 v[2][4];
        const bool has1 = (mb + 1 < t1) && (mb + 1 < t0 + (wave + 1) * TPW);
        ln_row(out + (size_t)mb * D, g_ln2, b_ln2, v[0], lane);
        st_row_bf16(x2b + (size_t)mb * D, v[0], lane);
        __builtin_amdgcn_sched_barrier(0);
        ln_row(out + (size_t)(has1 ? mb + 1 : mb) * D, g_ln2, b_ln2, v[1], lane);
        if (has1) st_row_bf16(x2b + (size_t)(mb + 1) * D, v[1], lane);
        __builtin_amdgcn_sched_barrier(0);
        float my[20];
#pragma unroll
        for (int c = 0; c < 20; ++c) {
            float a0 = 0.f, a1 = 0.f;
#pragma unroll
            for (int jj = 0; jj < 4; ++jj) { const f32x4 w4 = ((const f32x4*)(Wl + c * D))[lane + 64 * jj];
                a0 += (v[0][jj].x * w4.x + v[0][jj].y * w4.y) + (v[0][jj].z * w4.z + v[0][jj].w * w4.w);
                a1 += (v[1][jj].x * w4.x + v[1][jj].y * w4.y) + (v[1][jj].z * w4.z + v[1][jj].w * w4.w); }
            a0 = wave_sum(a0); a1 = wave_sum(a1);
            my[c] = (lane == 1) ? a1 : a0;
        }
        const int m = mb + lane;
        if (lane < 2 && m < t1 && m < t0 + (wave + 1) * TPW) {
            float gl[4]; int gi = 0; float gmx = -INFINITY;
#pragma unroll
            for (int i = 0; i < 4; ++i) { gl[i] = my[i] + b_group[i]; if (gl[i] > gmx) { gmx = gl[i]; gi = i; } }
            float gs = 0.f;
#pragma unroll
            for (int i = 0; i < 4; ++i) gs += __expf(gl[i] - gmx);
            const float gp = 1.f / gs;
            float el[4];
#pragma unroll
            for (int i = 0; i < 4; ++i) { float a = my[4 + i], bq = b_router[i];
                a = (gi == 1) ? my[8 + i] : a; a = (gi == 2) ? my[12 + i] : a; a = (gi == 3) ? my[16 + i] : a;
                bq = (gi == 1) ? b_router[4 + i] : bq; bq = (gi == 2) ? b_router[8 + i] : bq; bq = (gi == 3) ? b_router[12 + i] : bq;
                el[i] = a + bq; }
            int i0 = 0; float v0 = el[0];
#pragma unroll
            for (int i = 1; i < 4; ++i) if (el[i] > v0) { v0 = el[i]; i0 = i; }
            int i1 = -1; float v1 = -INFINITY;
#pragma unroll
            for (int i = 0; i < 4; ++i) if (i != i0 && el[i] > v1) { v1 = el[i]; i1 = i; }
            const float w0 = 1.f / (1.f + __expf(v1 - v0)), w1 = 1.f - w0;
            route_e[2 * m] = gi * 4 + i0; route_e[2 * m + 1] = gi * 4 + i1; route_g[2 * m] = gp * w0; route_g[2 * m + 1] = gp * w1;
            le[2 * (m - t0)] = gi * 4 + i0; le[2 * (m - t0) + 1] = gi * 4 + i1;
        }
      }
      __syncthreads();
      const int np = 2 * (t1 - t0);
      for (int i = tid; i < np; i += 512) { const int e = le[i]; int r = 0; for (int j2 = 0; j2 < i; ++j2) r += (le[j2] == e) ? 1 : 0; rank[2 * t0 + i] = r; }
      if (tid < 16) { int c = 0; for (int j2 = 0; j2 < np; ++j2) c += (le[j2] == tid) ? 1 : 0; blkcnt[bid * 16 + tid] = c; }
    }
    PHASE_END
    PHASE_BEGIN
    {
        int* sh = (int*)lds_raw;
        { const int e = tid & 15, part = tid >> 4; int tot = 0, base = 0;
          for (int b = part; b < G; b += 32) { const int c = blkcnt[b * 16 + e]; tot += c; if (b < bid) base += c; }
          sh[128 + part * 16 + e] = tot; sh[640 + part * 16 + e] = base; }
        __syncthreads();
        if (tid < 16) { int tot = 0, base = 0;
#pragma unroll 8
            for (int part = 0; part < 32; ++part) { tot += sh[128 + part * 16 + tid]; base += sh[640 + part * 16 + tid]; } sh[tid] = base; sh[64 + tid] = tot; }
        __syncthreads();
        if (tid == 0) { int sacc = 0; for (int e = 0; e < 16; ++e) { sh[16 + e] = sacc; sacc += (sh[64 + e] + 255) & ~255; } sh[32] = sacc; if (bid == 0) for (int e = 0; e <= 16; ++e) segw[e] = sh[16 + e]; }
        __syncthreads();
        if (bid == 0) { for (int e = 0; e < 16; ++e) for (int pos = sh[16 + e] + sh[64 + e] + tid; pos < sh[16 + e + 1]; pos += 512) { pair_tok[pos] = -1; pair_gate[pos] = 0.f; } }
        const int t0 = bid * TPB, t1 = (t0 + TPB < T) ? t0 + TPB : T, np = 2 * (t1 - t0);
        for (int i = tid; i < np; i += 512) { const int pi = 2 * t0 + i, e = route_e[pi], pos = sh[16 + e] + sh[e] + rank[pi]; pair_tok[pos] = pi >> 1; pair_gate[pos] = route_g[pi]; tokpos[pi] = pos; }
    }
    PHASE_END
    PHASE_BEGIN
    { const SchedMoE S{(const char*)x2b, (const char*)Wt_gu, segw, pair_tok, segw[16] / 256, 4, G, bid, (size_t)256 * 2048, (size_t)1024 * 2048, (size_t)256 * 2048};
      const pg8::EpiGateUp E{Hs, pair_gate}; pg8::gemm_phase<true>(tid, ldsp, pg8::Gemm{1024, 1024, 1024}, S, E); }
    PHASE_END
    PHASE_BEGIN
    { const SchedMoE S{(const char*)Hs, (const char*)Wt_dn, segw, nullptr, segw[16] / 256, 4, G, bid, (size_t)256 * 1024, (size_t)1024 * 1024, (size_t)256 * 1024};
      const pg8::EpiBf16 E{Yb, 1024, nullptr}; pg8::gemm_phase(tid, ldsp, pg8::Gemm{512, 512, 512}, S, E); }
    PHASE_END
    PHASE_BEGIN
    for (int m = gw; m < T; m += NGW) { float* row = out + (size_t)m * D; const int p0 = tokpos[2 * m], p1 = tokpos[2 * m + 1];
        const u32x2* y0 = (const u32x2*)(Yb + (size_t)p0 * D); const u32x2* y1 = (const u32x2*)(Yb + (size_t)p1 * D);
        f32x4 v[4]; float sacc = 0.f;
        ln_row(row, g_ln2, b_ln2, v, lane);
#pragma unroll
        for (int jj = 0; jj < 4; ++jj) { const u32x2 a = y0[lane + 64 * jj], b = y1[lane + 64 * jj]; f32x4 z = v[jj] * ALPHA;
            z.x += bflo(a.x) + bflo(b.x); z.y += bfhi(a.x) + bfhi(b.x); z.z += bflo(a.y) + bflo(b.y); z.w += bfhi(a.y) + bfhi(b.y); v[jj] = z; sacc += (z.x + z.y) + (z.z + z.w); }
        const float mean = wave_sum(sacc) * (1.f / D); float s2 = 0.f;
#pragma unroll
        for (int jj = 0; jj < 4; ++jj) { v[jj] = v[jj] - mean; s2 += (v[jj].x * v[jj].x + v[jj].y * v[jj].y) + (v[jj].z * v[jj].z + v[jj].w * v[jj].w); }
        const float rstd = 1.f / sqrtf(wave_sum(s2) * (1.f / D) + LN_EPS);
#pragma unroll
        for (int jj = 0; jj < 4; ++jj) { const f32x4 gg = ((const f32x4*)g_ln3)[lane + 64 * jj], bb = ((const f32x4*)b_ln3)[lane + 64 * jj]; ((f32x4*)row)[lane + 64 * jj] = v[jj] * rstd * gg + bb; } }
    PHASE_END
}

constexpr int N_PHASES = 16;
constexpr int LDS_BYTES = 147456;

extern "C" void kernel_launch(void* const* d_in, const int* in_sizes, int n_in, void* d_out, int out_size, void* d_ws, size_t ws_size, hipStream_t stream) {
    static int grid = 0;
    if (grid == 0) {
        int dev = 0, cus = 0, per_cu = 0;
        hipGetDevice(&dev);
        hipDeviceGetAttribute(&cus, hipDeviceAttributeMultiprocessorCount, dev);
        hipFuncSetAttribute((const void*)fwd_kernel, hipFuncAttributeMaxDynamicSharedMemorySize, LDS_BYTES);
        hipOccupancyMaxActiveBlocksPerMultiprocessor(&per_cu, (const void*)fwd_kernel, 512, LDS_BYTES);
        if (per_cu < 1) { fprintf(stderr, "occupancy query returned %d\n", per_cu); per_cu = 1; }
        grid = cus * 1;
        if (ws_size < WS_END) { fprintf(stderr, "workspace too small\n"); grid = -1; }
    }
    if (grid < 0) return;
    if (hipMemsetAsync((char*)d_ws + WS_CTL, 0, 65536, stream) != hipSuccess) { fprintf(stderr, "memset failed\n"); return; }
    Params p{};
    for (int i = 0; i < 26; ++i) p.in[i] = (const float*)d_in[i];
    p.out = (float*)d_out; p.ws = (unsigned char*)d_ws;
#if MK_N_LAUNCHES == 1
    p.ph_lo = 0; p.ph_hi = 64;
    void* args[] = {&p};
    hipError_t e = hipLaunchCooperativeKernel((const void*)fwd_kernel, dim3(grid), dim3(512), args, LDS_BYTES, stream);
    if (e != hipSuccess) fprintf(stderr, "cooperative launch failed: %s (grid %d)\n", hipGetErrorString(e), grid);
#else
    for (int ph = 0; ph < N_PHASES; ++ph) { p.ph_lo = ph; p.ph_hi = ph + 1; hipLaunchKernelGGL(fwd_kernel, dim3(grid), dim3(512), LDS_BYTES, stream, p); }
#endif
}
```

```cpp
#include <hip/hip_runtime.h>
#include <hip/hip_cooperative_groups.h>
#include <cstdio>
#include <cstdint>
namespace cg = cooperative_groups;

#ifndef PROBE_MASK
#define PROBE_MASK 0
#endif
#ifndef PROBE_T
#define PROBE_T -1
#endif
#ifndef MK_N_LAUNCHES
#define MK_N_LAUNCHES 1
#endif

typedef unsigned short bf16;
typedef float f32x4 __attribute__((ext_vector_type(4)));
typedef unsigned u32x4 __attribute__((ext_vector_type(4)));
typedef unsigned u32x2 __attribute__((ext_vector_type(2)));

constexpr int BATCH = 2, SEQ = 8192, D = 1024, T = BATCH * SEQ, MEM = 256, NMEM = BATCH * MEM;
constexpr int CONV_CH = 512, CONV_W = 31, NH = 8, NKV = 2, HD = 64, ATTN_W = 512, KV_W = 128, WINDOW = 128;
constexpr int D_IN = 1792, MH = 4, MHD = 256, NG = 4, EPG = 4, NE = 16, DE = 512;
constexpr float ALPHA = 1.189207115002721f, LN_EPS = 1e-5f;
constexpr int NPAIR = 2 * T, NPAIR_PAD = NPAIR + NE * 256;
constexpr int LDS_BYTES_K = 147456;

constexpr size_t MiB = 1u << 20;
constexpr size_t WS_CTL = 0;
constexpr size_t WS_ROUTE = 1 * MiB;
constexpr size_t WS_BLKCNT = 1 * MiB + 512 * 1024;
constexpr size_t WS_SEG = 1 * MiB + 640 * 1024;
constexpr size_t WS_RANK = 2 * MiB;
constexpr size_t WS_PTOK = 2 * MiB + 256 * 1024;
constexpr size_t WS_PGATE = 2 * MiB + 512 * 1024;
constexpr size_t WS_TOKPOS = 2 * MiB + 768 * 1024;
constexpr size_t WS_KVM = 3 * MiB;
constexpr size_t WS_MEMB = 5 * MiB;
constexpr size_t WS_A = 8 * MiB;
constexpr size_t WS_B = 48 * MiB;
constexpr size_t WS_DD = 88 * MiB;
constexpr size_t WS_WIN = 164 * MiB;
constexpr size_t WS_WOUT = 168 * MiB, WS_WMQ = 170 * MiB, WS_WMKV = 172 * MiB, WS_WMO = 176 * MiB;
constexpr size_t WS_WGU = 178 * MiB;
constexpr size_t WS_WDN = 210 * MiB;
constexpr size_t WS_ST1 = 226 * MiB;
constexpr size_t WS_CS1 = 128 * 1024;
constexpr size_t WS_MT = 228 * MiB;
constexpr size_t WS_NT = 232 * MiB;
constexpr size_t WS_CSS = 192 * 1024;
constexpr size_t WS_CSP = 256 * 1024;
constexpr size_t WS_END = 236 * MiB;

struct Params { const float* in[26]; float* out; unsigned char* ws; int ph_lo, ph_hi; };

__device__ __forceinline__ unsigned f2bf(float f) { unsigned u = __builtin_bit_cast(unsigned, f); return (u + 0x7fffu + ((u >> 16) & 1u)) >> 16; }
__device__ __forceinline__ float bf2f(bf16 b) { return __builtin_bit_cast(float, (unsigned)b << 16); }
__device__ __forceinline__ unsigned pk2(float lo, float hi) { return f2bf(lo) | (f2bf(hi) << 16); }
template <int CTRL, int ROWMASK> __device__ __forceinline__ float dpp_f(float v) { return __builtin_bit_cast(float, __builtin_amdgcn_update_dpp(0, __builtin_bit_cast(int, v), CTRL, ROWMASK, 0xF, false)); }
__device__ __forceinline__ float wave_sum(float v) {
    v += dpp_f<0xB1, 0xF>(v);
    v += dpp_f<0x4E, 0xF>(v);
    v += dpp_f<0x141, 0xF>(v);
    v += dpp_f<0x140, 0xF>(v);
    v += dpp_f<0x142, 0xA>(v);
    v += dpp_f<0x143, 0xC>(v);
    return __builtin_bit_cast(float, __builtin_amdgcn_readlane(__builtin_bit_cast(int, v), 63));
}
__device__ __forceinline__ float wave_max(float v) {
    v = fmaxf(v, __builtin_bit_cast(float, __builtin_amdgcn_update_dpp(__builtin_bit_cast(int, v), __builtin_bit_cast(int, v), 0xB1, 0xF, 0xF, false)));
    v = fmaxf(v, __builtin_bit_cast(float, __builtin_amdgcn_update_dpp(__builtin_bit_cast(int, v), __builtin_bit_cast(int, v), 0x4E, 0xF, 0xF, false)));
    v = fmaxf(v, __builtin_bit_cast(float, __builtin_amdgcn_update_dpp(__builtin_bit_cast(int, v), __builtin_bit_cast(int, v), 0x141, 0xF, 0xF, false)));
    v = fmaxf(v, __builtin_bit_cast(float, __builtin_amdgcn_update_dpp(__builtin_bit_cast(int, v), __builtin_bit_cast(int, v), 0x140, 0xF, 0xF, false)));
    v = fmaxf(v, __builtin_bit_cast(float, __builtin_amdgcn_update_dpp(__builtin_bit_cast(int, v), __builtin_bit_cast(int, v), 0x142, 0xA, 0xF, false)));
    v = fmaxf(v, __builtin_bit_cast(float, __builtin_amdgcn_update_dpp(__builtin_bit_cast(int, v), __builtin_bit_cast(int, v), 0x143, 0xC, 0xF, false)));
    return __builtin_bit_cast(float, __builtin_amdgcn_readlane(__builtin_bit_cast(int, v), 63));
}
__device__ __forceinline__ int lane_fresh() { int l; asm volatile("v_mbcnt_lo_u32_b32 %0, -1, 0\n\tv_mbcnt_hi_u32_b32 %0, -1, %0" : "=v"(l)); return l; }
__device__ __forceinline__ float ldA(const bf16* p) { return bf2f(*p); }
__device__ __forceinline__ float ldA(const float* p) { return *p; }

template <int NB, class FA, class FB, class FE>
__device__ __forceinline__ void ngemm_tile(int tid, float* lds, int K, int m0, int n0, FA fa, FB fb, FE fe) {
    float* As = lds;
    float* Bs = lds + 16 * 132;
    const int ty = tid >> 4, tx = tid & 15;
    float acc[NB][4][4];
#pragma unroll
    for (int b = 0; b < NB; ++b)
#pragma unroll
        for (int i = 0; i < 4; ++i)
#pragma unroll
            for (int j = 0; j < 4; ++j) acc[b][i][j] = 0.f;
    for (int k0 = 0; k0 < K; k0 += 16) {
        { const int r = tid >> 2, kk = (tid & 3) * 4;
#pragma unroll
            for (int i = 0; i < 4; ++i) As[(kk + i) * 132 + r] = fa(m0 + r, k0 + kk + i); }
#pragma unroll
        for (int b = 0; b < NB; ++b) { const int kk = tid >> 5, nn = (tid & 31) * 2;
            Bs[(b * 16 + kk) * 68 + nn] = fb(b, k0 + kk, n0 + nn); Bs[(b * 16 + kk) * 68 + nn + 1] = fb(b, k0 + kk, n0 + nn + 1); }
        __syncthreads();
#pragma unroll 4
        for (int k = 0; k < 16; ++k) {
            const f32x4 a = *(const f32x4*)&As[k * 132 + ty * 4];
#pragma unroll
            for (int b = 0; b < NB; ++b) { const f32x4 bb = *(const f32x4*)&Bs[(b * 16 + k) * 68 + tx * 4];
#pragma unroll
                for (int i = 0; i < 4; ++i)
#pragma unroll
                    for (int j = 0; j < 4; ++j) acc[b][i][j] += a[i] * bb[j]; }
        }
        __syncthreads();
    }
#pragma unroll
    for (int i = 0; i < 4; ++i)
#pragma unroll
        for (int j = 0; j < 4; ++j) fe(m0 + ty * 4 + i, n0 + tx * 4 + j, acc[0][i][j], acc[NB - 1][i][j]);
}

__device__ __forceinline__ void ln_row(const float* src, const float* g, const float* b, f32x4 (&v)[4], int lane) {
    const f32x4* xr = (const f32x4*)src + lane; float s = 0.f;
#pragma unroll
    for (int j = 0; j < 4; ++j) { v[j] = xr[64 * j]; s += (v[j].x + v[j].y) + (v[j].z + v[j].w); }
    const float mean = wave_sum(s) * (1.f / D); float s2 = 0.f;
#pragma unroll
    for (int j = 0; j < 4; ++j) { v[j] = v[j] - mean; s2 += (v[j].x * v[j].x + v[j].y * v[j].y) + (v[j].z * v[j].z + v[j].w * v[j].w); }
    const float rstd = 1.f / sqrtf(wave_sum(s2) * (1.f / D) + LN_EPS);
#pragma unroll
    for (int j = 0; j < 4; ++j) { const f32x4 gg = ((const f32x4*)g)[lane + 64 * j], bb = ((const f32x4*)b)[lane + 64 * j]; v[j] = v[j] * rstd * gg + bb; }
}
__device__ __forceinline__ void ld_row(const float* src, f32x4 (&v)[4], int lane) {
#pragma unroll
    for (int j = 0; j < 4; ++j) v[j] = ((const f32x4*)src)[lane + 64 * j];
}
__device__ __forceinline__ void ln_regs(f32x4 (&v)[4], const float* g, const float* b, int lane) {
    float s = 0.f;
#pragma unroll
    for (int j = 0; j < 4; ++j) s += (v[j].x + v[j].y) + (v[j].z + v[j].w);
    const float mean = wave_sum(s) * (1.f / D); float s2 = 0.f;
#pragma unroll
    for (int j = 0; j < 4; ++j) { v[j] = v[j] - mean; s2 += (v[j].x * v[j].x + v[j].y * v[j].y) + (v[j].z * v[j].z + v[j].w * v[j].w); }
    const float rstd = 1.f / sqrtf(wave_sum(s2) * (1.f / D) + LN_EPS);
#pragma unroll
    for (int j = 0; j < 4; ++j) { const f32x4 gg = ((const f32x4*)g)[lane + 64 * j], bb = ((const f32x4*)b)[lane + 64 * j]; v[j] = v[j] * rstd * gg + bb; }
}
__device__ __forceinline__ void st_row_f32(float* dst, const f32x4 (&v)[4], float scale, int lane) {
#pragma unroll
    for (int j = 0; j < 4; ++j) ((f32x4*)dst)[lane + 64 * j] = v[j] * scale;
}
__device__ __forceinline__ void st_row_bf16(bf16* dst, const f32x4 (&v)[4], int lane) {
#pragma unroll
    for (int j = 0; j < 4; ++j) { u32x2 w; w.x = pk2(v[j].x, v[j].y); w.y = pk2(v[j].z, v[j].w); ((u32x2*)dst)[lane + 64 * j] = w; }
}


namespace pg8 {
#define PG8_LAS __attribute__((address_space(3)))
typedef unsigned short bf16_t;
typedef short bf16x8 __attribute__((ext_vector_type(8)));
constexpr int BM = 256, BK = 64, HALF = 128, HTB = HALF * BK * 2, STAGE_BYTES = 8 * HTB, NXCD = 8, WGM = 8;
__device__ __forceinline__ int lds_byte(int r, int c) { const int st = (r >> 4) * 2 + (c >> 5), rr = r & 15, cc = c & 31, ob = rr * 64 + cc * 2; return st * 1024 + (ob ^ (((ob >> 9) & 1) << 5)); }
__device__ __forceinline__ void stage_rc(int b, int& R, int& C) { const int st = b / 1024, sb = b % 1024, swz = sb ^ (((sb >> 9) & 1) << 5); R = (st >> 1) * 16 + swz / 64; C = (st & 1) * 32 + (swz % 64) / 2; }
__device__ __forceinline__ int perm32(int rho) { const int n = rho >> 4, i = rho & 15; return 8 * (i >> 2) + 4 * n + (i & 3); }
struct Unit { const char* A; const char* B; const int* rows; int pm, pn, kind, aux, rb, half; };
struct Gemm { int lda, ldb, K; };
__device__ __forceinline__ void tile_of(int L, int nM, int nN, int& pm, int& pn) {
    const int nwg = nM * nN; int wgid = L; { const int q = nwg / NXCD, r = nwg % NXCD, xcd = wgid % NXCD, off = wgid / NXCD; wgid = (xcd < r ? xcd * (q + 1) : r * (q + 1) + (xcd - r) * q) + off; }
    const int nig = WGM * nN, gid = wgid / nig, fm = gid * WGM, gsz = (nM - fm) < WGM ? (nM - fm) : WGM;
    pm = fm + ((wgid % nig) % gsz); pn = (wgid % nig) / gsz;
}
__device__ __forceinline__ unsigned cvt_pk_bf16(float lo, float hi) { unsigned r; asm volatile("v_cvt_pk_bf16_f32 %0, %1, %2" : "=v"(r) : "v"(lo), "v"(hi)); return r; }

template <bool GATHER = false, bool HALFU = false, class Epi, class Sched>
__device__ __forceinline__ void gemm_phase(int tid, PG8_LAS unsigned char* lds, const Gemm g, const Sched& S, const Epi& E) {
    const int wid = __builtin_amdgcn_readfirstlane(tid >> 6), lane = tid & 63, wr = wid >> 2, wc = wid & 3, fr = lane & 15, fq = lane >> 4;
    const int K = g.K, nt = K / BK;
    unsigned voffA[2], voffB[2]; int gR[2]; unsigned gC[2];
#pragma unroll
    for (int i = 0; i < 2; ++i) { int R, C; stage_rc(tid * 16 + i * 8192, R, C); const int Rb = Epi::PERM ? ((R & ~31) + perm32(R & 31)) : R;
        voffA[i] = (unsigned)(R * g.lda + C) * 2u; voffB[i] = (unsigned)(Rb * g.ldb + C) * 2u; gR[i] = R; gC[i] = (unsigned)C * 2u; }
    unsigned vgc[2][2], vgn[2][2];
    const size_t kstep = (size_t)(BK * 2);
    const size_t hstepA = (size_t)HALF * g.lda * 2, hstepB = (size_t)HALF * g.ldb * 2;
    const unsigned ldsw = (unsigned)wid * 1024u;
    const int aoff = lds_byte(wr * 64 + fr, fq * 8), boff = lds_byte(wc * 32 + fr, fq * 8);
#define PG8_SA(b, h) (((b) * 2 + (h)) * HTB)
#define PG8_SB(b, h) ((4 + (b) * 2 + (h)) * HTB)
#define PG8_STAGE(bufoff, gbase, voff) do { _Pragma("unroll") for (int _i = 0; _i < 2; ++_i) \
        __builtin_amdgcn_global_load_lds((const unsigned*)((const char*)(gbase) + (voff)[_i]), (PG8_LAS unsigned*)(lds + (bufoff) + ldsw + _i * 8192), 16, 0, 0); } while (0)
#define PG8_GOFF(dst, rows) do { _Pragma("unroll") for (int _h = 0; _h < 2; ++_h) _Pragma("unroll") for (int _i = 0; _i < 2; ++_i) { int _t = (rows)[_h * HALF + gR[_i]]; _t = _t < 0 ? 0 : _t; dst[_h][_i] = (unsigned)_t * (unsigned)(g.lda * 2) + gC[_i]; } } while (0)
#define PG8_STAGE_A(bufoff, h, kptr, useNext) do { if constexpr (GATHER) { unsigned _v[2]; _v[0] = (useNext) ? vgn[h][0] : vgc[h][0]; _v[1] = (useNext) ? vgn[h][1] : vgc[h][1]; PG8_STAGE(bufoff, kptr, _v); } \
        else { PG8_STAGE(bufoff, (kptr) + (h) * hstepA, voffA); } } while (0)
#define PG8_LDA(dst, b, h) do { _Pragma("unroll") for (int m = 0; m < 4; ++m) _Pragma("unroll") for (int k = 0; k < 2; ++k) dst[m][k] = *(const PG8_LAS bf16x8*)(lds + PG8_SA(b, h) + aoff + m * 2048 + k * 1024); } while (0)
#define PG8_LDB(dst, b, h) do { _Pragma("unroll") for (int n = 0; n < 2; ++n) _Pragma("unroll") for (int k = 0; k < 2; ++k) dst[n][k] = *(const PG8_LAS bf16x8*)(lds + PG8_SB(b, h) + boff + n * 2048 + k * 1024); } while (0)
#define PG8_MMA(ai, bj, At, Bt) do { __builtin_amdgcn_s_setprio(1); _Pragma("unroll") for (int m = 0; m < 4; ++m) _Pragma("unroll") for (int n = 0; n < 2; ++n) _Pragma("unroll") for (int k = 0; k < 2; ++k) \
        acc[ai][bj][m][n] = __builtin_amdgcn_mfma_f32_16x16x32_bf16(Bt[n][k], At[m][k], acc[ai][bj][m][n], 0, 0, 0); __builtin_amdgcn_s_setprio(0); } while (0)
#define PG8_WAIT_V(n) asm volatile("s_waitcnt vmcnt(" #n ")" ::: "memory")
#define PG8_WAIT_L(n) asm volatile("s_waitcnt lgkmcnt(" #n ")" ::: "memory")
#define PG8_BAR __builtin_amdgcn_s_barrier()
#define PG8_SCHED __builtin_amdgcn_sched_barrier(0)
    Unit cur, nxt; int ui = 0;
    if (!S.next(0, cur)) return;
    f32x4 acc[2][2][4][2];
#pragma unroll
    for (int a = 0; a < 2; ++a)
#pragma unroll
        for (int b = 0; b < 2; ++b)
#pragma unroll
            for (int m = 0; m < 4; ++m)
#pragma unroll
                for (int n = 0; n < 2; ++n) acc[a][b][m][n] = (f32x4){0.f, 0.f, 0.f, 0.f};
    bf16x8 At[4][2], B0[2][2], B1[2][2];
    const char* cA = cur.A; const char* cB = cur.B;
    if constexpr (GATHER) { PG8_GOFF(vgc, cur.rows); }
    PG8_STAGE(PG8_SB(0, 0), cB, voffB); PG8_STAGE(PG8_SB(0, 1), cB + hstepB, voffB); PG8_STAGE_A(PG8_SA(0, 0), 0, cA, false); PG8_STAGE_A(PG8_SA(0, 1), 1, cA, false);
    if (wr == 1) PG8_BAR;
    PG8_WAIT_V(2); PG8_BAR;
    PG8_STAGE(PG8_SB(1, 0), cB + kstep, voffB); PG8_STAGE_A(PG8_SA(1, 0), 0, cA + kstep, false); PG8_STAGE(PG8_SB(1, 1), cB + hstepB + kstep, voffB);
    PG8_WAIT_V(6); PG8_BAR;
    for (;;) {
        const bool has_next = S.next(ui + 1, nxt);
        const char* nA = has_next ? nxt.A : cA; const char* nB = has_next ? nxt.B : cB;
        if constexpr (GATHER) { if (has_next) { PG8_GOFF(vgn, nxt.rows); asm volatile("" : "+v"(vgn[0][0]), "+v"(vgn[0][1]), "+v"(vgn[1][0]), "+v"(vgn[1][1]));   } else { _Pragma("unroll") for (int _h = 0; _h < 2; ++_h) { vgn[_h][0] = vgc[_h][0]; vgn[_h][1] = vgc[_h][1]; } } }
        for (int t = 0; t < nt; t += 2) {
            const bool last = (t == nt - 2);
            const char* a1 = cA + (size_t)(t + 1) * kstep;
            const char* a2 = last ? nA : cA + (size_t)(t + 2) * kstep; const char* b2 = last ? nB : cB + (size_t)(t + 2) * kstep;
            const char* a3 = a2 + kstep; const char* b3 = b2 + kstep;
            PG8_LDB(B0, 0, 0); PG8_LDB(B1, 0, 1); PG8_SCHED; PG8_LDA(At, 0, 0); PG8_STAGE_A(PG8_SA(1, 1), 1, a1, false);
            PG8_WAIT_V(8); PG8_WAIT_L(0); PG8_BAR; PG8_MMA(0, 0, At, B0); PG8_MMA(0, 1, At, B1); PG8_BAR; PG8_SCHED;
            PG8_LDA(At, 0, 1); PG8_STAGE(PG8_SB(0, 0), b2, voffB); PG8_STAGE(PG8_SB(0, 1), b2 + hstepB, voffB); PG8_STAGE_A(PG8_SA(0, 0), 0, a2, last);
            PG8_WAIT_V(8); PG8_WAIT_L(0); PG8_BAR; if (!HALFU || !cur.half) { PG8_MMA(1, 0, At, B0); PG8_MMA(1, 1, At, B1); } PG8_BAR; PG8_SCHED;
            PG8_LDB(B0, 1, 0); PG8_LDB(B1, 1, 1); PG8_SCHED; PG8_LDA(At, 1, 0); PG8_STAGE_A(PG8_SA(0, 1), 1, a2, last);
            PG8_WAIT_V(8); PG8_WAIT_L(0); PG8_BAR; PG8_MMA(0, 0, At, B0); PG8_MMA(0, 1, At, B1); PG8_BAR; PG8_SCHED;
            PG8_LDA(At, 1, 1); PG8_STAGE(PG8_SB(1, 0), b3, voffB); PG8_STAGE(PG8_SB(1, 1), b3 + hstepB, voffB); PG8_STAGE_A(PG8_SA(1, 0), 0, a3, last);
            PG8_WAIT_V(8); PG8_WAIT_L(0); PG8_BAR; if (!HALFU || !cur.half) { PG8_MMA(1, 0, At, B0); PG8_MMA(1, 1, At, B1); } PG8_BAR; PG8_SCHED;
        }
        if (wr == 0) PG8_BAR;
        E(acc, cur, wr, wc, fr, fq);
        if (!has_next) break;
#pragma unroll
        for (int a = 0; a < 2; ++a)
#pragma unroll
            for (int b = 0; b < 2; ++b)
#pragma unroll
                for (int m = 0; m < 4; ++m)
#pragma unroll
                    for (int n = 0; n < 2; ++n) acc[a][b][m][n] = (f32x4){0.f, 0.f, 0.f, 0.f};
        cur = nxt; cA = nA; cB = nB; ++ui;
        if constexpr (GATHER) { _Pragma("unroll") for (int _h = 0; _h < 2; ++_h) { vgc[_h][0] = vgn[_h][0]; vgc[_h][1] = vgn[_h][1]; } }
        if (wr == 1) PG8_BAR;
    }
    PG8_WAIT_V(0);
    PG8_BAR;
#undef PG8_SA
#undef PG8_SB
#undef PG8_STAGE
#undef PG8_LDA
#undef PG8_GOFF
#undef PG8_STAGE_A
#undef PG8_LDB
#undef PG8_MMA
#undef PG8_WAIT_V
#undef PG8_WAIT_L
#undef PG8_BAR
#undef PG8_SCHED
}

__device__ __forceinline__ u32x4 pack8(const f32x4 v0, const f32x4 v1) { u32x4 w; w.x = cvt_pk_bf16(v0[0], v0[1]); w.y = cvt_pk_bf16(v0[2], v0[3]); w.z = cvt_pk_bf16(v1[0], v1[1]); w.w = cvt_pk_bf16(v1[2], v1[3]); return w; }
__device__ __forceinline__ float sigm(float g) { return __builtin_amdgcn_rcpf(1.f + __expf(-g)); }

struct EpiBf16 {
    static constexpr bool PERM = true;
    bf16_t* O; int ldc; const float* bias;
    __device__ __forceinline__ void operator()(const f32x4 (&acc)[2][2][4][2], const Unit& u, int wr, int wc, int fr, int fq) const {
        const int row0 = u.pm * BM + wr * 64 + fr, col0 = u.pn * BM + wc * 32 + 8 * fq;
        f32x4 bv[2][2];
#pragma unroll
        for (int bj = 0; bj < 2; ++bj)
#pragma unroll
            for (int n = 0; n < 2; ++n) bv[bj][n] = bias ? *(const f32x4*)(bias + col0 + bj * HALF + 4 * n) : (f32x4){0.f, 0.f, 0.f, 0.f};
#pragma unroll
        for (int ai = 0; ai < 2; ++ai)
#pragma unroll
            for (int m = 0; m < 4; ++m) { bf16_t* rowp = O + (size_t)(row0 + ai * HALF + m * 16) * ldc + col0;
#pragma unroll
                for (int bj = 0; bj < 2; ++bj) *(u32x4*)(rowp + bj * HALF) = pack8(acc[ai][bj][m][0] + bv[bj][0], acc[ai][bj][m][1] + bv[bj][1]); }
    }
};
struct EpiP1 {
    static constexpr bool PERM = true;
    bf16_t *hglu, *qkv, *kvm; const float* b_in;
    __device__ __forceinline__ void operator()(const f32x4 (&acc)[2][2][4][2], const Unit& u, int wr, int wc, int fr, int fq) const {
        if (u.kind == 0) {
            const int row0 = u.pm * BM + wr * 64 + fr, cb = u.pn * 128 + wc * 32 + 8 * fq;
            f32x4 ba[2], bg[2];
#pragma unroll
            for (int n = 0; n < 2; ++n) { ba[n] = *(const f32x4*)(b_in + cb + 4 * n); bg[n] = *(const f32x4*)(b_in + 512 + cb + 4 * n); }
#pragma unroll
            for (int ai = 0; ai < 2; ++ai)
#pragma unroll
                for (int m = 0; m < 4; ++m) { f32x4 h[2];
#pragma unroll
                    for (int n = 0; n < 2; ++n) { const f32x4 a = acc[ai][0][m][n] + ba[n], gt = acc[ai][1][m][n] + bg[n];
                        h[n] = (f32x4){a[0] * sigm(gt[0]), a[1] * sigm(gt[1]), a[2] * sigm(gt[2]), a[3] * sigm(gt[3])}; }
                    *(u32x4*)(hglu + (size_t)(row0 + ai * HALF + m * 16) * 512 + cb) = pack8(h[0], h[1]); }
        } else if (u.kind == 1) { EpiBf16 e{qkv - 1024, 768, b_in}; e(acc, u, wr, wc, fr, fq);
        } else { EpiBf16 e{kvm, 2048, nullptr}; e(acc, u, wr, wc, fr, fq); }
    }
};
struct EpiResF32 {
    static constexpr bool PERM = false;
    const float* res; float* out; float alpha;
    __device__ __forceinline__ void operator()(const f32x4 (&acc)[2][2][4][2], const Unit& u, int wr, int wc, int fr, int fq) const {
        const int row0 = u.pm * BM + wr * 64 + fr, col0 = u.pn * BM + wc * 32 + 4 * fq;
#pragma unroll
        for (int ai = 0; ai < 2; ++ai)
#pragma unroll
            for (int m = 0; m < 4; ++m) { const size_t off = (size_t)(row0 + ai * HALF + m * 16) * 1024 + col0;
#pragma unroll
                for (int bj = 0; bj < 2; ++bj)
#pragma unroll
                    for (int n = 0; n < 2; ++n) { const f32x4 r = *(const f32x4*)(res + off + bj * HALF + n * 16); *(f32x4*)(out + off + bj * HALF + n * 16) = r * alpha + acc[ai][bj][m][n]; } }
    }
};
struct EpiSoftmax {
    static constexpr bool PERM = true;
    bf16_t* P; PG8_LAS float* xl;
    __device__ __forceinline__ void operator()(const f32x4 (&acc)[2][2][4][2], const Unit& u, int wr, int wc, int fr, int fq) const {
        const float sc = 0.0625f * 1.4426950408889634f;
#pragma unroll
        for (int ai = 0; ai < 2; ++ai)
#pragma unroll
            for (int m = 0; m < 4; ++m) { float mx = -INFINITY;
#pragma unroll
                for (int bj = 0; bj < 2; ++bj)
#pragma unroll
                    for (int n = 0; n < 2; ++n) { const f32x4 v = acc[ai][bj][m][n]; mx = fmaxf(mx, fmaxf(fmaxf(v[0], v[1]), fmaxf(v[2], v[3]))); }
                mx = fmaxf(mx, __shfl_xor(mx, 16)); mx = fmaxf(mx, __shfl_xor(mx, 32));
                float s = 0.f;
#pragma unroll
                for (int bj = 0; bj < 2; ++bj)
#pragma unroll
                    for (int n = 0; n < 2; ++n) { const f32x4 v = acc[ai][bj][m][n]; s += (__builtin_amdgcn_exp2f((v[0] - mx) * sc) + __builtin_amdgcn_exp2f((v[1] - mx) * sc)) + (__builtin_amdgcn_exp2f((v[2] - mx) * sc) + __builtin_amdgcn_exp2f((v[3] - mx) * sc)); }
                s += __shfl_xor(s, 16); s += __shfl_xor(s, 32);
                if (fq == 0) { PG8_LAS float* q = xl + ((ai * HALF + wr * 64 + m * 16 + fr) * 4 + wc) * 2; q[0] = mx; q[1] = s; } }
        asm volatile("s_waitcnt lgkmcnt(0)" ::: "memory"); __builtin_amdgcn_s_barrier(); asm volatile("" ::: "memory");
        const int row0 = u.pm * BM + wr * 64 + fr, col0 = u.pn * BM + wc * 32 + 8 * fq;
#pragma unroll
        for (int ai = 0; ai < 2; ++ai)
#pragma unroll
            for (int m = 0; m < 4; ++m) { const PG8_LAS f32x4* q = (const PG8_LAS f32x4*)(xl + (ai * HALF + wr * 64 + m * 16 + fr) * 8); const f32x4 q0 = q[0], q1 = q[1];
                const float M = fmaxf(fmaxf(q0[0], q0[2]), fmaxf(q1[0], q1[2]));
                const float S = (q0[1] * __builtin_amdgcn_exp2f((q0[0] - M) * sc) + q0[3] * __builtin_amdgcn_exp2f((q0[2] - M) * sc)) + (q1[1] * __builtin_amdgcn_exp2f((q1[0] - M) * sc) + q1[3] * __builtin_amdgcn_exp2f((q1[2] - M) * sc));
                const float inv = 1.f / S; bf16_t* rowp = P + (size_t)(row0 + ai * HALF + m * 16) * 1024 + col0;
#pragma unroll
                for (int bj = 0; bj < 2; ++bj) { f32x4 p[2];
#pragma unroll
                    for (int n = 0; n < 2; ++n) { const f32x4 v = acc[ai][bj][m][n];
                        p[n] = (f32x4){__builtin_amdgcn_exp2f((v[0] - M) * sc) * inv, __builtin_amdgcn_exp2f((v[1] - M) * sc) * inv, __builtin_amdgcn_exp2f((v[2] - M) * sc) * inv, __builtin_amdgcn_exp2f((v[3] - M) * sc) * inv}; }
                    *(u32x4*)(rowp + bj * HALF) = pack8(p[0], p[1]); } }
        asm volatile("s_waitcnt lgkmcnt(0)" ::: "memory"); __builtin_amdgcn_s_barrier(); asm volatile("" ::: "memory");
    }
};
struct EpiGateUp {
    static constexpr bool PERM = true;
    bf16_t* Hs; const float* pair_gate;
    __device__ __forceinline__ void operator()(const f32x4 (&acc)[2][2][4][2], const Unit& u, int wr, int wc, int fr, int fq) const {
        const int row0 = u.rb + wr * 64 + fr, cb = u.pn * 128 + wc * 32 + 8 * fq;
        float pgv[2][4];
#pragma unroll
        for (int ai = 0; ai < 2; ++ai)
#pragma unroll
            for (int m = 0; m < 4; ++m) pgv[ai][m] = (ai == 0 || !u.half) ? pair_gate[row0 + ai * HALF + m * 16] : 0.f;
#pragma unroll
        for (int ai = 0; ai < 2; ++ai) { if (ai == 1 && u.half) break;
#pragma unroll
            for (int m = 0; m < 4; ++m) { const int row = row0 + ai * HALF + m * 16; const float pg = pgv[ai][m]; f32x4 h[2];
#pragma unroll
                for (int n = 0; n < 2; ++n) { const f32x4 gt = acc[ai][0][m][n], up = acc[ai][1][m][n];
                    h[n] = (f32x4){gt[0] * sigm(gt[0]) * up[0] * pg, gt[1] * sigm(gt[1]) * up[1] * pg, gt[2] * sigm(gt[2]) * up[2] * pg, gt[3] * sigm(gt[3]) * up[3] * pg}; }
                if (pg == 0.f) { h[0] = (f32x4){0.f, 0.f, 0.f, 0.f}; h[1] = h[0]; }
                *(u32x4*)(Hs + (size_t)row * 512 + cb) = pack8(h[0], h[1]); } }
    }
};
struct EpiY {
    static constexpr bool PERM = true;
    bf16_t* Y;
    __device__ __forceinline__ void operator()(const f32x4 (&acc)[2][2][4][2], const Unit& u, int wr, int wc, int fr, int fq) const {
        const int row0 = u.rb + wr * 64 + fr, col0 = u.pn * BM + wc * 32 + 8 * fq;
#pragma unroll
        for (int ai = 0; ai < 2; ++ai) { if (ai == 1 && u.half) break;
#pragma unroll
            for (int m = 0; m < 4; ++m) { bf16_t* rowp = Y + (size_t)(row0 + ai * HALF + m * 16) * 1024 + col0;
#pragma unroll
                for (int bj = 0; bj < 2; ++bj) *(u32x4*)(rowp + bj * HALF) = pack8(acc[ai][bj][m][0], acc[ai][bj][m][1]); } }
    }
};
struct EpiDown {
    static constexpr bool PERM = false;
    float* out; const int* pair_tok;
    __device__ __forceinline__ void operator()(const f32x4 (&acc)[2][2][4][2], const Unit& u, int wr, int wc, int fr, int fq) const {
        const int row0 = u.pm * BM + wr * 64 + fr, col0 = u.pn * BM + wc * 32 + 4 * fq;
#pragma unroll
        for (int ai = 0; ai < 2; ++ai)
#pragma unroll
            for (int m = 0; m < 4; ++m) { const int tok = pair_tok[row0 + ai * HALF + m * 16];
                if (tok >= 0) { float* rp = out + (size_t)tok * 1024 + col0;
#pragma unroll
                    for (int bj = 0; bj < 2; ++bj)
#pragma unroll
                        for (int n = 0; n < 2; ++n)
#pragma unroll
                            for (int i = 0; i < 4; ++i) unsafeAtomicAdd(rp + bj * HALF + n * 16 + i, acc[ai][bj][m][n][i]); } }
    }
};

__device__ __forceinline__ void row_stats16(const float* stats, int row, int fq, float& mu, float& rstd) {
    const f32x4* sp = (const f32x4*)(stats + (size_t)row * 32 + fq * 8); const f32x4 a = sp[0], b = sp[1];
    float s = (a[0] + a[2]) + (b[0] + b[2]), ss = (a[1] + a[3]) + (b[1] + b[3]);
    s += __shfl_xor(s, 16); s += __shfl_xor(s, 32); ss += __shfl_xor(ss, 16); ss += __shfl_xor(ss, 32);
    mu = s * (1.f / 1024.f); const float var = ss * (1.f / 1024.f) - mu * mu; rstd = 1.f / sqrtf(var + 1e-5f);
}
struct EpiResStats {
    static constexpr bool PERM = false;
    const float* res; float* out; bf16_t* zb; float* stats; float alpha;
    __device__ __forceinline__ void operator()(const f32x4 (&acc)[2][2][4][2], const Unit& u, int wr, int wc, int fr, int fq) const {
        const int row0 = u.pm * BM + wr * 64 + fr, col0 = u.pn * BM + wc * 32 + 4 * fq;
#pragma unroll
        for (int ai = 0; ai < 2; ++ai)
#pragma unroll
            for (int m = 0; m < 4; ++m) { const int row = row0 + ai * HALF + m * 16; const size_t off = (size_t)row * 1024 + col0; float sm = 0.f, ss = 0.f;
#pragma unroll
                for (int bj = 0; bj < 2; ++bj)
#pragma unroll
                    for (int n = 0; n < 2; ++n) { const f32x4 r = *(const f32x4*)(res + off + bj * HALF + n * 16); const f32x4 z = r * alpha + acc[ai][bj][m][n];
                        u32x2 w; w.x = cvt_pk_bf16(z[0], z[1]); w.y = cvt_pk_bf16(z[2], z[3]); *(u32x2*)(zb + off + bj * HALF + n * 16) = w;
                        sm += (z[0] + z[1]) + (z[2] + z[3]); ss += (z[0] * z[0] + z[1] * z[1]) + (z[2] * z[2] + z[3] * z[3]); }
                sm += __shfl_xor(sm, 16); sm += __shfl_xor(sm, 32); ss += __shfl_xor(ss, 16); ss += __shfl_xor(ss, 32);
                if (fq == 0) *(float2*)(stats + (size_t)row * 32 + (u.pn * 4 + wc) * 2) = make_float2(sm, ss); }
    }
};
struct EpiResLn {
    static constexpr bool PERM = false;
    float* out; const bf16_t* zb; const float* stats; const float* g; const float* b; float alpha;
    __device__ __forceinline__ void operator()(const f32x4 (&acc)[2][2][4][2], const Unit& u, int wr, int wc, int fr, int fq) const {
        const int row0 = u.pm * BM + wr * 64 + fr, col0 = u.pn * BM + wc * 32 + 4 * fq;
        f32x4 gv[2][2], bv[2][2];
#pragma unroll
        for (int bj = 0; bj < 2; ++bj)
#pragma unroll
            for (int n = 0; n < 2; ++n) { gv[bj][n] = *(const f32x4*)(g + col0 + bj * HALF + n * 16); bv[bj][n] = *(const f32x4*)(b + col0 + bj * HALF + n * 16); }
#pragma unroll
        for (int ai = 0; ai < 2; ++ai)
#pragma unroll
            for (int m = 0; m < 4; ++m) { const int row = row0 + ai * HALF + m * 16; const size_t off = (size_t)row * 1024 + col0; float mu, rstd; row_stats16(stats, row, fq, mu, rstd);
#pragma unroll
                for (int bj = 0; bj < 2; ++bj)
#pragma unroll
                    for (int n = 0; n < 2; ++n) { const u32x2 zw = *(const u32x2*)(zb + off + bj * HALF + n * 16);
                        const f32x4 z = (f32x4){__builtin_bit_cast(float, zw.x << 16), __builtin_bit_cast(float, zw.x & 0xffff0000u), __builtin_bit_cast(float, zw.y << 16), __builtin_bit_cast(float, zw.y & 0xffff0000u)};
                        const f32x4 x1 = (z - mu) * rstd * gv[bj][n] + bv[bj][n];
                        *(f32x4*)(out + off + bj * HALF + n * 16) = x1 * alpha + acc[ai][bj][m][n]; } }
    }
};
struct EpiRank1 {
    static constexpr bool PERM = true;
    bf16_t* O; const float* stats; const float* cs; const float* bw;
    __device__ __forceinline__ void operator()(const f32x4 (&acc)[2][2][4][2], const Unit& u, int wr, int wc, int fr, int fq) const {
        const int row0 = u.pm * BM + wr * 64 + fr, col0 = u.pn * BM + wc * 32 + 8 * fq;
        f32x4 cv[2][2], wv[2][2];
#pragma unroll
        for (int bj = 0; bj < 2; ++bj)
#pragma unroll
            for (int n = 0; n < 2; ++n) { cv[bj][n] = *(const f32x4*)(cs + col0 + bj * HALF + 4 * n); wv[bj][n] = *(const f32x4*)(bw + col0 + bj * HALF + 4 * n); }
#pragma unroll
        for (int ai = 0; ai < 2; ++ai)
#pragma unroll
            for (int m = 0; m < 4; ++m) { const int row = row0 + ai * HALF + m * 16; float mu, rstd; row_stats16(stats, row, fq, mu, rstd); bf16_t* rowp = O + (size_t)row * 1024 + col0;
#pragma unroll
                for (int bj = 0; bj < 2; ++bj) *(u32x4*)(rowp + bj * HALF) = pack8((acc[ai][bj][m][0] - cv[bj][0] * mu) * rstd + wv[bj][0], (acc[ai][bj][m][1] - cv[bj][1] * mu) * rstd + wv[bj][1]); }
    }
};

struct EpiPre {
    static constexpr bool PERM = true;
    bf16_t* O; float* csp;
    __device__ __forceinline__ void operator()(const f32x4 (&acc)[2][2][4][2], const Unit& u, int wr, int wc, int fr, int fq) const {
        const int row0 = u.pm * BM + wr * 64 + fr, col0 = u.pn * BM + wc * 32 + 8 * fq;
#pragma unroll
        for (int ai = 0; ai < 2; ++ai)
#pragma unroll
            for (int m = 0; m < 4; ++m) { const int row = row0 + ai * HALF + m * 16; bf16_t* rowp = O + ((size_t)u.aux * 1024 + row) * 1024 + col0; float sm = 0.f;
#pragma unroll
                for (int bj = 0; bj < 2; ++bj) { const u32x4 w = pack8(acc[ai][bj][m][0], acc[ai][bj][m][1]); *(u32x4*)(rowp + bj * HALF) = w;
#pragma unroll
                    for (int e = 0; e < 4; ++e) sm += __builtin_bit_cast(float, w[e] << 16) + __builtin_bit_cast(float, w[e] & 0xffff0000u); }
                if (csp) { sm += __shfl_xor(sm, 16); sm += __shfl_xor(sm, 32); if (fq == 0) csp[((size_t)u.aux * 1024 + row) * 16 + u.pn * 4 + wc] = sm; } }
    }
};
struct EpiSoftmaxLn {
    static constexpr bool PERM = true;
    bf16_t* P; PG8_LAS float* xl; const float* stats; const float* cs; const float* bw;
    __device__ __forceinline__ void operator()(f32x4 (&acc)[2][2][4][2], const Unit& u, int wr, int wc, int fr, int fq) const {
        const float sc = 0.0625f * 1.4426950408889634f;
        const int row0 = u.pm * BM + wr * 64 + fr, col0 = u.pn * BM + wc * 32 + 8 * fq;
        { f32x4 cv[2][2], wv[2][2];
#pragma unroll
          for (int bj = 0; bj < 2; ++bj)
#pragma unroll
            for (int n = 0; n < 2; ++n) { cv[bj][n] = *(const f32x4*)(cs + u.aux * 1024 + col0 + bj * HALF + 4 * n); wv[bj][n] = *(const f32x4*)(bw + u.aux * 1024 + col0 + bj * HALF + 4 * n); }
#pragma unroll
          for (int ai = 0; ai < 2; ++ai)
#pragma unroll
            for (int m = 0; m < 4; ++m) { float mu, rstd; row_stats16(stats, row0 + ai * HALF + m * 16, fq, mu, rstd);
#pragma unroll
                for (int bj = 0; bj < 2; ++bj)
#pragma unroll
                    for (int n = 0; n < 2; ++n) acc[ai][bj][m][n] = (acc[ai][bj][m][n] - cv[bj][n] * mu) * rstd + wv[bj][n]; } }
#pragma unroll
        for (int ai = 0; ai < 2; ++ai)
#pragma unroll
            for (int m = 0; m < 4; ++m) { float mx = -INFINITY;
#pragma unroll
                for (int bj = 0; bj < 2; ++bj)
#pragma unroll
                    for (int n = 0; n < 2; ++n) { const f32x4 v = acc[ai][bj][m][n]; mx = fmaxf(mx, fmaxf(fmaxf(v[0], v[1]), fmaxf(v[2], v[3]))); }
                mx = fmaxf(mx, __shfl_xor(mx, 16)); mx = fmaxf(mx, __shfl_xor(mx, 32));
                float sm = 0.f;
#pragma unroll
                for (int bj = 0; bj < 2; ++bj)
#pragma unroll
                    for (int n = 0; n < 2; ++n) { const f32x4 v = acc[ai][bj][m][n]; sm += (__builtin_amdgcn_exp2f((v[0] - mx) * sc) + __builtin_amdgcn_exp2f((v[1] - mx) * sc)) + (__builtin_amdgcn_exp2f((v[2] - mx) * sc) + __builtin_amdgcn_exp2f((v[3] - mx) * sc)); }
                sm += __shfl_xor(sm, 16); sm += __shfl_xor(sm, 32);
                if (fq == 0) { PG8_LAS float* q = xl + ((ai * HALF + wr * 64 + m * 16 + fr) * 4 + wc) * 2; q[0] = mx; q[1] = sm; } }
        asm volatile("s_waitcnt lgkmcnt(0)" ::: "memory"); __builtin_amdgcn_s_barrier(); asm volatile("" ::: "memory");
#pragma unroll
        for (int ai = 0; ai < 2; ++ai)
#pragma unroll
            for (int m = 0; m < 4; ++m) { const PG8_LAS f32x4* q = (const PG8_LAS f32x4*)(xl + (ai * HALF + wr * 64 + m * 16 + fr) * 8); const f32x4 q0 = q[0], q1 = q[1];
                const float M = fmaxf(fmaxf(q0[0], q0[2]), fmaxf(q1[0], q1[2]));
                const float S = (q0[1] * __builtin_amdgcn_exp2f((q0[0] - M) * sc) + q0[3] * __builtin_amdgcn_exp2f((q0[2] - M) * sc)) + (q1[1] * __builtin_amdgcn_exp2f((q1[0] - M) * sc) + q1[3] * __builtin_amdgcn_exp2f((q1[2] - M) * sc));
                const float inv = 1.f / S; bf16_t* rowp = P + (size_t)(row0 + ai * HALF + m * 16) * 1024 + col0;
#pragma unroll
                for (int bj = 0; bj < 2; ++bj) { f32x4 pq[2];
#pragma unroll
                    for (int n = 0; n < 2; ++n) { const f32x4 v = acc[ai][bj][m][n];
                        pq[n] = (f32x4){__builtin_amdgcn_exp2f((v[0] - M) * sc) * inv, __builtin_amdgcn_exp2f((v[1] - M) * sc) * inv, __builtin_amdgcn_exp2f((v[2] - M) * sc) * inv, __builtin_amdgcn_exp2f((v[3] - M) * sc) * inv}; }
                    *(u32x4*)(rowp + bj * HALF) = pack8(pq[0], pq[1]); } }
        asm volatile("s_waitcnt lgkmcnt(0)" ::: "memory"); __builtin_amdgcn_s_barrier(); asm volatile("" ::: "memory");
    }
};
struct DenseSched {
    const char* A; const char* B; int nM, nN, G, c; size_t strideA, strideB;
    __device__ __forceinline__ bool next(int i, Unit& u) const { const int L = i * G + c; if (L >= nM * nN) return false; tile_of(L, nM, nN, u.pm, u.pn); u.A = A + (size_t)u.pm * strideA; u.B = B + (size_t)u.pn * strideB; u.kind = 0; u.aux = 0; u.rows = nullptr; return true; }
};
}


#define LAS __attribute__((address_space(3)))
__device__ __forceinline__ void transpose_item(const float* W, int N, bf16* WT, int Kd, int k0, int n0, int drow0, LAS float* scr, int lane, const float* gk = nullptr) {
    float wv[32];
#pragma unroll
    for (int i = 0; i < 32; ++i) { const int kk = 2 * i + (lane >> 5); wv[i] = __builtin_nontemporal_load(W + (size_t)(k0 + kk) * N + n0 + (lane & 31)); }
#pragma unroll
    for (int i = 0; i < 32; ++i) { const int kk = 2 * i + (lane >> 5); float t = wv[i]; if (gk) t *= gk[k0 + kk]; scr[kk * 33 + (lane & 31)] = t; }
    asm volatile("s_waitcnt lgkmcnt(0)" ::: "memory");
    const int c = lane & 7;
#pragma unroll
    for (int j = 0; j < 4; ++j) { const int n = (lane >> 3) + 8 * j; const LAS float* sp = scr + (8 * c) * 33 + n;
        u32x4 o; o.x = pk2(sp[0 * 33], sp[1 * 33]); o.y = pk2(sp[2 * 33], sp[3 * 33]); o.z = pk2(sp[4 * 33], sp[5 * 33]); o.w = pk2(sp[6 * 33], sp[7 * 33]);
        *(u32x4*)(WT + (size_t)(drow0 + n) * Kd + k0 + 8 * c) = o; }
    asm volatile("s_waitcnt lgkmcnt(0)" ::: "memory");
}


typedef short bf16x8v __attribute__((ext_vector_type(8)));
__device__ __forceinline__ float bflo(unsigned v) { return __builtin_bit_cast(float, v << 16); }
__device__ __forceinline__ float bfhi(unsigned v) { return __builtin_bit_cast(float, v & 0xffff0000u); }

__device__ __forceinline__ void conv_unit(unsigned char* lds, const bf16* hglu, const float* w_dw, const float* b_dw, const float* g_cn, const float* b_cn, bf16* ycat, int cu, int tid) {
    const int lane = tid & 63, wave = tid >> 6;
    bf16* hin = (bf16*)lds; float* cout = (float*)(lds + 63488);
    const int t0 = cu * 32, s0 = t0 % SEQ;
    for (int c = tid; c < 62 * 64; c += 512) { const int row = c >> 6, part = c & 63; u32x4 v = (u32x4){0u, 0u, 0u, 0u};
        if (s0 - 30 + row >= 0) v = *(const u32x4*)(hglu + (size_t)(t0 - 30 + row) * 512 + part * 8);
        *(u32x4*)(hin + row * 512 + part * 8) = v; }
    __syncthreads();
    {
        const int cp = tid & 255, th = tid >> 8;
        float w0[CONV_W], w1[CONV_W];
#pragma unroll
        for (int j = 0; j < CONV_W; ++j) { const float2 ww = *(const float2*)(w_dw + j * CONV_CH + 2 * cp); w0[j] = ww.x; w1[j] = ww.y; }
        const float2 bb = *(const float2*)(b_dw + 2 * cp);
#pragma unroll 1
        for (int grp = 0; grp < 2; ++grp) { const int tt0 = th * 16 + grp * 8;
            float a0[8], a1[8];
#pragma unroll
            for (int o = 0; o < 8; ++o) { a0[o] = bb.x; a1[o] = bb.y; }
#pragma unroll
            for (int r = 0; r < 38; ++r) { const unsigned v = *(const unsigned*)(hin + (tt0 + r) * 512 + 2 * cp); const float lo = bflo(v), hi = bfhi(v);
#pragma unroll
                for (int o = 0; o < 8; ++o) { const int j = r - o; if (j >= 0 && j < CONV_W) { a0[o] += w0[j] * lo; a1[o] += w1[j] * hi; } } }
#pragma unroll
            for (int o = 0; o < 8; ++o) *(float2*)(cout + (tt0 + o) * 512 + 2 * cp) = make_float2(a0[o], a1[o]);
        }
    }
    __syncthreads();
    {
        const f32x4 g0 = *(const f32x4*)(g_cn + 8 * lane), g1 = *(const f32x4*)(g_cn + 8 * lane + 4), c0 = *(const f32x4*)(b_cn + 8 * lane), c1 = *(const f32x4*)(b_cn + 8 * lane + 4);
#pragma unroll 1
        for (int i = 0; i < 4; ++i) { const int tt = wave * 4 + i;
            f32x4 v0 = *(const f32x4*)(cout + tt * 512 + 8 * lane), v1 = *(const f32x4*)(cout + tt * 512 + 8 * lane + 4);
            const float mean = wave_sum((v0.x + v0.y) + (v0.z + v0.w) + (v1.x + v1.y) + (v1.z + v1.w)) * (1.f / 512.f);
            v0 = v0 - mean; v1 = v1 - mean;
            const float var = wave_sum((v0.x * v0.x + v0.y * v0.y) + (v0.z * v0.z + v0.w * v0.w) + (v1.x * v1.x + v1.y * v1.y) + (v1.z * v1.z + v1.w * v1.w)) * (1.f / 512.f);
            const float rstd = 1.f / sqrtf(var + LN_EPS);
            f32x4 y0 = v0 * rstd * g0 + c0, y1 = v1 * rstd * g1 + c1;
#pragma unroll
            for (int e = 0; e < 4; ++e) { y0[e] = y0[e] * pg8::sigm(y0[e]); y1[e] = y1[e] * pg8::sigm(y1[e]); }
            *(u32x4*)(ycat + (size_t)(t0 + tt) * 1024 + 8 * lane) = pg8::pack8(y0, y1); }
    }
    __syncthreads();
}

__device__ __forceinline__ void swa_unit(unsigned char* lds, const bf16* qkv, const float* sinks, bf16* ycat, int b, int kvh, int qb, int tid) {
    const int lane = tid & 63, wave = tid >> 6, q4 = lane >> 4, c16 = lane & 15;
    bf16* Ks = (bf16*)lds; bf16* VT = (bf16*)(lds + 36864);
    const long t0 = (long)b * SEQ + (long)qb * 128, tk0 = t0 - 128;
#pragma unroll
    for (int i = 0; i < 4; ++i) { const int c = tid + 512 * i, row = c >> 3, part = c & 7; const bool ok = (qb > 0) || (row >= 128);
        u32x4 kv = (u32x4){0u, 0u, 0u, 0u}, vv = kv;
        if (ok) { const bf16* rp = qkv + (tk0 + row) * 768 + 512 + kvh * 64 + part * 8; kv = *(const u32x4*)rp; vv = *(const u32x4*)(rp + 128); }
        *(u32x4*)(Ks + row * 72 + part * 8) = kv;
#pragma unroll
        for (int e = 0; e < 4; ++e) { VT[(part * 8 + 2 * e) * 264 + row] = (bf16)(vv[e] & 0xffffu); VT[(part * 8 + 2 * e + 1) * 264 + row] = (bf16)(vv[e] >> 16); } }
    __syncthreads();
    const int g = wave >> 1, hq = kvh * 4 + g, i0 = (wave & 1) * 64;
    const float L2E = 1.4426950408889634f, sc = 0.125f * L2E, sink2 = sinks[hq] * L2E;
#pragma unroll 1
    for (int qt = 0; qt < 4; ++qt) {
        const int iq = i0 + qt * 16, kt0 = iq >> 4, iqc = iq + c16;
        const bf16* qp = qkv + (t0 + iqc) * 768 + hq * 64 + 8 * q4;
        const bf16x8v Q0 = *(const bf16x8v*)qp, Q1 = *(const bf16x8v*)(qp + 32);
        f32x4 sv[9];
#pragma unroll
        for (int kt = 0; kt < 9; ++kt) { const bf16* kp = Ks + ((kt0 + kt) * 16 + c16) * 72 + 8 * q4;
            f32x4 a = (f32x4){0.f, 0.f, 0.f, 0.f};
            a = __builtin_amdgcn_mfma_f32_16x16x32_bf16(*(const bf16x8v*)kp, Q0, a, 0, 0, 0);
            a = __builtin_amdgcn_mfma_f32_16x16x32_bf16(*(const bf16x8v*)(kp + 32), Q1, a, 0, 0, 0);
            sv[kt] = a; }
        float mx = sink2;
#pragma unroll
        for (int kt = 0; kt < 9; ++kt)
#pragma unroll
            for (int r = 0; r < 4; ++r) { const int j = (kt0 + kt) * 16 + 4 * q4 + r; const bool ok = (j > iqc) && (j <= iqc + 128) && (qb > 0 || j >= 128);
                const float v = ok ? sv[kt][r] * sc : -INFINITY; sv[kt][r] = v; mx = fmaxf(mx, v); }
        mx = fmaxf(mx, __shfl_xor(mx, 16)); mx = fmaxf(mx, __shfl_xor(mx, 32));
        float sum = 0.f;
#pragma unroll
        for (int kt = 0; kt < 9; ++kt)
#pragma unroll
            for (int r = 0; r < 4; ++r) { const float pv = __builtin_amdgcn_exp2f(sv[kt][r] - mx); sv[kt][r] = pv; sum += pv; }
        sum += __shfl_xor(sum, 16); sum += __shfl_xor(sum, 32);
        sum += __builtin_amdgcn_exp2f(sink2 - mx);
        const float inv = 1.f / sum;
        f32x4 o[4];
#pragma unroll
        for (int dt = 0; dt < 4; ++dt) o[dt] = (f32x4){0.f, 0.f, 0.f, 0.f};
#pragma unroll
        for (int pp = 0; pp < 5; ++pp) { const int T0 = kt0 + 2 * pp, T1 = (pp < 4) ? T0 + 1 : T0;
            const f32x4 pa = sv[2 * pp], pb = (pp < 4) ? sv[2 * pp + 1] : (f32x4){0.f, 0.f, 0.f, 0.f};
            const u32x4 pw = pg8::pack8(pa, pb); const bf16x8v Bp = __builtin_bit_cast(bf16x8v, pw);
#pragma unroll
            for (int dt = 0; dt < 4; ++dt) { const bf16* vp = VT + (dt * 16 + c16) * 264 + 4 * q4;
                const u32x2 lo = *(const u32x2*)(vp + T0 * 16), hi = *(const u32x2*)(vp + T1 * 16);
                const u32x4 aw = (u32x4){lo.x, lo.y, hi.x, hi.y};
                o[dt] = __builtin_amdgcn_mfma_f32_16x16x32_bf16(__builtin_bit_cast(bf16x8v, aw), Bp, o[dt], 0, 0, 0); } }
        bf16* op = ycat + (t0 + iqc) * 1024 + 512 + hq * 64 + 4 * q4;
#pragma unroll
        for (int dt = 0; dt < 4; ++dt) { u32x2 w; w.x = pg8::cvt_pk_bf16(o[dt][0] * inv, o[dt][1] * inv); w.y = pg8::cvt_pk_bf16(o[dt][2] * inv, o[dt][3] * inv); *(u32x2*)(op + dt * 16) = w; }
    }
    __syncthreads();
}


#define XB_TMO      128
#define XB_XCNT(j)  (256  + 64 * (j))
#define XB_XSUB(j)  (1280 + 64 * (j))
#define XB_XGEN(j)  (2304 + 64 * (j))
#define XB_TOP      3328
#define XB_TOPGEN   3392
#define XCD_BAR_WORDS 3456
#define XB_SPIN_CAP (1u << 20)
__device__ __forceinline__ unsigned xb_ld(unsigned* p)              { return __hip_atomic_load(p, __ATOMIC_RELAXED, __HIP_MEMORY_SCOPE_AGENT); }
__device__ __forceinline__ unsigned xb_add(unsigned* p, unsigned v) { return __hip_atomic_fetch_add(p, v, __ATOMIC_RELAXED, __HIP_MEMORY_SCOPE_AGENT); }
__device__ __forceinline__ unsigned xb_xcc_id() { return (unsigned)__builtin_amdgcn_s_getreg((3 << 11) | 20) & 0xFu; }
#define XB_SPIN(cond, bar) do { unsigned _sp = 0; while (cond) { __builtin_amdgcn_s_sleep(1); \
    if ((++_sp & 255u) == 0u) { if (xb_ld(&(bar)[XB_TMO])) break; if (_sp > XB_SPIN_CAP) { atomicAdd(&(bar)[XB_TMO], 1u); break; } } } } while (0)
struct XcdBarrier { unsigned* bar; unsigned x; volatile __attribute__((address_space(3))) unsigned* st; };
__device__ __forceinline__ XcdBarrier xcd_barrier_post(unsigned* bar, volatile __attribute__((address_space(3))) unsigned* st) {
    XcdBarrier b; b.bar = bar; b.x = xb_xcc_id(); b.st = st;
    if (threadIdx.x == 0) (void)xb_add(&bar[XB_XCNT(b.x)], 1u);
    return b;
}
__device__ __forceinline__ void xcd_barrier_complete(unsigned* bar, unsigned x, unsigned& nloc, unsigned& nx) {
    const unsigned G = gridDim.x * gridDim.y * gridDim.z;
    unsigned sum, cnt, mine, sp = 0u;
    for (;;) {
        sum = 0u; cnt = 0u; mine = 0u;
#pragma unroll
        for (unsigned j = 0; j < 16; ++j) { const unsigned c = xb_ld(&bar[XB_XCNT(j)]); sum += c; cnt += (c > 0u) ? 1u : 0u; mine = (j == x) ? c : mine; }
        if (sum == G) break;
        __builtin_amdgcn_s_sleep(1);
        if ((++sp & 255u) == 0u) { if (xb_ld(&bar[XB_TMO])) break; if (sp > XB_SPIN_CAP) { atomicAdd(&bar[XB_TMO], 1u); break; } }
    }
    nloc = mine > 0u ? mine : 1u; nx = cnt > 0u ? cnt : 1u;
}
__device__ __forceinline__ void xcd_barrier(const XcdBarrier& b, int tid) {
    asm volatile("s_waitcnt vmcnt(0)" ::: "memory");
    __syncthreads();
    if (tid == 0) {
        unsigned* bar = b.bar;
        __builtin_amdgcn_s_waitcnt(0);
        unsigned nloc = b.st[0], nx = b.st[1];
        if (nloc == 0u) { xcd_barrier_complete(bar, b.x, nloc, nx); b.st[0] = nloc; b.st[1] = nx; }
        const unsigned old = xb_add(&bar[XB_XSUB(b.x)], 1u);
        const unsigned gen = old / nloc;
        if (old + 1u == (gen + 1u) * nloc) {
            __builtin_amdgcn_fence(__ATOMIC_RELEASE, "agent");
            asm volatile("s_waitcnt vmcnt(0)" ::: "memory");
            const unsigned og = xb_add(&bar[XB_TOP], 1u);
            const unsigned tg = og / nx;
            if (og + 1u == (tg + 1u) * nx) xb_add(&bar[XB_TOPGEN], 1u);
            else XB_SPIN(xb_ld(&bar[XB_TOPGEN]) == tg, bar);
            __builtin_amdgcn_fence(__ATOMIC_ACQUIRE, "agent");
            xb_add(&bar[XB_XGEN(b.x)], 1u);
            asm volatile("s_waitcnt vmcnt(0)" ::: "memory");
        } else {
            XB_SPIN(xb_ld(&bar[XB_XGEN(b.x)]) == gen, bar);
            __builtin_amdgcn_fence(__ATOMIC_ACQUIRE, "agent");
            asm volatile("s_waitcnt vmcnt(0)" ::: "memory");
        }
    }
    __syncthreads();
}

struct SchedMoE { const char* A; const char* W; const int* tab; const int* rows; int nF, nH, G, c; size_t lda2, strideE, strideN;
    __device__ __forceinline__ bool next(int i, pg8::Unit& u) const { const int L = i * G + c; int t;
        if (L < nF * 4) { pg8::tile_of(L, nF, 4, t, u.pn); u.half = 0; } else if (L < (nF + nH) * 4) { pg8::tile_of(L - nF * 4, nH, 4, t, u.pn); t += nF; u.half = 1; } else return false;
        const int rb = tab[2 + t], e = tab[2 + 192 + t];
        u.pm = t; u.kind = 0; u.aux = e; u.rb = rb; u.rows = rows ? rows + rb : nullptr; u.A = rows ? A : A + (size_t)rb * lda2; u.B = W + (size_t)e * strideE + (size_t)u.pn * strideN; return true; } };

__global__ void __launch_bounds__(512, 2) fwd_kernel(Params p) {
    extern __shared__ __attribute__((aligned(16))) unsigned char lds_raw[];
    float* ldsf = (float*)lds_raw;
    cg::grid_group grid = cg::this_grid();
    const int G = gridDim.x, bid = blockIdx.x, NGW = G * 8;
    const int wid_s = __builtin_amdgcn_readfirstlane((int)threadIdx.x >> 6);
    unsigned char* ws = p.ws;
    const float *x = p.in[0], *mem = p.in[1], *w_in = p.in[2], *b_in = p.in[3], *w_dw = p.in[4], *b_dw = p.in[5], *g_cn = p.in[6], *b_cn = p.in[7], *sinks = p.in[8],
                *w_out = p.in[9], *g_ln1 = p.in[10], *b_ln1 = p.in[11], *w_mq = p.in[12], *w_mkv = p.in[13], *w_mo = p.in[14], *g_ln2 = p.in[15], *b_ln2 = p.in[16],
                *w_group = p.in[17], *b_group = p.in[18], *w_router = p.in[19], *b_router = p.in[20], *w_gate = p.in[21], *w_up = p.in[22], *w_down = p.in[23],
                *g_ln3 = p.in[24], *b_ln3 = p.in[25];
    float* out = p.out;
    bf16* xb = (bf16*)(ws + WS_A); bf16* ycat = (bf16*)(ws + WS_A); bf16* qm = (bf16*)(ws + WS_A); bf16* om = (bf16*)(ws + WS_A); bf16* Hs = (bf16*)(ws + WS_A);
    bf16* hglu = (bf16*)(ws + WS_B); bf16* qkv = (bf16*)(ws + WS_B + (size_t)T * 512 * 2); bf16* x1b = (bf16*)(ws + WS_B); bf16* Pb2 = (bf16*)(ws + WS_A); bf16* x2b = (bf16*)(ws + WS_B);
    float* Sbuf = (float*)(ws + WS_DD); bf16* Xs = (bf16*)(ws + WS_DD);
    bf16* kvm = (bf16*)(ws + WS_KVM); bf16* memb = (bf16*)(ws + WS_MEMB); bf16* MT = (bf16*)(ws + WS_MT); bf16* NT = (bf16*)(ws + WS_NT);
    float* csS = (float*)(ws + WS_CSS); float* bwS = csS + 2048; float* csp = (float*)(ws + WS_CSP);
    bf16* Wt_in = (bf16*)(ws + WS_WIN); bf16* Wt_out = (bf16*)(ws + WS_WOUT); bf16* Wqb = (bf16*)(ws + WS_WMQ); bf16* Wt_mkv = (bf16*)(ws + WS_WMKV); bf16* Wt_mo = (bf16*)(ws + WS_WMO);
    bf16* Wt_gu = (bf16*)(ws + WS_WGU); bf16* Wt_dn = (bf16*)(ws + WS_WDN);
    PG8_LAS unsigned char* ldsp = (PG8_LAS unsigned char*)lds_raw;
    float* stats1 = (float*)(ws + WS_ST1); float* cs1 = (float*)(ws + WS_CS1); float* bw1 = cs1 + 1024;
    int* route_e = (int*)(ws + WS_ROUTE); float* route_g = (float*)(ws + WS_ROUTE + (size_t)T * 8);
    int* blkcnt = (int*)(ws + WS_BLKCNT); int* segw = (int*)(ws + WS_SEG); int* rank = (int*)(ws + WS_RANK);
    int* pair_tok = (int*)(ws + WS_PTOK); float* pair_gate = (float*)(ws + WS_PGATE); int* tokpos = (int*)(ws + WS_TOKPOS); bf16* Yb = (bf16*)(ws + WS_DD);

    const int lo = p.ph_lo, hi = p.ph_hi;
    int ph = 0;
    unsigned long long tprev = (PROBE_T >= 0) ? __builtin_amdgcn_s_memrealtime() : 0ull, tprobe = 0ull;
    volatile __attribute__((address_space(3))) unsigned* bst = (volatile __attribute__((address_space(3))) unsigned*)(ldsp + LDS_BYTES_K - 64);
    if (threadIdx.x == 0) { bst[0] = 0u; bst[1] = 0u; }
    __syncthreads();
    const XcdBarrier xbar = xcd_barrier_post((unsigned*)(ws + WS_CTL), bst);
    if (lo > hi) grid.sync();
#define PHASE_BEGIN if (lo <= ph && ph < hi) { for (int rep_ = 0; rep_ < ((((unsigned)PROBE_MASK >> ph) & 1u) ? 2 : 1); ++rep_) { const int tid = wid_s * 64 + lane_fresh(); const int lane = tid & 63, wave = tid >> 6, gw = bid * 8 + wave; (void)lane; (void)wave; (void)gw;
#define PHASE_END } } if (lo <= ph && ph + 1 < hi) xcd_barrier(xbar, wid_s * 64 + lane_fresh()); if (PROBE_T >= 0) { const unsigned long long tn_ = __builtin_amdgcn_s_memrealtime(); if (ph == PROBE_T) tprobe = tn_ - tprev; tprev = tn_; } ++ph;

    PHASE_BEGIN
    {
        const size_t n4 = (size_t)T * D / 4, stride = (size_t)G * 512;
        for (size_t i0 = (size_t)bid * 512 + tid; i0 < n4; i0 += 8 * stride) { f32x4 v[8];
#pragma unroll
            for (int q = 0; q < 8; ++q) { const size_t i = i0 + q * stride; v[q] = (i < n4) ? __builtin_nontemporal_load((const f32x4*)x + i) : (f32x4){0.f, 0.f, 0.f, 0.f}; }
#pragma unroll
            for (int q = 0; q < 8; ++q) { const size_t i = i0 + q * stride; if (i < n4) { u32x2 w; w.x = pk2(v[q].x, v[q].y); w.y = pk2(v[q].z, v[q].w); ((u32x2*)xb)[i] = w; } } } }
    for (size_t i = (size_t)bid * 512 + tid; i < (size_t)NMEM * D / 4; i += (size_t)G * 512) { const f32x4 v = ((const f32x4*)mem)[i]; u32x2 w; w.x = pk2(v.x, v.y); w.y = pk2(v.z, v.w); ((u32x2*)memb)[i] = w; }
    {
        LAS float* scr = (LAS float*)(ldsp + wave * 16384);
        constexpr int I_IN = 16 * 56, I_SQ = 16 * 32, I_KV = 16 * 64, I_EX = 16 * 256;
        constexpr int NITEMS = I_IN + 2 * I_SQ + I_KV + 3 * I_EX;
        for (int it = gw; it < NITEMS; it += NGW) { int r = it;
            if (r < I_IN) { const int kb = r / 56, nb = r % 56, n0 = nb * 32; const int dr = n0 < 512 ? (n0 >> 7) * 256 + (n0 & 127) : (n0 < 1024 ? ((n0 - 512) >> 7) * 256 + 128 + (n0 & 127) : n0);
                transpose_item(w_in, D_IN, Wt_in, 1024, kb * 64, n0, dr, scr, lane); continue; } r -= I_IN;
            if (r < I_SQ) { transpose_item(w_out, 1024, Wt_out, 1024, (r / 32) * 64, (r % 32) * 32, (r % 32) * 32, scr, lane); continue; } r -= I_SQ;
            if (r < I_SQ) { transpose_item(w_mo, 1024, Wt_mo, 1024, (r / 32) * 64, (r % 32) * 32, (r % 32) * 32, scr, lane); continue; } r -= I_SQ;
            if (r < I_KV) { transpose_item(w_mkv, 2048, Wt_mkv, 1024, (r / 64) * 64, (r % 64) * 32, (r % 64) * 32, scr, lane); continue; } r -= I_KV;
            if (r < I_EX) { const int e = r / 256, q = r % 256, n0 = (q % 16) * 32; transpose_item(w_gate + (size_t)e * D * DE, DE, Wt_gu + (size_t)e * 1024 * 1024, 1024, (q / 16) * 64, n0, (n0 >> 7) * 256 + (n0 & 127), scr, lane); continue; } r -= I_EX;
            if (r < I_EX) { const int e = r / 256, q = r % 256, n0 = (q % 16) * 32; transpose_item(w_up + (size_t)e * D * DE, DE, Wt_gu + (size_t)e * 1024 * 1024, 1024, (q / 16) * 64, n0, (n0 >> 7) * 256 + 128 + (n0 & 127), scr, lane); continue; } r -= I_EX;
            { const int e = r / 256, q = r % 256; transpose_item(w_down + (size_t)e * DE * D, D, Wt_dn + (size_t)e * 1024 * 512, 512, (q / 32) * 64, (q % 32) * 32, (q % 32) * 32, scr, lane); }
        }
        for (int it = gw; it < 256; it += NGW) {
            f32x4 b4 = (f32x4){0.f, 0.f, 0.f, 0.f};
#pragma unroll 4
            for (int i = 0; i < 16; ++i) { const int k = lane + 64 * i; const f32x4 w = *(const f32x4*)(w_mq + (size_t)k * 1024 + 4 * it); b4 += w * b_ln1[k]; }
#pragma unroll
            for (int e = 0; e < 4; ++e) b4[e] = wave_sum(b4[e]);
            if (lane == 0) *(f32x4*)(bw1 + 4 * it) = b4; }
    }
    {   const size_t n4 = (size_t)D * D / 4, stride = (size_t)G * 512;
        for (size_t i0 = (size_t)bid * 512 + tid; i0 < n4; i0 += 2 * stride) { f32x4 v[2];
#pragma unroll
            for (int q = 0; q < 2; ++q) { const size_t i = i0 + q * stride; v[q] = (i < n4) ? ((const f32x4*)w_mq)[i] : (f32x4){0.f, 0.f, 0.f, 0.f}; }
#pragma unroll
            for (int q = 0; q < 2; ++q) { const size_t i = i0 + q * stride; if (i < n4) { const f32x4 t = v[q] * g_ln1[i >> 8]; u32x2 w; w.x = pk2(t.x, t.y); w.y = pk2(t.z, t.w); ((u32x2*)Wqb)[i] = w; } } } }
    PHASE_END

    PHASE_BEGIN
    {
        struct SchedP1 { const char *xb, *win, *memb, *wkv; int G, c;
            __device__ __forceinline__ bool next(int i, pg8::Unit& u) const { const int L = i * G + c; u.aux = 0;
                if (L < 448) { pg8::tile_of(L, 64, 7, u.pm, u.pn); u.A = xb + (size_t)u.pm * 256 * 2048; u.B = win + (size_t)u.pn * 256 * 2048; u.kind = u.pn < 4 ? 0 : 1; return true; }
                if (L < 464) { const int r = L - 448; u.pm = r >> 3; u.pn = r & 7; u.A = memb + (size_t)u.pm * 256 * 2048; u.B = wkv + (size_t)u.pn * 256 * 2048; u.kind = 2; return true; }
                return false; } };
        const SchedP1 S{(const char*)xb, (const char*)Wt_in, (const char*)memb, (const char*)Wt_mkv, G, bid};
        const pg8::EpiP1 E{hglu, qkv, kvm, b_in};
        pg8::gemm_phase(tid, ldsp, pg8::Gemm{1024, 1024, 1024}, S, E);
    }
    PHASE_END

    PHASE_BEGIN
    for (int cu = bid; cu < T / 32; cu += G) conv_unit(lds_raw, hglu, w_dw, b_dw, g_cn, b_cn, ycat, cu, tid);
    for (int u = bid; u < BATCH * NKV * (SEQ / 128); u += G) swa_unit(lds_raw, qkv, sinks, ycat, u >> 7, (u >> 6) & 1, u & 63, tid);
    {
        struct SchedMT { const char *kvm, *wq; int c;
            __device__ __forceinline__ bool next(int i, pg8::Unit& u) const { if (i > 0 || c < 0 || c >= 32) return false; const int b = c >> 4, h = (c >> 2) & 3, pn = c & 3; u.pm = h; u.pn = pn; u.aux = b; u.kind = 0;
                u.A = kvm + ((size_t)(b * 256) * 2048 + h * 256) * 2; u.B = wq + ((size_t)(pn * 256) * 1024 + h * 256) * 2; return true; } };
        struct SchedNT { const char *wo, *kvm; int c;
            __device__ __forceinline__ bool next(int i, pg8::Unit& u) const { if (i > 0 || c < 0 || c >= 32) return false; const int b = c >> 4, h = (c >> 2) & 3, pm = c & 3; u.pm = pm; u.pn = h; u.aux = b; u.kind = 0;
                u.A = wo + ((size_t)(pm * 256) * 1024 + h * 256) * 2; u.B = kvm + ((size_t)(b * 256) * 2048 + 1024 + h * 256) * 2; return true; } };
        const SchedMT S1{(const char*)kvm, (const char*)Wqb, bid}; const pg8::EpiPre E1{MT, csp};
        pg8::gemm_phase(wid_s * 64 + lane_fresh(), ldsp, pg8::Gemm{2048, 1024, 256}, S1, E1);
        const SchedNT S2{(const char*)Wt_mo, (const char*)kvm, bid - 32}; const pg8::EpiPre E2{NT, nullptr};
        pg8::gemm_phase(wid_s * 64 + lane_fresh(), ldsp, pg8::Gemm{1024, 2048, 256}, S2, E2);
    }
    PHASE_END

    PHASE_BEGIN
    for (int r = gw; r < 2048; r += NGW) { const int b = r >> 10, hk = r & 1023, h = hk >> 8, key = hk & 255;
        const float c = wave_sum(lane < 16 ? csp[(size_t)r * 16 + lane] : 0.f);
        const u32x2 kk = *(const u32x2*)(kvm + (size_t)(b * 256 + key) * 2048 + h * 256 + 4 * lane); const f32x4 bq = *(const f32x4*)(bw1 + h * 256 + 4 * lane);
        const float w = wave_sum((bflo(kk.x) * bq[0] + bfhi(kk.x) * bq[1]) + (bflo(kk.y) * bq[2] + bfhi(kk.y) * bq[3]));
        if (lane == 0) { csS[r] = c; bwS[r] = w; } }
    { const pg8::DenseSched S{(const char*)ycat, (const char*)Wt_out, 64, 4, G, bid, (size_t)256 * 2048, (size_t)256 * 2048};
      const pg8::EpiResStats E{x, out, x1b, stats1, ALPHA}; pg8::gemm_phase(tid, ldsp, pg8::Gemm{1024, 1024, 1024}, S, E); }
    PHASE_END
    PHASE_BEGIN
    {   struct SchedS { const char *z, *mt; int G, c;
            __device__ __forceinline__ bool next(int i, pg8::Unit& u) const { const int L = i * G + c; if (L >= 256) return false; pg8::tile_of(L, 64, 4, u.pm, u.pn); u.kind = 0; u.aux = u.pm >> 5;
                u.A = z + (size_t)u.pm * 256 * 2048; u.B = mt + ((size_t)u.aux * 1024 * 1024 + (size_t)u.pn * 256 * 1024) * 2; return true; } };
        const SchedS S{(const char*)x1b, (const char*)MT, G, bid};
        const pg8::EpiSoftmaxLn E{Pb2, (PG8_LAS float*)(ldsp + 131072), stats1, csS, bwS};
        pg8::gemm_phase(tid, ldsp, pg8::Gemm{1024, 1024, 1024}, S, E);
    }
    PHASE_END
    PHASE_BEGIN
    {   struct SchedN { const char *P, *nt; int G, c;
            __device__ __forceinline__ bool next(int i, pg8::Unit& u) const { const int L = i * G + c; if (L >= 256) return false; pg8::tile_of(L, 64, 4, u.pm, u.pn); u.kind = 0; u.aux = u.pm >> 5;
                u.A = P + (size_t)u.pm * 256 * 2048; u.B = nt + ((size_t)u.aux * 1024 * 1024 + (size_t)u.pn * 256 * 1024) * 2; return true; } };
        const SchedN S{(const char*)Pb2, (const char*)NT, G, bid};
        const pg8::EpiResLn E{out, x1b, stats1, g_ln1, b_ln1, ALPHA}; pg8::gemm_phase(tid, ldsp, pg8::Gemm{1024, 1024, 1024}, S, E);
    }
    PHASE_END
    const int TPB = (T + G - 1) / G;
    PHASE_BEGIN
    { const int t0 = bid * TPB, t1 = (t0 + TPB < T) ? t0 + TPB : T;
      float* Wl = ldsf;
      int* le = (int*)(lds_raw + 81920);
      for (int k = tid; k < D; k += 512) { const f32x4 wg = *(const f32x4*)(w_group + (size_t)k * 4);
          Wl[0 * D + k] = wg.x; Wl[1 * D + k] = wg.y; Wl[2 * D + k] = wg.z; Wl[3 * D + k] = wg.w;
#pragma unroll
          for (int gq = 0; gq < 4; ++gq) { const f32x4 wr = *(const f32x4*)(w_router + ((size_t)gq * D + k) * 4);
              Wl[(4 + gq * 4 + 0) * D + k] = wr.x; Wl[(4 + gq * 4 + 1) * D + k] = wr.y; Wl[(4 + gq * 4 + 2) * D + k] = wr.z; Wl[(4 + gq * 4 + 3) * D + k] = wr.w; } }
      __syncthreads();
      const int TPW = (TPB + 7) / 8;
      const int mend = (t0 + (wave + 1) * TPW < t1) ? t0 + (wave + 1) * TPW : t1;
      f32x4 raw[2][4];
      { const int mb0 = t0 + wave * TPW; if (mb0 < mend) { ld_row(out + (size_t)mb0 * D, raw[0], lane); ld_row(out + (size_t)((mb0 + 1 < mend) ? mb0 + 1 : mb0) * D, raw[1], lane); } }
      for (int mb = t0 + wave * TPW; mb < mend; mb += 2) {
        f32x4 v[2][4];
        const bool has1 = (mb + 1 < mend);
#pragma unroll
        for (int jj = 0; jj < 4; ++jj) { v[0][jj] = raw[0][jj]; v[1][jj] = raw[1][jj]; }
        if (mb + 2 < mend) { ld_row(out + (size_t)(mb + 2) * D, raw[0], lane); ld_row(out + (size_t)((mb + 3 < mend) ? mb + 3 : mb + 2) * D, raw[1], lane); }
        ln_regs(v[0], g_ln2, b_ln2, lane);
        st_row_bf16(x2b + (size_t)mb * D, v[0], lane);
        ln_regs(v[1], g_ln2, b_ln2, lane);
        if (has1) st_row_bf16(x2b + (size_t)(mb + 1) * D, v[1], lane);
        float my[20];
#pragma unroll
        for (int c = 0; c < 20; ++c) {
            float a0 = 0.f, a1 = 0.f;
#pragma unroll
            for (int jj = 0; jj < 4; ++jj) { const f32x4 w4 = ((const f32x4*)(Wl + c * D))[lane + 64 * jj];
                a0 += (v[0][jj].x * w4.x + v[0][jj].y * w4.y) + (v[0][jj].z * w4.z + v[0][jj].w * w4.w);
                a1 += (v[1][jj].x * w4.x + v[1][jj].y * w4.y) + (v[1][jj].z * w4.z + v[1][jj].w * w4.w); }
            a0 = wave_sum(a0); a1 = wave_sum(a1);
            my[c] = (lane == 1) ? a1 : a0;
        }
        const int m = mb + lane;
        if (lane < 2 && m < mend) {
            float gl[4]; int gi = 0; float gmx = -INFINITY;
#pragma unroll
            for (int i = 0; i < 4; ++i) { gl[i] = my[i] + b_group[i]; if (gl[i] > gmx) { gmx = gl[i]; gi = i; } }
            float gs = 0.f;
#pragma unroll
            for (int i = 0; i < 4; ++i) gs += __expf(gl[i] - gmx);
            const float gp = 1.f / gs;
            float el[4];
#pragma unroll
            for (int i = 0; i < 4; ++i) { float a = my[4 + i], bq = b_router[i];
                a = (gi == 1) ? my[8 + i] : a; a = (gi == 2) ? my[12 + i] : a; a = (gi == 3) ? my[16 + i] : a;
                bq = (gi == 1) ? b_router[4 + i] : bq; bq = (gi == 2) ? b_router[8 + i] : bq; bq = (gi == 3) ? b_router[12 + i] : bq;
                el[i] = a + bq; }
            int i0 = 0; float v0 = el[0];
#pragma unroll
            for (int i = 1; i < 4; ++i) if (el[i] > v0) { v0 = el[i]; i0 = i; }
            int i1 = -1; float v1 = -INFINITY;
#pragma unroll
            for (int i = 0; i < 4; ++i) if (i != i0 && el[i] > v1) { v1 = el[i]; i1 = i; }
            const float w0 = 1.f / (1.f + __expf(v1 - v0)), w1 = 1.f - w0;
            route_e[2 * m] = gi * 4 + i0; route_e[2 * m + 1] = gi * 4 + i1; route_g[2 * m] = gp * w0; route_g[2 * m + 1] = gp * w1;
            le[2 * (m - t0)] = gi * 4 + i0; le[2 * (m - t0) + 1] = gi * 4 + i1;
        }
      }
      __syncthreads();
      const int np = 2 * (t1 - t0);
      for (int i = tid; i < np; i += 512) { const int e = le[i]; int r = 0; for (int j2 = 0; j2 < i; ++j2) r += (le[j2] == e) ? 1 : 0; rank[2 * t0 + i] = r; }
      if (tid < 16) { int c = 0; for (int j2 = 0; j2 < np; ++j2) c += (le[j2] == tid) ? 1 : 0; blkcnt[bid * 16 + tid] = c; }
    }
    PHASE_END
    PHASE_BEGIN
    {
        int* sh = (int*)lds_raw;
        const int t0 = bid * TPB, t1 = (t0 + TPB < T) ? t0 + TPB : T, np = 2 * (t1 - t0);
        int my_e = 0, my_r = 0; float my_g = 0.f;
        if (tid < np) { const int pi = 2 * t0 + tid; my_e = route_e[pi]; my_r = rank[pi]; my_g = route_g[pi]; }
        { const int e = tid & 15, part = tid >> 4; int tot = 0, base = 0; int cv[8];
#pragma unroll
          for (int q = 0; q < 8; ++q) { const int b = part + 32 * q; cv[q] = (b < G) ? blkcnt[b * 16 + e] : 0; }
#pragma unroll
          for (int q = 0; q < 8; ++q) { const int b = part + 32 * q; tot += cv[q]; if (b < bid) base += cv[q]; }
          for (int b = part + 256; b < G; b += 32) { const int c = blkcnt[b * 16 + e]; tot += c; if (b < bid) base += c; }
          sh[128 + part * 16 + e] = tot; sh[640 + part * 16 + e] = base; }
        __syncthreads();
        if (tid < 16) { int tot = 0, base = 0;
#pragma unroll 8
            for (int part = 0; part < 32; ++part) { tot += sh[128 + part * 16 + tid]; base += sh[640 + part * 16 + tid]; } sh[tid] = base; sh[64 + tid] = tot; }
        __syncthreads();
        if (tid == 0) { int sacc = 0, nF = 0, nH = 0;
            for (int e = 0; e < 16; ++e) { const int n = sh[64 + e], nf = n >> 8, nh = ((n & 255) + 127) >> 7; sh[16 + e] = sacc; sacc += nf * 256 + nh * 128; nF += nf; nH += nh; }
            sh[32] = sacc;
            if (bid == 0) { segw[0] = nF; segw[1] = nH; int tf = 0, th = nF;
                for (int e = 0; e < 16; ++e) { const int n = sh[64 + e], nf = n >> 8, nh = ((n & 255) + 127) >> 7;
                    for (int k = 0; k < nf; ++k) { segw[2 + tf] = sh[16 + e] + 256 * k; segw[2 + 192 + tf] = e; ++tf; }
                    for (int k = 0; k < nh; ++k) { segw[2 + th] = sh[16 + e] + 256 * nf + 128 * k; segw[2 + 192 + th] = e; ++th; } } } }
        __syncthreads();
        if (bid == 0) { for (int e = 0; e < 16; ++e) for (int pos = sh[16 + e] + sh[64 + e] + tid; pos < sh[16 + e + 1]; pos += 512) { pair_tok[pos] = -1; pair_gate[pos] = 0.f; } }
        if (tid < np) { const int pi = 2 * t0 + tid, pos = sh[16 + my_e] + sh[my_e] + my_r; pair_tok[pos] = pi >> 1; pair_gate[pos] = my_g; tokpos[pi] = pos; }
    }
    PHASE_END
    PHASE_BEGIN
    { const SchedMoE S{(const char*)x2b, (const char*)Wt_gu, segw, pair_tok, segw[0], segw[1], G, bid, (size_t)2048, (size_t)1024 * 2048, (size_t)256 * 2048};
      const pg8::EpiGateUp E{Hs, pair_gate}; pg8::gemm_phase<true, true>(tid, ldsp, pg8::Gemm{1024, 1024, 1024}, S, E); }
    PHASE_END
    PHASE_BEGIN
    { const SchedMoE S{(const char*)Hs, (const char*)Wt_dn, segw, nullptr, segw[0], segw[1], G, bid, (size_t)1024, (size_t)1024 * 1024, (size_t)256 * 1024};
      const pg8::EpiY E{Yb}; pg8::gemm_phase<false, true>(tid, ldsp, pg8::Gemm{512, 512, 512}, S, E); }
    PHASE_END
    PHASE_BEGIN
    for (int mbase = gw; mbase < T; mbase += 8 * NGW) {
        int tp = 0;
        if (lane < 16) { const int mm = mbase + (lane >> 1) * NGW; if (mm < T) tp = tokpos[2 * mm + (lane & 1)]; }
        u32x2 xa[4], ya[4], yb[4];
#define P9_LOAD(mm, ii) do { const int p0_ = __builtin_amdgcn_readlane(tp, 2 * (ii)), p1_ = __builtin_amdgcn_readlane(tp, 2 * (ii) + 1); \
        _Pragma("unroll") for (int jj = 0; jj < 4; ++jj) { xa[jj] = ((const u32x2*)(x2b + (size_t)(mm) * D))[lane + 64 * jj]; ya[jj] = ((const u32x2*)(Yb + (size_t)p0_ * D))[lane + 64 * jj]; yb[jj] = ((const u32x2*)(Yb + (size_t)p1_ * D))[lane + 64 * jj]; } } while (0)
        P9_LOAD(mbase, 0);
        for (int i = 0; i < 8; ++i) { const int m = mbase + i * NGW; if (m >= T) break;
            f32x4 v[4]; float sacc = 0.f;
#pragma unroll
            for (int jj = 0; jj < 4; ++jj) { f32x4 z;
                z.x = bflo(xa[jj].x) * ALPHA + (bflo(ya[jj].x) + bflo(yb[jj].x)); z.y = bfhi(xa[jj].x) * ALPHA + (bfhi(ya[jj].x) + bfhi(yb[jj].x));
                z.z = bflo(xa[jj].y) * ALPHA + (bflo(ya[jj].y) + bflo(yb[jj].y)); z.w = bfhi(xa[jj].y) * ALPHA + (bfhi(ya[jj].y) + bfhi(yb[jj].y)); v[jj] = z; sacc += (z.x + z.y) + (z.z + z.w); }
            if (i + 1 < 8 && m + NGW < T) P9_LOAD(m + NGW, i + 1);
            const float mean = wave_sum(sacc) * (1.f / D); float s2 = 0.f;
#pragma unroll
            for (int jj = 0; jj < 4; ++jj) { v[jj] = v[jj] - mean; s2 += (v[jj].x * v[jj].x + v[jj].y * v[jj].y) + (v[jj].z * v[jj].z + v[jj].w * v[jj].w); }
            const float rstd = 1.f / sqrtf(wave_sum(s2) * (1.f / D) + LN_EPS);
            float* row = out + (size_t)m * D;
#pragma unroll
            for (int jj = 0; jj < 4; ++jj) { const f32x4 gg = ((const f32x4*)g_ln3)[lane + 64 * jj], bb = ((const f32x4*)b_ln3)[lane + 64 * jj]; ((f32x4*)row)[lane + 64 * jj] = v[jj] * rstd * gg + bb; } }
#undef P9_LOAD
    }
    PHASE_END
    if (PROBE_T >= 0 && blockIdx.x == 0) { const unsigned long long tend = __builtin_amdgcn_s_memrealtime() + 9ull * tprobe; while (__builtin_amdgcn_s_memrealtime() < tend) __builtin_amdgcn_s_sleep(8); }
}

constexpr int N_PHASES = 16;
constexpr int LDS_BYTES = 147456;

extern "C" void kernel_launch(void* const* d_in, const int* in_sizes, int n_in, void* d_out, int out_size, void* d_ws, size_t ws_size, hipStream_t stream) {
    static int grid = 0;
    if (grid == 0) {
        int dev = 0, cus = 0, per_cu = 0;
        hipGetDevice(&dev);
        hipDeviceGetAttribute(&cus, hipDeviceAttributeMultiprocessorCount, dev);
        hipFuncSetAttribute((const void*)fwd_kernel, hipFuncAttributeMaxDynamicSharedMemorySize, LDS_BYTES);
        hipOccupancyMaxActiveBlocksPerMultiprocessor(&per_cu, (const void*)fwd_kernel, 512, LDS_BYTES);
        if (per_cu < 1) { fprintf(stderr, "occupancy query returned %d\n", per_cu); per_cu = 1; }
        grid = cus * 1;
        if (ws_size < WS_END) { fprintf(stderr, "workspace too small\n"); grid = -1; }
    }
    if (grid < 0) return;
    if (hipMemsetAsync((char*)d_ws + WS_CTL, 0, 65536, stream) != hipSuccess) { fprintf(stderr, "memset failed\n"); return; }
    Params p{};
    for (int i = 0; i < 26; ++i) p.in[i] = (const float*)d_in[i];
    p.out = (float*)d_out; p.ws = (unsigned char*)d_ws;
#if MK_N_LAUNCHES == 1
    p.ph_lo = 0; p.ph_hi = 64;
    void* args[] = {&p};
    hipError_t e = hipLaunchCooperativeKernel((const void*)fwd_kernel, dim3(grid), dim3(512), args, LDS_BYTES, stream);
    if (e != hipSuccess) fprintf(stderr, "cooperative launch failed: %s (grid %d)\n", hipGetErrorString(e), grid);
#else
    for (int ph = 0; ph < N_PHASES; ++ph) { p.ph_lo = ph; p.ph_hi = ph + 1; hipLaunchKernelGGL(fwd_kernel, dim3(grid), dim3(512), LDS_BYTES, stream, p); }
#endif
}
```

```cpp
#include <hip/hip_runtime.h>
#include <hip/hip_cooperative_groups.h>
#include <cstdio>
#include <cstdint>
namespace cg = cooperative_groups;

#ifndef PROBE_MASK
#define PROBE_MASK 0
#endif
#ifndef PROBE_T
#define PROBE_T -1
#endif
#ifndef MK_N_LAUNCHES
#define MK_N_LAUNCHES 1
#endif

typedef unsigned short bf16;
typedef float f32x4 __attribute__((ext_vector_type(4)));
typedef unsigned u32x4 __attribute__((ext_vector_type(4)));
typedef unsigned u32x2 __attribute__((ext_vector_type(2)));

constexpr int BATCH = 2, SEQ = 8192, D = 1024, T = BATCH * SEQ, MEM = 256, NMEM = BATCH * MEM;
constexpr int CONV_CH = 512, CONV_W = 31, NH = 8, NKV = 2, HD = 64, ATTN_W = 512, KV_W = 128, WINDOW = 128;
constexpr int D_IN = 1792, MH = 4, MHD = 256, NG = 4, EPG = 4, NE = 16, DE = 512;
constexpr float ALPHA = 1.189207115002721f, LN_EPS = 1e-5f;
constexpr int NPAIR = 2 * T, NPAIR_PAD = NPAIR + NE * 256;
constexpr int LDS_BYTES_K = 147456;

constexpr size_t MiB = 1u << 20;
constexpr size_t WS_CTL = 0;
constexpr size_t WS_ROUTE = 1 * MiB;
constexpr size_t WS_BLKCNT = 1 * MiB + 512 * 1024;
constexpr size_t WS_SEG = 1 * MiB + 640 * 1024;
constexpr size_t WS_RANK = 2 * MiB;
constexpr size_t WS_PTOK = 2 * MiB + 256 * 1024;
constexpr size_t WS_PGATE = 2 * MiB + 512 * 1024;
constexpr size_t WS_TOKPOS = 2 * MiB + 768 * 1024;
constexpr size_t WS_KVM = 3 * MiB;
constexpr size_t WS_MEMB = 5 * MiB;
constexpr size_t WS_A = 8 * MiB;
constexpr size_t WS_B = 48 * MiB;
constexpr size_t WS_DD = 88 * MiB;
constexpr size_t WS_WIN = 164 * MiB;
constexpr size_t WS_WOUT = 168 * MiB, WS_WMQ = 170 * MiB, WS_WMKV = 172 * MiB, WS_WMO = 176 * MiB;
constexpr size_t WS_WGU = 178 * MiB;
constexpr size_t WS_WDN = 210 * MiB;
constexpr size_t WS_ST1 = 226 * MiB;
constexpr size_t WS_CS1 = 128 * 1024;
constexpr size_t WS_MT = 228 * MiB;
constexpr size_t WS_NT = 232 * MiB;
constexpr size_t WS_CSS = 192 * 1024;
constexpr size_t WS_CSP = 256 * 1024;
constexpr size_t WS_END = 236 * MiB;

struct Params { const float* in[26]; float* out; unsigned char* ws; int ph_lo, ph_hi; };

__device__ __forceinline__ unsigned f2bf(float f) { unsigned u = __builtin_bit_cast(unsigned, f); return (u + 0x7fffu + ((u >> 16) & 1u)) >> 16; }
__device__ __forceinline__ float bf2f(bf16 b) { return __builtin_bit_cast(float, (unsigned)b << 16); }
__device__ __forceinline__ unsigned pk2(float lo, float hi) { return f2bf(lo) | (f2bf(hi) << 16); }
template <int CTRL, int ROWMASK> __device__ __forceinline__ float dpp_f(float v) { return __builtin_bit_cast(float, __builtin_amdgcn_update_dpp(0, __builtin_bit_cast(int, v), CTRL, ROWMASK, 0xF, false)); }
__device__ __forceinline__ float wave_sum(float v) {
    v += dpp_f<0xB1, 0xF>(v);
    v += dpp_f<0x4E, 0xF>(v);
    v += dpp_f<0x141, 0xF>(v);
    v += dpp_f<0x140, 0xF>(v);
    v += dpp_f<0x142, 0xA>(v);
    v += dpp_f<0x143, 0xC>(v);
    return __builtin_bit_cast(float, __builtin_amdgcn_readlane(__builtin_bit_cast(int, v), 63));
}
__device__ __forceinline__ float wave_max(float v) {
    v = fmaxf(v, __builtin_bit_cast(float, __builtin_amdgcn_update_dpp(__builtin_bit_cast(int, v), __builtin_bit_cast(int, v), 0xB1, 0xF, 0xF, false)));
    v = fmaxf(v, __builtin_bit_cast(float, __builtin_amdgcn_update_dpp(__builtin_bit_cast(int, v), __builtin_bit_cast(int, v), 0x4E, 0xF, 0xF, false)));
    v = fmaxf(v, __builtin_bit_cast(float, __builtin_amdgcn_update_dpp(__builtin_bit_cast(int, v), __builtin_bit_cast(int, v), 0x141, 0xF, 0xF, false)));
    v = fmaxf(v, __builtin_bit_cast(float, __builtin_amdgcn_update_dpp(__builtin_bit_cast(int, v), __builtin_bit_cast(int, v), 0x140, 0xF, 0xF, false)));
    v = fmaxf(v, __builtin_bit_cast(float, __builtin_amdgcn_update_dpp(__builtin_bit_cast(int, v), __builtin_bit_cast(int, v), 0x142, 0xA, 0xF, false)));
    v = fmaxf(v, __builtin_bit_cast(float, __builtin_amdgcn_update_dpp(__builtin_bit_cast(int, v), __builtin_bit_cast(int, v), 0x143, 0xC, 0xF, false)));
    return __builtin_bit_cast(float, __builtin_amdgcn_readlane(__builtin_bit_cast(int, v), 63));
}
__device__ __forceinline__ int lane_fresh() { int l; asm volatile("v_mbcnt_lo_u32_b32 %0, -1, 0\n\tv_mbcnt_hi_u32_b32 %0, -1, %0" : "=v"(l)); return l; }
__device__ __forceinline__ float ldA(const bf16* p) { return bf2f(*p); }
__device__ __forceinline__ float ldA(const float* p) { return *p; }

template <int NB, class FA, class FB, class FE>
__device__ __forceinline__ void ngemm_tile(int tid, float* lds, int K, int m0, int n0, FA fa, FB fb, FE fe) {
    float* As = lds;
    float* Bs = lds + 16 * 132;
    const int ty = tid >> 4, tx = tid & 15;
    float acc[NB][4][4];
#pragma unroll
    for (int b = 0; b < NB; ++b)
#pragma unroll
        for (int i = 0; i < 4; ++i)
#pragma unroll
            for (int j = 0; j < 4; ++j) acc[b][i][j] = 0.f;
    for (int k0 = 0; k0 < K; k0 += 16) {
        { const int r = tid >> 2, kk = (tid & 3) * 4;
#pragma unroll
            for (int i = 0; i < 4; ++i) As[(kk + i) * 132 + r] = fa(m0 + r, k0 + kk + i); }
#pragma unroll
        for (int b = 0; b < NB; ++b) { const int kk = tid >> 5, nn = (tid & 31) * 2;
            Bs[(b * 16 + kk) * 68 + nn] = fb(b, k0 + kk, n0 + nn); Bs[(b * 16 + kk) * 68 + nn + 1] = fb(b, k0 + kk, n0 + nn + 1); }
        __syncthreads();
#pragma unroll 4
        for (int k = 0; k < 16; ++k) {
            const f32x4 a = *(const f32x4*)&As[k * 132 + ty * 4];
#pragma unroll
            for (int b = 0; b < NB; ++b) { const f32x4 bb = *(const f32x4*)&Bs[(b * 16 + k) * 68 + tx * 4];
#pragma unroll
                for (int i = 0; i < 4; ++i)
#pragma unroll
                    for (int j = 0; j < 4; ++j) acc[b][i][j] += a[i] * bb[j]; }
        }
        __syncthreads();
    }
#pragma unroll
    for (int i = 0; i < 4; ++i)
#pragma unroll
        for (int j = 0; j < 4; ++j) fe(m0 + ty * 4 + i, n0 + tx * 4 + j, acc[0][i][j], acc[NB - 1][i][j]);
}

__device__ __forceinline__ void ln_row(const float* src, const float* g, const float* b, f32x4 (&v)[4], int lane) {
    const f32x4* xr = (const f32x4*)src + lane; float s = 0.f;
#pragma unroll
    for (int j = 0; j < 4; ++j) { v[j] = xr[64 * j]; s += (v[j].x + v[j].y) + (v[j].z + v[j].w); }
    const float mean = wave_sum(s) * (1.f / D); float s2 = 0.f;
#pragma unroll
    for (int j = 0; j < 4; ++j) { v[j] = v[j] - mean; s2 += (v[j].x * v[j].x + v[j].y * v[j].y) + (v[j].z * v[j].z + v[j].w * v[j].w); }
    const float rstd = 1.f / sqrtf(wave_sum(s2) * (1.f / D) + LN_EPS);
#pragma unroll
    for (int j = 0; j < 4; ++j) { const f32x4 gg = ((const f32x4*)g)[lane + 64 * j], bb = ((const f32x4*)b)[lane + 64 * j]; v[j] = v[j] * rstd * gg + bb; }
}
__device__ __forceinline__ void ld_row(const float* src, f32x4 (&v)[4], int lane) {
#pragma unroll
    for (int j = 0; j < 4; ++j) v[j] = ((const f32x4*)src)[lane + 64 * j];
}
__device__ __forceinline__ void ln_regs(f32x4 (&v)[4], const float* g, const float* b, int lane) {
    float s = 0.f;
#pragma unroll
    for (int j = 0; j < 4; ++j) s += (v[j].x + v[j].y) + (v[j].z + v[j].w);
    const float mean = wave_sum(s) * (1.f / D); float s2 = 0.f;
#pragma unroll
    for (int j = 0; j < 4; ++j) { v[j] = v[j] - mean; s2 += (v[j].x * v[j].x + v[j].y * v[j].y) + (v[j].z * v[j].z + v[j].w * v[j].w); }
    const float rstd = 1.f / sqrtf(wave_sum(s2) * (1.f / D) + LN_EPS);
#pragma unroll
    for (int j = 0; j < 4; ++j) { const f32x4 gg = ((const f32x4*)g)[lane + 64 * j], bb = ((const f32x4*)b)[lane + 64 * j]; v[j] = v[j] * rstd * gg + bb; }
}
__device__ __forceinline__ void st_row_f32(float* dst, const f32x4 (&v)[4], float scale, int lane) {
#pragma unroll
    for (int j = 0; j < 4; ++j) ((f32x4*)dst)[lane + 64 * j] = v[j] * scale;
}
__device__ __forceinline__ void st_row_bf16(bf16* dst, const f32x4 (&v)[4], int lane) {
#pragma unroll
    for (int j = 0; j < 4; ++j) { u32x2 w; w.x = pk2(v[j].x, v[j].y); w.y = pk2(v[j].z, v[j].w); ((u32x2*)dst)[lane + 64 * j] = w; }
}


namespace pg8 {
#define PG8_LAS __attribute__((address_space(3)))
typedef unsigned short bf16_t;
typedef short bf16x8 __attribute__((ext_vector_type(8)));
constexpr int BM = 256, BK = 64, HALF = 128, HTB = HALF * BK * 2, STAGE_BYTES = 8 * HTB, NXCD = 8, WGM = 8;
__device__ __forceinline__ int lds_byte(int r, int c) { const int st = (r >> 4) * 2 + (c >> 5), rr = r & 15, cc = c & 31, ob = rr * 64 + cc * 2; return st * 1024 + (ob ^ (((ob >> 9) & 1) << 5)); }
__device__ __forceinline__ void stage_rc(int b, int& R, int& C) { const int st = b / 1024, sb = b % 1024, swz = sb ^ (((sb >> 9) & 1) << 5); R = (st >> 1) * 16 + swz / 64; C = (st & 1) * 32 + (swz % 64) / 2; }
__device__ __forceinline__ int perm32(int rho) { const int n = rho >> 4, i = rho & 15; return 8 * (i >> 2) + 4 * n + (i & 3); }
struct Unit { const char* A; const char* B; const int* rows; int pm, pn, kind, aux, rb, half; };
struct Gemm { int lda, ldb, K; };
__device__ __forceinline__ void tile_of(int L, int nM, int nN, int& pm, int& pn) {
    const int nwg = nM * nN; int wgid = L; { const int q = nwg / NXCD, r = nwg % NXCD, xcd = wgid % NXCD, off = wgid / NXCD; wgid = (xcd < r ? xcd * (q + 1) : r * (q + 1) + (xcd - r) * q) + off; }
    const int nig = WGM * nN, gid = wgid / nig, fm = gid * WGM, gsz = (nM - fm) < WGM ? (nM - fm) : WGM;
    pm = fm + ((wgid % nig) % gsz); pn = (wgid % nig) / gsz;
}
__device__ __forceinline__ unsigned cvt_pk_bf16(float lo, float hi) { unsigned r; asm volatile("v_cvt_pk_bf16_f32 %0, %1, %2" : "=v"(r) : "v"(lo), "v"(hi)); return r; }

template <bool GATHER = false, bool HALFU = false, class Epi, class Sched>
__device__ __forceinline__ void gemm_phase(int tid, PG8_LAS unsigned char* lds, const Gemm g, const Sched& S, const Epi& E) {
    const int wid = __builtin_amdgcn_readfirstlane(tid >> 6), lane = tid & 63, wr = wid >> 2, wc = wid & 3, fr = lane & 15, fq = lane >> 4;
    const int K = g.K, nt = K / BK;
    unsigned voffA[2], voffB[2]; int gR[2]; unsigned gC[2];
#pragma unroll
    for (int i = 0; i < 2; ++i) { int R, C; stage_rc(tid * 16 + i * 8192, R, C); const int Rb = Epi::PERM ? ((R & ~31) + perm32(R & 31)) : R;
        voffA[i] = (unsigned)(R * g.lda + C) * 2u; voffB[i] = (unsigned)(Rb * g.ldb + C) * 2u; gR[i] = R; gC[i] = (unsigned)C * 2u; }
    unsigned vgc[2][2], vgn[2][2];
    const size_t kstep = (size_t)(BK * 2);
    const size_t hstepA = (size_t)HALF * g.lda * 2, hstepB = (size_t)HALF * g.ldb * 2;
    const unsigned ldsw = (unsigned)wid * 1024u;
    const int aoff = lds_byte(wr * 64 + fr, fq * 8), boff = lds_byte(wc * 32 + fr, fq * 8);
#define PG8_SA(b, h) (((b) * 2 + (h)) * HTB)
#define PG8_SB(b, h) ((4 + (b) * 2 + (h)) * HTB)
#define PG8_STAGE(bufoff, gbase, voff) do { _Pragma("unroll") for (int _i = 0; _i < 2; ++_i) \
        __builtin_amdgcn_global_load_lds((const unsigned*)((const char*)(gbase) + (voff)[_i]), (PG8_LAS unsigned*)(lds + (bufoff) + ldsw + _i * 8192), 16, 0, 0); } while (0)
#define PG8_GOFF(dst, rows) do { _Pragma("unroll") for (int _h = 0; _h < 2; ++_h) _Pragma("unroll") for (int _i = 0; _i < 2; ++_i) { int _t = (rows)[_h * HALF + gR[_i]]; _t = _t < 0 ? 0 : _t; dst[_h][_i] = (unsigned)_t * (unsigned)(g.lda * 2) + gC[_i]; } } while (0)
#define PG8_STAGE_A(bufoff, h, kptr, useNext) do { if constexpr (GATHER) { unsigned _v[2]; _v[0] = (useNext) ? vgn[h][0] : vgc[h][0]; _v[1] = (useNext) ? vgn[h][1] : vgc[h][1]; PG8_STAGE(bufoff, kptr, _v); } \
        else { PG8_STAGE(bufoff, (kptr) + (h) * hstepA, voffA); } } while (0)
#define PG8_LDA(dst, b, h) do { _Pragma("unroll") for (int m = 0; m < 4; ++m) _Pragma("unroll") for (int k = 0; k < 2; ++k) dst[m][k] = *(const PG8_LAS bf16x8*)(lds + PG8_SA(b, h) + aoff + m * 2048 + k * 1024); } while (0)
#define PG8_LDB(dst, b, h) do { _Pragma("unroll") for (int n = 0; n < 2; ++n) _Pragma("unroll") for (int k = 0; k < 2; ++k) dst[n][k] = *(const PG8_LAS bf16x8*)(lds + PG8_SB(b, h) + boff + n * 2048 + k * 1024); } while (0)
#define PG8_MMA(ai, bj, At, Bt) do { __builtin_amdgcn_s_setprio(1); _Pragma("unroll") for (int m = 0; m < 4; ++m) _Pragma("unroll") for (int n = 0; n < 2; ++n) _Pragma("unroll") for (int k = 0; k < 2; ++k) \
        acc[ai][bj][m][n] = __builtin_amdgcn_mfma_f32_16x16x32_bf16(Bt[n][k], At[m][k], acc[ai][bj][m][n], 0, 0, 0); __builtin_amdgcn_s_setprio(0); } while (0)
#define PG8_WAIT_V(n) asm volatile("s_waitcnt vmcnt(" #n ")" ::: "memory")
#define PG8_WAIT_L(n) asm volatile("s_waitcnt lgkmcnt(" #n ")" ::: "memory")
#define PG8_BAR __builtin_amdgcn_s_barrier()
#define PG8_SCHED __builtin_amdgcn_sched_barrier(0)
    Unit cur, nxt; int ui = 0;
    if (!S.next(0, cur)) return;
    f32x4 acc[2][2][4][2];
#pragma unroll
    for (int a = 0; a < 2; ++a)
#pragma unroll
        for (int b = 0; b < 2; ++b)
#pragma unroll
            for (int m = 0; m < 4; ++m)
#pragma unroll
                for (int n = 0; n < 2; ++n) acc[a][b][m][n] = (f32x4){0.f, 0.f, 0.f, 0.f};
    bf16x8 At[4][2], B0[2][2], B1[2][2];
    const char* cA = cur.A; const char* cB = cur.B;
    if constexpr (GATHER) { PG8_GOFF(vgc, cur.rows); }
    PG8_STAGE(PG8_SB(0, 0), cB, voffB); PG8_STAGE(PG8_SB(0, 1), cB + hstepB, voffB); PG8_STAGE_A(PG8_SA(0, 0), 0, cA, false); PG8_STAGE_A(PG8_SA(0, 1), 1, cA, false);
    if (wr == 1) PG8_BAR;
    PG8_WAIT_V(2); PG8_BAR;
    PG8_STAGE(PG8_SB(1, 0), cB + kstep, voffB); PG8_STAGE_A(PG8_SA(1, 0), 0, cA + kstep, false); PG8_STAGE(PG8_SB(1, 1), cB + hstepB + kstep, voffB);
    PG8_WAIT_V(6); PG8_BAR;
    for (;;) {
        const bool has_next = S.next(ui + 1, nxt);
        const char* nA = has_next ? nxt.A : cA; const char* nB = has_next ? nxt.B : cB;
        if constexpr (GATHER) { if (has_next) { PG8_GOFF(vgn, nxt.rows); asm volatile("" : "+v"(vgn[0][0]), "+v"(vgn[0][1]), "+v"(vgn[1][0]), "+v"(vgn[1][1]));   } else { _Pragma("unroll") for (int _h = 0; _h < 2; ++_h) { vgn[_h][0] = vgc[_h][0]; vgn[_h][1] = vgc[_h][1]; } } }
        for (int t = 0; t < nt; t += 2) {
            const bool last = (t == nt - 2);
            const char* a1 = cA + (size_t)(t + 1) * kstep;
            const char* a2 = last ? nA : cA + (size_t)(t + 2) * kstep; const char* b2 = last ? nB : cB + (size_t)(t + 2) * kstep;
            const char* a3 = a2 + kstep; const char* b3 = b2 + kstep;
            PG8_LDB(B0, 0, 0); PG8_LDB(B1, 0, 1); PG8_SCHED; PG8_LDA(At, 0, 0); PG8_STAGE_A(PG8_SA(1, 1), 1, a1, false);
            PG8_WAIT_V(8); PG8_WAIT_L(0); PG8_BAR; PG8_MMA(0, 0, At, B0); PG8_MMA(0, 1, At, B1); PG8_BAR; PG8_SCHED;
            PG8_LDA(At, 0, 1); PG8_STAGE(PG8_SB(0, 0), b2, voffB); PG8_STAGE(PG8_SB(0, 1), b2 + hstepB, voffB); PG8_STAGE_A(PG8_SA(0, 0), 0, a2, last);
            PG8_WAIT_V(8); PG8_WAIT_L(0); PG8_BAR; if (!HALFU || !cur.half) { PG8_MMA(1, 0, At, B0); PG8_MMA(1, 1, At, B1); } PG8_BAR; PG8_SCHED;
            PG8_LDB(B0, 1, 0); PG8_LDB(B1, 1, 1); PG8_SCHED; PG8_LDA(At, 1, 0); PG8_STAGE_A(PG8_SA(0, 1), 1, a2, last);
            PG8_WAIT_V(8); PG8_WAIT_L(0); PG8_BAR; PG8_MMA(0, 0, At, B0); PG8_MMA(0, 1, At, B1); PG8_BAR; PG8_SCHED;
            PG8_LDA(At, 1, 1); PG8_STAGE(PG8_SB(1, 0), b3, voffB); PG8_STAGE(PG8_SB(1, 1), b3 + hstepB, voffB); PG8_STAGE_A(PG8_SA(1, 0), 0, a3, last);
            PG8_WAIT_V(8); PG8_WAIT_L(0); PG8_BAR; if (!HALFU || !cur.half) { PG8_MMA(1, 0, At, B0); PG8_MMA(1, 1, At, B1); } PG8_BAR; PG8_SCHED;
        }
        if (wr == 0) PG8_BAR;
        E(acc, cur, wr, wc, fr, fq);
        if (!has_next) break;
#pragma unroll
        for (int a = 0; a < 2; ++a)
#pragma unroll
            for (int b = 0; b < 2; ++b)
#pragma unroll
                for (int m = 0; m < 4; ++m)
#pragma unroll
                    for (int n = 0; n < 2; ++n) acc[a][b][m][n] = (f32x4){0.f, 0.f, 0.f, 0.f};
        cur = nxt; cA = nA; cB = nB; ++ui;
        if constexpr (GATHER) { _Pragma("unroll") for (int _h = 0; _h < 2; ++_h) { vgc[_h][0] = vgn[_h][0]; vgc[_h][1] = vgn[_h][1]; } }
        if (wr == 1) PG8_BAR;
    }
    PG8_WAIT_V(0);
    PG8_BAR;
#undef PG8_SA
#undef PG8_SB
#undef PG8_STAGE
#undef PG8_LDA
#undef PG8_GOFF
#undef PG8_STAGE_A
#undef PG8_LDB
#undef PG8_MMA
#undef PG8_WAIT_V
#undef PG8_WAIT_L
#undef PG8_BAR
#undef PG8_SCHED
}

__device__ __forceinline__ u32x4 pack8(const f32x4 v0, const f32x4 v1) { u32x4 w; w.x = cvt_pk_bf16(v0[0], v0[1]); w.y = cvt_pk_bf16(v0[2], v0[3]); w.z = cvt_pk_bf16(v1[0], v1[1]); w.w = cvt_pk_bf16(v1[2], v1[3]); return w; }
__device__ __forceinline__ float sigm(float g) { return __builtin_amdgcn_rcpf(1.f + __expf(-g)); }

struct EpiBf16 {
    static constexpr bool PERM = true;
    bf16_t* O; int ldc; const float* bias;
    __device__ __forceinline__ void operator()(const f32x4 (&acc)[2][2][4][2], const Unit& u, int wr, int wc, int fr, int fq) const {
        const int row0 = u.pm * BM + wr * 64 + fr, col0 = u.pn * BM + wc * 32 + 8 * fq;
        f32x4 bv[2][2];
#pragma unroll
        for (int bj = 0; bj < 2; ++bj)
#pragma unroll
            for (int n = 0; n < 2; ++n) bv[bj][n] = bias ? *(const f32x4*)(bias + col0 + bj * HALF + 4 * n) : (f32x4){0.f, 0.f, 0.f, 0.f};
#pragma unroll
        for (int ai = 0; ai < 2; ++ai)
#pragma unroll
            for (int m = 0; m < 4; ++m) { bf16_t* rowp = O + (size_t)(row0 + ai * HALF + m * 16) * ldc + col0;
#pragma unroll
                for (int bj = 0; bj < 2; ++bj) *(u32x4*)(rowp + bj * HALF) = pack8(acc[ai][bj][m][0] + bv[bj][0], acc[ai][bj][m][1] + bv[bj][1]); }
    }
};
struct EpiP1 {
    static constexpr bool PERM = true;
    bf16_t *hglu, *qkv, *kvm; const float* b_in;
    __device__ __forceinline__ void operator()(const f32x4 (&acc)[2][2][4][2], const Unit& u, int wr, int wc, int fr, int fq) const {
        if (u.kind == 0) {
            const int row0 = u.pm * BM + wr * 64 + fr, cb = u.pn * 128 + wc * 32 + 8 * fq;
            f32x4 ba[2], bg[2];
#pragma unroll
            for (int n = 0; n < 2; ++n) { ba[n] = *(const f32x4*)(b_in + cb + 4 * n); bg[n] = *(const f32x4*)(b_in + 512 + cb + 4 * n); }
#pragma unroll
            for (int ai = 0; ai < 2; ++ai)
#pragma unroll
                for (int m = 0; m < 4; ++m) { f32x4 h[2];
#pragma unroll
                    for (int n = 0; n < 2; ++n) { const f32x4 a = acc[ai][0][m][n] + ba[n], gt = acc[ai][1][m][n] + bg[n];
                        h[n] = (f32x4){a[0] * sigm(gt[0]), a[1] * sigm(gt[1]), a[2] * sigm(gt[2]), a[3] * sigm(gt[3])}; }
                    *(u32x4*)(hglu + (size_t)(row0 + ai * HALF + m * 16) * 512 + cb) = pack8(h[0], h[1]); }
        } else if (u.kind == 1) { EpiBf16 e{qkv - 1024, 768, b_in}; e(acc, u, wr, wc, fr, fq);
        } else { EpiBf16 e{kvm, 2048, nullptr}; e(acc, u, wr, wc, fr, fq); }
    }
};
struct EpiResF32 {
    static constexpr bool PERM = false;
    const float* res; float* out; float alpha;
    __device__ __forceinline__ void operator()(const f32x4 (&acc)[2][2][4][2], const Unit& u, int wr, int wc, int fr, int fq) const {
        const int row0 = u.pm * BM + wr * 64 + fr, col0 = u.pn * BM + wc * 32 + 4 * fq;
#pragma unroll
        for (int ai = 0; ai < 2; ++ai)
#pragma unroll
            for (int m = 0; m < 4; ++m) { const size_t off = (size_t)(row0 + ai * HALF + m * 16) * 1024 + col0;
#pragma unroll
                for (int bj = 0; bj < 2; ++bj)
#pragma unroll
                    for (int n = 0; n < 2; ++n) { const f32x4 r = *(const f32x4*)(res + off + bj * HALF + n * 16); *(f32x4*)(out + off + bj * HALF + n * 16) = r * alpha + acc[ai][bj][m][n]; } }
    }
};
struct EpiSoftmax {
    static constexpr bool PERM = true;
    bf16_t* P; PG8_LAS float* xl;
    __device__ __forceinline__ void operator()(const f32x4 (&acc)[2][2][4][2], const Unit& u, int wr, int wc, int fr, int fq) const {
        const float sc = 0.0625f * 1.4426950408889634f;
#pragma unroll
        for (int ai = 0; ai < 2; ++ai)
#pragma unroll
            for (int m = 0; m < 4; ++m) { float mx = -INFINITY;
#pragma unroll
                for (int bj = 0; bj < 2; ++bj)
#pragma unroll
                    for (int n = 0; n < 2; ++n) { const f32x4 v = acc[ai][bj][m][n]; mx = fmaxf(mx, fmaxf(fmaxf(v[0], v[1]), fmaxf(v[2], v[3]))); }
                mx = fmaxf(mx, __shfl_xor(mx, 16)); mx = fmaxf(mx, __shfl_xor(mx, 32));
                float s = 0.f;
#pragma unroll
                for (int bj = 0; bj < 2; ++bj)
#pragma unroll
                    for (int n = 0; n < 2; ++n) { const f32x4 v = acc[ai][bj][m][n]; s += (__builtin_amdgcn_exp2f((v[0] - mx) * sc) + __builtin_amdgcn_exp2f((v[1] - mx) * sc)) + (__builtin_amdgcn_exp2f((v[2] - mx) * sc) + __builtin_amdgcn_exp2f((v[3] - mx) * sc)); }
                s += __shfl_xor(s, 16); s += __shfl_xor(s, 32);
                if (fq == 0) { PG8_LAS float* q = xl + ((ai * HALF + wr * 64 + m * 16 + fr) * 4 + wc) * 2; q[0] = mx; q[1] = s; } }
        asm volatile("s_waitcnt lgkmcnt(0)" ::: "memory"); __builtin_amdgcn_s_barrier(); asm volatile("" ::: "memory");
        const int row0 = u.pm * BM + wr * 64 + fr, col0 = u.pn * BM + wc * 32 + 8 * fq;
#pragma unroll
        for (int ai = 0; ai < 2; ++ai)
#pragma unroll
            for (int m = 0; m < 4; ++m) { const PG8_LAS f32x4* q = (const PG8_LAS f32x4*)(xl + (ai * HALF + wr * 64 + m * 16 + fr) * 8); const f32x4 q0 = q[0], q1 = q[1];
                const float M = fmaxf(fmaxf(q0[0], q0[2]), fmaxf(q1[0], q1[2]));
                const float S = (q0[1] * __builtin_amdgcn_exp2f((q0[0] - M) * sc) + q0[3] * __builtin_amdgcn_exp2f((q0[2] - M) * sc)) + (q1[1] * __builtin_amdgcn_exp2f((q1[0] - M) * sc) + q1[3] * __builtin_amdgcn_exp2f((q1[2] - M) * sc));
                const float inv = 1.f / S; bf16_t* rowp = P + (size_t)(row0 + ai * HALF + m * 16) * 1024 + col0;
#pragma unroll
                for (int bj = 0; bj < 2; ++bj) { f32x4 p[2];
#pragma unroll
                    for (int n = 0; n < 2; ++n) { const f32x4 v = acc[ai][bj][m][n];
                        p[n] = (f32x4){__builtin_amdgcn_exp2f((v[0] - M) * sc) * inv, __builtin_amdgcn_exp2f((v[1] - M) * sc) * inv, __builtin_amdgcn_exp2f((v[2] - M) * sc) * inv, __builtin_amdgcn_exp2f((v[3] - M) * sc) * inv}; }
                    *(u32x4*)(rowp + bj * HALF) = pack8(p[0], p[1]); } }
        asm volatile("s_waitcnt lgkmcnt(0)" ::: "memory"); __builtin_amdgcn_s_barrier(); asm volatile("" ::: "memory");
    }
};
struct EpiGateUp {
    static constexpr bool PERM = true;
    bf16_t* Hs; const float* pair_gate;
    __device__ __forceinline__ void operator()(const f32x4 (&acc)[2][2][4][2], const Unit& u, int wr, int wc, int fr, int fq) const {
        const int row0 = u.rb + wr * 64 + fr, cb = u.pn * 128 + wc * 32 + 8 * fq;
        float pgv[2][4];
#pragma unroll
        for (int ai = 0; ai < 2; ++ai)
#pragma unroll
            for (int m = 0; m < 4; ++m) pgv[ai][m] = (ai == 0 || !u.half) ? pair_gate[row0 + ai * HALF + m * 16] : 0.f;
#pragma unroll
        for (int ai = 0; ai < 2; ++ai) { if (ai == 1 && u.half) break;
#pragma unroll
            for (int m = 0; m < 4; ++m) { const int row = row0 + ai * HALF + m * 16; const float pg = pgv[ai][m]; f32x4 h[2];
#pragma unroll
                for (int n = 0; n < 2; ++n) { const f32x4 gt = acc[ai][0][m][n], up = acc[ai][1][m][n];
                    h[n] = (f32x4){gt[0] * sigm(gt[0]) * up[0] * pg, gt[1] * sigm(gt[1]) * up[1] * pg, gt[2] * sigm(gt[2]) * up[2] * pg, gt[3] * sigm(gt[3]) * up[3] * pg}; }
                if (pg == 0.f) { h[0] = (f32x4){0.f, 0.f, 0.f, 0.f}; h[1] = h[0]; }
                *(u32x4*)(Hs + (size_t)row * 512 + cb) = pack8(h[0], h[1]); } }
    }
};
struct EpiY {
    static constexpr bool PERM = true;
    bf16_t* Y;
    __device__ __forceinline__ void operator()(const f32x4 (&acc)[2][2][4][2], const Unit& u, int wr, int wc, int fr, int fq) const {
        const int row0 = u.rb + wr * 64 + fr, col0 = u.pn * BM + wc * 32 + 8 * fq;
#pragma unroll
        for (int ai = 0; ai < 2; ++ai) { if (ai == 1 && u.half) break;
#pragma unroll
            for (int m = 0; m < 4; ++m) { bf16_t* rowp = Y + (size_t)(row0 + ai * HALF + m * 16) * 1024 + col0;
#pragma unroll
                for (int bj = 0; bj < 2; ++bj) *(u32x4*)(rowp + bj * HALF) = pack8(acc[ai][bj][m][0], acc[ai][bj][m][1]); } }
    }
};
struct EpiDown {
    static constexpr bool PERM = false;
    float* out; const int* pair_tok;
    __device__ __forceinline__ void operator()(const f32x4 (&acc)[2][2][4][2], const Unit& u, int wr, int wc, int fr, int fq) const {
        const int row0 = u.pm * BM + wr * 64 + fr, col0 = u.pn * BM + wc * 32 + 4 * fq;
#pragma unroll
        for (int ai = 0; ai < 2; ++ai)
#pragma unroll
            for (int m = 0; m < 4; ++m) { const int tok = pair_tok[row0 + ai * HALF + m * 16];
                if (tok >= 0) { float* rp = out + (size_t)tok * 1024 + col0;
#pragma unroll
                    for (int bj = 0; bj < 2; ++bj)
#pragma unroll
                        for (int n = 0; n < 2; ++n)
#pragma unroll
                            for (int i = 0; i < 4; ++i) unsafeAtomicAdd(rp + bj * HALF + n * 16 + i, acc[ai][bj][m][n][i]); } }
    }
};

__device__ __forceinline__ void row_stats16(const float* stats, int row, int fq, float& mu, float& rstd) {
    const f32x4* sp = (const f32x4*)(stats + (size_t)row * 32 + fq * 8); const f32x4 a = sp[0], b = sp[1];
    float s = (a[0] + a[2]) + (b[0] + b[2]), ss = (a[1] + a[3]) + (b[1] + b[3]);
    s += __shfl_xor(s, 16); s += __shfl_xor(s, 32); ss += __shfl_xor(ss, 16); ss += __shfl_xor(ss, 32);
    mu = s * (1.f / 1024.f); const float var = ss * (1.f / 1024.f) - mu * mu; rstd = 1.f / sqrtf(var + 1e-5f);
}
struct EpiResStats {
    static constexpr bool PERM = false;
    const bf16_t* resb; bf16_t* zb; float* stats; float alpha;
    __device__ __forceinline__ void operator()(const f32x4 (&acc)[2][2][4][2], const Unit& u, int wr, int wc, int fr, int fq) const {
        const int row0 = u.pm * BM + wr * 64 + fr, col0 = u.pn * BM + wc * 32 + 4 * fq;
#pragma unroll
        for (int ai = 0; ai < 2; ++ai)
#pragma unroll
            for (int m = 0; m < 4; ++m) { const int row = row0 + ai * HALF + m * 16; const size_t off = (size_t)row * 1024 + col0; float sm = 0.f, ss = 0.f;
#pragma unroll
                for (int bj = 0; bj < 2; ++bj)
#pragma unroll
                    for (int n = 0; n < 2; ++n) { const u32x2 rw = *(const u32x2*)(resb + off + bj * HALF + n * 16);
                        const f32x4 r = (f32x4){__builtin_bit_cast(float, rw.x << 16), __builtin_bit_cast(float, rw.x & 0xffff0000u), __builtin_bit_cast(float, rw.y << 16), __builtin_bit_cast(float, rw.y & 0xffff0000u)};
                        const f32x4 z = r * alpha + acc[ai][bj][m][n];
                        u32x2 w; w.x = cvt_pk_bf16(z[0], z[1]); w.y = cvt_pk_bf16(z[2], z[3]); *(u32x2*)(zb + off + bj * HALF + n * 16) = w;
                        sm += (z[0] + z[1]) + (z[2] + z[3]); ss += (z[0] * z[0] + z[1] * z[1]) + (z[2] * z[2] + z[3] * z[3]); }
                sm += __shfl_xor(sm, 16); sm += __shfl_xor(sm, 32); ss += __shfl_xor(ss, 16); ss += __shfl_xor(ss, 32);
                if (fq == 0) *(float2*)(stats + (size_t)row * 32 + (u.pn * 4 + wc) * 2) = make_float2(sm, ss); }
    }
};
struct EpiResLn {
    static constexpr bool PERM = false;
    float* out; const bf16_t* zb; const float* stats; const float* g; const float* b; float alpha;
    __device__ __forceinline__ void operator()(const f32x4 (&acc)[2][2][4][2], const Unit& u, int wr, int wc, int fr, int fq) const {
        const int row0 = u.pm * BM + wr * 64 + fr, col0 = u.pn * BM + wc * 32 + 4 * fq;
        f32x4 gv[2][2], bv[2][2];
#pragma unroll
        for (int bj = 0; bj < 2; ++bj)
#pragma unroll
            for (int n = 0; n < 2; ++n) { gv[bj][n] = *(const f32x4*)(g + col0 + bj * HALF + n * 16); bv[bj][n] = *(const f32x4*)(b + col0 + bj * HALF + n * 16); }
#pragma unroll
        for (int ai = 0; ai < 2; ++ai)
#pragma unroll
            for (int m = 0; m < 4; ++m) { const int row = row0 + ai * HALF + m * 16; const size_t off = (size_t)row * 1024 + col0; float mu, rstd; row_stats16(stats, row, fq, mu, rstd);
#pragma unroll
                for (int bj = 0; bj < 2; ++bj)
#pragma unroll
                    for (int n = 0; n < 2; ++n) { const u32x2 zw = *(const u32x2*)(zb + off + bj * HALF + n * 16);
                        const f32x4 z = (f32x4){__builtin_bit_cast(float, zw.x << 16), __builtin_bit_cast(float, zw.x & 0xffff0000u), __builtin_bit_cast(float, zw.y << 16), __builtin_bit_cast(float, zw.y & 0xffff0000u)};
                        const f32x4 x1 = (z - mu) * rstd * gv[bj][n] + bv[bj][n];
                        *(f32x4*)(out + off + bj * HALF + n * 16) = x1 * alpha + acc[ai][bj][m][n]; } }
    }
};
struct EpiRank1 {
    static constexpr bool PERM = true;
    bf16_t* O; const float* stats; const float* cs; const float* bw;
    __device__ __forceinline__ void operator()(const f32x4 (&acc)[2][2][4][2], const Unit& u, int wr, int wc, int fr, int fq) const {
        const int row0 = u.pm * BM + wr * 64 + fr, col0 = u.pn * BM + wc * 32 + 8 * fq;
        f32x4 cv[2][2], wv[2][2];
#pragma unroll
        for (int bj = 0; bj < 2; ++bj)
#pragma unroll
            for (int n = 0; n < 2; ++n) { cv[bj][n] = *(const f32x4*)(cs + col0 + bj * HALF + 4 * n); wv[bj][n] = *(const f32x4*)(bw + col0 + bj * HALF + 4 * n); }
#pragma unroll
        for (int ai = 0; ai < 2; ++ai)
#pragma unroll
            for (int m = 0; m < 4; ++m) { const int row = row0 + ai * HALF + m * 16; float mu, rstd; row_stats16(stats, row, fq, mu, rstd); bf16_t* rowp = O + (size_t)row * 1024 + col0;
#pragma unroll
                for (int bj = 0; bj < 2; ++bj) *(u32x4*)(rowp + bj * HALF) = pack8((acc[ai][bj][m][0] - cv[bj][0] * mu) * rstd + wv[bj][0], (acc[ai][bj][m][1] - cv[bj][1] * mu) * rstd + wv[bj][1]); }
    }
};

struct EpiPre {
    static constexpr bool PERM = true;
    bf16_t* O; float* csp;
    __device__ __forceinline__ void operator()(const f32x4 (&acc)[2][2][4][2], const Unit& u, int wr, int wc, int fr, int fq) const {
        const int row0 = u.pm * BM + wr * 64 + fr, col0 = u.pn * BM + wc * 32 + 8 * fq;
#pragma unroll
        for (int ai = 0; ai < 2; ++ai)
#pragma unroll
            for (int m = 0; m < 4; ++m) { const int row = row0 + ai * HALF + m * 16; bf16_t* rowp = O + ((size_t)u.aux * 1024 + row) * 1024 + col0; float sm = 0.f;
#pragma unroll
                for (int bj = 0; bj < 2; ++bj) { const u32x4 w = pack8(acc[ai][bj][m][0], acc[ai][bj][m][1]); *(u32x4*)(rowp + bj * HALF) = w;
#pragma unroll
                    for (int e = 0; e < 4; ++e) sm += __builtin_bit_cast(float, w[e] << 16) + __builtin_bit_cast(float, w[e] & 0xffff0000u); }
                if (csp) { sm += __shfl_xor(sm, 16); sm += __shfl_xor(sm, 32); if (fq == 0) csp[((size_t)u.aux * 1024 + row) * 16 + u.pn * 4 + wc] = sm; } }
    }
};
struct EpiSoftmaxLn {
    static constexpr bool PERM = true;
    bf16_t* P; PG8_LAS float* xl; const float* stats; const float* cs; const float* bw;
    __device__ __forceinline__ void operator()(f32x4 (&acc)[2][2][4][2], const Unit& u, int wr, int wc, int fr, int fq) const {
        const float sc = 0.0625f * 1.4426950408889634f;
        const int row0 = u.pm * BM + wr * 64 + fr, col0 = u.pn * BM + wc * 32 + 8 * fq;
        { f32x4 cv[2][2], wv[2][2];
#pragma unroll
          for (int bj = 0; bj < 2; ++bj)
#pragma unroll
            for (int n = 0; n < 2; ++n) { cv[bj][n] = *(const f32x4*)(cs + u.aux * 1024 + col0 + bj * HALF + 4 * n); wv[bj][n] = *(const f32x4*)(bw + u.aux * 1024 + col0 + bj * HALF + 4 * n); }
#pragma unroll
          for (int ai = 0; ai < 2; ++ai)
#pragma unroll
            for (int m = 0; m < 4; ++m) { float mu, rstd; row_stats16(stats, row0 + ai * HALF + m * 16, fq, mu, rstd);
#pragma unroll
                for (int bj = 0; bj < 2; ++bj)
#pragma unroll
                    for (int n = 0; n < 2; ++n) acc[ai][bj][m][n] = (acc[ai][bj][m][n] - cv[bj][n] * mu) * rstd + wv[bj][n]; } }
#pragma unroll
        for (int ai = 0; ai < 2; ++ai)
#pragma unroll
            for (int m = 0; m < 4; ++m) { float mx = -INFINITY;
#pragma unroll
                for (int bj = 0; bj < 2; ++bj)
#pragma unroll
                    for (int n = 0; n < 2; ++n) { const f32x4 v = acc[ai][bj][m][n]; mx = fmaxf(mx, fmaxf(fmaxf(v[0], v[1]), fmaxf(v[2], v[3]))); }
                mx = fmaxf(mx, __shfl_xor(mx, 16)); mx = fmaxf(mx, __shfl_xor(mx, 32));
                float sm = 0.f;
#pragma unroll
                for (int bj = 0; bj < 2; ++bj)
#pragma unroll
                    for (int n = 0; n < 2; ++n) { const f32x4 v = acc[ai][bj][m][n];
                        const f32x4 e = (f32x4){__builtin_amdgcn_exp2f((v[0] - mx) * sc), __builtin_amdgcn_exp2f((v[1] - mx) * sc), __builtin_amdgcn_exp2f((v[2] - mx) * sc), __builtin_amdgcn_exp2f((v[3] - mx) * sc)};
                        acc[ai][bj][m][n] = e; sm += (e[0] + e[1]) + (e[2] + e[3]); }
                sm += __shfl_xor(sm, 16); sm += __shfl_xor(sm, 32);
                if (fq == 0) { PG8_LAS float* q = xl + ((ai * HALF + wr * 64 + m * 16 + fr) * 4 + wc) * 2; q[0] = mx; q[1] = sm; } }
        asm volatile("s_waitcnt lgkmcnt(0)" ::: "memory"); __builtin_amdgcn_s_barrier(); asm volatile("" ::: "memory");
#pragma unroll
        for (int ai = 0; ai < 2; ++ai)
#pragma unroll
            for (int m = 0; m < 4; ++m) { const PG8_LAS f32x4* q = (const PG8_LAS f32x4*)(xl + (ai * HALF + wr * 64 + m * 16 + fr) * 8); const f32x4 q0 = q[0], q1 = q[1];
                const float M = fmaxf(fmaxf(q0[0], q0[2]), fmaxf(q1[0], q1[2]));
                const float S = (q0[1] * __builtin_amdgcn_exp2f((q0[0] - M) * sc) + q0[3] * __builtin_amdgcn_exp2f((q0[2] - M) * sc)) + (q1[1] * __builtin_amdgcn_exp2f((q1[0] - M) * sc) + q1[3] * __builtin_amdgcn_exp2f((q1[2] - M) * sc));
                const float mine = (wc == 0) ? q0[0] : (wc == 1) ? q0[2] : (wc == 2) ? q1[0] : q1[2];
                const float fac = __builtin_amdgcn_exp2f((mine - M) * sc) / S; bf16_t* rowp = P + (size_t)(row0 + ai * HALF + m * 16) * 1024 + col0;
#pragma unroll
                for (int bj = 0; bj < 2; ++bj) *(u32x4*)(rowp + bj * HALF) = pack8(acc[ai][bj][m][0] * fac, acc[ai][bj][m][1] * fac); }
        asm volatile("s_waitcnt lgkmcnt(0)" ::: "memory"); __builtin_amdgcn_s_barrier(); asm volatile("" ::: "memory");
    }
};
struct DenseSched {
    const char* A; const char* B; int nM, nN, G, c; size_t strideA, strideB;
    __device__ __forceinline__ bool next(int i, Unit& u) const { const int L = i * G + c; if (L >= nM * nN) return false; tile_of(L, nM, nN, u.pm, u.pn); u.A = A + (size_t)u.pm * strideA; u.B = B + (size_t)u.pn * strideB; u.kind = 0; u.aux = 0; u.rows = nullptr; return true; }
};
}


#define LAS __attribute__((address_space(3)))
struct TItem { const float* W; bf16* WT; const float* gk; int N, Kd, k0, n0, drow0; };
__device__ __forceinline__ void titem_load(const TItem& t, float (&wv)[32], int lane) {
#pragma unroll
    for (int i = 0; i < 32; ++i) { const int kk = 2 * i + (lane >> 5); wv[i] = __builtin_nontemporal_load(t.W + (size_t)(t.k0 + kk) * t.N + t.n0 + (lane & 31)); }
}
__device__ __forceinline__ void titem_store(const TItem& t, const float (&wv)[32], LAS float* scr, int lane) {
#pragma unroll
    for (int i = 0; i < 32; ++i) { const int kk = 2 * i + (lane >> 5); float v = wv[i]; if (t.gk) v *= t.gk[t.k0 + kk]; scr[kk * 33 + (lane & 31)] = v; }
    asm volatile("s_waitcnt lgkmcnt(0)" ::: "memory");
    const int c = lane & 7;
#pragma unroll
    for (int j = 0; j < 4; ++j) { const int n = (lane >> 3) + 8 * j; const LAS float* sp = scr + (8 * c) * 33 + n;
        u32x4 o; o.x = pk2(sp[0 * 33], sp[1 * 33]); o.y = pk2(sp[2 * 33], sp[3 * 33]); o.z = pk2(sp[4 * 33], sp[5 * 33]); o.w = pk2(sp[6 * 33], sp[7 * 33]);
        *(u32x4*)(t.WT + (size_t)(t.drow0 + n) * t.Kd + t.k0 + 8 * c) = o; }
    asm volatile("s_waitcnt lgkmcnt(0)" ::: "memory");
}
__device__ __forceinline__ void transpose_item(const float* W, int N, bf16* WT, int Kd, int k0, int n0, int drow0, LAS float* scr, int lane, const float* gk = nullptr) {
    const TItem t{W, WT, gk, N, Kd, k0, n0, drow0}; float wv[32]; titem_load(t, wv, lane); titem_store(t, wv, scr, lane);
}

typedef short bf16x8v __attribute__((ext_vector_type(8)));
__device__ __forceinline__ float bflo(unsigned v) { return __builtin_bit_cast(float, v << 16); }
__device__ __forceinline__ float bfhi(unsigned v) { return __builtin_bit_cast(float, v & 0xffff0000u); }

__device__ __forceinline__ void conv_unit(unsigned char* lds, const bf16* hglu, const float* w_dw, const float* b_dw, const float* g_cn, const float* b_cn, bf16* ycat, int cu, int tid) {
    const int lane = tid & 63, wave = tid >> 6;
    bf16* hin = (bf16*)lds; float* cout = (float*)(lds + 63488);
    const int t0 = cu * 32, s0 = t0 % SEQ;
    for (int c = tid; c < 62 * 64; c += 512) { const int row = c >> 6, part = c & 63; u32x4 v = (u32x4){0u, 0u, 0u, 0u};
        if (s0 - 30 + row >= 0) v = *(const u32x4*)(hglu + (size_t)(t0 - 30 + row) * 512 + part * 8);
        *(u32x4*)(hin + row * 512 + part * 8) = v; }
    __syncthreads();
    {
        const int cp = tid & 255, th = tid >> 8;
        typedef float f32x2 __attribute__((ext_vector_type(2)));
        f32x2 wj[CONV_W];
#pragma unroll
        for (int j = 0; j < CONV_W; ++j) wj[j] = *(const f32x2*)(w_dw + j * CONV_CH + 2 * cp);
        const f32x2 bb = *(const f32x2*)(b_dw + 2 * cp);
#pragma unroll 1
        for (int grp = 0; grp < 2; ++grp) { const int tt0 = th * 16 + grp * 8;
            f32x2 ac[8];
#pragma unroll
            for (int o = 0; o < 8; ++o) ac[o] = bb;
#pragma unroll
            for (int r = 0; r < 38; ++r) { const unsigned v = *(const unsigned*)(hin + (tt0 + r) * 512 + 2 * cp); const f32x2 hv = (f32x2){bflo(v), bfhi(v)};
#pragma unroll
                for (int o = 0; o < 8; ++o) { const int j = r - o; if (j >= 0 && j < CONV_W) ac[o] = __builtin_elementwise_fma(wj[j], hv, ac[o]); } }
#pragma unroll
            for (int o = 0; o < 8; ++o) *(f32x2*)(cout + (tt0 + o) * 512 + 2 * cp) = ac[o];
        }
    }
    __syncthreads();
    {
        const f32x4 g0 = *(const f32x4*)(g_cn + 8 * lane), g1 = *(const f32x4*)(g_cn + 8 * lane + 4), c0 = *(const f32x4*)(b_cn + 8 * lane), c1 = *(const f32x4*)(b_cn + 8 * lane + 4);
#pragma unroll 1
        for (int i = 0; i < 4; ++i) { const int tt = wave * 4 + i;
            f32x4 v0 = *(const f32x4*)(cout + tt * 512 + 8 * lane), v1 = *(const f32x4*)(cout + tt * 512 + 8 * lane + 4);
            const float mean = wave_sum((v0.x + v0.y) + (v0.z + v0.w) + (v1.x + v1.y) + (v1.z + v1.w)) * (1.f / 512.f);
            v0 = v0 - mean; v1 = v1 - mean;
            const float var = wave_sum((v0.x * v0.x + v0.y * v0.y) + (v0.z * v0.z + v0.w * v0.w) + (v1.x * v1.x + v1.y * v1.y) + (v1.z * v1.z + v1.w * v1.w)) * (1.f / 512.f);
            const float rstd = 1.f / sqrtf(var + LN_EPS);
            f32x4 y0 = v0 * rstd * g0 + c0, y1 = v1 * rstd * g1 + c1;
#pragma unroll
            for (int e = 0; e < 4; ++e) { y0[e] = y0[e] * pg8::sigm(y0[e]); y1[e] = y1[e] * pg8::sigm(y1[e]); }
            *(u32x4*)(ycat + (size_t)(t0 + tt) * 1024 + 8 * lane) = pg8::pack8(y0, y1); }
    }
    __syncthreads();
}

__device__ __forceinline__ void swa_unit(unsigned char* lds, const bf16* qkv, const float* sinks, bf16* ycat, int b, int kvh, int qb, int tid) {
    const int lane = tid & 63, wave = tid >> 6, q4 = lane >> 4, c16 = lane & 15;
    bf16* Ks = (bf16*)lds; bf16* VT = (bf16*)(lds + 36864);
    const long t0 = (long)b * SEQ + (long)qb * 128, tk0 = t0 - 128;
#pragma unroll
    for (int i = 0; i < 4; ++i) { const int c = tid + 512 * i, row = c >> 3, part = c & 7; const bool ok = (qb > 0) || (row >= 128);
        u32x4 kv = (u32x4){0u, 0u, 0u, 0u}, vv = kv;
        if (ok) { const bf16* rp = qkv + (tk0 + row) * 768 + 512 + kvh * 64 + part * 8; kv = *(const u32x4*)rp; vv = *(const u32x4*)(rp + 128); }
        *(u32x4*)(Ks + row * 72 + part * 8) = kv;
#pragma unroll
        for (int e = 0; e < 4; ++e) { VT[(part * 8 + 2 * e) * 264 + row] = (bf16)(vv[e] & 0xffffu); VT[(part * 8 + 2 * e + 1) * 264 + row] = (bf16)(vv[e] >> 16); } }
    __syncthreads();
    const int g = wave >> 1, hq = kvh * 4 + g, i0 = (wave & 1) * 64;
    const float L2E = 1.4426950408889634f, sc = 0.125f * L2E, sink2 = sinks[hq] * L2E;
    bf16x8v Qf[4][2];
#pragma unroll
    for (int qt = 0; qt < 4; ++qt) { const bf16* qp = qkv + (t0 + i0 + qt * 16 + c16) * 768 + hq * 64 + 8 * q4; Qf[qt][0] = *(const bf16x8v*)qp; Qf[qt][1] = *(const bf16x8v*)(qp + 32); }
#pragma unroll
    for (int qt = 0; qt < 4; ++qt) {
        const int iq = i0 + qt * 16, kt0 = iq >> 4, iqc = iq + c16;
        const bf16x8v Q0 = Qf[qt][0], Q1 = Qf[qt][1];
        f32x4 sv[9];
#pragma unroll
        for (int kt = 0; kt < 9; ++kt) { const bf16* kp = Ks + ((kt0 + kt) * 16 + c16) * 72 + 8 * q4;
            f32x4 a = (f32x4){0.f, 0.f, 0.f, 0.f};
            a = __builtin_amdgcn_mfma_f32_16x16x32_bf16(*(const bf16x8v*)kp, Q0, a, 0, 0, 0);
            a = __builtin_amdgcn_mfma_f32_16x16x32_bf16(*(const bf16x8v*)(kp + 32), Q1, a, 0, 0, 0);
            sv[kt] = a; }
        float mx = sink2;
#pragma unroll
        for (int kt = 0; kt < 9; ++kt)
#pragma unroll
            for (int r = 0; r < 4; ++r) { const int j = (kt0 + kt) * 16 + 4 * q4 + r; const bool ok = (j > iqc) && (j <= iqc + 128) && (qb > 0 || j >= 128);
                const float v = ok ? sv[kt][r] * sc : -INFINITY; sv[kt][r] = v; mx = fmaxf(mx, v); }
        mx = fmaxf(mx, __shfl_xor(mx, 16)); mx = fmaxf(mx, __shfl_xor(mx, 32));
        float sum = 0.f;
#pragma unroll
        for (int kt = 0; kt < 9; ++kt)
#pragma unroll
            for (int r = 0; r < 4; ++r) { const float pv = __builtin_amdgcn_exp2f(sv[kt][r] - mx); sv[kt][r] = pv; sum += pv; }
        sum += __shfl_xor(sum, 16); sum += __shfl_xor(sum, 32);
        sum += __builtin_amdgcn_exp2f(sink2 - mx);
        const float inv = 1.f / sum;
        f32x4 o[4];
#pragma unroll
        for (int dt = 0; dt < 4; ++dt) o[dt] = (f32x4){0.f, 0.f, 0.f, 0.f};
#pragma unroll
        for (int pp = 0; pp < 5; ++pp) { const int T0 = kt0 + 2 * pp, T1 = (pp < 4) ? T0 + 1 : T0;
            const f32x4 pa = sv[2 * pp], pb = (pp < 4) ? sv[2 * pp + 1] : (f32x4){0.f, 0.f, 0.f, 0.f};
            const u32x4 pw = pg8::pack8(pa, pb); const bf16x8v Bp = __builtin_bit_cast(bf16x8v, pw);
#pragma unroll
            for (int dt = 0; dt < 4; ++dt) { const bf16* vp = VT + (dt * 16 + c16) * 264 + 4 * q4;
                const u32x2 lo = *(const u32x2*)(vp + T0 * 16), hi = *(const u32x2*)(vp + T1 * 16);
                const u32x4 aw = (u32x4){lo.x, lo.y, hi.x, hi.y};
                o[dt] = __builtin_amdgcn_mfma_f32_16x16x32_bf16(__builtin_bit_cast(bf16x8v, aw), Bp, o[dt], 0, 0, 0); } }
        bf16* op = ycat + (t0 + iqc) * 1024 + 512 + hq * 64 + 4 * q4;
#pragma unroll
        for (int dt = 0; dt < 4; ++dt) { u32x2 w; w.x = pg8::cvt_pk_bf16(o[dt][0] * inv, o[dt][1] * inv); w.y = pg8::cvt_pk_bf16(o[dt][2] * inv, o[dt][3] * inv); *(u32x2*)(op + dt * 16) = w; }
    }
    __syncthreads();
}


#define XB_TMO      128
#define XB_XCNT(j)  (256  + 64 * (j))
#define XB_XSUB(j)  (1280 + 64 * (j))
#define XB_XGEN(j)  (2304 + 64 * (j))
#define XB_TOP      3328
#define XB_TOPGEN   3392
#define XCD_BAR_WORDS 3456
#define XB_SPIN_CAP (1u << 20)
__device__ __forceinline__ unsigned xb_ld(unsigned* p)              { return __hip_atomic_load(p, __ATOMIC_RELAXED, __HIP_MEMORY_SCOPE_AGENT); }
__device__ __forceinline__ unsigned xb_add(unsigned* p, unsigned v) { return __hip_atomic_fetch_add(p, v, __ATOMIC_RELAXED, __HIP_MEMORY_SCOPE_AGENT); }
__device__ __forceinline__ unsigned xb_xcc_id() { return (unsigned)__builtin_amdgcn_s_getreg((3 << 11) | 20) & 0xFu; }
#define XB_SPIN(cond, bar) do { unsigned _sp = 0; while (cond) { __builtin_amdgcn_s_sleep(1); \
    if ((++_sp & 255u) == 0u) { if (xb_ld(&(bar)[XB_TMO])) break; if (_sp > XB_SPIN_CAP) { atomicAdd(&(bar)[XB_TMO], 1u); break; } } } } while (0)
struct XcdBarrier { unsigned* bar; unsigned x; volatile __attribute__((address_space(3))) unsigned* st; };
__device__ __forceinline__ XcdBarrier xcd_barrier_post(unsigned* bar, volatile __attribute__((address_space(3))) unsigned* st) {
    XcdBarrier b; b.bar = bar; b.x = xb_xcc_id(); b.st = st;
    if (threadIdx.x == 0) (void)xb_add(&bar[XB_XCNT(b.x)], 1u);
    return b;
}
__device__ __forceinline__ void xcd_barrier_complete(unsigned* bar, unsigned x, unsigned& nloc, unsigned& nx) {
    const unsigned G = gridDim.x * gridDim.y * gridDim.z;
    unsigned sum, cnt, mine, sp = 0u;
    for (;;) {
        sum = 0u; cnt = 0u; mine = 0u;
#pragma unroll
        for (unsigned j = 0; j < 16; ++j) { const unsigned c = xb_ld(&bar[XB_XCNT(j)]); sum += c; cnt += (c > 0u) ? 1u : 0u; mine = (j == x) ? c : mine; }
        if (sum == G) break;
        __builtin_amdgcn_s_sleep(1);
        if ((++sp & 255u) == 0u) { if (xb_ld(&bar[XB_TMO])) break; if (sp > XB_SPIN_CAP) { atomicAdd(&bar[XB_TMO], 1u); break; } }
    }
    nloc = mine > 0u ? mine : 1u; nx = cnt > 0u ? cnt : 1u;
}
__device__ __forceinline__ void xcd_barrier(const XcdBarrier& b, int tid) {
    asm volatile("s_waitcnt vmcnt(0)" ::: "memory");
    __syncthreads();
    if (tid == 0) {
        unsigned* bar = b.bar;
        __builtin_amdgcn_s_waitcnt(0);
        unsigned nloc = b.st[0], nx = b.st[1];
        if (nloc == 0u) { xcd_barrier_complete(bar, b.x, nloc, nx); b.st[0] = nloc; b.st[1] = nx; }
        const unsigned old = xb_add(&bar[XB_XSUB(b.x)], 1u);
        const unsigned gen = old / nloc;
        if (old + 1u == (gen + 1u) * nloc) {
            __builtin_amdgcn_fence(__ATOMIC_RELEASE, "agent");
            asm volatile("s_waitcnt vmcnt(0)" ::: "memory");
            const unsigned og = xb_add(&bar[XB_TOP], 1u);
            const unsigned tg = og / nx;
            if (og + 1u == (tg + 1u) * nx) xb_add(&bar[XB_TOPGEN], 1u);
            else XB_SPIN(xb_ld(&bar[XB_TOPGEN]) == tg, bar);
            __builtin_amdgcn_fence(__ATOMIC_ACQUIRE, "agent");
            xb_add(&bar[XB_XGEN(b.x)], 1u);
            asm volatile("s_waitcnt vmcnt(0)" ::: "memory");
        } else {
            XB_SPIN(xb_ld(&bar[XB_XGEN(b.x)]) == gen, bar);
            __builtin_amdgcn_fence(__ATOMIC_ACQUIRE, "agent");
            asm volatile("s_waitcnt vmcnt(0)" ::: "memory");
        }
    }
    __syncthreads();
}

struct SchedMoE { const char* A; const char* W; const int* tab; const int* rows; int nF, nH, G, c; size_t lda2, strideE, strideN;
    __device__ __forceinline__ bool next(int i, pg8::Unit& u) const { const int L = i * G + c; int t;
        if (L < nF * 4) { pg8::tile_of(L, nF, 4, t, u.pn); u.half = 0; } else if (L < (nF + nH) * 4) { pg8::tile_of(L - nF * 4, nH, 4, t, u.pn); t += nF; u.half = 1; } else return false;
        const int rb = tab[2 + t], e = tab[2 + 192 + t];
        u.pm = t; u.kind = 0; u.aux = e; u.rb = rb; u.rows = rows ? rows + rb : nullptr; u.A = rows ? A : A + (size_t)rb * lda2; u.B = W + (size_t)e * strideE + (size_t)u.pn * strideN; return true; } };

__global__ void __launch_bounds__(512, 2) fwd_kernel(Params p) {
    extern __shared__ __attribute__((aligned(16))) unsigned char lds_raw[];
    float* ldsf = (float*)lds_raw;
    cg::grid_group grid = cg::this_grid();
    const int G = gridDim.x, bid = blockIdx.x, NGW = G * 8;
    const int wid_s = __builtin_amdgcn_readfirstlane((int)threadIdx.x >> 6);
    unsigned char* ws = p.ws;
    const float *x = p.in[0], *mem = p.in[1], *w_in = p.in[2], *b_in = p.in[3], *w_dw = p.in[4], *b_dw = p.in[5], *g_cn = p.in[6], *b_cn = p.in[7], *sinks = p.in[8],
                *w_out = p.in[9], *g_ln1 = p.in[10], *b_ln1 = p.in[11], *w_mq = p.in[12], *w_mkv = p.in[13], *w_mo = p.in[14], *g_ln2 = p.in[15], *b_ln2 = p.in[16],
                *w_group = p.in[17], *b_group = p.in[18], *w_router = p.in[19], *b_router = p.in[20], *w_gate = p.in[21], *w_up = p.in[22], *w_down = p.in[23],
                *g_ln3 = p.in[24], *b_ln3 = p.in[25];
    float* out = p.out;
    bf16* xb = (bf16*)(ws + WS_DD); bf16* ycat = (bf16*)(ws + WS_A); bf16* Hs = (bf16*)(ws + WS_A);
    bf16* hglu = (bf16*)(ws + WS_B); bf16* qkv = (bf16*)(ws + WS_B + (size_t)T * 512 * 2); bf16* x1b = (bf16*)(ws + WS_B); bf16* Pb2 = (bf16*)(ws + WS_A); bf16* x2b = (bf16*)(ws + WS_B);
    float* Sbuf = (float*)(ws + WS_DD); bf16* Xs = (bf16*)(ws + WS_DD);
    bf16* kvm = (bf16*)(ws + WS_KVM); bf16* memb = (bf16*)(ws + WS_MEMB); bf16* MT = (bf16*)(ws + WS_MT); bf16* NT = (bf16*)(ws + WS_NT);
    float* csS = (float*)(ws + WS_CSS); float* bwS = csS + 2048; float* csp = (float*)(ws + WS_CSP);
    bf16* Wt_in = (bf16*)(ws + WS_WIN); bf16* Wt_out = (bf16*)(ws + WS_WOUT); bf16* Wqb = (bf16*)(ws + WS_WMQ); bf16* Wt_mkv = (bf16*)(ws + WS_WMKV); bf16* Wt_mo = (bf16*)(ws + WS_WMO);
    bf16* Wt_gu = (bf16*)(ws + WS_WGU); bf16* Wt_dn = (bf16*)(ws + WS_WDN);
    PG8_LAS unsigned char* ldsp = (PG8_LAS unsigned char*)lds_raw;
    float* stats1 = (float*)(ws + WS_ST1); float* cs1 = (float*)(ws + WS_CS1); float* bw1 = cs1 + 1024;
    int* route_e = (int*)(ws + WS_ROUTE); float* route_g = (float*)(ws + WS_ROUTE + (size_t)T * 8);
    int* blkcnt = (int*)(ws + WS_BLKCNT); int* segw = (int*)(ws + WS_SEG); int* rank = (int*)(ws + WS_RANK);
    int* pair_tok = (int*)(ws + WS_PTOK); float* pair_gate = (float*)(ws + WS_PGATE); int* tokpos = (int*)(ws + WS_TOKPOS); bf16* Yb = (bf16*)(ws + WS_DD);

    const int lo = p.ph_lo, hi = p.ph_hi;
    int ph = 0;
    unsigned long long tprev = (PROBE_T >= 0) ? __builtin_amdgcn_s_memrealtime() : 0ull, tprobe = 0ull, tmark = 0ull; (void)tmark;
    volatile __attribute__((address_space(3))) unsigned* bst = (volatile __attribute__((address_space(3))) unsigned*)(ldsp + LDS_BYTES_K - 64);
    if (threadIdx.x == 0) { bst[0] = 0u; bst[1] = 0u; }
    __syncthreads();
    const XcdBarrier xbar = xcd_barrier_post((unsigned*)(ws + WS_CTL), bst);
    if (lo > hi) grid.sync();
#define PM(k) do { if (PROBE_T == 100 + (k)) tmark = __builtin_amdgcn_s_memrealtime(); } while (0)
#define PME(k) do { if (PROBE_T == 100 + (k)) tprobe += __builtin_amdgcn_s_memrealtime() - tmark; } while (0)
#define PHASE_BEGIN if (lo <= ph && ph < hi) { for (int rep_ = 0; rep_ < ((((unsigned)PROBE_MASK >> ph) & 1u) ? 2 : 1); ++rep_) { const int tid = wid_s * 64 + lane_fresh(); const int lane = tid & 63, wave = tid >> 6, gw = bid * 8 + wave; (void)lane; (void)wave; (void)gw;
#define PHASE_END } } if (lo <= ph && ph + 1 < hi) xcd_barrier(xbar, wid_s * 64 + lane_fresh()); if (PROBE_T >= 0) { const unsigned long long tn_ = __builtin_amdgcn_s_memrealtime(); if (ph == PROBE_T) tprobe = tn_ - tprev; tprev = tn_; } ++ph;

    PHASE_BEGIN
    {
        const size_t n4 = (size_t)T * D / 4, stride = (size_t)G * 512;
        for (size_t i0 = (size_t)bid * 512 + tid; i0 < n4; i0 += 8 * stride) { f32x4 v[8];
#pragma unroll
            for (int q = 0; q < 8; ++q) { const size_t i = i0 + q * stride; v[q] = (i < n4) ? __builtin_nontemporal_load((const f32x4*)x + i) : (f32x4){0.f, 0.f, 0.f, 0.f}; }
#pragma unroll
            for (int q = 0; q < 8; ++q) { const size_t i = i0 + q * stride; if (i < n4) { u32x2 w; w.x = pk2(v[q].x, v[q].y); w.y = pk2(v[q].z, v[q].w); ((u32x2*)xb)[i] = w; } } } }
    for (size_t i = (size_t)bid * 512 + tid; i < (size_t)NMEM * D / 4; i += (size_t)G * 512) { const f32x4 v = ((const f32x4*)mem)[i]; u32x2 w; w.x = pk2(v.x, v.y); w.y = pk2(v.z, v.w); ((u32x2*)memb)[i] = w; }
    {
        LAS float* scr = (LAS float*)(ldsp + wave * 16384);
        constexpr int I_IN = 16 * 56, I_KV = 16 * 64;
        for (int it = gw; it < I_IN + I_KV; it += NGW) { int r = it;
            if (r < I_IN) { const int kb = r / 56, nb = r % 56, n0 = nb * 32; const int dr = n0 < 512 ? (n0 >> 7) * 256 + (n0 & 127) : (n0 < 1024 ? ((n0 - 512) >> 7) * 256 + 128 + (n0 & 127) : n0);
                transpose_item(w_in, D_IN, Wt_in, 1024, kb * 64, n0, dr, scr, lane); continue; } r -= I_IN;
            transpose_item(w_mkv, 2048, Wt_mkv, 1024, (r / 64) * 64, (r % 64) * 32, (r % 64) * 32, scr, lane); }
    }
    PHASE_END

    PHASE_BEGIN
    for (int pass = 0; pass < 2; ++pass) {
      if ((pass == 0) == ((bid & 1) == 0)) {
        const int tl = wid_s * 64 + lane_fresh(), ll = tl & 63, wl = tl >> 6;
        LAS float* scr = (LAS float*)(ldsp + wl * 16384);
        constexpr int I_SQ = 16 * 32, I_EX = 16 * 256, N_T = 2 * I_SQ + 3 * I_EX, N_Q = 1024, N_B = 256, N_ALL = N_T + N_Q + N_B;
        int nb2 = 464 - G; nb2 = nb2 < 0 ? 0 : (nb2 > G ? G : nb2);
        const int NVB = nb2 + (G - nb2) * 3, nmine = (bid < nb2) ? 1 : 3, vb0 = (bid < nb2) ? bid : nb2 + (bid - nb2) * 3;
        auto decode = [&](int r, TItem& t) {
            if (r < I_SQ) { t = TItem{w_out, Wt_out, nullptr, 1024, 1024, (r / 32) * 64, (r % 32) * 32, (r % 32) * 32}; return; } r -= I_SQ;
            if (r < I_SQ) { t = TItem{w_mo, Wt_mo, nullptr, 1024, 1024, (r / 32) * 64, (r % 32) * 32, (r % 32) * 32}; return; } r -= I_SQ;
            if (r < I_EX) { const int e = r / 256, q = r % 256, n0 = (q % 16) * 32; t = TItem{w_gate + (size_t)e * D * DE, Wt_gu + (size_t)e * 1024 * 1024, nullptr, DE, 1024, (q / 16) * 64, n0, (n0 >> 7) * 256 + (n0 & 127)}; return; } r -= I_EX;
            if (r < I_EX) { const int e = r / 256, q = r % 256, n0 = (q % 16) * 32; t = TItem{w_up + (size_t)e * D * DE, Wt_gu + (size_t)e * 1024 * 1024, nullptr, DE, 1024, (q / 16) * 64, n0, (n0 >> 7) * 256 + 128 + (n0 & 127)}; return; } r -= I_EX;
            { const int e = r / 256, q = r % 256; t = TItem{w_down + (size_t)e * DE * D, Wt_dn + (size_t)e * 1024 * 512, nullptr, D, 512, (q / 32) * 64, (q % 32) * 32, (q % 32) * 32}; } };
        for (int vk = 0; vk < nmine; ++vk) {
          int it = (vb0 + vk) * 8 + wl;
          for (; it + NVB * 8 < N_T; it += 2 * NVB * 8) {
              TItem ta, tb; decode(it, ta); decode(it + NVB * 8, tb); float wa[32], wb[32];
              titem_load(ta, wa, ll); titem_load(tb, wb, ll); titem_store(ta, wa, scr, ll); titem_store(tb, wb, scr, ll); }
          for (; it < N_ALL; it += NVB * 8) { int r = it;
            if (r < N_T) { TItem ta; decode(r, ta); float wa[32]; titem_load(ta, wa, ll); titem_store(ta, wa, scr, ll); continue; } r -= N_T;
            if (r < N_Q) {
                f32x4 v[4];
#pragma unroll
                for (int q = 0; q < 4; ++q) v[q] = ((const f32x4*)w_mq)[(size_t)r * 256 + ll + 64 * q];
                const float gk = g_ln1[r];
#pragma unroll
                for (int q = 0; q < 4; ++q) { const f32x4 t = v[q] * gk; u32x2 w; w.x = pk2(t.x, t.y); w.y = pk2(t.z, t.w); ((u32x2*)Wqb)[(size_t)r * 256 + ll + 64 * q] = w; }
                continue; } r -= N_Q;
            {
                f32x4 b4 = (f32x4){0.f, 0.f, 0.f, 0.f};
#pragma unroll 4
                for (int i2 = 0; i2 < 16; ++i2) { const int k = ll + 64 * i2; const f32x4 w = *(const f32x4*)(w_mq + (size_t)k * 1024 + 4 * r); b4 += w * b_ln1[k]; }
#pragma unroll
                for (int e = 0; e < 4; ++e) b4[e] = wave_sum(b4[e]);
                if (ll == 0) *(f32x4*)(bw1 + 4 * r) = b4; }
          }
        }
        __syncthreads();
      } else {
        struct SchedP1 { const char *xb, *win, *memb, *wkv; int G, c;
            __device__ __forceinline__ bool next(int i, pg8::Unit& u) const { const int L = i * G + c; u.aux = 0;
                if (L < 448) { pg8::tile_of(L, 64, 7, u.pm, u.pn); u.A = xb + (size_t)u.pm * 256 * 2048; u.B = win + (size_t)u.pn * 256 * 2048; u.kind = u.pn < 4 ? 0 : 1; return true; }
                if (L < 464) { const int r = L - 448; u.pm = r >> 3; u.pn = r & 7; u.A = memb + (size_t)u.pm * 256 * 2048; u.B = wkv + (size_t)u.pn * 256 * 2048; u.kind = 2; return true; }
                return false; } };
        const SchedP1 S{(const char*)xb, (const char*)Wt_in, (const char*)memb, (const char*)Wt_mkv, G, bid};
        const pg8::EpiP1 E{hglu, qkv, kvm, b_in};
        pg8::gemm_phase(wid_s * 64 + lane_fresh(), ldsp, pg8::Gemm{1024, 1024, 1024}, S, E);
      }
    }
    PHASE_END

    PHASE_BEGIN
    PM(0); for (int cu = bid; cu < T / 32; cu += G) conv_unit(lds_raw, hglu, w_dw, b_dw, g_cn, b_cn, ycat, cu, tid); PME(0);
    PM(1); for (int u = bid; u < BATCH * NKV * (SEQ / 128); u += G) swa_unit(lds_raw, qkv, sinks, ycat, u >> 7, (u >> 6) & 1, u & 63, tid); PME(1);
    PM(2);
    {
        struct SchedMT { const char *kvm, *wq; int c;
            __device__ __forceinline__ bool next(int i, pg8::Unit& u) const { if (i > 0 || c < 0 || c >= 32) return false; const int b = c >> 4, h = (c >> 2) & 3, pn = c & 3; u.pm = h; u.pn = pn; u.aux = b; u.kind = 0;
                u.A = kvm + ((size_t)(b * 256) * 2048 + h * 256) * 2; u.B = wq + ((size_t)(pn * 256) * 1024 + h * 256) * 2; return true; } };
        struct SchedNT { const char *wo, *kvm; int c;
            __device__ __forceinline__ bool next(int i, pg8::Unit& u) const { if (i > 0 || c < 0 || c >= 32) return false; const int b = c >> 4, h = (c >> 2) & 3, pm = c & 3; u.pm = pm; u.pn = h; u.aux = b; u.kind = 0;
                u.A = wo + ((size_t)(pm * 256) * 1024 + h * 256) * 2; u.B = kvm + ((size_t)(b * 256) * 2048 + 1024 + h * 256) * 2; return true; } };
        const SchedMT S1{(const char*)kvm, (const char*)Wqb, bid}; const pg8::EpiPre E1{MT, csp};
        pg8::gemm_phase(wid_s * 64 + lane_fresh(), ldsp, pg8::Gemm{2048, 1024, 256}, S1, E1);
        const SchedNT S2{(const char*)Wt_mo, (const char*)kvm, bid - 32}; const pg8::EpiPre E2{NT, nullptr};
        pg8::gemm_phase(wid_s * 64 + lane_fresh(), ldsp, pg8::Gemm{1024, 2048, 256}, S2, E2);
    }
    PME(2);
    PHASE_END

    PHASE_BEGIN
    for (int r = gw; r < 2048; r += NGW) { const int b = r >> 10, hk = r & 1023, h = hk >> 8, key = hk & 255;
        const float c = wave_sum(lane < 16 ? csp[(size_t)r * 16 + lane] : 0.f);
        const u32x2 kk = *(const u32x2*)(kvm + (size_t)(b * 256 + key) * 2048 + h * 256 + 4 * lane); const f32x4 bq = *(const f32x4*)(bw1 + h * 256 + 4 * lane);
        const float w = wave_sum((bflo(kk.x) * bq[0] + bfhi(kk.x) * bq[1]) + (bflo(kk.y) * bq[2] + bfhi(kk.y) * bq[3]));
        if (lane == 0) { csS[r] = c; bwS[r] = w; } }
    { const pg8::DenseSched S{(const char*)ycat, (const char*)Wt_out, 64, 4, G, bid, (size_t)256 * 2048, (size_t)256 * 2048};
      const pg8::EpiResStats E{xb, x1b, stats1, ALPHA}; PM(7); pg8::gemm_phase(tid, ldsp, pg8::Gemm{1024, 1024, 1024}, S, E); PME(7); }
    PHASE_END
    PHASE_BEGIN
    {   struct SchedS { const char *z, *mt; int G, c;
            __device__ __forceinline__ bool next(int i, pg8::Unit& u) const { const int L = i * G + c; if (L >= 256) return false; pg8::tile_of(L, 64, 4, u.pm, u.pn); u.kind = 0; u.aux = u.pm >> 5;
                u.A = z + (size_t)u.pm * 256 * 2048; u.B = mt + ((size_t)u.aux * 1024 * 1024 + (size_t)u.pn * 256 * 1024) * 2; return true; } };
        const SchedS S{(const char*)x1b, (const char*)MT, G, bid};
        const pg8::EpiSoftmaxLn E{Pb2, (PG8_LAS float*)(ldsp + 131072), stats1, csS, bwS};
        PM(8); pg8::gemm_phase(tid, ldsp, pg8::Gemm{1024, 1024, 1024}, S, E); PME(8);
    }
    PHASE_END
    PHASE_BEGIN
    {   struct SchedN { const char *P, *nt; int G, c;
            __device__ __forceinline__ bool next(int i, pg8::Unit& u) const { const int L = i * G + c; if (L >= 256) return false; pg8::tile_of(L, 64, 4, u.pm, u.pn); u.kind = 0; u.aux = u.pm >> 5;
                u.A = P + (size_t)u.pm * 256 * 2048; u.B = nt + ((size_t)u.aux * 1024 * 1024 + (size_t)u.pn * 256 * 1024) * 2; return true; } };
        const SchedN S{(const char*)Pb2, (const char*)NT, G, bid};
        const pg8::EpiResLn E{out, x1b, stats1, g_ln1, b_ln1, ALPHA}; pg8::gemm_phase(tid, ldsp, pg8::Gemm{1024, 1024, 1024}, S, E);
    }
    PHASE_END
    const int TPB = (T + G - 1) / G;
    PHASE_BEGIN
    { const int t0 = bid * TPB, t1 = (t0 + TPB < T) ? t0 + TPB : T;
      float* Wl = ldsf;
      int* le = (int*)(lds_raw + 81920);
      for (int k = tid; k < D; k += 512) { const f32x4 wg = *(const f32x4*)(w_group + (size_t)k * 4);
          Wl[0 * D + k] = wg.x; Wl[1 * D + k] = wg.y; Wl[2 * D + k] = wg.z; Wl[3 * D + k] = wg.w;
#pragma unroll
          for (int gq = 0; gq < 4; ++gq) { const f32x4 wr = *(const f32x4*)(w_router + ((size_t)gq * D + k) * 4);
              Wl[(4 + gq * 4 + 0) * D + k] = wr.x; Wl[(4 + gq * 4 + 1) * D + k] = wr.y; Wl[(4 + gq * 4 + 2) * D + k] = wr.z; Wl[(4 + gq * 4 + 3) * D + k] = wr.w; } }
      __syncthreads();
      PM(4);
      const int TPW = (TPB + 7) / 8;
      const int mend = (t0 + (wave + 1) * TPW < t1) ? t0 + (wave + 1) * TPW : t1;
      f32x4 raw[2][4];
      { const int mb0 = t0 + wave * TPW; if (mb0 < mend) { ld_row(out + (size_t)mb0 * D, raw[0], lane); ld_row(out + (size_t)((mb0 + 1 < mend) ? mb0 + 1 : mb0) * D, raw[1], lane); } }
      for (int mb = t0 + wave * TPW; mb < mend; mb += 2) {
        f32x4 v[2][4];
        const bool has1 = (mb + 1 < mend);
#pragma unroll
        for (int jj = 0; jj < 4; ++jj) { v[0][jj] = raw[0][jj]; v[1][jj] = raw[1][jj]; }
        if (mb + 2 < mend) { ld_row(out + (size_t)(mb + 2) * D, raw[0], lane); ld_row(out + (size_t)((mb + 3 < mend) ? mb + 3 : mb + 2) * D, raw[1], lane); }
        ln_regs(v[0], g_ln2, b_ln2, lane);
        st_row_bf16(x2b + (size_t)mb * D, v[0], lane);
        ln_regs(v[1], g_ln2, b_ln2, lane);
        if (has1) st_row_bf16(x2b + (size_t)(mb + 1) * D, v[1], lane);
        float my[20];
#pragma unroll
        for (int c = 0; c < 20; ++c) {
            typedef float f32x2 __attribute__((ext_vector_type(2)));
            f32x2 p0 = (f32x2){0.f, 0.f}, p1 = p0;
#pragma unroll
            for (int jj = 0; jj < 4; ++jj) { const f32x4 w4 = ((const f32x4*)(Wl + c * D))[lane + 64 * jj]; const f32x2 wl2 = (f32x2){w4.x, w4.y}, wh2 = (f32x2){w4.z, w4.w};
                p0 = __builtin_elementwise_fma((f32x2){v[0][jj].x, v[0][jj].y}, wl2, p0); p0 = __builtin_elementwise_fma((f32x2){v[0][jj].z, v[0][jj].w}, wh2, p0);
                p1 = __builtin_elementwise_fma((f32x2){v[1][jj].x, v[1][jj].y}, wl2, p1); p1 = __builtin_elementwise_fma((f32x2){v[1][jj].z, v[1][jj].w}, wh2, p1); }
            float a0 = wave_sum(p0.x + p0.y), a1 = wave_sum(p1.x + p1.y);
            my[c] = (lane == 1) ? a1 : a0;
        }
        const int m = mb + lane;
        if (lane < 2 && m < mend) {
            float gl[4]; int gi = 0; float gmx = -INFINITY;
#pragma unroll
            for (int i = 0; i < 4; ++i) { gl[i] = my[i] + b_group[i]; if (gl[i] > gmx) { gmx = gl[i]; gi = i; } }
            float gs = 0.f;
#pragma unroll
            for (int i = 0; i < 4; ++i) gs += __expf(gl[i] - gmx);
            const float gp = 1.f / gs;
            float el[4];
#pragma unroll
            for (int i = 0; i < 4; ++i) { float a = my[4 + i], bq = b_router[i];
                a = (gi == 1) ? my[8 + i] : a; a = (gi == 2) ? my[12 + i] : a; a = (gi == 3) ? my[16 + i] : a;
                bq = (gi == 1) ? b_router[4 + i] : bq; bq = (gi == 2) ? b_router[8 + i] : bq; bq = (gi == 3) ? b_router[12 + i] : bq;
                el[i] = a + bq; }
            int i0 = 0; float v0 = el[0];
#pragma unroll
            for (int i = 1; i < 4; ++i) if (el[i] > v0) { v0 = el[i]; i0 = i; }
            int i1 = -1; float v1 = -INFINITY;
#pragma unroll
            for (int i = 0; i < 4; ++i) if (i != i0 && el[i] > v1) { v1 = el[i]; i1 = i; }
            const float w0 = 1.f / (1.f + __expf(v1 - v0)), w1 = 1.f - w0;
            route_e[2 * m] = gi * 4 + i0; route_e[2 * m + 1] = gi * 4 + i1; route_g[2 * m] = gp * w0; route_g[2 * m + 1] = gp * w1;
            le[2 * (m - t0)] = gi * 4 + i0; le[2 * (m - t0) + 1] = gi * 4 + i1;
        }
      }
      __syncthreads();
      PME(4); PM(5);
      const int np = 2 * (t1 - t0);
      for (int i = tid; i < np; i += 512) { const int e = le[i]; int r = 0; for (int j2 = 0; j2 < i; ++j2) r += (le[j2] == e) ? 1 : 0; rank[2 * t0 + i] = r; }
      if (tid < 16) { int c = 0; for (int j2 = 0; j2 < np; ++j2) c += (le[j2] == tid) ? 1 : 0; blkcnt[bid * 16 + tid] = c; }
      PME(5);
    }
    PHASE_END
    PHASE_BEGIN
    {
        int* sh = (int*)lds_raw;
        const int t0 = bid * TPB, t1 = (t0 + TPB < T) ? t0 + TPB : T, np = 2 * (t1 - t0);
        int my_e = 0, my_r = 0; float my_g = 0.f;
        if (tid < np) { const int pi = 2 * t0 + tid; my_e = route_e[pi]; my_r = rank[pi]; my_g = route_g[pi]; }
        { const int e = tid & 15, part = tid >> 4; int tot = 0, base = 0; int cv[8];
#pragma unroll
          for (int q = 0; q < 8; ++q) { const int b = part + 32 * q; cv[q] = (b < G) ? blkcnt[b * 16 + e] : 0; }
#pragma unroll
          for (int q = 0; q < 8; ++q) { const int b = part + 32 * q; tot += cv[q]; if (b < bid) base += cv[q]; }
          for (int b = part + 256; b < G; b += 32) { const int c = blkcnt[b * 16 + e]; tot += c; if (b < bid) base += c; }
          sh[128 + part * 16 + e] = tot; sh[640 + part * 16 + e] = base; }
        __syncthreads();
        if (tid < 16) { int tot = 0, base = 0;
#pragma unroll 8
            for (int part = 0; part < 32; ++part) { tot += sh[128 + part * 16 + tid]; base += sh[640 + part * 16 + tid]; } sh[tid] = base; sh[64 + tid] = tot; }
        __syncthreads();
        if (tid == 0) { int sacc = 0, nF = 0, nH = 0;
            for (int e = 0; e < 16; ++e) { const int n = sh[64 + e], nf = n >> 8, nh = ((n & 255) + 127) >> 7; sh[16 + e] = sacc; sacc += nf * 256 + nh * 128; nF += nf; nH += nh; }
            sh[32] = sacc;
            if (bid == 0) { segw[0] = nF; segw[1] = nH; int tf = 0, th = nF;
                for (int e = 0; e < 16; ++e) { const int n = sh[64 + e], nf = n >> 8, nh = ((n & 255) + 127) >> 7;
                    for (int k = 0; k < nf; ++k) { segw[2 + tf] = sh[16 + e] + 256 * k; segw[2 + 192 + tf] = e; ++tf; }
                    for (int k = 0; k < nh; ++k) { segw[2 + th] = sh[16 + e] + 256 * nf + 128 * k; segw[2 + 192 + th] = e; ++th; } } } }
        __syncthreads();
        if (bid == 0) { for (int e = 0; e < 16; ++e) for (int pos = sh[16 + e] + sh[64 + e] + tid; pos < sh[16 + e + 1]; pos += 512) { pair_tok[pos] = -1; pair_gate[pos] = 0.f; } }
        if (tid < np) { const int pi = 2 * t0 + tid, pos = sh[16 + my_e] + sh[my_e] + my_r; pair_tok[pos] = pi >> 1; pair_gate[pos] = my_g; tokpos[pi] = pos; }
    }
    PHASE_END
    PHASE_BEGIN
    { const SchedMoE S{(const char*)x2b, (const char*)Wt_gu, segw, pair_tok, segw[0], segw[1], G, bid, (size_t)2048, (size_t)1024 * 2048, (size_t)256 * 2048};
      const pg8::EpiGateUp E{Hs, pair_gate}; PM(6); pg8::gemm_phase<true, true>(tid, ldsp, pg8::Gemm{1024, 1024, 1024}, S, E); PME(6); }
    PHASE_END
    PHASE_BEGIN
    { const SchedMoE S{(const char*)Hs, (const char*)Wt_dn, segw, nullptr, segw[0], segw[1], G, bid, (size_t)1024, (size_t)1024 * 1024, (size_t)256 * 1024};
      const pg8::EpiY E{Yb}; PM(9); pg8::gemm_phase<false, true>(tid, ldsp, pg8::Gemm{512, 512, 512}, S, E); PME(9); }
    PHASE_END
    PHASE_BEGIN
    for (int mbase = gw; mbase < T; mbase += 8 * NGW) {
        int tp = 0;
        if (lane < 16) { const int mm = mbase + (lane >> 1) * NGW; if (mm < T) tp = tokpos[2 * mm + (lane & 1)]; }
        u32x2 xa[4], ya[4], yb[4];
#define P9_LOAD(mm, ii) do { const int p0_ = __builtin_amdgcn_readlane(tp, 2 * (ii)), p1_ = __builtin_amdgcn_readlane(tp, 2 * (ii) + 1); \
        _Pragma("unroll") for (int jj = 0; jj < 4; ++jj) { xa[jj] = ((const u32x2*)(x2b + (size_t)(mm) * D))[lane + 64 * jj]; ya[jj] = ((const u32x2*)(Yb + (size_t)p0_ * D))[lane + 64 * jj]; yb[jj] = ((const u32x2*)(Yb + (size_t)p1_ * D))[lane + 64 * jj]; } } while (0)
        P9_LOAD(mbase, 0);
        for (int i = 0; i < 8; ++i) { const int m = mbase + i * NGW; if (m >= T) break;
            f32x4 v[4]; float sacc = 0.f;
#pragma unroll
            for (int jj = 0; jj < 4; ++jj) { f32x4 z;
                z.x = bflo(xa[jj].x) * ALPHA + (bflo(ya[jj].x) + bflo(yb[jj].x)); z.y = bfhi(xa[jj].x) * ALPHA + (bfhi(ya[jj].x) + bfhi(yb[jj].x));
                z.z = bflo(xa[jj].y) * ALPHA + (bflo(ya[jj].y) + bflo(yb[jj].y)); z.w = bfhi(xa[jj].y) * ALPHA + (bfhi(ya[jj].y) + bfhi(yb[jj].y)); v[jj] = z; sacc += (z.x + z.y) + (z.z + z.w); }
            if (i + 1 < 8 && m + NGW < T) P9_LOAD(m + NGW, i + 1);
            const float mean = wave_sum(sacc) * (1.f / D); float s2 = 0.f;
#pragma unroll
            for (int jj = 0; jj < 4; ++jj) { v[jj] = v[jj] - mean; s2 += (v[jj].x * v[jj].x + v[jj].y * v[jj].y) + (v[jj].z * v[jj].z + v[jj].w * v[jj].w); }
            const float rstd = 1.f / sqrtf(wave_sum(s2) * (1.f / D) + LN_EPS);
            float* row = out + (size_t)m * D;
#pragma unroll
            for (int jj = 0; jj < 4; ++jj) { const f32x4 gg = ((const f32x4*)g_ln3)[lane + 64 * jj], bb = ((const f32x4*)b_ln3)[lane + 64 * jj]; ((f32x4*)row)[lane + 64 * jj] = v[jj] * rstd * gg + bb; } }
#undef P9_LOAD
    }
    PHASE_END
    if (PROBE_T >= 0 && blockIdx.x == 0) { const unsigned long long tend = __builtin_amdgcn_s_memrealtime() + 9ull * tprobe; while (__builtin_amdgcn_s_memrealtime() < tend) __builtin_amdgcn_s_sleep(8); }
}

constexpr int N_PHASES = 16;
constexpr int LDS_BYTES = 147456;

extern "C" void kernel_launch(void* const* d_in, const int* in_sizes, int n_in, void* d_out, int out_size, void* d_ws, size_t ws_size, hipStream_t stream) {
    static int grid = 0;
    if (grid == 0) {
        int dev = 0, cus = 0, per_cu = 0;
        hipGetDevice(&dev);
        hipDeviceGetAttribute(&cus, hipDeviceAttributeMultiprocessorCount, dev);
        hipFuncSetAttribute((const void*)fwd_kernel, hipFuncAttributeMaxDynamicSharedMemorySize, LDS_BYTES);
        hipOccupancyMaxActiveBlocksPerMultiprocessor(&per_cu, (const void*)fwd_kernel, 512, LDS_BYTES);
        if (per_cu < 1) { fprintf(stderr, "occupancy query returned %d\n", per_cu); per_cu = 1; }
        grid = cus * 1;
        if (ws_size < WS_END) { fprintf(stderr, "workspace too small\n"); grid = -1; }
    }
    if (grid < 0) return;
    if (hipMemsetAsync((char*)d_ws + WS_CTL, 0, 65536, stream) != hipSuccess) { fprintf(stderr, "memset failed\n"); return; }
    Params p{};
    for (int i = 0; i < 26; ++i) p.in[i] = (const float*)d_in[i];
    p.out = (float*)d_out; p.ws = (unsigned char*)d_ws;
#if MK_N_LAUNCHES == 1
    p.ph_lo = 0; p.ph_hi = 64;
    void* args[] = {&p};
    hipError_t e = hipLaunchCooperativeKernel((const void*)fwd_kernel, dim3(grid), dim3(512), args, LDS_BYTES, stream);
    if (e != hipSuccess) fprintf(stderr, "cooperative launch failed: %s (grid %d)\n", hipGetErrorString(e), grid);
#else
    for (int ph = 0; ph < N_PHASES; ++ph) { p.ph_lo = ph; p.ph_hi = ph + 1; hipLaunchKernelGGL(fwd_kernel, dim3(grid), dim3(512), LDS_BYTES, stream, p); }
#endif
}
```

```cpp
#include <hip/hip_runtime.h>
#include <hip/hip_cooperative_groups.h>
#include <cstdio>
#include <cstdint>
namespace cg = cooperative_groups;

#ifndef PROBE_MASK
#define PROBE_MASK 0
#endif
#ifndef PROBE_T
#define PROBE_T -1
#endif
#ifndef MK_N_LAUNCHES
#define MK_N_LAUNCHES 1
#endif

typedef unsigned short bf16;
typedef float f32x4 __attribute__((ext_vector_type(4)));
typedef unsigned u32x4 __attribute__((ext_vector_type(4)));
typedef unsigned u32x2 __attribute__((ext_vector_type(2)));

constexpr int BATCH = 2, SEQ = 8192, D = 1024, T = BATCH * SEQ, MEM = 256, NMEM = BATCH * MEM;
constexpr int CONV_CH = 512, CONV_W = 31, NH = 8, NKV = 2, HD = 64, ATTN_W = 512, KV_W = 128, WINDOW = 128;
constexpr int D_IN = 1792, MH = 4, MHD = 256, NG = 4, EPG = 4, NE = 16, DE = 512;
constexpr float ALPHA = 1.189207115002721f, LN_EPS = 1e-5f;
constexpr int NPAIR = 2 * T, NPAIR_PAD = NPAIR + NE * 256;
constexpr int LDS_BYTES_K = 147456;

constexpr size_t MiB = 1u << 20;
constexpr size_t WS_CTL = 0;
constexpr size_t WS_ROUTE = 1 * MiB;
constexpr size_t WS_BLKCNT = 1 * MiB + 512 * 1024;
constexpr size_t WS_SEG = 1 * MiB + 640 * 1024;
constexpr size_t WS_RANK = 2 * MiB;
constexpr size_t WS_PTOK = 2 * MiB + 256 * 1024;
constexpr size_t WS_PGATE = 2 * MiB + 512 * 1024;
constexpr size_t WS_TOKPOS = 2 * MiB + 768 * 1024;
constexpr size_t WS_KVM = 3 * MiB;
constexpr size_t WS_MEMB = 5 * MiB;
constexpr size_t WS_A = 8 * MiB;
constexpr size_t WS_B = 48 * MiB;
constexpr size_t WS_DD = 88 * MiB;
constexpr size_t WS_WIN = 164 * MiB;
constexpr size_t WS_WOUT = 168 * MiB, WS_WMQ = 170 * MiB, WS_WMKV = 172 * MiB, WS_WMO = 176 * MiB;
constexpr size_t WS_WGU = 178 * MiB;
constexpr size_t WS_WDN = 210 * MiB;
constexpr size_t WS_ST1 = 226 * MiB;
constexpr size_t WS_CS1 = 128 * 1024;
constexpr size_t WS_MT = 228 * MiB;
constexpr size_t WS_NT = 232 * MiB;
constexpr size_t WS_CSS = 192 * 1024;
constexpr size_t WS_CSP = 256 * 1024;
constexpr size_t WS_END = 236 * MiB;

struct Params { const float* in[26]; float* out; unsigned char* ws; int ph_lo, ph_hi; };

__device__ __forceinline__ unsigned f2bf(float f) { unsigned u = __builtin_bit_cast(unsigned, f); return (u + 0x7fffu + ((u >> 16) & 1u)) >> 16; }
__device__ __forceinline__ float bf2f(bf16 b) { return __builtin_bit_cast(float, (unsigned)b << 16); }
__device__ __forceinline__ unsigned pk2(float lo, float hi) { return f2bf(lo) | (f2bf(hi) << 16); }
template <int CTRL, int ROWMASK> __device__ __forceinline__ float dpp_f(float v) { return __builtin_bit_cast(float, __builtin_amdgcn_update_dpp(0, __builtin_bit_cast(int, v), CTRL, ROWMASK, 0xF, false)); }
__device__ __forceinline__ float wave_sum(float v) {
    v += dpp_f<0xB1, 0xF>(v);
    v += dpp_f<0x4E, 0xF>(v);
    v += dpp_f<0x141, 0xF>(v);
    v += dpp_f<0x140, 0xF>(v);
    v += dpp_f<0x142, 0xA>(v);
    v += dpp_f<0x143, 0xC>(v);
    return __builtin_bit_cast(float, __builtin_amdgcn_readlane(__builtin_bit_cast(int, v), 63));
}
__device__ __forceinline__ float wave_max(float v) {
    v = fmaxf(v, __builtin_bit_cast(float, __builtin_amdgcn_update_dpp(__builtin_bit_cast(int, v), __builtin_bit_cast(int, v), 0xB1, 0xF, 0xF, false)));
    v = fmaxf(v, __builtin_bit_cast(float, __builtin_amdgcn_update_dpp(__builtin_bit_cast(int, v), __builtin_bit_cast(int, v), 0x4E, 0xF, 0xF, false)));
    v = fmaxf(v, __builtin_bit_cast(float, __builtin_amdgcn_update_dpp(__builtin_bit_cast(int, v), __builtin_bit_cast(int, v), 0x141, 0xF, 0xF, false)));
    v = fmaxf(v, __builtin_bit_cast(float, __builtin_amdgcn_update_dpp(__builtin_bit_cast(int, v), __builtin_bit_cast(int, v), 0x140, 0xF, 0xF, false)));
    v = fmaxf(v, __builtin_bit_cast(float, __builtin_amdgcn_update_dpp(__builtin_bit_cast(int, v), __builtin_bit_cast(int, v), 0x142, 0xA, 0xF, false)));
    v = fmaxf(v, __builtin_bit_cast(float, __builtin_amdgcn_update_dpp(__builtin_bit_cast(int, v), __builtin_bit_cast(int, v), 0x143, 0xC, 0xF, false)));
    return __builtin_bit_cast(float, __builtin_amdgcn_readlane(__builtin_bit_cast(int, v), 63));
}
__device__ __forceinline__ int lane_fresh() { int l; asm volatile("v_mbcnt_lo_u32_b32 %0, -1, 0\n\tv_mbcnt_hi_u32_b32 %0, -1, %0" : "=v"(l)); return l; }
__device__ __forceinline__ float ldA(const bf16* p) { return bf2f(*p); }
__device__ __forceinline__ float ldA(const float* p) { return *p; }


template <int CTRL> __device__ __forceinline__ float dpp_mov(float v) { return __builtin_bit_cast(float, __builtin_amdgcn_update_dpp(0, __builtin_bit_cast(int, v), CTRL, 0xF, 0xF, false)); }
__device__ __forceinline__ float reduce40(const float (&p0)[20], const float (&p1)[20], int lane) {
    float r5[20];
#pragma unroll
    for (int c = 0; c < 20; ++c) { float a = p0[c], b = p1[c];
        asm volatile("s_nop 1\n\tv_permlane32_swap_b32 %0, %1\n\ts_nop 1" : "+v"(a), "+v"(b));
        r5[c] = a + b; }
    float r4[10];
#pragma unroll
    for (int c = 0; c < 10; ++c) { float a = r5[c], b = r5[c + 10];
        asm volatile("s_nop 1\n\tv_permlane16_swap_b32 %0, %1\n\ts_nop 1" : "+v"(a), "+v"(b));
        r4[c] = a + b; }
    const bool b3 = (lane & 8) != 0, b2 = (lane & 4) != 0, b1 = (lane & 2) != 0, b0 = (lane & 1) != 0;
    float r3[5];
#pragma unroll
    for (int c = 0; c < 5; ++c) { const float a = r4[c] + dpp_mov<0x128>(r4[c]), b = r4[c + 5] + dpp_mov<0x128>(r4[c + 5]); r3[c] = b3 ? b : a; }
    float r2[3];
    { const float a0 = r3[0] + dpp_mov<0x141>(r3[0]), a3 = r3[3] + dpp_mov<0x141>(r3[3]), a1 = r3[1] + dpp_mov<0x141>(r3[1]), a4 = r3[4] + dpp_mov<0x141>(r3[4]);
      r2[0] = b2 ? a3 : a0; r2[1] = b2 ? a4 : a1; r2[2] = r3[2] + dpp_mov<0x141>(r3[2]); }
    float r1[2];
    { const float a0 = r2[0] + dpp_mov<0x4E>(r2[0]), a2 = r2[2] + dpp_mov<0x4E>(r2[2]); r1[0] = b1 ? a2 : a0; r1[1] = r2[1] + dpp_mov<0x4E>(r2[1]); }
    const float a0 = r1[0] + dpp_mov<0xB1>(r1[0]), a1 = r1[1] + dpp_mov<0xB1>(r1[1]);
    return b0 ? a1 : a0;
}

template <int NB, class FA, class FB, class FE>
__device__ __forceinline__ void ngemm_tile(int tid, float* lds, int K, int m0, int n0, FA fa, FB fb, FE fe) {
    float* As = lds;
    float* Bs = lds + 16 * 132;
    const int ty = tid >> 4, tx = tid & 15;
    float acc[NB][4][4];
#pragma unroll
    for (int b = 0; b < NB; ++b)
#pragma unroll
        for (int i = 0; i < 4; ++i)
#pragma unroll
            for (int j = 0; j < 4; ++j) acc[b][i][j] = 0.f;
    for (int k0 = 0; k0 < K; k0 += 16) {
        { const int r = tid >> 2, kk = (tid & 3) * 4;
#pragma unroll
            for (int i = 0; i < 4; ++i) As[(kk + i) * 132 + r] = fa(m0 + r, k0 + kk + i); }
#pragma unroll
        for (int b = 0; b < NB; ++b) { const int kk = tid >> 5, nn = (tid & 31) * 2;
            Bs[(b * 16 + kk) * 68 + nn] = fb(b, k0 + kk, n0 + nn); Bs[(b * 16 + kk) * 68 + nn + 1] = fb(b, k0 + kk, n0 + nn + 1); }
        __syncthreads();
#pragma unroll 4
        for (int k = 0; k < 16; ++k) {
            const f32x4 a = *(const f32x4*)&As[k * 132 + ty * 4];
#pragma unroll
            for (int b = 0; b < NB; ++b) { const f32x4 bb = *(const f32x4*)&Bs[(b * 16 + k) * 68 + tx * 4];
#pragma unroll
                for (int i = 0; i < 4; ++i)
#pragma unroll
                    for (int j = 0; j < 4; ++j) acc[b][i][j] += a[i] * bb[j]; }
        }
        __syncthreads();
    }
#pragma unroll
    for (int i = 0; i < 4; ++i)
#pragma unroll
        for (int j = 0; j < 4; ++j) fe(m0 + ty * 4 + i, n0 + tx * 4 + j, acc[0][i][j], acc[NB - 1][i][j]);
}

__device__ __forceinline__ void ln_row(const float* src, const float* g, const float* b, f32x4 (&v)[4], int lane) {
    const f32x4* xr = (const f32x4*)src + lane; float s = 0.f;
#pragma unroll
    for (int j = 0; j < 4; ++j) { v[j] = xr[64 * j]; s += (v[j].x + v[j].y) + (v[j].z + v[j].w); }
    const float mean = wave_sum(s) * (1.f / D); float s2 = 0.f;
#pragma unroll
    for (int j = 0; j < 4; ++j) { v[j] = v[j] - mean; s2 += (v[j].x * v[j].x + v[j].y * v[j].y) + (v[j].z * v[j].z + v[j].w * v[j].w); }
    const float rstd = 1.f / sqrtf(wave_sum(s2) * (1.f / D) + LN_EPS);
#pragma unroll
    for (int j = 0; j < 4; ++j) { const f32x4 gg = ((const f32x4*)g)[lane + 64 * j], bb = ((const f32x4*)b)[lane + 64 * j]; v[j] = v[j] * rstd * gg + bb; }
}
__device__ __forceinline__ void ld_row(const float* src, f32x4 (&v)[4], int lane) {
#pragma unroll
    for (int j = 0; j < 4; ++j) v[j] = ((const f32x4*)src)[lane + 64 * j];
}
__device__ __forceinline__ void ld_row_bf16(const bf16* src, f32x4 (&v)[4], int lane) {
#pragma unroll
    for (int j = 0; j < 4; ++j) { const u32x2 q = ((const u32x2*)src)[lane + 64 * j];
        v[j] = (f32x4){__builtin_bit_cast(float, q.x << 16), __builtin_bit_cast(float, q.x & 0xffff0000u), __builtin_bit_cast(float, q.y << 16), __builtin_bit_cast(float, q.y & 0xffff0000u)}; }
}
__device__ __forceinline__ void ln_regs(f32x4 (&v)[4], const float* g, const float* b, int lane) {
    float s = 0.f;
#pragma unroll
    for (int j = 0; j < 4; ++j) s += (v[j].x + v[j].y) + (v[j].z + v[j].w);
    const float mean = wave_sum(s) * (1.f / D); float s2 = 0.f;
#pragma unroll
    for (int j = 0; j < 4; ++j) { v[j] = v[j] - mean; s2 += (v[j].x * v[j].x + v[j].y * v[j].y) + (v[j].z * v[j].z + v[j].w * v[j].w); }
    const float rstd = 1.f / sqrtf(wave_sum(s2) * (1.f / D) + LN_EPS);
#pragma unroll
    for (int j = 0; j < 4; ++j) { const f32x4 gg = ((const f32x4*)g)[lane + 64 * j], bb = ((const f32x4*)b)[lane + 64 * j]; v[j] = v[j] * rstd * gg + bb; }
}
__device__ __forceinline__ void st_row_f32(float* dst, const f32x4 (&v)[4], float scale, int lane) {
#pragma unroll
    for (int j = 0; j < 4; ++j) ((f32x4*)dst)[lane + 64 * j] = v[j] * scale;
}
__device__ __forceinline__ void st_row_bf16(bf16* dst, const f32x4 (&v)[4], int lane) {
#pragma unroll
    for (int j = 0; j < 4; ++j) { u32x2 w; w.x = pk2(v[j].x, v[j].y); w.y = pk2(v[j].z, v[j].w); ((u32x2*)dst)[lane + 64 * j] = w; }
}


namespace pg8 {
#define PG8_LAS __attribute__((address_space(3)))
typedef unsigned short bf16_t;
typedef short bf16x8 __attribute__((ext_vector_type(8)));
constexpr int BM = 256, BK = 64, HALF = 128, HTB = HALF * BK * 2, STAGE_BYTES = 8 * HTB, NXCD = 8, WGM = 8;
__device__ __forceinline__ int lds_byte(int r, int c) { const int st = (r >> 4) * 2 + (c >> 5), rr = r & 15, cc = c & 31, ob = rr * 64 + cc * 2; return st * 1024 + (ob ^ (((ob >> 9) & 1) << 5)); }
__device__ __forceinline__ void stage_rc(int b, int& R, int& C) { const int st = b / 1024, sb = b % 1024, swz = sb ^ (((sb >> 9) & 1) << 5); R = (st >> 1) * 16 + swz / 64; C = (st & 1) * 32 + (swz % 64) / 2; }
__device__ __forceinline__ int perm32(int rho) { const int n = rho >> 4, i = rho & 15; return 8 * (i >> 2) + 4 * n + (i & 3); }
struct Unit { const char* A; const char* B; const int* rows; int pm, pn, kind, aux, rb, half; };
struct Gemm { int lda, ldb, K; };
__device__ __forceinline__ void tile_of(int L, int nM, int nN, int& pm, int& pn) {
    const int nwg = nM * nN; int wgid = L; { const int q = nwg / NXCD, r = nwg % NXCD, xcd = wgid % NXCD, off = wgid / NXCD; wgid = (xcd < r ? xcd * (q + 1) : r * (q + 1) + (xcd - r) * q) + off; }
    const int nig = WGM * nN, gid = wgid / nig, fm = gid * WGM, gsz = (nM - fm) < WGM ? (nM - fm) : WGM;
    pm = fm + ((wgid % nig) % gsz); pn = (wgid % nig) / gsz;
}
__device__ __forceinline__ unsigned cvt_pk_bf16(float lo, float hi) { unsigned r; asm volatile("v_cvt_pk_bf16_f32 %0, %1, %2" : "=v"(r) : "v"(lo), "v"(hi)); return r; }

template <bool GATHER = false, bool HALFU = false, class Epi, class Sched>
__device__ __forceinline__ void gemm_phase(int tid, PG8_LAS unsigned char* lds, const Gemm g, const Sched& S, const Epi& E) {
    const int wid = __builtin_amdgcn_readfirstlane(tid >> 6), lane = tid & 63, wr = wid >> 2, wc = wid & 3, fr = lane & 15, fq = lane >> 4;
    const int K = g.K, nt = K / BK;
    unsigned voffA[2], voffB[2]; int gR[2]; unsigned gC[2];
#pragma unroll
    for (int i = 0; i < 2; ++i) { int R, C; stage_rc(tid * 16 + i * 8192, R, C); const int Rb = Epi::PERM ? ((R & ~31) + perm32(R & 31)) : R;
        voffA[i] = (unsigned)(R * g.lda + C) * 2u; voffB[i] = (unsigned)(Rb * g.ldb + C) * 2u; gR[i] = R; gC[i] = (unsigned)C * 2u; }
    unsigned vgc[2][2], vgn[2][2];
    const size_t kstep = (size_t)(BK * 2);
    const size_t hstepA = (size_t)HALF * g.lda * 2, hstepB = (size_t)HALF * g.ldb * 2;
    const unsigned ldsw = (unsigned)wid * 1024u;
    const int aoff = lds_byte(wr * 64 + fr, fq * 8), boff = lds_byte(wc * 32 + fr, fq * 8);
#define PG8_SA(b, h) (((b) * 2 + (h)) * HTB)
#define PG8_SB(b, h) ((4 + (b) * 2 + (h)) * HTB)
#define PG8_STAGE(bufoff, gbase, voff) do { _Pragma("unroll") for (int _i = 0; _i < 2; ++_i) \
        __builtin_amdgcn_global_load_lds((const unsigned*)((const char*)(gbase) + (voff)[_i]), (PG8_LAS unsigned*)(lds + (bufoff) + ldsw + _i * 8192), 16, 0, 0); } while (0)
#define PG8_GOFF(dst, rows) do { _Pragma("unroll") for (int _h = 0; _h < 2; ++_h) _Pragma("unroll") for (int _i = 0; _i < 2; ++_i) { int _t = (rows)[_h * HALF + gR[_i]]; _t = _t < 0 ? 0 : _t; dst[_h][_i] = (unsigned)_t * (unsigned)(g.lda * 2) + gC[_i]; } } while (0)
#define PG8_STAGE_A(bufoff, h, kptr, useNext) do { if constexpr (GATHER) { unsigned _v[2]; _v[0] = (useNext) ? vgn[h][0] : vgc[h][0]; _v[1] = (useNext) ? vgn[h][1] : vgc[h][1]; PG8_STAGE(bufoff, kptr, _v); } \
        else { PG8_STAGE(bufoff, (kptr) + (h) * hstepA, voffA); } } while (0)
#define PG8_LDA(dst, b, h) do { _Pragma("unroll") for (int m = 0; m < 4; ++m) _Pragma("unroll") for (int k = 0; k < 2; ++k) dst[m][k] = *(const PG8_LAS bf16x8*)(lds + PG8_SA(b, h) + aoff + m * 2048 + k * 1024); } while (0)
#define PG8_LDB(dst, b, h) do { _Pragma("unroll") for (int n = 0; n < 2; ++n) _Pragma("unroll") for (int k = 0; k < 2; ++k) dst[n][k] = *(const PG8_LAS bf16x8*)(lds + PG8_SB(b, h) + boff + n * 2048 + k * 1024); } while (0)
#define PG8_MMA(ai, bj, At, Bt) do { __builtin_amdgcn_s_setprio(1); _Pragma("unroll") for (int m = 0; m < 4; ++m) _Pragma("unroll") for (int n = 0; n < 2; ++n) _Pragma("unroll") for (int k = 0; k < 2; ++k) \
        acc[ai][bj][m][n] = __builtin_amdgcn_mfma_f32_16x16x32_bf16(Bt[n][k], At[m][k], acc[ai][bj][m][n], 0, 0, 0); __builtin_amdgcn_s_setprio(0); } while (0)
#define PG8_WAIT_V(n) asm volatile("s_waitcnt vmcnt(" #n ")" ::: "memory")
#define PG8_WAIT_L(n) asm volatile("s_waitcnt lgkmcnt(" #n ")" ::: "memory")
#define PG8_BAR __builtin_amdgcn_s_barrier()
#define PG8_SCHED __builtin_amdgcn_sched_barrier(0)
    Unit cur, nxt; int ui = 0;
    if (!S.next(0, cur)) return;
    f32x4 acc[2][2][4][2];
#pragma unroll
    for (int a = 0; a < 2; ++a)
#pragma unroll
        for (int b = 0; b < 2; ++b)
#pragma unroll
            for (int m = 0; m < 4; ++m)
#pragma unroll
                for (int n = 0; n < 2; ++n) acc[a][b][m][n] = (f32x4){0.f, 0.f, 0.f, 0.f};
    bf16x8 At[4][2], B0[2][2], B1[2][2];
    const char* cA = cur.A; const char* cB = cur.B;
    if constexpr (GATHER) { PG8_GOFF(vgc, cur.rows); }
    PG8_STAGE(PG8_SB(0, 0), cB, voffB); PG8_STAGE(PG8_SB(0, 1), cB + hstepB, voffB); PG8_STAGE_A(PG8_SA(0, 0), 0, cA, false); PG8_STAGE_A(PG8_SA(0, 1), 1, cA, false);
    if (wr == 1) PG8_BAR;
    PG8_WAIT_V(2); PG8_BAR;
    PG8_STAGE(PG8_SB(1, 0), cB + kstep, voffB); PG8_STAGE_A(PG8_SA(1, 0), 0, cA + kstep, false); PG8_STAGE(PG8_SB(1, 1), cB + hstepB + kstep, voffB);
    PG8_WAIT_V(6); PG8_BAR;
    for (;;) {
        const bool has_next = S.next(ui + 1, nxt);
        const char* nA = has_next ? nxt.A : cA; const char* nB = has_next ? nxt.B : cB;
        if constexpr (GATHER) { if (has_next) { PG8_GOFF(vgn, nxt.rows); asm volatile("" : "+v"(vgn[0][0]), "+v"(vgn[0][1]), "+v"(vgn[1][0]), "+v"(vgn[1][1]));   } else { _Pragma("unroll") for (int _h = 0; _h < 2; ++_h) { vgn[_h][0] = vgc[_h][0]; vgn[_h][1] = vgc[_h][1]; } } }
        for (int t = 0; t < nt; t += 2) {
            const bool last = (t == nt - 2);
            const char* a1 = cA + (size_t)(t + 1) * kstep;
            const char* a2 = last ? nA : cA + (size_t)(t + 2) * kstep; const char* b2 = last ? nB : cB + (size_t)(t + 2) * kstep;
            const char* a3 = a2 + kstep; const char* b3 = b2 + kstep;
            PG8_LDB(B0, 0, 0); PG8_LDB(B1, 0, 1); PG8_SCHED; PG8_LDA(At, 0, 0); PG8_STAGE_A(PG8_SA(1, 1), 1, a1, false);
            PG8_WAIT_V(8); PG8_WAIT_L(0); PG8_BAR; PG8_MMA(0, 0, At, B0); PG8_MMA(0, 1, At, B1); PG8_BAR; PG8_SCHED;
            PG8_LDA(At, 0, 1); PG8_STAGE(PG8_SB(0, 0), b2, voffB); PG8_STAGE(PG8_SB(0, 1), b2 + hstepB, voffB); PG8_STAGE_A(PG8_SA(0, 0), 0, a2, last);
            PG8_WAIT_V(8); PG8_WAIT_L(0); PG8_BAR; if (!HALFU || !cur.half) { PG8_MMA(1, 0, At, B0); PG8_MMA(1, 1, At, B1); } PG8_BAR; PG8_SCHED;
            PG8_LDB(B0, 1, 0); PG8_LDB(B1, 1, 1); PG8_SCHED; PG8_LDA(At, 1, 0); PG8_STAGE_A(PG8_SA(0, 1), 1, a2, last);
            PG8_WAIT_V(8); PG8_WAIT_L(0); PG8_BAR; PG8_MMA(0, 0, At, B0); PG8_MMA(0, 1, At, B1); PG8_BAR; PG8_SCHED;
            PG8_LDA(At, 1, 1); PG8_STAGE(PG8_SB(1, 0), b3, voffB); PG8_STAGE(PG8_SB(1, 1), b3 + hstepB, voffB); PG8_STAGE_A(PG8_SA(1, 0), 0, a3, last);
            PG8_WAIT_V(8); PG8_WAIT_L(0); PG8_BAR; if (!HALFU || !cur.half) { PG8_MMA(1, 0, At, B0); PG8_MMA(1, 1, At, B1); } PG8_BAR; PG8_SCHED;
        }
        if (wr == 0) PG8_BAR;
        E(acc, cur, wr, wc, fr, fq);
        if (!has_next) break;
#pragma unroll
        for (int a = 0; a < 2; ++a)
#pragma unroll
            for (int b = 0; b < 2; ++b)
#pragma unroll
                for (int m = 0; m < 4; ++m)
#pragma unroll
                    for (int n = 0; n < 2; ++n) acc[a][b][m][n] = (f32x4){0.f, 0.f, 0.f, 0.f};
        cur = nxt; cA = nA; cB = nB; ++ui;
        if constexpr (GATHER) { _Pragma("unroll") for (int _h = 0; _h < 2; ++_h) { vgc[_h][0] = vgn[_h][0]; vgc[_h][1] = vgn[_h][1]; } }
        if (wr == 1) PG8_BAR;
    }
    PG8_WAIT_V(0);
    PG8_BAR;
#undef PG8_SA
#undef PG8_SB
#undef PG8_STAGE
#undef PG8_LDA
#undef PG8_GOFF
#undef PG8_STAGE_A
#undef PG8_LDB
#undef PG8_MMA
#undef PG8_WAIT_V
#undef PG8_WAIT_L
#undef PG8_BAR
#undef PG8_SCHED
}

__device__ __forceinline__ u32x4 pack8(const f32x4 v0, const f32x4 v1) { u32x4 w; w.x = cvt_pk_bf16(v0[0], v0[1]); w.y = cvt_pk_bf16(v0[2], v0[3]); w.z = cvt_pk_bf16(v1[0], v1[1]); w.w = cvt_pk_bf16(v1[2], v1[3]); return w; }
__device__ __forceinline__ float sigm(float g) { return __builtin_amdgcn_rcpf(1.f + __expf(-g)); }

struct EpiBf16 {
    static constexpr bool PERM = true;
    bf16_t* O; int ldc; const float* bias;
    __device__ __forceinline__ void operator()(const f32x4 (&acc)[2][2][4][2], const Unit& u, int wr, int wc, int fr, int fq) const {
        const int row0 = u.pm * BM + wr * 64 + fr, col0 = u.pn * BM + wc * 32 + 8 * fq;
        f32x4 bv[2][2];
#pragma unroll
        for (int bj = 0; bj < 2; ++bj)
#pragma unroll
            for (int n = 0; n < 2; ++n) bv[bj][n] = bias ? *(const f32x4*)(bias + col0 + bj * HALF + 4 * n) : (f32x4){0.f, 0.f, 0.f, 0.f};
#pragma unroll
        for (int ai = 0; ai < 2; ++ai)
#pragma unroll
            for (int m = 0; m < 4; ++m) { bf16_t* rowp = O + (size_t)(row0 + ai * HALF + m * 16) * ldc + col0;
#pragma unroll
                for (int bj = 0; bj < 2; ++bj) *(u32x4*)(rowp + bj * HALF) = pack8(acc[ai][bj][m][0] + bv[bj][0], acc[ai][bj][m][1] + bv[bj][1]); }
    }
};
struct EpiP1 {
    static constexpr bool PERM = true;
    bf16_t *hglu, *qkv, *kvm; const float* b_in;
    __device__ __forceinline__ void operator()(const f32x4 (&acc)[2][2][4][2], const Unit& u, int wr, int wc, int fr, int fq) const {
        if (u.kind == 0) {
            const int row0 = u.pm * BM + wr * 64 + fr, cb = u.pn * 128 + wc * 32 + 8 * fq;
            f32x4 ba[2], bg[2];
#pragma unroll
            for (int n = 0; n < 2; ++n) { ba[n] = *(const f32x4*)(b_in + cb + 4 * n); bg[n] = *(const f32x4*)(b_in + 512 + cb + 4 * n); }
#pragma unroll
            for (int ai = 0; ai < 2; ++ai)
#pragma unroll
                for (int m = 0; m < 4; ++m) { f32x4 h[2];
#pragma unroll
                    for (int n = 0; n < 2; ++n) { const f32x4 a = acc[ai][0][m][n] + ba[n], gt = acc[ai][1][m][n] + bg[n];
                        h[n] = (f32x4){a[0] * sigm(gt[0]), a[1] * sigm(gt[1]), a[2] * sigm(gt[2]), a[3] * sigm(gt[3])}; }
                    *(u32x4*)(hglu + (size_t)(row0 + ai * HALF + m * 16) * 512 + cb) = pack8(h[0], h[1]); }
        } else if (u.kind == 1) { EpiBf16 e{qkv - 1024, 768, b_in}; e(acc, u, wr, wc, fr, fq);
        } else { EpiBf16 e{kvm, 2048, nullptr}; e(acc, u, wr, wc, fr, fq); }
    }
};
struct EpiResF32 {
    static constexpr bool PERM = false;
    const float* res; float* out; float alpha;
    __device__ __forceinline__ void operator()(const f32x4 (&acc)[2][2][4][2], const Unit& u, int wr, int wc, int fr, int fq) const {
        const int row0 = u.pm * BM + wr * 64 + fr, col0 = u.pn * BM + wc * 32 + 4 * fq;
#pragma unroll
        for (int ai = 0; ai < 2; ++ai)
#pragma unroll
            for (int m = 0; m < 4; ++m) { const size_t off = (size_t)(row0 + ai * HALF + m * 16) * 1024 + col0;
#pragma unroll
                for (int bj = 0; bj < 2; ++bj)
#pragma unroll
                    for (int n = 0; n < 2; ++n) { const f32x4 r = *(const f32x4*)(res + off + bj * HALF + n * 16); *(f32x4*)(out + off + bj * HALF + n * 16) = r * alpha + acc[ai][bj][m][n]; } }
    }
};
struct EpiSoftmax {
    static constexpr bool PERM = true;
    bf16_t* P; PG8_LAS float* xl;
    __device__ __forceinline__ void operator()(const f32x4 (&acc)[2][2][4][2], const Unit& u, int wr, int wc, int fr, int fq) const {
        const float sc = 0.0625f * 1.4426950408889634f;
#pragma unroll
        for (int ai = 0; ai < 2; ++ai)
#pragma unroll
            for (int m = 0; m < 4; ++m) { float mx = -INFINITY;
#pragma unroll
                for (int bj = 0; bj < 2; ++bj)
#pragma unroll
                    for (int n = 0; n < 2; ++n) { const f32x4 v = acc[ai][bj][m][n]; mx = fmaxf(mx, fmaxf(fmaxf(v[0], v[1]), fmaxf(v[2], v[3]))); }
                mx = fmaxf(mx, __shfl_xor(mx, 16)); mx = fmaxf(mx, __shfl_xor(mx, 32));
                float s = 0.f;
#pragma unroll
                for (int bj = 0; bj < 2; ++bj)
#pragma unroll
                    for (int n = 0; n < 2; ++n) { const f32x4 v = acc[ai][bj][m][n]; s += (__builtin_amdgcn_exp2f((v[0] - mx) * sc) + __builtin_amdgcn_exp2f((v[1] - mx) * sc)) + (__builtin_amdgcn_exp2f((v[2] - mx) * sc) + __builtin_amdgcn_exp2f((v[3] - mx) * sc)); }
                s += __shfl_xor(s, 16); s += __shfl_xor(s, 32);
                if (fq == 0) { PG8_LAS float* q = xl + ((ai * HALF + wr * 64 + m * 16 + fr) * 4 + wc) * 2; q[0] = mx; q[1] = s; } }
        asm volatile("s_waitcnt lgkmcnt(0)" ::: "memory"); __builtin_amdgcn_s_barrier(); asm volatile("" ::: "memory");
        const int row0 = u.pm * BM + wr * 64 + fr, col0 = u.pn * BM + wc * 32 + 8 * fq;
#pragma unroll
        for (int ai = 0; ai < 2; ++ai)
#pragma unroll
            for (int m = 0; m < 4; ++m) { const PG8_LAS f32x4* q = (const PG8_LAS f32x4*)(xl + (ai * HALF + wr * 64 + m * 16 + fr) * 8); const f32x4 q0 = q[0], q1 = q[1];
                const float M = fmaxf(fmaxf(q0[0], q0[2]), fmaxf(q1[0], q1[2]));
                const float S = (q0[1] * __builtin_amdgcn_exp2f((q0[0] - M) * sc) + q0[3] * __builtin_amdgcn_exp2f((q0[2] - M) * sc)) + (q1[1] * __builtin_amdgcn_exp2f((q1[0] - M) * sc) + q1[3] * __builtin_amdgcn_exp2f((q1[2] - M) * sc));
                const float inv = 1.f / S; bf16_t* rowp = P + (size_t)(row0 + ai * HALF + m * 16) * 1024 + col0;
#pragma unroll
                for (int bj = 0; bj < 2; ++bj) { f32x4 p[2];
#pragma unroll
                    for (int n = 0; n < 2; ++n) { const f32x4 v = acc[ai][bj][m][n];
                        p[n] = (f32x4){__builtin_amdgcn_exp2f((v[0] - M) * sc) * inv, __builtin_amdgcn_exp2f((v[1] - M) * sc) * inv, __builtin_amdgcn_exp2f((v[2] - M) * sc) * inv, __builtin_amdgcn_exp2f((v[3] - M) * sc) * inv}; }
                    *(u32x4*)(rowp + bj * HALF) = pack8(p[0], p[1]); } }
        asm volatile("s_waitcnt lgkmcnt(0)" ::: "memory"); __builtin_amdgcn_s_barrier(); asm volatile("" ::: "memory");
    }
};
struct EpiGateUp {
    static constexpr bool PERM = true;
    bf16_t* Hs; const float* pair_gate;
    __device__ __forceinline__ void operator()(const f32x4 (&acc)[2][2][4][2], const Unit& u, int wr, int wc, int fr, int fq) const {
        const int row0 = u.rb + wr * 64 + fr, cb = u.pn * 128 + wc * 32 + 8 * fq;
        float pgv[2][4];
#pragma unroll
        for (int ai = 0; ai < 2; ++ai)
#pragma unroll
            for (int m = 0; m < 4; ++m) pgv[ai][m] = (ai == 0 || !u.half) ? pair_gate[row0 + ai * HALF + m * 16] : 0.f;
#pragma unroll
        for (int ai = 0; ai < 2; ++ai) { if (ai == 1 && u.half) break;
#pragma unroll
            for (int m = 0; m < 4; ++m) { const int row = row0 + ai * HALF + m * 16; const float pg = pgv[ai][m]; f32x4 h[2];
#pragma unroll
                for (int n = 0; n < 2; ++n) { const f32x4 gt = acc[ai][0][m][n], up = acc[ai][1][m][n];
                    h[n] = (f32x4){gt[0] * sigm(gt[0]) * up[0] * pg, gt[1] * sigm(gt[1]) * up[1] * pg, gt[2] * sigm(gt[2]) * up[2] * pg, gt[3] * sigm(gt[3]) * up[3] * pg}; }
                if (pg == 0.f) { h[0] = (f32x4){0.f, 0.f, 0.f, 0.f}; h[1] = h[0]; }
                *(u32x4*)(Hs + (size_t)row * 512 + cb) = pack8(h[0], h[1]); } }
    }
};
struct EpiY {
    static constexpr bool PERM = true;
    bf16_t* Y;
    __device__ __forceinline__ void operator()(const f32x4 (&acc)[2][2][4][2], const Unit& u, int wr, int wc, int fr, int fq) const {
        const int row0 = u.rb + wr * 64 + fr, col0 = u.pn * BM + wc * 32 + 8 * fq;
#pragma unroll
        for (int ai = 0; ai < 2; ++ai) { if (ai == 1 && u.half) break;
#pragma unroll
            for (int m = 0; m < 4; ++m) { bf16_t* rowp = Y + (size_t)(row0 + ai * HALF + m * 16) * 1024 + col0;
#pragma unroll
                for (int bj = 0; bj < 2; ++bj) *(u32x4*)(rowp + bj * HALF) = pack8(acc[ai][bj][m][0], acc[ai][bj][m][1]); } }
    }
};
struct EpiDown {
    static constexpr bool PERM = false;
    float* out; const int* pair_tok;
    __device__ __forceinline__ void operator()(const f32x4 (&acc)[2][2][4][2], const Unit& u, int wr, int wc, int fr, int fq) const {
        const int row0 = u.pm * BM + wr * 64 + fr, col0 = u.pn * BM + wc * 32 + 4 * fq;
#pragma unroll
        for (int ai = 0; ai < 2; ++ai)
#pragma unroll
            for (int m = 0; m < 4; ++m) { const int tok = pair_tok[row0 + ai * HALF + m * 16];
                if (tok >= 0) { float* rp = out + (size_t)tok * 1024 + col0;
#pragma unroll
                    for (int bj = 0; bj < 2; ++bj)
#pragma unroll
                        for (int n = 0; n < 2; ++n)
#pragma unroll
                            for (int i = 0; i < 4; ++i) unsafeAtomicAdd(rp + bj * HALF + n * 16 + i, acc[ai][bj][m][n][i]); } }
    }
};

__device__ __forceinline__ void row_stats16(const float* stats, int row, int fq, float& mu, float& rstd) {
    const f32x4* sp = (const f32x4*)(stats + (size_t)row * 32 + fq * 8); const f32x4 a = sp[0], b = sp[1];
    float s = (a[0] + a[2]) + (b[0] + b[2]), ss = (a[1] + a[3]) + (b[1] + b[3]);
    s += __shfl_xor(s, 16); s += __shfl_xor(s, 32); ss += __shfl_xor(ss, 16); ss += __shfl_xor(ss, 32);
    mu = s * (1.f / 1024.f); const float var = ss * (1.f / 1024.f) - mu * mu; rstd = 1.f / sqrtf(var + 1e-5f);
}
__device__ __forceinline__ void row_stats16x4(const float* stats, int rowh, int fq, float (&mu)[4], float (&rstd)[4]) {
    f32x4 sa[4], sb[4];
#pragma unroll
    for (int m = 0; m < 4; ++m) { const f32x4* sp = (const f32x4*)(stats + (size_t)(rowh + m * 16) * 32 + fq * 8); sa[m] = sp[0]; sb[m] = sp[1]; }
#pragma unroll
    for (int m = 0; m < 4; ++m) { const f32x4 a = sa[m], b = sb[m];
        float s = (a[0] + a[2]) + (b[0] + b[2]), ss = (a[1] + a[3]) + (b[1] + b[3]);
        s += __shfl_xor(s, 16); s += __shfl_xor(s, 32); ss += __shfl_xor(ss, 16); ss += __shfl_xor(ss, 32);
        const float mm = s * (1.f / 1024.f); mu[m] = mm; rstd[m] = 1.f / sqrtf(ss * (1.f / 1024.f) - mm * mm + 1e-5f); }
}
struct EpiResStats {
    static constexpr bool PERM = false;
    const bf16_t* resb; bf16_t* zb; float* stats; float alpha;
    __device__ __forceinline__ void operator()(const f32x4 (&acc)[2][2][4][2], const Unit& u, int wr, int wc, int fr, int fq) const {
        const int row0 = u.pm * BM + wr * 64 + fr, col0 = u.pn * BM + wc * 32 + 4 * fq;
#pragma unroll
        for (int ai = 0; ai < 2; ++ai) {
            u32x2 rw[4][2][2];
#pragma unroll
            for (int m = 0; m < 4; ++m)
#pragma unroll
                for (int bj = 0; bj < 2; ++bj)
#pragma unroll
                    for (int n = 0; n < 2; ++n) rw[m][bj][n] = *(const u32x2*)(resb + (size_t)(row0 + ai * HALF + m * 16) * 1024 + col0 + bj * HALF + n * 16);
#pragma unroll
            for (int m = 0; m < 4; ++m) { const int row = row0 + ai * HALF + m * 16; const size_t off = (size_t)row * 1024 + col0; float sm = 0.f, ss = 0.f;
#pragma unroll
                for (int bj = 0; bj < 2; ++bj)
#pragma unroll
                    for (int n = 0; n < 2; ++n) { const u32x2 q = rw[m][bj][n];
                        const f32x4 r = (f32x4){__builtin_bit_cast(float, q.x << 16), __builtin_bit_cast(float, q.x & 0xffff0000u), __builtin_bit_cast(float, q.y << 16), __builtin_bit_cast(float, q.y & 0xffff0000u)};
                        const f32x4 z = r * alpha + acc[ai][bj][m][n];
                        u32x2 w; w.x = cvt_pk_bf16(z[0], z[1]); w.y = cvt_pk_bf16(z[2], z[3]); *(u32x2*)(zb + off + bj * HALF + n * 16) = w;
                        sm += (z[0] + z[1]) + (z[2] + z[3]); ss += (z[0] * z[0] + z[1] * z[1]) + (z[2] * z[2] + z[3] * z[3]); }
                sm += __shfl_xor(sm, 16); sm += __shfl_xor(sm, 32); ss += __shfl_xor(ss, 16); ss += __shfl_xor(ss, 32);
                if (fq == 0) *(float2*)(stats + (size_t)row * 32 + (u.pn * 4 + wc) * 2) = make_float2(sm, ss); } }
    }
};
struct EpiResLn {
    static constexpr bool PERM = false;
    bf16_t* out; const bf16_t* zb; const float* stats; const float* g; const float* b; float alpha;
    __device__ __forceinline__ void operator()(const f32x4 (&acc)[2][2][4][2], const Unit& u, int wr, int wc, int fr, int fq) const {
        const int row0 = u.pm * BM + wr * 64 + fr, col0 = u.pn * BM + wc * 32 + 4 * fq;
        f32x4 gv[2][2], bv[2][2];
#pragma unroll
        for (int bj = 0; bj < 2; ++bj)
#pragma unroll
            for (int n = 0; n < 2; ++n) { gv[bj][n] = *(const f32x4*)(g + col0 + bj * HALF + n * 16); bv[bj][n] = *(const f32x4*)(b + col0 + bj * HALF + n * 16); }
#pragma unroll
        for (int ai = 0; ai < 2; ++ai) {
            float mu[4], rstd[4]; row_stats16x4(stats, row0 + ai * HALF, fq, mu, rstd);
            u32x2 zw[4][2][2];
#pragma unroll
            for (int m = 0; m < 4; ++m)
#pragma unroll
                for (int bj = 0; bj < 2; ++bj)
#pragma unroll
                    for (int n = 0; n < 2; ++n) zw[m][bj][n] = *(const u32x2*)(zb + (size_t)(row0 + ai * HALF + m * 16) * 1024 + col0 + bj * HALF + n * 16);
#pragma unroll
            for (int m = 0; m < 4; ++m) { const size_t off = (size_t)(row0 + ai * HALF + m * 16) * 1024 + col0; const float mm = mu[m], rs = rstd[m];
#pragma unroll
                for (int bj = 0; bj < 2; ++bj)
#pragma unroll
                    for (int n = 0; n < 2; ++n) { const u32x2 q = zw[m][bj][n];
                        const f32x4 z = (f32x4){__builtin_bit_cast(float, q.x << 16), __builtin_bit_cast(float, q.x & 0xffff0000u), __builtin_bit_cast(float, q.y << 16), __builtin_bit_cast(float, q.y & 0xffff0000u)};
                        const f32x4 x1 = (z - mm) * rs * gv[bj][n] + bv[bj][n];
                        const f32x4 z2 = x1 * alpha + acc[ai][bj][m][n]; u32x2 w; w.x = cvt_pk_bf16(z2[0], z2[1]); w.y = cvt_pk_bf16(z2[2], z2[3]); *(u32x2*)(out + off + bj * HALF + n * 16) = w; } } }
    }
};
struct EpiRank1 {
    static constexpr bool PERM = true;
    bf16_t* O; const float* stats; const float* cs; const float* bw;
    __device__ __forceinline__ void operator()(const f32x4 (&acc)[2][2][4][2], const Unit& u, int wr, int wc, int fr, int fq) const {
        const int row0 = u.pm * BM + wr * 64 + fr, col0 = u.pn * BM + wc * 32 + 8 * fq;
        f32x4 cv[2][2], wv[2][2];
#pragma unroll
        for (int bj = 0; bj < 2; ++bj)
#pragma unroll
            for (int n = 0; n < 2; ++n) { cv[bj][n] = *(const f32x4*)(cs + col0 + bj * HALF + 4 * n); wv[bj][n] = *(const f32x4*)(bw + col0 + bj * HALF + 4 * n); }
#pragma unroll
        for (int ai = 0; ai < 2; ++ai)
#pragma unroll
            for (int m = 0; m < 4; ++m) { const int row = row0 + ai * HALF + m * 16; float mu, rstd; row_stats16(stats, row, fq, mu, rstd); bf16_t* rowp = O + (size_t)row * 1024 + col0;
#pragma unroll
                for (int bj = 0; bj < 2; ++bj) *(u32x4*)(rowp + bj * HALF) = pack8((acc[ai][bj][m][0] - cv[bj][0] * mu) * rstd + wv[bj][0], (acc[ai][bj][m][1] - cv[bj][1] * mu) * rstd + wv[bj][1]); }
    }
};

struct EpiPre {
    static constexpr bool PERM = true;
    bf16_t* O; float* csp;
    __device__ __forceinline__ void operator()(const f32x4 (&acc)[2][2][4][2], const Unit& u, int wr, int wc, int fr, int fq) const {
        const int row0 = u.pm * BM + wr * 64 + fr, col0 = u.pn * BM + wc * 32 + 8 * fq;
#pragma unroll
        for (int ai = 0; ai < 2; ++ai)
#pragma unroll
            for (int m = 0; m < 4; ++m) { const int row = row0 + ai * HALF + m * 16; bf16_t* rowp = O + ((size_t)u.aux * 1024 + row) * 1024 + col0; float sm = 0.f;
#pragma unroll
                for (int bj = 0; bj < 2; ++bj) { const u32x4 w = pack8(acc[ai][bj][m][0], acc[ai][bj][m][1]); *(u32x4*)(rowp + bj * HALF) = w;
#pragma unroll
                    for (int e = 0; e < 4; ++e) sm += __builtin_bit_cast(float, w[e] << 16) + __builtin_bit_cast(float, w[e] & 0xffff0000u); }
                if (csp) { sm += __shfl_xor(sm, 16); sm += __shfl_xor(sm, 32); if (fq == 0) csp[((size_t)u.aux * 1024 + row) * 16 + u.pn * 4 + wc] = sm; } }
    }
};
struct EpiSoftmaxLn {
    static constexpr bool PERM = true;
    bf16_t* P; PG8_LAS float* xl; const float* stats; const float* cs; const float* bw;
    __device__ __forceinline__ void operator()(f32x4 (&acc)[2][2][4][2], const Unit& u, int wr, int wc, int fr, int fq) const {
        const float sc = 0.0625f * 1.4426950408889634f;
        const int row0 = u.pm * BM + wr * 64 + fr, col0 = u.pn * BM + wc * 32 + 8 * fq;
        unsigned xw = (unsigned)(size_t)(xl + ((wr * 64 + fr) * 4 + wc) * 2), xr = (unsigned)(size_t)(xl + (wr * 64 + fr) * 8);
        asm volatile("" : "+v"(xw), "+v"(xr));
        PG8_LAS float* const xwp = (PG8_LAS float*)(size_t)xw; const PG8_LAS float* const xrp = (const PG8_LAS float*)(size_t)xr;
        { f32x4 cv[2][2], wv[2][2];
#pragma unroll
          for (int bj = 0; bj < 2; ++bj)
#pragma unroll
            for (int n = 0; n < 2; ++n) { cv[bj][n] = *(const f32x4*)(cs + u.aux * 1024 + col0 + bj * HALF + 4 * n); wv[bj][n] = *(const f32x4*)(bw + u.aux * 1024 + col0 + bj * HALF + 4 * n); }
#pragma unroll
          for (int ai = 0; ai < 2; ++ai) { float mu8[4], rs8[4];
#pragma unroll
            for (int m = 0; m < 4; ++m) row_stats16(stats, row0 + ai * HALF + m * 16, fq, mu8[m], rs8[m]);
#pragma unroll
            for (int m = 0; m < 4; ++m) {
#pragma unroll
                for (int bj = 0; bj < 2; ++bj)
#pragma unroll
                    for (int n = 0; n < 2; ++n) acc[ai][bj][m][n] = (acc[ai][bj][m][n] - cv[bj][n] * mu8[m]) * rs8[m] + wv[bj][n]; } } }
#pragma unroll
        for (int ai = 0; ai < 2; ++ai)
#pragma unroll
            for (int m = 0; m < 4; ++m) { float mx = -INFINITY;
#pragma unroll
                for (int bj = 0; bj < 2; ++bj)
#pragma unroll
                    for (int n = 0; n < 2; ++n) { const f32x4 v = acc[ai][bj][m][n]; mx = fmaxf(mx, fmaxf(fmaxf(v[0], v[1]), fmaxf(v[2], v[3]))); }
                mx = fmaxf(mx, __shfl_xor(mx, 16)); mx = fmaxf(mx, __shfl_xor(mx, 32));
                float sm = 0.f;
#pragma unroll
                for (int bj = 0; bj < 2; ++bj)
#pragma unroll
                    for (int n = 0; n < 2; ++n) { const f32x4 v = acc[ai][bj][m][n];
                        const f32x4 e = (f32x4){__builtin_amdgcn_exp2f((v[0] - mx) * sc), __builtin_amdgcn_exp2f((v[1] - mx) * sc), __builtin_amdgcn_exp2f((v[2] - mx) * sc), __builtin_amdgcn_exp2f((v[3] - mx) * sc)};
                        acc[ai][bj][m][n] = e; sm += (e[0] + e[1]) + (e[2] + e[3]); }
                sm += __shfl_xor(sm, 16); sm += __shfl_xor(sm, 32);
                if (fq == 0) { PG8_LAS float* q = xwp + (ai * HALF + m * 16) * 8; q[0] = mx; q[1] = sm; } }
        asm volatile("s_waitcnt lgkmcnt(0)" ::: "memory"); __builtin_amdgcn_s_barrier(); asm volatile("" ::: "memory");
#pragma unroll
        for (int ai = 0; ai < 2; ++ai)
#pragma unroll
            for (int m = 0; m < 4; ++m) { const PG8_LAS f32x4* q = (const PG8_LAS f32x4*)(xrp + (ai * HALF + m * 16) * 8); const f32x4 q0 = q[0], q1 = q[1];
                const float M = fmaxf(fmaxf(q0[0], q0[2]), fmaxf(q1[0], q1[2]));
                const float S = (q0[1] * __builtin_amdgcn_exp2f((q0[0] - M) * sc) + q0[3] * __builtin_amdgcn_exp2f((q0[2] - M) * sc)) + (q1[1] * __builtin_amdgcn_exp2f((q1[0] - M) * sc) + q1[3] * __builtin_amdgcn_exp2f((q1[2] - M) * sc));
                const float mine = (wc == 0) ? q0[0] : (wc == 1) ? q0[2] : (wc == 2) ? q1[0] : q1[2];
                const float fac = __builtin_amdgcn_exp2f((mine - M) * sc) / S; bf16_t* rowp = P + (size_t)(row0 + ai * HALF + m * 16) * 1024 + col0;
#pragma unroll
                for (int bj = 0; bj < 2; ++bj) *(u32x4*)(rowp + bj * HALF) = pack8(acc[ai][bj][m][0] * fac, acc[ai][bj][m][1] * fac); }
        asm volatile("s_waitcnt lgkmcnt(0)" ::: "memory"); __builtin_amdgcn_s_barrier(); asm volatile("" ::: "memory");
    }
};
struct DenseSched {
    const char* A; const char* B; int nM, nN, G, c; size_t strideA, strideB;
    __device__ __forceinline__ bool next(int i, Unit& u) const { const int L = i * G + c; if (L >= nM * nN) return false; tile_of(L, nM, nN, u.pm, u.pn); u.A = A + (size_t)u.pm * strideA; u.B = B + (size_t)u.pn * strideB; u.kind = 0; u.aux = 0; u.rows = nullptr; return true; }
};
}


#define LAS __attribute__((address_space(3)))
struct TItem { const float* W; bf16* WT; const float* gk; int N, Kd, k0, n0, drow0; };
__device__ __forceinline__ void titem_load(const TItem& t, float (&wv)[32], int lane) {
#pragma unroll
    for (int i = 0; i < 32; ++i) { const int kk = 2 * i + (lane >> 5); wv[i] = __builtin_nontemporal_load(t.W + (size_t)(t.k0 + kk) * t.N + t.n0 + (lane & 31)); }
}
__device__ __forceinline__ void titem_store(const TItem& t, const float (&wv)[32], LAS float* scr, int lane) {
#pragma unroll
    for (int i = 0; i < 32; ++i) { const int kk = 2 * i + (lane >> 5); float v = wv[i]; if (t.gk) v *= t.gk[t.k0 + kk]; scr[kk * 33 + (lane & 31)] = v; }
    asm volatile("s_waitcnt lgkmcnt(0)" ::: "memory");
    const int c = lane & 7;
#pragma unroll
    for (int j = 0; j < 4; ++j) { const int n = (lane >> 3) + 8 * j; const LAS float* sp = scr + (8 * c) * 33 + n;
        u32x4 o; o.x = pk2(sp[0 * 33], sp[1 * 33]); o.y = pk2(sp[2 * 33], sp[3 * 33]); o.z = pk2(sp[4 * 33], sp[5 * 33]); o.w = pk2(sp[6 * 33], sp[7 * 33]);
        *(u32x4*)(t.WT + (size_t)(t.drow0 + n) * t.Kd + t.k0 + 8 * c) = o; }
    asm volatile("s_waitcnt lgkmcnt(0)" ::: "memory");
}
__device__ __forceinline__ void transpose_item(const float* W, int N, bf16* WT, int Kd, int k0, int n0, int drow0, LAS float* scr, int lane, const float* gk = nullptr) {
    const TItem t{W, WT, gk, N, Kd, k0, n0, drow0}; float wv[32]; titem_load(t, wv, lane); titem_store(t, wv, scr, lane);
}

typedef short bf16x8v __attribute__((ext_vector_type(8)));
__device__ __forceinline__ float bflo(unsigned v) { return __builtin_bit_cast(float, v << 16); }
__device__ __forceinline__ float bfhi(unsigned v) { return __builtin_bit_cast(float, v & 0xffff0000u); }

__device__ __forceinline__ void conv_load(const bf16* hglu, int cu, int tid, u32x4 (&pre)[8]) {
    const int t0 = cu * 32, s0 = t0 % SEQ;
#pragma unroll
    for (int i = 0; i < 8; ++i) { const int c = tid + 512 * i, row = c >> 6, part = c & 63; u32x4 v = (u32x4){0u, 0u, 0u, 0u};
        if (c < 62 * 64 && s0 - 30 + row >= 0) v = *(const u32x4*)(hglu + (size_t)(t0 - 30 + row) * 512 + part * 8);
        pre[i] = v; }
}
__device__ __forceinline__ void conv_stage(unsigned char* lds, int tid, const u32x4 (&pre)[8]) {
    bf16* hin = (bf16*)lds;
#pragma unroll
    for (int i = 0; i < 8; ++i) { const int c = tid + 512 * i, row = c >> 6, part = c & 63; if (c < 62 * 64) *(u32x4*)(hin + row * 512 + part * 8) = pre[i]; }
}
typedef float f32x2c __attribute__((ext_vector_type(2)));
struct ConvW { f32x2c wj[CONV_W]; f32x2c bb; f32x4 g0, g1, c0, c1; };
__device__ __forceinline__ void conv_weights(const float* w_dw, const float* b_dw, const float* g_cn, const float* b_cn, int tid, ConvW& w) {
    const int cp = tid & 255, lane = tid & 63;
#pragma unroll
    for (int j = 0; j < CONV_W; ++j) w.wj[j] = *(const f32x2c*)(w_dw + j * CONV_CH + 2 * cp);
    w.bb = *(const f32x2c*)(b_dw + 2 * cp);
    w.g0 = *(const f32x4*)(g_cn + 8 * lane); w.g1 = *(const f32x4*)(g_cn + 8 * lane + 4); w.c0 = *(const f32x4*)(b_cn + 8 * lane); w.c1 = *(const f32x4*)(b_cn + 8 * lane + 4);
}
__device__ __forceinline__ void conv_unit(unsigned char* lds, const ConvW& w, bf16* ycat, int cu, int tid) {
    const int lane = tid & 63, wave = tid >> 6;
    bf16* hin = (bf16*)lds; float* cout = (float*)(lds + 63488);
    const int t0 = cu * 32;
    {
        const int cp = tid & 255, th = tid >> 8;
#pragma unroll 1
        for (int grp = 0; grp < 2; ++grp) { const int tt0 = th * 16 + grp * 8;
            f32x2c ac[8];
#pragma unroll
            for (int o = 0; o < 8; ++o) ac[o] = w.bb;
#pragma unroll
            for (int r = 0; r < 38; ++r) { const unsigned v = *(const unsigned*)(hin + (tt0 + r) * 512 + 2 * cp); const f32x2c hv = (f32x2c){bflo(v), bfhi(v)};
#pragma unroll
                for (int o = 0; o < 8; ++o) { const int j = r - o; if (j >= 0 && j < CONV_W) ac[o] = __builtin_elementwise_fma(w.wj[j], hv, ac[o]); } }
#pragma unroll
            for (int o = 0; o < 8; ++o) *(f32x2c*)(cout + (tt0 + o) * 512 + 2 * cp) = ac[o];
        }
    }
    __syncthreads();
    {
        f32x4 v0[4], v1[4]; float mean[4], rstd[4];
#pragma unroll
        for (int i = 0; i < 4; ++i) { const int tt = wave * 4 + i; v0[i] = *(const f32x4*)(cout + tt * 512 + 8 * lane); v1[i] = *(const f32x4*)(cout + tt * 512 + 8 * lane + 4); }
#pragma unroll
        for (int i = 0; i < 4; ++i) mean[i] = wave_sum((v0[i].x + v0[i].y) + (v0[i].z + v0[i].w) + (v1[i].x + v1[i].y) + (v1[i].z + v1[i].w)) * (1.f / 512.f);
#pragma unroll
        for (int i = 0; i < 4; ++i) { v0[i] = v0[i] - mean[i]; v1[i] = v1[i] - mean[i];
            rstd[i] = wave_sum((v0[i].x * v0[i].x + v0[i].y * v0[i].y) + (v0[i].z * v0[i].z + v0[i].w * v0[i].w) + (v1[i].x * v1[i].x + v1[i].y * v1[i].y) + (v1[i].z * v1[i].z + v1[i].w * v1[i].w)) * (1.f / 512.f); }
#pragma unroll
        for (int i = 0; i < 4; ++i) { const int tt = wave * 4 + i; const float rs = 1.f / sqrtf(rstd[i] + LN_EPS);
            f32x4 y0 = v0[i] * rs * w.g0 + w.c0, y1 = v1[i] * rs * w.g1 + w.c1;
#pragma unroll
            for (int e = 0; e < 4; ++e) { y0[e] = y0[e] * pg8::sigm(y0[e]); y1[e] = y1[e] * pg8::sigm(y1[e]); }
            *(u32x4*)(ycat + (size_t)(t0 + tt) * 1024 + 8 * lane) = pg8::pack8(y0, y1); }
    }
    __syncthreads();
}

__device__ __forceinline__ void swa_load(const bf16* qkv, int b, int kvh, int qb, int tid, u32x4 (&kk)[4], u32x4 (&vq)[4]) {
    const long tk0 = (long)b * SEQ + (long)qb * 128 - 128;
#pragma unroll
    for (int i = 0; i < 4; ++i) { const int c = tid + 512 * i, row = c >> 3, part = c & 7; const bool ok = (qb > 0) || (row >= 128);
        u32x4 kv = (u32x4){0u, 0u, 0u, 0u}, vv = kv;
        if (ok) { const bf16* rp = qkv + (tk0 + row) * 768 + 512 + kvh * 64 + part * 8; kv = *(const u32x4*)rp; vv = *(const u32x4*)(rp + 128); }
        kk[i] = kv; vq[i] = vv; }
}
__device__ __forceinline__ void swa_unit(unsigned char* lds, const bf16* qkv, const float* sinks, bf16* ycat, int b, int kvh, int qb, int tid, const u32x4 (&kk)[4], const u32x4 (&vq)[4]) {
    const int lane = tid & 63, wave = tid >> 6, q4 = lane >> 4, c16 = lane & 15;
    bf16* Ks = (bf16*)lds; bf16* VT = (bf16*)(lds + 36864);
    const long t0 = (long)b * SEQ + (long)qb * 128;
#pragma unroll
    for (int i = 0; i < 4; ++i) { const int c = tid + 512 * i, row = c >> 3, part = c & 7;
        const u32x4 kv = kk[i], vv = vq[i];
        *(u32x4*)(Ks + row * 72 + part * 8) = kv;
#pragma unroll
        for (int e = 0; e < 4; ++e) { VT[(part * 8 + 2 * e) * 264 + row] = (bf16)(vv[e] & 0xffffu); VT[(part * 8 + 2 * e + 1) * 264 + row] = (bf16)(vv[e] >> 16); } }
    __syncthreads();
    const int g = wave >> 1, hq = kvh * 4 + g, i0 = (wave & 1) * 64;
    const float L2E = 1.4426950408889634f, sc = 0.125f * L2E, sink2 = sinks[hq] * L2E;
    bf16x8v Qf[4][2];
#pragma unroll
    for (int qt = 0; qt < 4; ++qt) { const bf16* qp = qkv + (t0 + i0 + qt * 16 + c16) * 768 + hq * 64 + 8 * q4; Qf[qt][0] = *(const bf16x8v*)qp; Qf[qt][1] = *(const bf16x8v*)(qp + 32); }
#pragma unroll
    for (int qt = 0; qt < 4; ++qt) {
        const int iq = i0 + qt * 16, kt0 = iq >> 4, iqc = iq + c16;
        const bf16x8v Q0 = Qf[qt][0], Q1 = Qf[qt][1];
        f32x4 sv[9];
#pragma unroll
        for (int kt = 0; kt < 9; ++kt) { const bf16* kp = Ks + ((kt0 + kt) * 16 + c16) * 72 + 8 * q4;
            f32x4 a = (f32x4){0.f, 0.f, 0.f, 0.f};
            a = __builtin_amdgcn_mfma_f32_16x16x32_bf16(*(const bf16x8v*)kp, Q0, a, 0, 0, 0);
            a = __builtin_amdgcn_mfma_f32_16x16x32_bf16(*(const bf16x8v*)(kp + 32), Q1, a, 0, 0, 0);
            sv[kt] = a; }
        float mx = sink2;
#pragma unroll
        for (int kt = 0; kt < 9; ++kt)
#pragma unroll
            for (int r = 0; r < 4; ++r) { const int j = (kt0 + kt) * 16 + 4 * q4 + r; const bool ok = (j > iqc) && (j <= iqc + 128) && (qb > 0 || j >= 128);
                const float v = ok ? sv[kt][r] * sc : -INFINITY; sv[kt][r] = v; mx = fmaxf(mx, v); }
        mx = fmaxf(mx, __shfl_xor(mx, 16)); mx = fmaxf(mx, __shfl_xor(mx, 32));
        float sum = 0.f;
#pragma unroll
        for (int kt = 0; kt < 9; ++kt)
#pragma unroll
            for (int r = 0; r < 4; ++r) { const float pv = __builtin_amdgcn_exp2f(sv[kt][r] - mx); sv[kt][r] = pv; sum += pv; }
        sum += __shfl_xor(sum, 16); sum += __shfl_xor(sum, 32);
        sum += __builtin_amdgcn_exp2f(sink2 - mx);
        const float inv = 1.f / sum;
        f32x4 o[4];
#pragma unroll
        for (int dt = 0; dt < 4; ++dt) o[dt] = (f32x4){0.f, 0.f, 0.f, 0.f};
#pragma unroll
        for (int pp = 0; pp < 5; ++pp) { const int T0 = kt0 + 2 * pp, T1 = (pp < 4) ? T0 + 1 : T0;
            const f32x4 pa = sv[2 * pp], pb = (pp < 4) ? sv[2 * pp + 1] : (f32x4){0.f, 0.f, 0.f, 0.f};
            const u32x4 pw = pg8::pack8(pa, pb); const bf16x8v Bp = __builtin_bit_cast(bf16x8v, pw);
#pragma unroll
            for (int dt = 0; dt < 4; ++dt) { const bf16* vp = VT + (dt * 16 + c16) * 264 + 4 * q4;
                const u32x2 lo = *(const u32x2*)(vp + T0 * 16), hi = *(const u32x2*)(vp + T1 * 16);
                const u32x4 aw = (u32x4){lo.x, lo.y, hi.x, hi.y};
                o[dt] = __builtin_amdgcn_mfma_f32_16x16x32_bf16(__builtin_bit_cast(bf16x8v, aw), Bp, o[dt], 0, 0, 0); } }
        bf16* op = ycat + (t0 + iqc) * 1024 + 512 + hq * 64 + 4 * q4;
#pragma unroll
        for (int dt = 0; dt < 4; ++dt) { u32x2 w; w.x = pg8::cvt_pk_bf16(o[dt][0] * inv, o[dt][1] * inv); w.y = pg8::cvt_pk_bf16(o[dt][2] * inv, o[dt][3] * inv); *(u32x2*)(op + dt * 16) = w; }
    }
    __syncthreads();
}


#define XB_TMO      128
#define XB_XCNT(j)  (256  + 64 * (j))
#define XB_XSUB(j)  (1280 + 64 * (j))
#define XB_XGEN(j)  (2304 + 64 * (j))
#define XB_TOP      3328
#define XB_TOPGEN   3392
#define XCD_BAR_WORDS 3456
#define XB_SPIN_CAP (1u << 20)
__device__ __forceinline__ unsigned xb_ld(unsigned* p)              { return __hip_atomic_load(p, __ATOMIC_RELAXED, __HIP_MEMORY_SCOPE_AGENT); }
__device__ __forceinline__ unsigned xb_add(unsigned* p, unsigned v) { return __hip_atomic_fetch_add(p, v, __ATOMIC_RELAXED, __HIP_MEMORY_SCOPE_AGENT); }
__device__ __forceinline__ unsigned xb_xcc_id() { return (unsigned)__builtin_amdgcn_s_getreg((3 << 11) | 20) & 0xFu; }
#define XB_SPIN(cond, bar) do { unsigned _sp = 0; while (cond) { __builtin_amdgcn_s_sleep(1); \
    if ((++_sp & 255u) == 0u) { if (xb_ld(&(bar)[XB_TMO])) break; if (_sp > XB_SPIN_CAP) { atomicAdd(&(bar)[XB_TMO], 1u); break; } } } } while (0)
struct XcdBarrier { unsigned* bar; unsigned x; volatile __attribute__((address_space(3))) unsigned* st; };
__device__ __forceinline__ XcdBarrier xcd_barrier_post(unsigned* bar, volatile __attribute__((address_space(3))) unsigned* st) {
    XcdBarrier b; b.bar = bar; b.x = xb_xcc_id(); b.st = st;
    if (threadIdx.x == 0) (void)xb_add(&bar[XB_XCNT(b.x)], 1u);
    return b;
}
__device__ __forceinline__ void xcd_barrier_complete(unsigned* bar, unsigned x, unsigned& nloc, unsigned& nx) {
    const unsigned G = gridDim.x * gridDim.y * gridDim.z;
    unsigned sum, cnt, mine, sp = 0u;
    for (;;) {
        sum = 0u; cnt = 0u; mine = 0u;
#pragma unroll
        for (unsigned j = 0; j < 16; ++j) { const unsigned c = xb_ld(&bar[XB_XCNT(j)]); sum += c; cnt += (c > 0u) ? 1u : 0u; mine = (j == x) ? c : mine; }
        if (sum == G) break;
        __builtin_amdgcn_s_sleep(1);
        if ((++sp & 255u) == 0u) { if (xb_ld(&bar[XB_TMO])) break; if (sp > XB_SPIN_CAP) { atomicAdd(&bar[XB_TMO], 1u); break; } }
    }
    nloc = mine > 0u ? mine : 1u; nx = cnt > 0u ? cnt : 1u;
}
__device__ __forceinline__ void xcd_barrier(const XcdBarrier& b, int tid) {
    asm volatile("s_waitcnt vmcnt(0)" ::: "memory");
    __syncthreads();
    if (tid == 0) {
        unsigned* bar = b.bar;
        __builtin_amdgcn_s_waitcnt(0);
        unsigned nloc = b.st[0], nx = b.st[1];
        if (nloc == 0u) { xcd_barrier_complete(bar, b.x, nloc, nx); b.st[0] = nloc; b.st[1] = nx; }
        const unsigned old = xb_add(&bar[XB_XSUB(b.x)], 1u);
        const unsigned gen = old / nloc;
        if (old + 1u == (gen + 1u) * nloc) {
            __builtin_amdgcn_fence(__ATOMIC_RELEASE, "agent");
            asm volatile("s_waitcnt vmcnt(0)" ::: "memory");
            const unsigned og = xb_add(&bar[XB_TOP], 1u);
            const unsigned tg = og / nx;
            if (og + 1u == (tg + 1u) * nx) xb_add(&bar[XB_TOPGEN], 1u);
            else XB_SPIN(xb_ld(&bar[XB_TOPGEN]) == tg, bar);
            __builtin_amdgcn_fence(__ATOMIC_ACQUIRE, "agent");
            xb_add(&bar[XB_XGEN(b.x)], 1u);
            asm volatile("s_waitcnt vmcnt(0)" ::: "memory");
        } else {
            XB_SPIN(xb_ld(&bar[XB_XGEN(b.x)]) == gen, bar);
            __builtin_amdgcn_fence(__ATOMIC_ACQUIRE, "agent");
            asm volatile("s_waitcnt vmcnt(0)" ::: "memory");
        }
    }
    __syncthreads();
}

struct SchedMoE { const char* A; const char* W; const int* tab; const int* rows; int nF, nH, G, c; size_t lda2, strideE, strideN;
    __device__ __forceinline__ bool next(int i, pg8::Unit& u) const { const int L = i * G + c; int t;
        if (L < nF * 4) { pg8::tile_of(L, nF, 4, t, u.pn); u.half = 0; } else if (L < (nF + nH) * 4) { pg8::tile_of(L - nF * 4, nH, 4, t, u.pn); t += nF; u.half = 1; } else return false;
        const int rb = tab[2 + t], e = tab[2 + 192 + t];
        u.pm = t; u.kind = 0; u.aux = e; u.rb = rb; u.rows = rows ? rows + rb : nullptr; u.A = rows ? A : A + (size_t)rb * lda2; u.B = W + (size_t)e * strideE + (size_t)u.pn * strideN; return true; } };

__global__ void __launch_bounds__(512, 2) fwd_kernel(Params p) {
    extern __shared__ __attribute__((aligned(16))) unsigned char lds_raw[];
    float* ldsf = (float*)lds_raw;
    cg::grid_group grid = cg::this_grid();
    const int G = gridDim.x, bid = blockIdx.x, NGW = G * 8;
    const int wid_s = __builtin_amdgcn_readfirstlane((int)threadIdx.x >> 6);
    unsigned char* ws = p.ws;
    const float *x = p.in[0], *mem = p.in[1], *w_in = p.in[2], *b_in = p.in[3], *w_dw = p.in[4], *b_dw = p.in[5], *g_cn = p.in[6], *b_cn = p.in[7], *sinks = p.in[8],
                *w_out = p.in[9], *g_ln1 = p.in[10], *b_ln1 = p.in[11], *w_mq = p.in[12], *w_mkv = p.in[13], *w_mo = p.in[14], *g_ln2 = p.in[15], *b_ln2 = p.in[16],
                *w_group = p.in[17], *b_group = p.in[18], *w_router = p.in[19], *b_router = p.in[20], *w_gate = p.in[21], *w_up = p.in[22], *w_down = p.in[23],
                *g_ln3 = p.in[24], *b_ln3 = p.in[25];
    float* out = p.out;
    bf16* xb = (bf16*)(ws + WS_DD); bf16* ycat = (bf16*)(ws + WS_A); bf16* Hs = (bf16*)(ws + WS_A);
    bf16* hglu = (bf16*)(ws + WS_B); bf16* qkv = (bf16*)(ws + WS_B + (size_t)T * 512 * 2); bf16* x1b = (bf16*)(ws + WS_B); bf16* Pb2 = (bf16*)(ws + WS_A); bf16* x2b = (bf16*)(ws + WS_B);
    float* Sbuf = (float*)(ws + WS_DD); bf16* Xs = (bf16*)(ws + WS_DD);
    bf16* kvm = (bf16*)(ws + WS_KVM); bf16* memb = (bf16*)(ws + WS_MEMB); bf16* MT = (bf16*)(ws + WS_MT); bf16* NT = (bf16*)(ws + WS_NT);
    float* csS = (float*)(ws + WS_CSS); float* bwS = csS + 2048; float* csp = (float*)(ws + WS_CSP);
    bf16* Wt_in = (bf16*)(ws + WS_WIN); bf16* Wt_out = (bf16*)(ws + WS_WOUT); bf16* Wqb = (bf16*)(ws + WS_WMQ); bf16* Wt_mkv = (bf16*)(ws + WS_WMKV); bf16* Wt_mo = (bf16*)(ws + WS_WMO);
    bf16* Wt_gu = (bf16*)(ws + WS_WGU); bf16* Wt_dn = (bf16*)(ws + WS_WDN);
    PG8_LAS unsigned char* ldsp = (PG8_LAS unsigned char*)lds_raw;
    float* stats1 = (float*)(ws + WS_ST1); float* cs1 = (float*)(ws + WS_CS1); float* bw1 = cs1 + 1024;
    int* route_e = (int*)(ws + WS_ROUTE); float* route_g = (float*)(ws + WS_ROUTE + (size_t)T * 8);
    int* blkcnt = (int*)(ws + WS_BLKCNT); int* segw = (int*)(ws + WS_SEG); int* rank = (int*)(ws + WS_RANK);
    int* pair_tok = (int*)(ws + WS_PTOK); float* pair_gate = (float*)(ws + WS_PGATE); int* tokpos = (int*)(ws + WS_TOKPOS); bf16* Yb = (bf16*)(ws + WS_DD); bf16* z2b = (bf16*)(ws + WS_DD);

    const int lo = p.ph_lo, hi = p.ph_hi;
    int ph = 0;
    unsigned long long tprev = (PROBE_T >= 0) ? __builtin_amdgcn_s_memrealtime() : 0ull, tprobe = 0ull, tmark = 0ull; (void)tmark;
    volatile __attribute__((address_space(3))) unsigned* bst = (volatile __attribute__((address_space(3))) unsigned*)(ldsp + LDS_BYTES_K - 64);
    if (threadIdx.x == 0) { bst[0] = 0u; bst[1] = 0u; }
    __syncthreads();
    const XcdBarrier xbar = xcd_barrier_post((unsigned*)(ws + WS_CTL), bst);
    if (lo > hi) grid.sync();
#define PM(k) do { if (PROBE_T == 100 + (k)) tmark = __builtin_amdgcn_s_memrealtime(); } while (0)
#define PME(k) do { if (PROBE_T == 100 + (k)) tprobe += __builtin_amdgcn_s_memrealtime() - tmark; } while (0)
#define PHASE_BEGIN if (lo <= ph && ph < hi) { for (int rep_ = 0; rep_ < ((((unsigned)PROBE_MASK >> ph) & 1u) ? 2 : 1); ++rep_) { const int tid = wid_s * 64 + lane_fresh(); const int lane = tid & 63, wave = tid >> 6, gw = bid * 8 + wave; (void)lane; (void)wave; (void)gw;
#define PHASE_END } } if (lo <= ph && ph + 1 < hi) xcd_barrier(xbar, wid_s * 64 + lane_fresh()); if (PROBE_T >= 0) { const unsigned long long tn_ = __builtin_amdgcn_s_memrealtime(); if (ph == PROBE_T) tprobe = tn_ - tprev; tprev = tn_; } ++ph;

    PHASE_BEGIN
    {
        const size_t n4 = (size_t)T * D / 4, stride = (size_t)G * 512;
        for (size_t i0 = (size_t)bid * 512 + tid; i0 < n4; i0 += 8 * stride) { f32x4 v[8];
#pragma unroll
            for (int q = 0; q < 8; ++q) { const size_t i = i0 + q * stride; v[q] = (i < n4) ? __builtin_nontemporal_load((const f32x4*)x + i) : (f32x4){0.f, 0.f, 0.f, 0.f}; }
#pragma unroll
            for (int q = 0; q < 8; ++q) { const size_t i = i0 + q * stride; if (i < n4) { u32x2 w; w.x = pk2(v[q].x, v[q].y); w.y = pk2(v[q].z, v[q].w); ((u32x2*)xb)[i] = w; } } } }
    for (size_t i = (size_t)bid * 512 + tid; i < (size_t)NMEM * D / 4; i += (size_t)G * 512) { const f32x4 v = ((const f32x4*)mem)[i]; u32x2 w; w.x = pk2(v.x, v.y); w.y = pk2(v.z, v.w); ((u32x2*)memb)[i] = w; }
    {
        LAS float* scr = (LAS float*)(ldsp + wave * 16384);
        constexpr int I_IN = 16 * 56, I_KV = 16 * 64;
        for (int it = gw; it < I_IN + I_KV; it += NGW) { int r = it;
            if (r < I_IN) { const int kb = r / 56, nb = r % 56, n0 = nb * 32; const int dr = n0 < 512 ? (n0 >> 7) * 256 + (n0 & 127) : (n0 < 1024 ? ((n0 - 512) >> 7) * 256 + 128 + (n0 & 127) : n0);
                transpose_item(w_in, D_IN, Wt_in, 1024, kb * 64, n0, dr, scr, lane); continue; } r -= I_IN;
            transpose_item(w_mkv, 2048, Wt_mkv, 1024, (r / 64) * 64, (r % 64) * 32, (r % 64) * 32, scr, lane); }
    }
    PHASE_END

    PHASE_BEGIN
    for (int pass = 0; pass < 2; ++pass) {
      if ((pass == 0) == ((bid & 1) == 0)) {
        const int tl = wid_s * 64 + lane_fresh(), ll = tl & 63, wl = tl >> 6;
        LAS float* scr = (LAS float*)(ldsp + wl * 16384);
        constexpr int I_SQ = 16 * 32, I_EX = 16 * 256, N_T = 2 * I_SQ + 3 * I_EX, N_Q = 1024, N_B = 256, N_ALL = N_T + N_Q + N_B;
        int nb2 = 464 - G; nb2 = nb2 < 0 ? 0 : (nb2 > G ? G : nb2);
        const int NVB = nb2 + (G - nb2) * 3, nmine = (bid < nb2) ? 1 : 3, vb0 = (bid < nb2) ? bid : nb2 + (bid - nb2) * 3;
        auto decode = [&](int r, TItem& t) {
            if (r < I_SQ) { t = TItem{w_out, Wt_out, nullptr, 1024, 1024, (r / 32) * 64, (r % 32) * 32, (r % 32) * 32}; return; } r -= I_SQ;
            if (r < I_SQ) { t = TItem{w_mo, Wt_mo, nullptr, 1024, 1024, (r / 32) * 64, (r % 32) * 32, (r % 32) * 32}; return; } r -= I_SQ;
            if (r < I_EX) { const int e = r / 256, q = r % 256, n0 = (q % 16) * 32; t = TItem{w_gate + (size_t)e * D * DE, Wt_gu + (size_t)e * 1024 * 1024, nullptr, DE, 1024, (q / 16) * 64, n0, (n0 >> 7) * 256 + (n0 & 127)}; return; } r -= I_EX;
            if (r < I_EX) { const int e = r / 256, q = r % 256, n0 = (q % 16) * 32; t = TItem{w_up + (size_t)e * D * DE, Wt_gu + (size_t)e * 1024 * 1024, nullptr, DE, 1024, (q / 16) * 64, n0, (n0 >> 7) * 256 + 128 + (n0 & 127)}; return; } r -= I_EX;
            { const int e = r / 256, q = r % 256; t = TItem{w_down + (size_t)e * DE * D, Wt_dn + (size_t)e * 1024 * 512, nullptr, D, 512, (q / 32) * 64, (q % 32) * 32, (q % 32) * 32}; } };
        for (int vk = 0; vk < nmine; ++vk) {
          int it = (vb0 + vk) * 8 + wl;
          for (; it + NVB * 8 < N_T; it += 2 * NVB * 8) {
              TItem ta, tb; decode(it, ta); decode(it + NVB * 8, tb); float wa[32], wb[32];
              titem_load(ta, wa, ll); titem_load(tb, wb, ll); titem_store(ta, wa, scr, ll); titem_store(tb, wb, scr, ll); }
          for (; it < N_ALL; it += NVB * 8) { int r = it;
            if (r < N_T) { TItem ta; decode(r, ta); float wa[32]; titem_load(ta, wa, ll); titem_store(ta, wa, scr, ll); continue; } r -= N_T;
            if (r < N_Q) {
                f32x4 v[4];
#pragma unroll
                for (int q = 0; q < 4; ++q) v[q] = ((const f32x4*)w_mq)[(size_t)r * 256 + ll + 64 * q];
                const float gk = g_ln1[r];
#pragma unroll
                for (int q = 0; q < 4; ++q) { const f32x4 t = v[q] * gk; u32x2 w; w.x = pk2(t.x, t.y); w.y = pk2(t.z, t.w); ((u32x2*)Wqb)[(size_t)r * 256 + ll + 64 * q] = w; }
                continue; } r -= N_Q;
            {
                f32x4 b4 = (f32x4){0.f, 0.f, 0.f, 0.f};
#pragma unroll 4
                for (int i2 = 0; i2 < 16; ++i2) { const int k = ll + 64 * i2; const f32x4 w = *(const f32x4*)(w_mq + (size_t)k * 1024 + 4 * r); b4 += w * b_ln1[k]; }
#pragma unroll
                for (int e = 0; e < 4; ++e) b4[e] = wave_sum(b4[e]);
                if (ll == 0) *(f32x4*)(bw1 + 4 * r) = b4; }
          }
        }
        __syncthreads();
      } else {
        struct SchedP1 { const char *xb, *win, *memb, *wkv; int G, c;
            __device__ __forceinline__ bool next(int i, pg8::Unit& u) const { const int L = i * G + c; u.aux = 0;
                if (L < 448) { pg8::tile_of(L, 64, 7, u.pm, u.pn); u.A = xb + (size_t)u.pm * 256 * 2048; u.B = win + (size_t)u.pn * 256 * 2048; u.kind = u.pn < 4 ? 0 : 1; return true; }
                if (L < 464) { const int r = L - 448; u.pm = r >> 3; u.pn = r & 7; u.A = memb + (size_t)u.pm * 256 * 2048; u.B = wkv + (size_t)u.pn * 256 * 2048; u.kind = 2; return true; }
                return false; } };
        const SchedP1 S{(const char*)xb, (const char*)Wt_in, (const char*)memb, (const char*)Wt_mkv, G, bid};
        const pg8::EpiP1 E{hglu, qkv, kvm, b_in};
        pg8::gemm_phase(wid_s * 64 + lane_fresh(), ldsp, pg8::Gemm{1024, 1024, 1024}, S, E);
      }
    }
    PHASE_END

    PHASE_BEGIN
    PM(0);
    {   constexpr int NCU = T / 32, NSU = BATCH * NKV * (SEQ / 128);
        u32x4 pre[8], kk[4], vq[4]; ConvW cw; conv_weights(w_dw, b_dw, g_cn, b_cn, tid, cw);
        if (bid < NCU) conv_load(hglu, bid, tid, pre);
        for (int cu = bid; cu < NCU; cu += G) {
            conv_stage(lds_raw, tid, pre); __syncthreads();
            if (cu + G < NCU) conv_load(hglu, cu + G, tid, pre);
            conv_unit(lds_raw, cw, ycat, cu, tid);
        }
        PME(0); PM(1);
        if (bid < NSU) swa_load(qkv, bid >> 7, (bid >> 6) & 1, bid & 63, tid, kk, vq);
        for (int u = bid; u < NSU; u += G) {
            swa_unit(lds_raw, qkv, sinks, ycat, u >> 7, (u >> 6) & 1, u & 63, tid, kk, vq);
            if (u + G < NSU) swa_load(qkv, (u + G) >> 7, ((u + G) >> 6) & 1, (u + G) & 63, tid, kk, vq);
        }
    }
    PME(1);
    PM(2);
    {
        struct SchedMT { const char *kvm, *wq; int c;
            __device__ __forceinline__ bool next(int i, pg8::Unit& u) const { if (i > 0 || c < 0 || c >= 32) return false; const int b = c >> 4, h = (c >> 2) & 3, pn = c & 3; u.pm = h; u.pn = pn; u.aux = b; u.kind = 0;
                u.A = kvm + ((size_t)(b * 256) * 2048 + h * 256) * 2; u.B = wq + ((size_t)(pn * 256) * 1024 + h * 256) * 2; return true; } };
        struct SchedNT { const char *wo, *kvm; int c;
            __device__ __forceinline__ bool next(int i, pg8::Unit& u) const { if (i > 0 || c < 0 || c >= 32) return false; const int b = c >> 4, h = (c >> 2) & 3, pm = c & 3; u.pm = pm; u.pn = h; u.aux = b; u.kind = 0;
                u.A = wo + ((size_t)(pm * 256) * 1024 + h * 256) * 2; u.B = kvm + ((size_t)(b * 256) * 2048 + 1024 + h * 256) * 2; return true; } };
        const SchedMT S1{(const char*)kvm, (const char*)Wqb, bid}; const pg8::EpiPre E1{MT, csp};
        pg8::gemm_phase(wid_s * 64 + lane_fresh(), ldsp, pg8::Gemm{2048, 1024, 256}, S1, E1);
        const SchedNT S2{(const char*)Wt_mo, (const char*)kvm, bid - 32}; const pg8::EpiPre E2{NT, nullptr};
        pg8::gemm_phase(wid_s * 64 + lane_fresh(), ldsp, pg8::Gemm{1024, 2048, 256}, S2, E2);
    }
    PME(2);
    PHASE_END

    PHASE_BEGIN
    for (int r = gw; r < 2048; r += NGW) { const int b = r >> 10, hk = r & 1023, h = hk >> 8, key = hk & 255;
        const float c = wave_sum(lane < 16 ? csp[(size_t)r * 16 + lane] : 0.f);
        const u32x2 kk = *(const u32x2*)(kvm + (size_t)(b * 256 + key) * 2048 + h * 256 + 4 * lane); const f32x4 bq = *(const f32x4*)(bw1 + h * 256 + 4 * lane);
        const float w = wave_sum((bflo(kk.x) * bq[0] + bfhi(kk.x) * bq[1]) + (bflo(kk.y) * bq[2] + bfhi(kk.y) * bq[3]));
        if (lane == 0) { csS[r] = c; bwS[r] = w; } }
    { const pg8::DenseSched S{(const char*)ycat, (const char*)Wt_out, 64, 4, G, bid, (size_t)256 * 2048, (size_t)256 * 2048};
      const pg8::EpiResStats E{xb, x1b, stats1, ALPHA}; PM(7); pg8::gemm_phase(tid, ldsp, pg8::Gemm{1024, 1024, 1024}, S, E); PME(7); }
    PHASE_END
    PHASE_BEGIN
    {   struct SchedS { const char *z, *mt; int G, c;
            __device__ __forceinline__ bool next(int i, pg8::Unit& u) const { const int L = i * G + c; if (L >= 256) return false; pg8::tile_of(L, 64, 4, u.pm, u.pn); u.kind = 0; u.aux = u.pm >> 5;
                u.A = z + (size_t)u.pm * 256 * 2048; u.B = mt + ((size_t)u.aux * 1024 * 1024 + (size_t)u.pn * 256 * 1024) * 2; return true; } };
        const SchedS S{(const char*)x1b, (const char*)MT, G, bid};
        const pg8::EpiSoftmaxLn E{Pb2, (PG8_LAS float*)(ldsp + 131072), stats1, csS, bwS};
        PM(8); pg8::gemm_phase(tid, ldsp, pg8::Gemm{1024, 1024, 1024}, S, E); PME(8);
    }
    PHASE_END
    PHASE_BEGIN
    {   struct SchedN { const char *P, *nt; int G, c;
            __device__ __forceinline__ bool next(int i, pg8::Unit& u) const { const int L = i * G + c; if (L >= 256) return false; pg8::tile_of(L, 64, 4, u.pm, u.pn); u.kind = 0; u.aux = u.pm >> 5;
                u.A = P + (size_t)u.pm * 256 * 2048; u.B = nt + ((size_t)u.aux * 1024 * 1024 + (size_t)u.pn * 256 * 1024) * 2; return true; } };
        const SchedN S{(const char*)Pb2, (const char*)NT, G, bid};
        const pg8::EpiResLn E{z2b, x1b, stats1, g_ln1, b_ln1, ALPHA}; pg8::gemm_phase(tid, ldsp, pg8::Gemm{1024, 1024, 1024}, S, E);
    }
    PHASE_END
    const int TPB = (T + G - 1) / G;
    PHASE_BEGIN
    { const int t0 = bid * TPB, t1 = (t0 + TPB < T) ? t0 + TPB : T;
      float* Wl = ldsf;
      int* le = (int*)(lds_raw + 81920);
      for (int k = tid; k < D; k += 512) { const f32x4 wg = *(const f32x4*)(w_group + (size_t)k * 4);
          Wl[0 * D + k] = wg.x; Wl[1 * D + k] = wg.y; Wl[2 * D + k] = wg.z; Wl[3 * D + k] = wg.w;
#pragma unroll
          for (int gq = 0; gq < 4; ++gq) { const f32x4 wr = *(const f32x4*)(w_router + ((size_t)gq * D + k) * 4);
              Wl[(4 + gq * 4 + 0) * D + k] = wr.x; Wl[(4 + gq * 4 + 1) * D + k] = wr.y; Wl[(4 + gq * 4 + 2) * D + k] = wr.z; Wl[(4 + gq * 4 + 3) * D + k] = wr.w; } }
      __syncthreads();
      PM(4);
      const int TPW = (TPB + 7) / 8;
      const int mend = (t0 + (wave + 1) * TPW < t1) ? t0 + (wave + 1) * TPW : t1;
      float bgr[4], brt[16];
#pragma unroll
      for (int i = 0; i < 4; ++i) bgr[i] = b_group[i];
#pragma unroll
      for (int i = 0; i < 16; ++i) brt[i] = b_router[i];
      f32x4 raw[2][4];
      { const int mb0 = t0 + wave * TPW; if (mb0 < mend) { ld_row_bf16(z2b + (size_t)mb0 * D, raw[0], lane); ld_row_bf16(z2b + (size_t)((mb0 + 1 < mend) ? mb0 + 1 : mb0) * D, raw[1], lane); } }
      for (int mb = t0 + wave * TPW; mb < mend; mb += 2) {
        f32x4 v[2][4];
        const bool has1 = (mb + 1 < mend);
#pragma unroll
        for (int jj = 0; jj < 4; ++jj) { v[0][jj] = raw[0][jj]; v[1][jj] = raw[1][jj]; }
        if (mb + 2 < mend) { ld_row_bf16(z2b + (size_t)(mb + 2) * D, raw[0], lane); ld_row_bf16(z2b + (size_t)((mb + 3 < mend) ? mb + 3 : mb + 2) * D, raw[1], lane); }
        ln_regs(v[0], g_ln2, b_ln2, lane);
        st_row_bf16(x2b + (size_t)mb * D, v[0], lane);
        ln_regs(v[1], g_ln2, b_ln2, lane);
        if (has1) st_row_bf16(x2b + (size_t)(mb + 1) * D, v[1], lane);
        float pa[20], pb[20];
#pragma unroll
        for (int c = 0; c < 20; ++c) {
            typedef float f32x2 __attribute__((ext_vector_type(2)));
            f32x2 p0 = (f32x2){0.f, 0.f}, p1 = p0;
#pragma unroll
            for (int jj = 0; jj < 4; ++jj) { const f32x4 w4 = ((const f32x4*)(Wl + c * D))[lane + 64 * jj]; const f32x2 wl2 = (f32x2){w4.x, w4.y}, wh2 = (f32x2){w4.z, w4.w};
                p0 = __builtin_elementwise_fma((f32x2){v[0][jj].x, v[0][jj].y}, wl2, p0); p0 = __builtin_elementwise_fma((f32x2){v[0][jj].z, v[0][jj].w}, wh2, p0);
                p1 = __builtin_elementwise_fma((f32x2){v[1][jj].x, v[1][jj].y}, wl2, p1); p1 = __builtin_elementwise_fma((f32x2){v[1][jj].z, v[1][jj].w}, wh2, p1); }
            pa[c] = p0.x + p0.y; pb[c] = p1.x + p1.y;
        }
        float* red = (float*)(lds_raw + 98304) + wave * 64;
        red[lane] = reduce40(pa, pb, lane);
        asm volatile("s_waitcnt lgkmcnt(0)" ::: "memory");
        float my[20];
#pragma unroll
        for (int c = 0; c < 20; ++c) { constexpr int mm[5] = {0, 1, 2, 4, 5}; my[c] = red[32 * (lane & 1) + 16 * (c / 10) + 8 * ((c % 10) / 5) + mm[c % 5]]; }
        asm volatile("s_waitcnt lgkmcnt(0)" ::: "memory");
        const int m = mb + lane;
        if (lane < 2 && m < mend) {
            float gl[4]; int gi = 0; float gmx = -INFINITY;
#pragma unroll
            for (int i = 0; i < 4; ++i) { gl[i] = my[i] + bgr[i]; if (gl[i] > gmx) { gmx = gl[i]; gi = i; } }
            float gs = 0.f;
#pragma unroll
            for (int i = 0; i < 4; ++i) gs += __expf(gl[i] - gmx);
            const float gp = 1.f / gs;
            float el[4];
#pragma unroll
            for (int i = 0; i < 4; ++i) { float a = my[4 + i], bq = brt[i];
                a = (gi == 1) ? my[8 + i] : a; a = (gi == 2) ? my[12 + i] : a; a = (gi == 3) ? my[16 + i] : a;
                bq = (gi == 1) ? brt[4 + i] : bq; bq = (gi == 2) ? brt[8 + i] : bq; bq = (gi == 3) ? brt[12 + i] : bq;
                el[i] = a + bq; }
            int i0 = 0; float v0 = el[0];
#pragma unroll
            for (int i = 1; i < 4; ++i) if (el[i] > v0) { v0 = el[i]; i0 = i; }
            int i1 = -1; float v1 = -INFINITY;
#pragma unroll
            for (int i = 0; i < 4; ++i) if (i != i0 && el[i] > v1) { v1 = el[i]; i1 = i; }
            const float w0 = 1.f / (1.f + __expf(v1 - v0)), w1 = 1.f - w0;
            route_e[2 * m] = gi * 4 + i0; route_e[2 * m + 1] = gi * 4 + i1; route_g[2 * m] = gp * w0; route_g[2 * m + 1] = gp * w1;
            le[2 * (m - t0)] = gi * 4 + i0; le[2 * (m - t0) + 1] = gi * 4 + i1;
        }
      }
      __syncthreads();
      PME(4); PM(5);
      const int np = 2 * (t1 - t0);
      for (int i = tid; i < np; i += 512) { const int e = le[i]; int r = 0; for (int j2 = 0; j2 < i; ++j2) r += (le[j2] == e) ? 1 : 0; rank[2 * t0 + i] = r; }
      if (tid < 16) { int c = 0; for (int j2 = 0; j2 < np; ++j2) c += (le[j2] == tid) ? 1 : 0; blkcnt[bid * 16 + tid] = c; }
      PME(5);
    }
    PHASE_END
    PHASE_BEGIN
    {
        int* sh = (int*)lds_raw;
        const int t0 = bid * TPB, t1 = (t0 + TPB < T) ? t0 + TPB : T, np = 2 * (t1 - t0);
        int my_e = 0, my_r = 0; float my_g = 0.f;
        if (tid < np) { const int pi = 2 * t0 + tid; my_e = route_e[pi]; my_r = rank[pi]; my_g = route_g[pi]; }
        { const int e = tid & 15, part = tid >> 4; int tot = 0, base = 0; int cv[8];
#pragma unroll
          for (int q = 0; q < 8; ++q) { const int b = part + 32 * q; cv[q] = (b < G) ? blkcnt[b * 16 + e] : 0; }
#pragma unroll
          for (int q = 0; q < 8; ++q) { const int b = part + 32 * q; tot += cv[q]; if (b < bid) base += cv[q]; }
          for (int b = part + 256; b < G; b += 32) { const int c = blkcnt[b * 16 + e]; tot += c; if (b < bid) base += c; }
          sh[128 + part * 16 + e] = tot; sh[640 + part * 16 + e] = base; }
        __syncthreads();
        if (tid < 16) { int tot = 0, base = 0;
#pragma unroll 8
            for (int part = 0; part < 32; ++part) { tot += sh[128 + part * 16 + tid]; base += sh[640 + part * 16 + tid]; } sh[tid] = base; sh[64 + tid] = tot; }
        __syncthreads();
        if (tid == 0) { int sacc = 0, nF = 0, nH = 0;
            for (int e = 0; e < 16; ++e) { const int n = sh[64 + e], nf = n >> 8, nh = ((n & 255) + 127) >> 7; sh[16 + e] = sacc; sacc += nf * 256 + nh * 128; nF += nf; nH += nh; }
            sh[32] = sacc;
            if (bid == 0) { segw[0] = nF; segw[1] = nH; int tf = 0, th = nF;
                for (int e = 0; e < 16; ++e) { const int n = sh[64 + e], nf = n >> 8, nh = ((n & 255) + 127) >> 7;
                    for (int k = 0; k < nf; ++k) { segw[2 + tf] = sh[16 + e] + 256 * k; segw[2 + 192 + tf] = e; ++tf; }
                    for (int k = 0; k < nh; ++k) { segw[2 + th] = sh[16 + e] + 256 * nf + 128 * k; segw[2 + 192 + th] = e; ++th; } } } }
        __syncthreads();
        if (bid == 0) { for (int e = 0; e < 16; ++e) for (int pos = sh[16 + e] + sh[64 + e] + tid; pos < sh[16 + e + 1]; pos += 512) { pair_tok[pos] = -1; pair_gate[pos] = 0.f; } }
        if (tid < np) { const int pi = 2 * t0 + tid, pos = sh[16 + my_e] + sh[my_e] + my_r; pair_tok[pos] = pi >> 1; pair_gate[pos] = my_g; tokpos[pi] = pos; }
    }
    PHASE_END
    PHASE_BEGIN
    { const SchedMoE S{(const char*)x2b, (const char*)Wt_gu, segw, pair_tok, segw[0], segw[1], G, bid, (size_t)2048, (size_t)1024 * 2048, (size_t)256 * 2048};
      const pg8::EpiGateUp E{Hs, pair_gate}; PM(6); pg8::gemm_phase<true, true>(tid, ldsp, pg8::Gemm{1024, 1024, 1024}, S, E); PME(6); }
    PHASE_END
    PHASE_BEGIN
    { const SchedMoE S{(const char*)Hs, (const char*)Wt_dn, segw, nullptr, segw[0], segw[1], G, bid, (size_t)1024, (size_t)1024 * 1024, (size_t)256 * 1024};
      const pg8::EpiY E{Yb}; PM(9); pg8::gemm_phase<false, true>(tid, ldsp, pg8::Gemm{512, 512, 512}, S, E); PME(9); }
    PHASE_END
    PHASE_BEGIN
    for (int mbase = gw; mbase < T; mbase += 8 * NGW) {
        int tp = 0;
        if (lane < 16) { const int mm = mbase + (lane >> 1) * NGW; if (mm < T) tp = tokpos[2 * mm + (lane & 1)]; }
        u32x2 xa[4], ya[4], yb[4];
#define P9_LOAD(mm, ii) do { const int p0_ = __builtin_amdgcn_readlane(tp, 2 * (ii)), p1_ = __builtin_amdgcn_readlane(tp, 2 * (ii) + 1); \
        _Pragma("unroll") for (int jj = 0; jj < 4; ++jj) { xa[jj] = ((const u32x2*)(x2b + (size_t)(mm) * D))[lane + 64 * jj]; ya[jj] = ((const u32x2*)(Yb + (size_t)p0_ * D))[lane + 64 * jj]; yb[jj] = ((const u32x2*)(Yb + (size_t)p1_ * D))[lane + 64 * jj]; } } while (0)
        P9_LOAD(mbase, 0);
        for (int i = 0; i < 8; ++i) { const int m = mbase + i * NGW; if (m >= T) break;
            f32x4 v[4]; float sacc = 0.f;
#pragma unroll
            for (int jj = 0; jj < 4; ++jj) { f32x4 z;
                z.x = bflo(xa[jj].x) * ALPHA + (bflo(ya[jj].x) + bflo(yb[jj].x)); z.y = bfhi(xa[jj].x) * ALPHA + (bfhi(ya[jj].x) + bfhi(yb[jj].x));
                z.z = bflo(xa[jj].y) * ALPHA + (bflo(ya[jj].y) + bflo(yb[jj].y)); z.w = bfhi(xa[jj].y) * ALPHA + (bfhi(ya[jj].y) + bfhi(yb[jj].y)); v[jj] = z; sacc += (z.x + z.y) + (z.z + z.w); }
            if (i + 1 < 8 && m + NGW < T) P9_LOAD(m + NGW, i + 1);
            const float mean = wave_sum(sacc) * (1.f / D); float s2 = 0.f;
#pragma unroll
            for (int jj = 0; jj < 4; ++jj) { v[jj] = v[jj] - mean; s2 += (v[jj].x * v[jj].x + v[jj].y * v[jj].y) + (v[jj].z * v[jj].z + v[jj].w * v[jj].w); }
            const float rstd = 1.f / sqrtf(wave_sum(s2) * (1.f / D) + LN_EPS);
            float* row = out + (size_t)m * D;
#pragma unroll
            for (int jj = 0; jj < 4; ++jj) { const f32x4 gg = ((const f32x4*)g_ln3)[lane + 64 * jj], bb = ((const f32x4*)b_ln3)[lane + 64 * jj]; ((f32x4*)row)[lane + 64 * jj] = v[jj] * rstd * gg + bb; } }
#undef P9_LOAD
    }
    PHASE_END
    if (PROBE_T >= 0 && blockIdx.x == 0) { const unsigned long long tend = __builtin_amdgcn_s_memrealtime() + 9ull * tprobe; while (__builtin_amdgcn_s_memrealtime() < tend) __builtin_amdgcn_s_sleep(8); }
}

constexpr int N_PHASES = 16;
constexpr int LDS_BYTES = 147456;

extern "C" void kernel_launch(void* const* d_in, const int* in_sizes, int n_in, void* d_out, int out_size, void* d_ws, size_t ws_size, hipStream_t stream) {
    static int grid = 0;
    if (grid == 0) {
        int dev = 0, cus = 0, per_cu = 0;
        hipGetDevice(&dev);
        hipDeviceGetAttribute(&cus, hipDeviceAttributeMultiprocessorCount, dev);
        hipFuncSetAttribute((const void*)fwd_kernel, hipFuncAttributeMaxDynamicSharedMemorySize, LDS_BYTES);
        hipOccupancyMaxActiveBlocksPerMultiprocessor(&per_cu, (const void*)fwd_kernel, 512, LDS_BYTES);
        if (per_cu < 1) { fprintf(stderr, "occupancy query returned %d\n", per_cu); per_cu = 1; }
        grid = cus * 1;
        if (ws_size < WS_END) { fprintf(stderr, "workspace too small\n"); grid = -1; }
    }
    if (grid < 0) return;
    if (hipMemsetAsync((char*)d_ws + WS_CTL, 0, 65536, stream) != hipSuccess) { fprintf(stderr, "memset failed\n"); return; }
    Params p{};
    for (int i = 0; i < 26; ++i) p.in[i] = (const float*)d_in[i];
    p.out = (float*)d_out; p.ws = (unsigned char*)d_ws;
#if MK_N_LAUNCHES == 1
    p.ph_lo = 0; p.ph_hi = 64;
    void* args[] = {&p};
    hipError_t e = hipLaunchCooperativeKernel((const void*)fwd_kernel, dim3(grid), dim3(512), args, LDS_BYTES, stream);
    if (e != hipSuccess) fprintf(stderr, "cooperative launch failed: %s (grid %d)\n", hipGetErrorString(e), grid);
#else
    for (int ph = 0; ph < N_PHASES; ++ph) { p.ph_lo = ph; p.ph_hi = ph + 1; hipLaunchKernelGGL(fwd_kernel, dim3(grid), dim3(512), LDS_BYTES, stream, p); }
#endif
}
```

```cpp
#include <hip/hip_runtime.h>
#include <hip/hip_cooperative_groups.h>
#include <cstdio>
#include <cstdint>
namespace cg = cooperative_groups;

#ifndef PROBE_MASK
#define PROBE_MASK 0
#endif
#ifndef PROBE_T
#define PROBE_T -1
#endif
#ifndef MK_N_LAUNCHES
#define MK_N_LAUNCHES 1
#endif

typedef unsigned short bf16;
typedef float f32x4 __attribute__((ext_vector_type(4)));
typedef unsigned u32x4 __attribute__((ext_vector_type(4)));
typedef unsigned u32x2 __attribute__((ext_vector_type(2)));

constexpr int BATCH = 2, SEQ = 8192, D = 1024, T = BATCH * SEQ, MEM = 256, NMEM = BATCH * MEM;
constexpr int CONV_CH = 512, CONV_W = 31, NH = 8, NKV = 2, HD = 64, ATTN_W = 512, KV_W = 128, WINDOW = 128;
constexpr int D_IN = 1792, MH = 4, MHD = 256, NG = 4, EPG = 4, NE = 16, DE = 512;
constexpr float ALPHA = 1.189207115002721f, LN_EPS = 1e-5f;
constexpr int NPAIR = 2 * T, NPAIR_PAD = NPAIR + NE * 256;
constexpr int LDS_BYTES_K = 147456;

constexpr size_t MiB = 1u << 20;
constexpr size_t WS_CTL = 0;
constexpr size_t WS_ROUTE = 1 * MiB;
constexpr size_t WS_BLKCNT = 1 * MiB + 512 * 1024;
constexpr size_t WS_SEG = 1 * MiB + 640 * 1024;
constexpr size_t WS_RANK = 2 * MiB;
constexpr size_t WS_PTOK = 2 * MiB + 256 * 1024;
constexpr size_t WS_PGATE = 2 * MiB + 512 * 1024;
constexpr size_t WS_TOKPOS = 2 * MiB + 768 * 1024;
constexpr size_t WS_KVM = 3 * MiB;
constexpr size_t WS_MEMB = 5 * MiB;
constexpr size_t WS_A = 8 * MiB;
constexpr size_t WS_B = 48 * MiB;
constexpr size_t WS_DD = 88 * MiB;
constexpr size_t WS_WIN = 164 * MiB;
constexpr size_t WS_WOUT = 168 * MiB, WS_WMQ = 170 * MiB, WS_WMKV = 172 * MiB, WS_WMO = 176 * MiB;
constexpr size_t WS_WGU = 178 * MiB;
constexpr size_t WS_WDN = 210 * MiB;
constexpr size_t WS_ST1 = 226 * MiB;
constexpr size_t WS_CS1 = 128 * 1024;
constexpr size_t WS_MT = 228 * MiB;
constexpr size_t WS_NT = 232 * MiB;
constexpr size_t WS_CSS = 192 * 1024;
constexpr size_t WS_CSP = 256 * 1024;
constexpr size_t WS_END = 236 * MiB;

struct Params { const float* in[26]; float* out; unsigned char* ws; int ph_lo, ph_hi; };

__device__ __forceinline__ unsigned f2bf(float f) { unsigned u = __builtin_bit_cast(unsigned, f); return (u + 0x7fffu + ((u >> 16) & 1u)) >> 16; }
__device__ __forceinline__ float bf2f(bf16 b) { return __builtin_bit_cast(float, (unsigned)b << 16); }
__device__ __forceinline__ unsigned pk2(float lo, float hi) { return f2bf(lo) | (f2bf(hi) << 16); }
template <int CTRL, int ROWMASK> __device__ __forceinline__ float dpp_f(float v) { return __builtin_bit_cast(float, __builtin_amdgcn_update_dpp(0, __builtin_bit_cast(int, v), CTRL, ROWMASK, 0xF, false)); }
__device__ __forceinline__ float wave_sum(float v) {
    v += dpp_f<0xB1, 0xF>(v);
    v += dpp_f<0x4E, 0xF>(v);
    v += dpp_f<0x141, 0xF>(v);
    v += dpp_f<0x140, 0xF>(v);
    v += dpp_f<0x142, 0xA>(v);
    v += dpp_f<0x143, 0xC>(v);
    return __builtin_bit_cast(float, __builtin_amdgcn_readlane(__builtin_bit_cast(int, v), 63));
}
__device__ __forceinline__ float wave_max(float v) {
    v = fmaxf(v, __builtin_bit_cast(float, __builtin_amdgcn_update_dpp(__builtin_bit_cast(int, v), __builtin_bit_cast(int, v), 0xB1, 0xF, 0xF, false)));
    v = fmaxf(v, __builtin_bit_cast(float, __builtin_amdgcn_update_dpp(__builtin_bit_cast(int, v), __builtin_bit_cast(int, v), 0x4E, 0xF, 0xF, false)));
    v = fmaxf(v, __builtin_bit_cast(float, __builtin_amdgcn_update_dpp(__builtin_bit_cast(int, v), __builtin_bit_cast(int, v), 0x141, 0xF, 0xF, false)));
    v = fmaxf(v, __builtin_bit_cast(float, __builtin_amdgcn_update_dpp(__builtin_bit_cast(int, v), __builtin_bit_cast(int, v), 0x140, 0xF, 0xF, false)));
    v = fmaxf(v, __builtin_bit_cast(float, __builtin_amdgcn_update_dpp(__builtin_bit_cast(int, v), __builtin_bit_cast(int, v), 0x142, 0xA, 0xF, false)));
    v = fmaxf(v, __builtin_bit_cast(float, __builtin_amdgcn_update_dpp(__builtin_bit_cast(int, v), __builtin_bit_cast(int, v), 0x143, 0xC, 0xF, false)));
    return __builtin_bit_cast(float, __builtin_amdgcn_readlane(__builtin_bit_cast(int, v), 63));
}
__device__ __forceinline__ int lane_fresh() { int l; asm volatile("v_mbcnt_lo_u32_b32 %0, -1, 0\n\tv_mbcnt_hi_u32_b32 %0, -1, %0" : "=v"(l)); return l; }


template <int CTRL> __device__ __forceinline__ float dpp_mov(float v) { return __builtin_bit_cast(float, __builtin_amdgcn_update_dpp(0, __builtin_bit_cast(int, v), CTRL, 0xF, 0xF, false)); }
__device__ __forceinline__ float reduce40(const float (&p0)[20], const float (&p1)[20], int lane) {
    float r5[20];
#pragma unroll
    for (int c = 0; c < 20; ++c) { float a = p0[c], b = p1[c];
        asm volatile("s_nop 1\n\tv_permlane32_swap_b32 %0, %1\n\ts_nop 1" : "+v"(a), "+v"(b));
        r5[c] = a + b; }
    float r4[10];
#pragma unroll
    for (int c = 0; c < 10; ++c) { float a = r5[c], b = r5[c + 10];
        asm volatile("s_nop 1\n\tv_permlane16_swap_b32 %0, %1\n\ts_nop 1" : "+v"(a), "+v"(b));
        r4[c] = a + b; }
    const bool b3 = (lane & 8) != 0, b2 = (lane & 4) != 0, b1 = (lane & 2) != 0, b0 = (lane & 1) != 0;
    float r3[5];
#pragma unroll
    for (int c = 0; c < 5; ++c) { const float a = r4[c] + dpp_mov<0x128>(r4[c]), b = r4[c + 5] + dpp_mov<0x128>(r4[c + 5]); r3[c] = b3 ? b : a; }
    float r2[3];
    { const float a0 = r3[0] + dpp_mov<0x141>(r3[0]), a3 = r3[3] + dpp_mov<0x141>(r3[3]), a1 = r3[1] + dpp_mov<0x141>(r3[1]), a4 = r3[4] + dpp_mov<0x141>(r3[4]);
      r2[0] = b2 ? a3 : a0; r2[1] = b2 ? a4 : a1; r2[2] = r3[2] + dpp_mov<0x141>(r3[2]); }
    float r1[2];
    { const float a0 = r2[0] + dpp_mov<0x4E>(r2[0]), a2 = r2[2] + dpp_mov<0x4E>(r2[2]); r1[0] = b1 ? a2 : a0; r1[1] = r2[1] + dpp_mov<0x4E>(r2[1]); }
    const float a0 = r1[0] + dpp_mov<0xB1>(r1[0]), a1 = r1[1] + dpp_mov<0xB1>(r1[1]);
    return b0 ? a1 : a0;
}

__device__ __forceinline__ void ln_row(const float* src, const float* g, const float* b, f32x4 (&v)[4], int lane) {
    const f32x4* xr = (const f32x4*)src + lane; float s = 0.f;
#pragma unroll
    for (int j = 0; j < 4; ++j) { v[j] = xr[64 * j]; s += (v[j].x + v[j].y) + (v[j].z + v[j].w); }
    const float mean = wave_sum(s) * (1.f / D); float s2 = 0.f;
#pragma unroll
    for (int j = 0; j < 4; ++j) { v[j] = v[j] - mean; s2 += (v[j].x * v[j].x + v[j].y * v[j].y) + (v[j].z * v[j].z + v[j].w * v[j].w); }
    const float rstd = 1.f / sqrtf(wave_sum(s2) * (1.f / D) + LN_EPS);
#pragma unroll
    for (int j = 0; j < 4; ++j) { const f32x4 gg = ((const f32x4*)g)[lane + 64 * j], bb = ((const f32x4*)b)[lane + 64 * j]; v[j] = v[j] * rstd * gg + bb; }
}
__device__ __forceinline__ void ld_row(const float* src, f32x4 (&v)[4], int lane) {
#pragma unroll
    for (int j = 0; j < 4; ++j) v[j] = ((const f32x4*)src)[lane + 64 * j];
}
__device__ __forceinline__ void ld_row_bf16(const bf16* src, f32x4 (&v)[4], int lane) {
#pragma unroll
    for (int j = 0; j < 4; ++j) { const u32x2 q = ((const u32x2*)src)[lane + 64 * j];
        v[j] = (f32x4){__builtin_bit_cast(float, q.x << 16), __builtin_bit_cast(float, q.x & 0xffff0000u), __builtin_bit_cast(float, q.y << 16), __builtin_bit_cast(float, q.y & 0xffff0000u)}; }
}
__device__ __forceinline__ void ln_regs(f32x4 (&v)[4], const float* g, const float* b, int lane) {
    float s = 0.f;
#pragma unroll
    for (int j = 0; j < 4; ++j) s += (v[j].x + v[j].y) + (v[j].z + v[j].w);
    const float mean = wave_sum(s) * (1.f / D); float s2 = 0.f;
#pragma unroll
    for (int j = 0; j < 4; ++j) { v[j] = v[j] - mean; s2 += (v[j].x * v[j].x + v[j].y * v[j].y) + (v[j].z * v[j].z + v[j].w * v[j].w); }
    const float rstd = 1.f / sqrtf(wave_sum(s2) * (1.f / D) + LN_EPS);
#pragma unroll
    for (int j = 0; j < 4; ++j) { const f32x4 gg = ((const f32x4*)g)[lane + 64 * j], bb = ((const f32x4*)b)[lane + 64 * j]; v[j] = v[j] * rstd * gg + bb; }
}
__device__ __forceinline__ void st_row_f32(float* dst, const f32x4 (&v)[4], float scale, int lane) {
#pragma unroll
    for (int j = 0; j < 4; ++j) ((f32x4*)dst)[lane + 64 * j] = v[j] * scale;
}
__device__ __forceinline__ void st_row_bf16(bf16* dst, const f32x4 (&v)[4], int lane) {
#pragma unroll
    for (int j = 0; j < 4; ++j) { u32x2 w; w.x = pk2(v[j].x, v[j].y); w.y = pk2(v[j].z, v[j].w); ((u32x2*)dst)[lane + 64 * j] = w; }
}


namespace pg8 {
#define PG8_LAS __attribute__((address_space(3)))
typedef unsigned short bf16_t;
typedef short bf16x8 __attribute__((ext_vector_type(8)));
constexpr int BM = 256, BK = 64, HALF = 128, HTB = HALF * BK * 2, STAGE_BYTES = 8 * HTB, NXCD = 8, WGM = 8;
__device__ __forceinline__ int lds_byte(int r, int c) { const int st = (r >> 4) * 2 + (c >> 5), rr = r & 15, cc = c & 31, ob = rr * 64 + cc * 2; return st * 1024 + (ob ^ (((ob >> 9) & 1) << 5)); }
__device__ __forceinline__ void stage_rc(int b, int& R, int& C) { const int st = b / 1024, sb = b % 1024, swz = sb ^ (((sb >> 9) & 1) << 5); R = (st >> 1) * 16 + swz / 64; C = (st & 1) * 32 + (swz % 64) / 2; }
__device__ __forceinline__ int perm32(int rho) { const int n = rho >> 4, i = rho & 15; return 8 * (i >> 2) + 4 * n + (i & 3); }
struct Unit { const char* A; const char* B; const int* rows; int pm, pn, kind, aux, rb, half; };
struct Gemm { int lda, ldb, K; };
__device__ __forceinline__ void tile_of(int L, int nM, int nN, int& pm, int& pn) {
    const int nwg = nM * nN; int wgid = L; { const int q = nwg / NXCD, r = nwg % NXCD, xcd = wgid % NXCD, off = wgid / NXCD; wgid = (xcd < r ? xcd * (q + 1) : r * (q + 1) + (xcd - r) * q) + off; }
    const int nig = WGM * nN, gid = wgid / nig, fm = gid * WGM, gsz = (nM - fm) < WGM ? (nM - fm) : WGM;
    pm = fm + ((wgid % nig) % gsz); pn = (wgid % nig) / gsz;
}
__device__ __forceinline__ unsigned cvt_pk_bf16(float lo, float hi) { unsigned r; asm volatile("v_cvt_pk_bf16_f32 %0, %1, %2" : "=v"(r) : "v"(lo), "v"(hi)); return r; }

template <bool GATHER = false, bool HALFU = false, class Epi, class Sched>
__device__ __forceinline__ void gemm_phase(int tid, PG8_LAS unsigned char* lds, const Gemm g, const Sched& S, const Epi& E) {
    const int wid = __builtin_amdgcn_readfirstlane(tid >> 6), lane = tid & 63, wr = wid >> 2, wc = wid & 3, fr = lane & 15, fq = lane >> 4;
    const int K = g.K, nt = K / BK;
    unsigned voffA[2], voffB[2]; int gR[2]; unsigned gC[2];
#pragma unroll
    for (int i = 0; i < 2; ++i) { int R, C; stage_rc(tid * 16 + i * 8192, R, C); const int Rb = Epi::PERM ? ((R & ~31) + perm32(R & 31)) : R;
        voffA[i] = (unsigned)(R * g.lda + C) * 2u; voffB[i] = (unsigned)(Rb * g.ldb + C) * 2u; gR[i] = R; gC[i] = (unsigned)C * 2u; }
    unsigned vgc[2][2], vgn[2][2];
    const size_t kstep = (size_t)(BK * 2);
    const size_t hstepA = (size_t)HALF * g.lda * 2, hstepB = (size_t)HALF * g.ldb * 2;
    const unsigned ldsw = (unsigned)wid * 1024u;
    const int aoff = lds_byte(wr * 64 + fr, fq * 8), boff = lds_byte(wc * 32 + fr, fq * 8);
#define PG8_SA(b, h) (((b) * 2 + (h)) * HTB)
#define PG8_SB(b, h) ((4 + (b) * 2 + (h)) * HTB)
#define PG8_STAGE(bufoff, gbase, voff) do { _Pragma("unroll") for (int _i = 0; _i < 2; ++_i) \
        __builtin_amdgcn_global_load_lds((const unsigned*)((const char*)(gbase) + (voff)[_i]), (PG8_LAS unsigned*)(lds + (bufoff) + ldsw + _i * 8192), 16, 0, 0); } while (0)
#define PG8_GOFF(dst, rows) do { _Pragma("unroll") for (int _h = 0; _h < 2; ++_h) _Pragma("unroll") for (int _i = 0; _i < 2; ++_i) { int _t = (rows)[_h * HALF + gR[_i]]; _t = _t < 0 ? 0 : _t; dst[_h][_i] = (unsigned)_t * (unsigned)(g.lda * 2) + gC[_i]; } } while (0)
#define PG8_STAGE_A(bufoff, h, kptr, useNext) do { if constexpr (GATHER) { unsigned _v[2]; _v[0] = (useNext) ? vgn[h][0] : vgc[h][0]; _v[1] = (useNext) ? vgn[h][1] : vgc[h][1]; PG8_STAGE(bufoff, kptr, _v); } \
        else { PG8_STAGE(bufoff, (kptr) + (h) * hstepA, voffA); } } while (0)
#define PG8_LDA(dst, b, h) do { _Pragma("unroll") for (int m = 0; m < 4; ++m) _Pragma("unroll") for (int k = 0; k < 2; ++k) dst[m][k] = *(const PG8_LAS bf16x8*)(lds + PG8_SA(b, h) + aoff + m * 2048 + k * 1024); } while (0)
#define PG8_LDB(dst, b, h) do { _Pragma("unroll") for (int n = 0; n < 2; ++n) _Pragma("unroll") for (int k = 0; k < 2; ++k) dst[n][k] = *(const PG8_LAS bf16x8*)(lds + PG8_SB(b, h) + boff + n * 2048 + k * 1024); } while (0)
#define PG8_MMA(ai, bj, At, Bt) do { __builtin_amdgcn_s_setprio(1); _Pragma("unroll") for (int m = 0; m < 4; ++m) _Pragma("unroll") for (int n = 0; n < 2; ++n) _Pragma("unroll") for (int k = 0; k < 2; ++k) \
        acc[ai][bj][m][n] = __builtin_amdgcn_mfma_f32_16x16x32_bf16(Bt[n][k], At[m][k], acc[ai][bj][m][n], 0, 0, 0); __builtin_amdgcn_s_setprio(0); } while (0)
#define PG8_WAIT_V(n) asm volatile("s_waitcnt vmcnt(" #n ")" ::: "memory")
#define PG8_WAIT_L(n) asm volatile("s_waitcnt lgkmcnt(" #n ")" ::: "memory")
#define PG8_BAR __builtin_amdgcn_s_barrier()
#define PG8_SCHED __builtin_amdgcn_sched_barrier(0)
    Unit cur, nxt; int ui = 0;
    if (!S.next(0, cur)) return;
    f32x4 acc[2][2][4][2];
#pragma unroll
    for (int a = 0; a < 2; ++a)
#pragma unroll
        for (int b = 0; b < 2; ++b)
#pragma unroll
            for (int m = 0; m < 4; ++m)
#pragma unroll
                for (int n = 0; n < 2; ++n) acc[a][b][m][n] = (f32x4){0.f, 0.f, 0.f, 0.f};
    bf16x8 At[4][2], B0[2][2], B1[2][2];
    const char* cA = cur.A; const char* cB = cur.B;
    if constexpr (GATHER) { PG8_GOFF(vgc, cur.rows); }
    PG8_STAGE(PG8_SB(0, 0), cB, voffB); PG8_STAGE(PG8_SB(0, 1), cB + hstepB, voffB); PG8_STAGE_A(PG8_SA(0, 0), 0, cA, false); PG8_STAGE_A(PG8_SA(0, 1), 1, cA, false);
    if (wr == 1) PG8_BAR;
    PG8_WAIT_V(2); PG8_BAR;
    PG8_STAGE(PG8_SB(1, 0), cB + kstep, voffB); PG8_STAGE_A(PG8_SA(1, 0), 0, cA + kstep, false); PG8_STAGE(PG8_SB(1, 1), cB + hstepB + kstep, voffB);
    PG8_WAIT_V(6); PG8_BAR;
    for (;;) {
        const bool has_next = S.next(ui + 1, nxt);
        const char* nA = has_next ? nxt.A : cA; const char* nB = has_next ? nxt.B : cB;
        if constexpr (GATHER) { if (has_next) { PG8_GOFF(vgn, nxt.rows); asm volatile("" : "+v"(vgn[0][0]), "+v"(vgn[0][1]), "+v"(vgn[1][0]), "+v"(vgn[1][1]));   } else { _Pragma("unroll") for (int _h = 0; _h < 2; ++_h) { vgn[_h][0] = vgc[_h][0]; vgn[_h][1] = vgc[_h][1]; } } }
        for (int t = 0; t < nt; t += 2) {
            const bool last = (t == nt - 2);
            const char* a1 = cA + (size_t)(t + 1) * kstep;
            const char* a2 = last ? nA : cA + (size_t)(t + 2) * kstep; const char* b2 = last ? nB : cB + (size_t)(t + 2) * kstep;
            const char* a3 = a2 + kstep; const char* b3 = b2 + kstep;
            PG8_LDB(B0, 0, 0); PG8_LDB(B1, 0, 1); PG8_SCHED; PG8_LDA(At, 0, 0); PG8_STAGE_A(PG8_SA(1, 1), 1, a1, false);
            PG8_WAIT_V(8); PG8_WAIT_L(0); PG8_BAR; PG8_MMA(0, 0, At, B0); PG8_MMA(0, 1, At, B1); PG8_BAR; PG8_SCHED;
            PG8_LDA(At, 0, 1); PG8_STAGE(PG8_SB(0, 0), b2, voffB); PG8_STAGE(PG8_SB(0, 1), b2 + hstepB, voffB); PG8_STAGE_A(PG8_SA(0, 0), 0, a2, last);
            PG8_WAIT_V(8); PG8_WAIT_L(0); PG8_BAR; if (!HALFU || !cur.half) { PG8_MMA(1, 0, At, B0); PG8_MMA(1, 1, At, B1); } PG8_BAR; PG8_SCHED;
            PG8_LDB(B0, 1, 0); PG8_LDB(B1, 1, 1); PG8_SCHED; PG8_LDA(At, 1, 0); PG8_STAGE_A(PG8_SA(0, 1), 1, a2, last);
            PG8_WAIT_V(8); PG8_WAIT_L(0); PG8_BAR; PG8_MMA(0, 0, At, B0); PG8_MMA(0, 1, At, B1); PG8_BAR; PG8_SCHED;
            PG8_LDA(At, 1, 1); PG8_STAGE(PG8_SB(1, 0), b3, voffB); PG8_STAGE(PG8_SB(1, 1), b3 + hstepB, voffB); PG8_STAGE_A(PG8_SA(1, 0), 0, a3, last);
            PG8_WAIT_V(8); PG8_WAIT_L(0); PG8_BAR; if (!HALFU || !cur.half) { PG8_MMA(1, 0, At, B0); PG8_MMA(1, 1, At, B1); } PG8_BAR; PG8_SCHED;
        }
        if (wr == 0) PG8_BAR;
        E(acc, cur, wr, wc, fr, fq);
        if (!has_next) break;
#pragma unroll
        for (int a = 0; a < 2; ++a)
#pragma unroll
            for (int b = 0; b < 2; ++b)
#pragma unroll
                for (int m = 0; m < 4; ++m)
#pragma unroll
                    for (int n = 0; n < 2; ++n) acc[a][b][m][n] = (f32x4){0.f, 0.f, 0.f, 0.f};
        cur = nxt; cA = nA; cB = nB; ++ui;
        if constexpr (GATHER) { _Pragma("unroll") for (int _h = 0; _h < 2; ++_h) { vgc[_h][0] = vgn[_h][0]; vgc[_h][1] = vgn[_h][1]; } }
        if (wr == 1) PG8_BAR;
    }
    PG8_WAIT_V(0);
    PG8_BAR;
#undef PG8_SA
#undef PG8_SB
#undef PG8_STAGE
#undef PG8_LDA
#undef PG8_GOFF
#undef PG8_STAGE_A
#undef PG8_LDB
#undef PG8_MMA
#undef PG8_WAIT_V
#undef PG8_WAIT_L
#undef PG8_BAR
#undef PG8_SCHED
}

__device__ __forceinline__ u32x4 pack8(const f32x4 v0, const f32x4 v1) { u32x4 w; w.x = cvt_pk_bf16(v0[0], v0[1]); w.y = cvt_pk_bf16(v0[2], v0[3]); w.z = cvt_pk_bf16(v1[0], v1[1]); w.w = cvt_pk_bf16(v1[2], v1[3]); return w; }
__device__ __forceinline__ float sigm(float g) { return __builtin_amdgcn_rcpf(1.f + __expf(-g)); }

struct EpiBf16 {
    static constexpr bool PERM = true;
    bf16_t* O; int ldc; const float* bias;
    __device__ __forceinline__ void operator()(const f32x4 (&acc)[2][2][4][2], const Unit& u, int wr, int wc, int fr, int fq) const {
        const int row0 = u.pm * BM + wr * 64 + fr, col0 = u.pn * BM + wc * 32 + 8 * fq;
        f32x4 bv[2][2];
#pragma unroll
        for (int bj = 0; bj < 2; ++bj)
#pragma unroll
            for (int n = 0; n < 2; ++n) bv[bj][n] = bias ? *(const f32x4*)(bias + col0 + bj * HALF + 4 * n) : (f32x4){0.f, 0.f, 0.f, 0.f};
#pragma unroll
        for (int ai = 0; ai < 2; ++ai)
#pragma unroll
            for (int m = 0; m < 4; ++m) { bf16_t* rowp = O + (size_t)(row0 + ai * HALF + m * 16) * ldc + col0;
#pragma unroll
                for (int bj = 0; bj < 2; ++bj) *(u32x4*)(rowp + bj * HALF) = pack8(acc[ai][bj][m][0] + bv[bj][0], acc[ai][bj][m][1] + bv[bj][1]); }
    }
};
struct EpiP1 {
    static constexpr bool PERM = true;
    bf16_t *hglu, *qkv, *kvm; const float* b_in;
    __device__ __forceinline__ void operator()(const f32x4 (&acc)[2][2][4][2], const Unit& u, int wr, int wc, int fr, int fq) const {
        if (u.kind == 0) {
            const int row0 = u.pm * BM + wr * 64 + fr, cb = u.pn * 128 + wc * 32 + 8 * fq;
            f32x4 ba[2], bg[2];
#pragma unroll
            for (int n = 0; n < 2; ++n) { ba[n] = *(const f32x4*)(b_in + cb + 4 * n); bg[n] = *(const f32x4*)(b_in + 512 + cb + 4 * n); }
#pragma unroll
            for (int ai = 0; ai < 2; ++ai)
#pragma unroll
                for (int m = 0; m < 4; ++m) { f32x4 h[2];
#pragma unroll
                    for (int n = 0; n < 2; ++n) { const f32x4 a = acc[ai][0][m][n] + ba[n], gt = acc[ai][1][m][n] + bg[n];
                        h[n] = (f32x4){a[0] * sigm(gt[0]), a[1] * sigm(gt[1]), a[2] * sigm(gt[2]), a[3] * sigm(gt[3])}; }
                    *(u32x4*)(hglu + (size_t)(row0 + ai * HALF + m * 16) * 512 + cb) = pack8(h[0], h[1]); }
        } else if (u.kind == 1) { EpiBf16 e{qkv - 1024, 768, b_in}; e(acc, u, wr, wc, fr, fq);
        } else { EpiBf16 e{kvm, 2048, nullptr}; e(acc, u, wr, wc, fr, fq); }
    }
};
struct EpiGateUp {
    static constexpr bool PERM = true;
    bf16_t* Hs; const float* pair_gate;
    __device__ __forceinline__ void operator()(const f32x4 (&acc)[2][2][4][2], const Unit& u, int wr, int wc, int fr, int fq) const {
        const int row0 = u.rb + wr * 64 + fr, cb = u.pn * 128 + wc * 32 + 8 * fq;
        float pgv[2][4];
#pragma unroll
        for (int ai = 0; ai < 2; ++ai)
#pragma unroll
            for (int m = 0; m < 4; ++m) pgv[ai][m] = (ai == 0 || !u.half) ? pair_gate[row0 + ai * HALF + m * 16] : 0.f;
#pragma unroll
        for (int ai = 0; ai < 2; ++ai) { if (ai == 1 && u.half) break;
#pragma unroll
            for (int m = 0; m < 4; ++m) { const int row = row0 + ai * HALF + m * 16; const float pg = pgv[ai][m]; f32x4 h[2];
#pragma unroll
                for (int n = 0; n < 2; ++n) { const f32x4 gt = acc[ai][0][m][n], up = acc[ai][1][m][n];
                    h[n] = (f32x4){gt[0] * sigm(gt[0]) * up[0] * pg, gt[1] * sigm(gt[1]) * up[1] * pg, gt[2] * sigm(gt[2]) * up[2] * pg, gt[3] * sigm(gt[3]) * up[3] * pg}; }
                if (pg == 0.f) { h[0] = (f32x4){0.f, 0.f, 0.f, 0.f}; h[1] = h[0]; }
                *(u32x4*)(Hs + (size_t)row * 512 + cb) = pack8(h[0], h[1]); } }
    }
};
struct EpiY {
    static constexpr bool PERM = true;
    bf16_t* Y;
    __device__ __forceinline__ void operator()(const f32x4 (&acc)[2][2][4][2], const Unit& u, int wr, int wc, int fr, int fq) const {
        const int row0 = u.rb + wr * 64 + fr, col0 = u.pn * BM + wc * 32 + 8 * fq;
#pragma unroll
        for (int ai = 0; ai < 2; ++ai) { if (ai == 1 && u.half) break;
#pragma unroll
            for (int m = 0; m < 4; ++m) { bf16_t* rowp = Y + (size_t)(row0 + ai * HALF + m * 16) * 1024 + col0;
#pragma unroll
                for (int bj = 0; bj < 2; ++bj) *(u32x4*)(rowp + bj * HALF) = pack8(acc[ai][bj][m][0], acc[ai][bj][m][1]); } }
    }
};
__device__ __forceinline__ void row_stats16(const float* stats, int row, int fq, float& mu, float& rstd) {
    const f32x4* sp = (const f32x4*)(stats + (size_t)row * 32 + fq * 8); const f32x4 a = sp[0], b = sp[1];
    float s = (a[0] + a[2]) + (b[0] + b[2]), ss = (a[1] + a[3]) + (b[1] + b[3]);
    s += __shfl_xor(s, 16); s += __shfl_xor(s, 32); ss += __shfl_xor(ss, 16); ss += __shfl_xor(ss, 32);
    mu = s * (1.f / 1024.f); const float var = ss * (1.f / 1024.f) - mu * mu; rstd = 1.f / sqrtf(var + 1e-5f);
}
__device__ __forceinline__ void row_stats16x4(const float* stats, int rowh, int fq, float (&mu)[4], float (&rstd)[4]) {
    f32x4 sa[4], sb[4];
#pragma unroll
    for (int m = 0; m < 4; ++m) { const f32x4* sp = (const f32x4*)(stats + (size_t)(rowh + m * 16) * 32 + fq * 8); sa[m] = sp[0]; sb[m] = sp[1]; }
#pragma unroll
    for (int m = 0; m < 4; ++m) { const f32x4 a = sa[m], b = sb[m];
        float s = (a[0] + a[2]) + (b[0] + b[2]), ss = (a[1] + a[3]) + (b[1] + b[3]);
        s += __shfl_xor(s, 16); s += __shfl_xor(s, 32); ss += __shfl_xor(ss, 16); ss += __shfl_xor(ss, 32);
        const float mm = s * (1.f / 1024.f); mu[m] = mm; rstd[m] = 1.f / sqrtf(ss * (1.f / 1024.f) - mm * mm + 1e-5f); }
}
struct EpiResStats {
    static constexpr bool PERM = false;
    const bf16_t* resb; bf16_t* zb; float* stats; float alpha;
    __device__ __forceinline__ void operator()(const f32x4 (&acc)[2][2][4][2], const Unit& u, int wr, int wc, int fr, int fq) const {
        const int row0 = u.pm * BM + wr * 64 + fr, col0 = u.pn * BM + wc * 32 + 4 * fq;
#pragma unroll
        for (int ai = 0; ai < 2; ++ai) {
            u32x2 rw[4][2][2];
#pragma unroll
            for (int m = 0; m < 4; ++m)
#pragma unroll
                for (int bj = 0; bj < 2; ++bj)
#pragma unroll
                    for (int n = 0; n < 2; ++n) rw[m][bj][n] = *(const u32x2*)(resb + (size_t)(row0 + ai * HALF + m * 16) * 1024 + col0 + bj * HALF + n * 16);
#pragma unroll
            for (int m = 0; m < 4; ++m) { const int row = row0 + ai * HALF + m * 16; const size_t off = (size_t)row * 1024 + col0; float sm = 0.f, ss = 0.f;
#pragma unroll
                for (int bj = 0; bj < 2; ++bj)
#pragma unroll
                    for (int n = 0; n < 2; ++n) { const u32x2 q = rw[m][bj][n];
                        const f32x4 r = (f32x4){__builtin_bit_cast(float, q.x << 16), __builtin_bit_cast(float, q.x & 0xffff0000u), __builtin_bit_cast(float, q.y << 16), __builtin_bit_cast(float, q.y & 0xffff0000u)};
                        const f32x4 z = r * alpha + acc[ai][bj][m][n];
                        u32x2 w; w.x = cvt_pk_bf16(z[0], z[1]); w.y = cvt_pk_bf16(z[2], z[3]); *(u32x2*)(zb + off + bj * HALF + n * 16) = w;
                        sm += (z[0] + z[1]) + (z[2] + z[3]); ss += (z[0] * z[0] + z[1] * z[1]) + (z[2] * z[2] + z[3] * z[3]); }
                sm += __shfl_xor(sm, 16); sm += __shfl_xor(sm, 32); ss += __shfl_xor(ss, 16); ss += __shfl_xor(ss, 32);
                if (fq == 0) *(float2*)(stats + (size_t)row * 32 + (u.pn * 4 + wc) * 2) = make_float2(sm, ss); } }
    }
};
struct EpiResLn {
    static constexpr bool PERM = false;
    bf16_t* out; const bf16_t* zb; const float* stats; const float* g; const float* b; float alpha;
    __device__ __forceinline__ void operator()(const f32x4 (&acc)[2][2][4][2], const Unit& u, int wr, int wc, int fr, int fq) const {
        const int row0 = u.pm * BM + wr * 64 + fr, col0 = u.pn * BM + wc * 32 + 4 * fq;
        f32x4 gv[2][2], bv[2][2];
#pragma unroll
        for (int bj = 0; bj < 2; ++bj)
#pragma unroll
            for (int n = 0; n < 2; ++n) { gv[bj][n] = *(const f32x4*)(g + col0 + bj * HALF + n * 16); bv[bj][n] = *(const f32x4*)(b + col0 + bj * HALF + n * 16); }
#pragma unroll
        for (int ai = 0; ai < 2; ++ai) {
            float mu[4], rstd[4]; row_stats16x4(stats, row0 + ai * HALF, fq, mu, rstd);
            u32x2 zw[4][2][2];
#pragma unroll
            for (int m = 0; m < 4; ++m)
#pragma unroll
                for (int bj = 0; bj < 2; ++bj)
#pragma unroll
                    for (int n = 0; n < 2; ++n) zw[m][bj][n] = *(const u32x2*)(zb + (size_t)(row0 + ai * HALF + m * 16) * 1024 + col0 + bj * HALF + n * 16);
#pragma unroll
            for (int m = 0; m < 4; ++m) { const size_t off = (size_t)(row0 + ai * HALF + m * 16) * 1024 + col0; const float mm = mu[m], rs = rstd[m];
#pragma unroll
                for (int bj = 0; bj < 2; ++bj)
#pragma unroll
                    for (int n = 0; n < 2; ++n) { const u32x2 q = zw[m][bj][n];
                        const f32x4 z = (f32x4){__builtin_bit_cast(float, q.x << 16), __builtin_bit_cast(float, q.x & 0xffff0000u), __builtin_bit_cast(float, q.y << 16), __builtin_bit_cast(float, q.y & 0xffff0000u)};
                        const f32x4 x1 = (z - mm) * rs * gv[bj][n] + bv[bj][n];
                        const f32x4 z2 = x1 * alpha + acc[ai][bj][m][n]; u32x2 w; w.x = cvt_pk_bf16(z2[0], z2[1]); w.y = cvt_pk_bf16(z2[2], z2[3]); *(u32x2*)(out + off + bj * HALF + n * 16) = w; } } }
    }
};
struct EpiPre {
    static constexpr bool PERM = true;
    bf16_t* O; float* csp;
    __device__ __forceinline__ void operator()(const f32x4 (&acc)[2][2][4][2], const Unit& u, int wr, int wc, int fr, int fq) const {
        const int row0 = u.pm * BM + wr * 64 + fr, col0 = u.pn * BM + wc * 32 + 8 * fq;
#pragma unroll
        for (int ai = 0; ai < 2; ++ai)
#pragma unroll
            for (int m = 0; m < 4; ++m) { const int row = row0 + ai * HALF + m * 16; bf16_t* rowp = O + ((size_t)u.aux * 1024 + row) * 1024 + col0; float sm = 0.f;
#pragma unroll
                for (int bj = 0; bj < 2; ++bj) { const u32x4 w = pack8(acc[ai][bj][m][0], acc[ai][bj][m][1]); *(u32x4*)(rowp + bj * HALF) = w;
#pragma unroll
                    for (int e = 0; e < 4; ++e) sm += __builtin_bit_cast(float, w[e] << 16) + __builtin_bit_cast(float, w[e] & 0xffff0000u); }
                if (csp) { sm += __shfl_xor(sm, 16); sm += __shfl_xor(sm, 32); if (fq == 0) csp[((size_t)u.aux * 1024 + row) * 16 + u.pn * 4 + wc] = sm; } }
    }
};
struct EpiSoftmaxLn {
    static constexpr bool PERM = true;
    bf16_t* P; PG8_LAS float* xl; const float* stats; const float* cs; const float* bw;
    __device__ __forceinline__ void operator()(f32x4 (&acc)[2][2][4][2], const Unit& u, int wr, int wc, int fr, int fq) const {
        const float sc = 0.0625f * 1.4426950408889634f;
        const int row0 = u.pm * BM + wr * 64 + fr, col0 = u.pn * BM + wc * 32 + 8 * fq;
        unsigned xw = (unsigned)(size_t)(xl + ((wr * 64 + fr) * 4 + wc) * 2), xr = (unsigned)(size_t)(xl + (wr * 64 + fr) * 8);
        asm volatile("" : "+v"(xw), "+v"(xr));
        PG8_LAS float* const xwp = (PG8_LAS float*)(size_t)xw; const PG8_LAS float* const xrp = (const PG8_LAS float*)(size_t)xr;
        { f32x4 cv[2][2], wv[2][2];
#pragma unroll
          for (int bj = 0; bj < 2; ++bj)
#pragma unroll
            for (int n = 0; n < 2; ++n) { cv[bj][n] = *(const f32x4*)(cs + u.aux * 1024 + col0 + bj * HALF + 4 * n); wv[bj][n] = *(const f32x4*)(bw + u.aux * 1024 + col0 + bj * HALF + 4 * n); }
#pragma unroll
          for (int ai = 0; ai < 2; ++ai) { float mu8[4], rs8[4];
#pragma unroll
            for (int m = 0; m < 4; ++m) row_stats16(stats, row0 + ai * HALF + m * 16, fq, mu8[m], rs8[m]);
#pragma unroll
            for (int m = 0; m < 4; ++m) {
#pragma unroll
                for (int bj = 0; bj < 2; ++bj)
#pragma unroll
                    for (int n = 0; n < 2; ++n) acc[ai][bj][m][n] = (acc[ai][bj][m][n] - cv[bj][n] * mu8[m]) * rs8[m] + wv[bj][n]; } } }
#pragma unroll
        for (int ai = 0; ai < 2; ++ai)
#pragma unroll
            for (int m = 0; m < 4; ++m) { float mx = -INFINITY;
#pragma unroll
                for (int bj = 0; bj < 2; ++bj)
#pragma unroll
                    for (int n = 0; n < 2; ++n) { const f32x4 v = acc[ai][bj][m][n]; mx = fmaxf(mx, fmaxf(fmaxf(v[0], v[1]), fmaxf(v[2], v[3]))); }
                mx = fmaxf(mx, __shfl_xor(mx, 16)); mx = fmaxf(mx, __shfl_xor(mx, 32));
                float sm = 0.f;
#pragma unroll
                for (int bj = 0; bj < 2; ++bj)
#pragma unroll
                    for (int n = 0; n < 2; ++n) { const f32x4 v = acc[ai][bj][m][n];
                        const f32x4 e = (f32x4){__builtin_amdgcn_exp2f((v[0] - mx) * sc), __builtin_amdgcn_exp2f((v[1] - mx) * sc), __builtin_amdgcn_exp2f((v[2] - mx) * sc), __builtin_amdgcn_exp2f((v[3] - mx) * sc)};
                        acc[ai][bj][m][n] = e; sm += (e[0] + e[1]) + (e[2] + e[3]); }
                sm += __shfl_xor(sm, 16); sm += __shfl_xor(sm, 32);
                if (fq == 0) { PG8_LAS float* q = xwp + (ai * HALF + m * 16) * 8; q[0] = mx; q[1] = sm; } }
        asm volatile("s_waitcnt lgkmcnt(0)" ::: "memory"); __builtin_amdgcn_s_barrier(); asm volatile("" ::: "memory");
#pragma unroll
        for (int ai = 0; ai < 2; ++ai)
#pragma unroll
            for (int m = 0; m < 4; ++m) { const PG8_LAS f32x4* q = (const PG8_LAS f32x4*)(xrp + (ai * HALF + m * 16) * 8); const f32x4 q0 = q[0], q1 = q[1];
                const float M = fmaxf(fmaxf(q0[0], q0[2]), fmaxf(q1[0], q1[2]));
                const float S = (q0[1] * __builtin_amdgcn_exp2f((q0[0] - M) * sc) + q0[3] * __builtin_amdgcn_exp2f((q0[2] - M) * sc)) + (q1[1] * __builtin_amdgcn_exp2f((q1[0] - M) * sc) + q1[3] * __builtin_amdgcn_exp2f((q1[2] - M) * sc));
                const float mine = (wc == 0) ? q0[0] : (wc == 1) ? q0[2] : (wc == 2) ? q1[0] : q1[2];
                const float fac = __builtin_amdgcn_exp2f((mine - M) * sc) / S; bf16_t* rowp = P + (size_t)(row0 + ai * HALF + m * 16) * 1024 + col0;
#pragma unroll
                for (int bj = 0; bj < 2; ++bj) *(u32x4*)(rowp + bj * HALF) = pack8(acc[ai][bj][m][0] * fac, acc[ai][bj][m][1] * fac); }
        asm volatile("s_waitcnt lgkmcnt(0)" ::: "memory"); __builtin_amdgcn_s_barrier(); asm volatile("" ::: "memory");
    }
};
struct DenseSched {
    const char* A; const char* B; int nM, nN, G, c; size_t strideA, strideB;
    __device__ __forceinline__ bool next(int i, Unit& u) const { const int L = i * G + c; if (L >= nM * nN) return false; tile_of(L, nM, nN, u.pm, u.pn); u.A = A + (size_t)u.pm * strideA; u.B = B + (size_t)u.pn * strideB; u.kind = 0; u.aux = 0; u.rows = nullptr; return true; }
};
}


#define LAS __attribute__((address_space(3)))
struct TItem { const float* W; bf16* WT; const float* gk; int N, Kd, k0, n0, drow0; };
__device__ __forceinline__ void titem_load(const TItem& t, float (&wv)[32], int lane) {
#pragma unroll
    for (int i = 0; i < 32; ++i) { const int kk = 2 * i + (lane >> 5); wv[i] = __builtin_nontemporal_load(t.W + (size_t)(t.k0 + kk) * t.N + t.n0 + (lane & 31)); }
}
__device__ __forceinline__ void titem_store(const TItem& t, const float (&wv)[32], LAS float* scr, int lane) {
#pragma unroll
    for (int i = 0; i < 32; ++i) { const int kk = 2 * i + (lane >> 5); float v = wv[i]; if (t.gk) v *= t.gk[t.k0 + kk]; scr[kk * 33 + (lane & 31)] = v; }
    asm volatile("s_waitcnt lgkmcnt(0)" ::: "memory");
    const int c = lane & 7;
#pragma unroll
    for (int j = 0; j < 4; ++j) { const int n = (lane >> 3) + 8 * j; const LAS float* sp = scr + (8 * c) * 33 + n;
        u32x4 o; o.x = pk2(sp[0 * 33], sp[1 * 33]); o.y = pk2(sp[2 * 33], sp[3 * 33]); o.z = pk2(sp[4 * 33], sp[5 * 33]); o.w = pk2(sp[6 * 33], sp[7 * 33]);
        *(u32x4*)(t.WT + (size_t)(t.drow0 + n) * t.Kd + t.k0 + 8 * c) = o; }
    asm volatile("s_waitcnt lgkmcnt(0)" ::: "memory");
}
__device__ __forceinline__ void transpose_item(const float* W, int N, bf16* WT, int Kd, int k0, int n0, int drow0, LAS float* scr, int lane, const float* gk = nullptr) {
    const TItem t{W, WT, gk, N, Kd, k0, n0, drow0}; float wv[32]; titem_load(t, wv, lane); titem_store(t, wv, scr, lane);
}

typedef short bf16x8v __attribute__((ext_vector_type(8)));
__device__ __forceinline__ float bflo(unsigned v) { return __builtin_bit_cast(float, v << 16); }
__device__ __forceinline__ float bfhi(unsigned v) { return __builtin_bit_cast(float, v & 0xffff0000u); }

__device__ __forceinline__ void conv_load(const bf16* hglu, int cu, int tid, u32x4 (&pre)[8]) {
    const int t0 = cu * 32, s0 = t0 % SEQ;
#pragma unroll
    for (int i = 0; i < 8; ++i) { const int c = tid + 512 * i, row = c >> 6, part = c & 63; u32x4 v = (u32x4){0u, 0u, 0u, 0u};
        if (c < 62 * 64 && s0 - 30 + row >= 0) v = *(const u32x4*)(hglu + (size_t)(t0 - 30 + row) * 512 + part * 8);
        pre[i] = v; }
}
__device__ __forceinline__ void conv_stage(unsigned char* lds, int tid, const u32x4 (&pre)[8]) {
    bf16* hin = (bf16*)lds;
#pragma unroll
    for (int i = 0; i < 8; ++i) { const int c = tid + 512 * i, row = c >> 6, part = c & 63; if (c < 62 * 64) *(u32x4*)(hin + row * 512 + part * 8) = pre[i]; }
}
typedef float f32x2c __attribute__((ext_vector_type(2)));
struct ConvW { f32x2c wj[CONV_W]; f32x2c bb; f32x4 g0, g1, c0, c1; };
__device__ __forceinline__ void conv_weights(const float* w_dw, const float* b_dw, const float* g_cn, const float* b_cn, int tid, ConvW& w) {
    const int cp = tid & 255, lane = tid & 63;
#pragma unroll
    for (int j = 0; j < CONV_W; ++j) w.wj[j] = *(const f32x2c*)(w_dw + j * CONV_CH + 2 * cp);
    w.bb = *(const f32x2c*)(b_dw + 2 * cp);
    w.g0 = *(const f32x4*)(g_cn + 8 * lane); w.g1 = *(const f32x4*)(g_cn + 8 * lane + 4); w.c0 = *(const f32x4*)(b_cn + 8 * lane); w.c1 = *(const f32x4*)(b_cn + 8 * lane + 4);
}
template <class Hook> __device__ __forceinline__ void conv_unit(unsigned char* lds, const ConvW& w, bf16* ycat, int cu, int tid, Hook mid) {
    const int lane = tid & 63, wave = tid >> 6;
    bf16* hin = (bf16*)lds; float* cout = (float*)(lds + 63488);
    const int t0 = cu * 32;
    {
        const int cp = tid & 255, th = tid >> 8;
#pragma unroll 1
        for (int grp = 0; grp < 2; ++grp) { const int tt0 = th * 16 + grp * 8;
            f32x2c ac[8];
#pragma unroll
            for (int o = 0; o < 8; ++o) ac[o] = w.bb;
#pragma unroll
            for (int r = 0; r < 38; ++r) { const unsigned v = *(const unsigned*)(hin + (tt0 + r) * 512 + 2 * cp); const f32x2c hv = (f32x2c){bflo(v), bfhi(v)};
#pragma unroll
                for (int o = 0; o < 8; ++o) { const int j = r - o; if (j >= 0 && j < CONV_W) ac[o] = __builtin_elementwise_fma(w.wj[j], hv, ac[o]); } }
#pragma unroll
            for (int o = 0; o < 8; ++o) *(f32x2c*)(cout + (tt0 + o) * 512 + 2 * cp) = ac[o];
        }
    }
    __syncthreads();
    mid();
    {
        f32x4 v0[4], v1[4]; float mean[4], rstd[4];
#pragma unroll
        for (int i = 0; i < 4; ++i) { const int tt = wave * 4 + i; v0[i] = *(const f32x4*)(cout + tt * 512 + 8 * lane); v1[i] = *(const f32x4*)(cout + tt * 512 + 8 * lane + 4); }
#pragma unroll
        for (int i = 0; i < 4; ++i) mean[i] = wave_sum((v0[i].x + v0[i].y) + (v0[i].z + v0[i].w) + (v1[i].x + v1[i].y) + (v1[i].z + v1[i].w)) * (1.f / 512.f);
#pragma unroll
        for (int i = 0; i < 4; ++i) { v0[i] = v0[i] - mean[i]; v1[i] = v1[i] - mean[i];
            rstd[i] = wave_sum((v0[i].x * v0[i].x + v0[i].y * v0[i].y) + (v0[i].z * v0[i].z + v0[i].w * v0[i].w) + (v1[i].x * v1[i].x + v1[i].y * v1[i].y) + (v1[i].z * v1[i].z + v1[i].w * v1[i].w)) * (1.f / 512.f); }
#pragma unroll
        for (int i = 0; i < 4; ++i) { const int tt = wave * 4 + i; const float rs = 1.f / sqrtf(rstd[i] + LN_EPS);
            f32x4 y0 = v0[i] * rs * w.g0 + w.c0, y1 = v1[i] * rs * w.g1 + w.c1;
#pragma unroll
            for (int e = 0; e < 4; ++e) { y0[e] = y0[e] * pg8::sigm(y0[e]); y1[e] = y1[e] * pg8::sigm(y1[e]); }
            *(u32x4*)(ycat + (size_t)(t0 + tt) * 1024 + 8 * lane) = pg8::pack8(y0, y1); }
    }
    __syncthreads();
}

__device__ __forceinline__ void swa_load(const bf16* qkv, int b, int kvh, int qb, int tid, u32x4 (&kk)[4], u32x4 (&vq)[4]) {
    const long tk0 = (long)b * SEQ + (long)qb * 128 - 128;
#pragma unroll
    for (int i = 0; i < 4; ++i) { const int c = tid + 512 * i, row = c >> 3, part = c & 7; const bool ok = (qb > 0) || (row >= 128);
        u32x4 kv = (u32x4){0u, 0u, 0u, 0u}, vv = kv;
        if (ok) { const bf16* rp = qkv + (tk0 + row) * 768 + 512 + kvh * 64 + part * 8; kv = *(const u32x4*)rp; vv = *(const u32x4*)(rp + 128); }
        kk[i] = kv; vq[i] = vv; }
}
__device__ __forceinline__ void swa_unit(unsigned char* lds, const bf16* qkv, const float* sinks, bf16* ycat, int b, int kvh, int qb, int tid, const u32x4 (&kk)[4], const u32x4 (&vq)[4], unsigned long long& tpr) {
    const int lane = tid & 63, wave = tid >> 6, q4 = lane >> 4, c16 = lane & 15;
    bf16* Ks = (bf16*)lds; bf16* VT = (bf16*)(lds + 36864);
    const long t0 = (long)b * SEQ + (long)qb * 128;
#pragma unroll
    for (int i = 0; i < 4; ++i) { const int c = tid + 512 * i, row = c >> 3, part = c & 7;
        const u32x4 kv = kk[i], vv = vq[i];
        *(u32x4*)(Ks + row * 72 + part * 8) = kv;
#pragma unroll
        for (int e = 0; e < 4; ++e) { VT[(part * 8 + 2 * e) * 264 + row] = (bf16)(vv[e] & 0xffffu); VT[(part * 8 + 2 * e + 1) * 264 + row] = (bf16)(vv[e] >> 16); } }
    __syncthreads();
    unsigned long long tsw = 0; if (PROBE_T == 111) tsw = __builtin_amdgcn_s_memrealtime();
    const int g = wave >> 1, hq = kvh * 4 + g, i0 = (wave & 1) * 64;
    const float L2E = 1.4426950408889634f, sc = 0.125f * L2E, sink2 = sinks[hq] * L2E;
    bf16x8v Qc[2][2], Qn[2][2];
#pragma unroll
    for (int h = 0; h < 2; ++h) { const bf16* qp = qkv + (t0 + i0 + h * 16 + c16) * 768 + hq * 64 + 8 * q4; Qc[h][0] = *(const bf16x8v*)qp; Qc[h][1] = *(const bf16x8v*)(qp + 32); }
#pragma unroll 1
    for (int qp2 = 0; qp2 < 2; ++qp2) {
        if (qp2 == 0) {
#pragma unroll
            for (int h = 0; h < 2; ++h) { const bf16* qp = qkv + (t0 + i0 + (2 + h) * 16 + c16) * 768 + hq * 64 + 8 * q4; Qn[h][0] = *(const bf16x8v*)qp; Qn[h][1] = *(const bf16x8v*)(qp + 32); } }
        int kt0[2], iqc[2]; f32x4 sv[2][9]; float inv[2];
#pragma unroll
        for (int h = 0; h < 2; ++h) { const int iq = i0 + (2 * qp2 + h) * 16; kt0[h] = iq >> 4; iqc[h] = iq + c16; }
#pragma unroll
        for (int kt = 0; kt < 9; ++kt)
#pragma unroll
            for (int h = 0; h < 2; ++h) { const bf16* kp = Ks + ((kt0[h] + kt) * 16 + c16) * 72 + 8 * q4;
                f32x4 a = (f32x4){0.f, 0.f, 0.f, 0.f};
                a = __builtin_amdgcn_mfma_f32_16x16x32_bf16(*(const bf16x8v*)kp, Qc[h][0], a, 0, 0, 0);
                a = __builtin_amdgcn_mfma_f32_16x16x32_bf16(*(const bf16x8v*)(kp + 32), Qc[h][1], a, 0, 0, 0);
                sv[h][kt] = a; }
        float mx[2], sum[2];
#pragma unroll
        for (int h = 0; h < 2; ++h) { float m_ = sink2;
#pragma unroll
            for (int kt = 0; kt < 9; ++kt)
#pragma unroll
                for (int r = 0; r < 4; ++r) { const int j2 = (kt0[h] + kt) * 16 + 4 * q4 + r; const bool ok = (j2 > iqc[h]) && (j2 <= iqc[h] + 128) && (qb > 0 || j2 >= 128);
                    const float v = ok ? sv[h][kt][r] * sc : -INFINITY; sv[h][kt][r] = v; m_ = fmaxf(m_, v); }
            mx[h] = m_; }
#pragma unroll
        for (int h = 0; h < 2; ++h) mx[h] = fmaxf(mx[h], __shfl_xor(mx[h], 16));
#pragma unroll
        for (int h = 0; h < 2; ++h) mx[h] = fmaxf(mx[h], __shfl_xor(mx[h], 32));
#pragma unroll
        for (int h = 0; h < 2; ++h) { float s_ = 0.f;
#pragma unroll
            for (int kt = 0; kt < 9; ++kt)
#pragma unroll
                for (int r = 0; r < 4; ++r) { const float pv = __builtin_amdgcn_exp2f(sv[h][kt][r] - mx[h]); sv[h][kt][r] = pv; s_ += pv; }
            sum[h] = s_; }
#pragma unroll
        for (int h = 0; h < 2; ++h) sum[h] += __shfl_xor(sum[h], 16);
#pragma unroll
        for (int h = 0; h < 2; ++h) sum[h] += __shfl_xor(sum[h], 32);
#pragma unroll
        for (int h = 0; h < 2; ++h) inv[h] = 1.f / (sum[h] + __builtin_amdgcn_exp2f(sink2 - mx[h]));
        f32x4 o[2][4];
#pragma unroll
        for (int h = 0; h < 2; ++h)
#pragma unroll
            for (int dt = 0; dt < 4; ++dt) o[h][dt] = (f32x4){0.f, 0.f, 0.f, 0.f};
#pragma unroll
        for (int pp = 0; pp < 5; ++pp)
#pragma unroll
            for (int h = 0; h < 2; ++h) { const int T0 = kt0[h] + 2 * pp, T1 = (pp < 4) ? T0 + 1 : T0;
                const f32x4 pa = sv[h][2 * pp], pb = (pp < 4) ? sv[h][2 * pp + 1] : (f32x4){0.f, 0.f, 0.f, 0.f};
                const u32x4 pw = pg8::pack8(pa, pb); const bf16x8v Bp = __builtin_bit_cast(bf16x8v, pw);
#pragma unroll
                for (int dt = 0; dt < 4; ++dt) { const bf16* vp = VT + (dt * 16 + c16) * 264 + 4 * q4;
                    const u32x2 lo = *(const u32x2*)(vp + T0 * 16), hi = *(const u32x2*)(vp + T1 * 16);
                    const u32x4 aw = (u32x4){lo.x, lo.y, hi.x, hi.y};
                    o[h][dt] = __builtin_amdgcn_mfma_f32_16x16x32_bf16(__builtin_bit_cast(bf16x8v, aw), Bp, o[h][dt], 0, 0, 0); } }
#pragma unroll
        for (int h = 0; h < 2; ++h) { bf16* op = ycat + (t0 + iqc[h]) * 1024 + 512 + hq * 64 + 4 * q4;
#pragma unroll
            for (int dt = 0; dt < 4; ++dt) { u32x2 w; w.x = pg8::cvt_pk_bf16(o[h][dt][0] * inv[h], o[h][dt][1] * inv[h]); w.y = pg8::cvt_pk_bf16(o[h][dt][2] * inv[h], o[h][dt][3] * inv[h]); *(u32x2*)(op + dt * 16) = w; } }
#pragma unroll
        for (int h = 0; h < 2; ++h) { Qc[h][0] = Qn[h][0]; Qc[h][1] = Qn[h][1]; }
    }
    if (PROBE_T == 111) tpr += __builtin_amdgcn_s_memrealtime() - tsw;
    __syncthreads();
}


#define XB_TMO      128
#define XB_XCNT(j)  (256  + 64 * (j))
#define XB_XSUB(j)  (1280 + 64 * (j))
#define XB_XGEN(j)  (2304 + 64 * (j))
#define XB_TOP      3328
#define XB_TOPGEN   3392
#define XCD_BAR_WORDS 3456
#define XB_SPIN_CAP (1u << 20)
__device__ __forceinline__ unsigned xb_ld(unsigned* p)              { return __hip_atomic_load(p, __ATOMIC_RELAXED, __HIP_MEMORY_SCOPE_AGENT); }
__device__ __forceinline__ unsigned xb_add(unsigned* p, unsigned v) { return __hip_atomic_fetch_add(p, v, __ATOMIC_RELAXED, __HIP_MEMORY_SCOPE_AGENT); }
__device__ __forceinline__ unsigned xb_xcc_id() { return (unsigned)__builtin_amdgcn_s_getreg((3 << 11) | 20) & 0xFu; }
#define XB_SPIN(cond, bar) do { unsigned _sp = 0; while (cond) { __builtin_amdgcn_s_sleep(1); \
    if ((++_sp & 255u) == 0u) { if (xb_ld(&(bar)[XB_TMO])) break; if (_sp > XB_SPIN_CAP) { atomicAdd(&(bar)[XB_TMO], 1u); break; } } } } while (0)
struct XcdBarrier { unsigned* bar; unsigned x; volatile __attribute__((address_space(3))) unsigned* st; };
__device__ __forceinline__ XcdBarrier xcd_barrier_post(unsigned* bar, volatile __attribute__((address_space(3))) unsigned* st) {
    XcdBarrier b; b.bar = bar; b.x = xb_xcc_id(); b.st = st;
    if (threadIdx.x == 0) (void)xb_add(&bar[XB_XCNT(b.x)], 1u);
    return b;
}
__device__ __forceinline__ void xcd_barrier_complete(unsigned* bar, unsigned x, unsigned& nloc, unsigned& nx) {
    const unsigned G = gridDim.x * gridDim.y * gridDim.z;
    unsigned sum, cnt, mine, sp = 0u;
    for (;;) {
        sum = 0u; cnt = 0u; mine = 0u;
#pragma unroll
        for (unsigned j = 0; j < 16; ++j) { const unsigned c = xb_ld(&bar[XB_XCNT(j)]); sum += c; cnt += (c > 0u) ? 1u : 0u; mine = (j == x) ? c : mine; }
        if (sum == G) break;
        __builtin_amdgcn_s_sleep(1);
        if ((++sp & 255u) == 0u) { if (xb_ld(&bar[XB_TMO])) break; if (sp > XB_SPIN_CAP) { atomicAdd(&bar[XB_TMO], 1u); break; } }
    }
    nloc = mine > 0u ? mine : 1u; nx = cnt > 0u ? cnt : 1u;
}
__device__ __forceinline__ void xcd_barrier(const XcdBarrier& b, int tid) {
    asm volatile("s_waitcnt vmcnt(0)" ::: "memory");
    __syncthreads();
    if (tid == 0) {
        unsigned* bar = b.bar;
        __builtin_amdgcn_s_waitcnt(0);
        unsigned nloc = b.st[0], nx = b.st[1];
        if (nloc == 0u) { xcd_barrier_complete(bar, b.x, nloc, nx); b.st[0] = nloc; b.st[1] = nx; }
        const unsigned old = xb_add(&bar[XB_XSUB(b.x)], 1u);
        const unsigned gen = old / nloc;
        if (old + 1u == (gen + 1u) * nloc) {
            __builtin_amdgcn_fence(__ATOMIC_RELEASE, "agent");
            asm volatile("s_waitcnt vmcnt(0)" ::: "memory");
            const unsigned og = xb_add(&bar[XB_TOP], 1u);
            const unsigned tg = og / nx;
            if (og + 1u == (tg + 1u) * nx) xb_add(&bar[XB_TOPGEN], 1u);
            else XB_SPIN(xb_ld(&bar[XB_TOPGEN]) == tg, bar);
            __builtin_amdgcn_fence(__ATOMIC_ACQUIRE, "agent");
            xb_add(&bar[XB_XGEN(b.x)], 1u);
            asm volatile("s_waitcnt vmcnt(0)" ::: "memory");
        } else {
            XB_SPIN(xb_ld(&bar[XB_XGEN(b.x)]) == gen, bar);
            __builtin_amdgcn_fence(__ATOMIC_ACQUIRE, "agent");
            asm volatile("s_waitcnt vmcnt(0)" ::: "memory");
        }
    }
    __syncthreads();
}

struct SchedMoE { const char* A; const char* W; const int* tab; const int* rows; int nF, nH, G, c; size_t lda2, strideE, strideN;
    __device__ __forceinline__ bool next(int i, pg8::Unit& u) const { const int L = i * G + c; int t;
        if (L < nF * 4) { pg8::tile_of(L, nF, 4, t, u.pn); u.half = 0; } else if (L < (nF + nH) * 4) { pg8::tile_of(L - nF * 4, nH, 4, t, u.pn); t += nF; u.half = 1; } else return false;
        const int rb = tab[2 + t], e = tab[2 + 192 + t];
        u.pm = t; u.kind = 0; u.aux = e; u.rb = rb; u.rows = rows ? rows + rb : nullptr; u.A = rows ? A : A + (size_t)rb * lda2; u.B = W + (size_t)e * strideE + (size_t)u.pn * strideN; return true; } };

__global__ void __launch_bounds__(512, 2) fwd_kernel(Params p) {
    extern __shared__ __attribute__((aligned(16))) unsigned char lds_raw[];
    float* ldsf = (float*)lds_raw;
    cg::grid_group grid = cg::this_grid();
    const int G = gridDim.x, bid = blockIdx.x, NGW = G * 8;
    const int wid_s = __builtin_amdgcn_readfirstlane((int)threadIdx.x >> 6);
    unsigned char* ws = p.ws;
    const float *x = p.in[0], *mem = p.in[1], *w_in = p.in[2], *b_in = p.in[3], *w_dw = p.in[4], *b_dw = p.in[5], *g_cn = p.in[6], *b_cn = p.in[7], *sinks = p.in[8],
                *w_out = p.in[9], *g_ln1 = p.in[10], *b_ln1 = p.in[11], *w_mq = p.in[12], *w_mkv = p.in[13], *w_mo = p.in[14], *g_ln2 = p.in[15], *b_ln2 = p.in[16],
                *w_group = p.in[17], *b_group = p.in[18], *w_router = p.in[19], *b_router = p.in[20], *w_gate = p.in[21], *w_up = p.in[22], *w_down = p.in[23],
                *g_ln3 = p.in[24], *b_ln3 = p.in[25];
    float* out = p.out;
    bf16* xb = (bf16*)(ws + WS_DD); bf16* ycat = (bf16*)(ws + WS_A); bf16* Hs = (bf16*)(ws + WS_A);
    bf16* hglu = (bf16*)(ws + WS_B); bf16* qkv = (bf16*)(ws + WS_B + (size_t)T * 512 * 2); bf16* x1b = (bf16*)(ws + WS_B); bf16* Pb2 = (bf16*)(ws + WS_A); bf16* x2b = (bf16*)(ws + WS_B);
    float* Sbuf = (float*)(ws + WS_DD); bf16* Xs = (bf16*)(ws + WS_DD);
    bf16* kvm = (bf16*)(ws + WS_KVM); bf16* memb = (bf16*)(ws + WS_MEMB); bf16* MT = (bf16*)(ws + WS_MT); bf16* NT = (bf16*)(ws + WS_NT);
    float* csS = (float*)(ws + WS_CSS); float* bwS = csS + 2048; float* csp = (float*)(ws + WS_CSP);
    bf16* Wt_in = (bf16*)(ws + WS_WIN); bf16* Wt_out = (bf16*)(ws + WS_WOUT); bf16* Wqb = (bf16*)(ws + WS_WMQ); bf16* Wt_mkv = (bf16*)(ws + WS_WMKV); bf16* Wt_mo = (bf16*)(ws + WS_WMO);
    bf16* Wt_gu = (bf16*)(ws + WS_WGU); bf16* Wt_dn = (bf16*)(ws + WS_WDN);
    PG8_LAS unsigned char* ldsp = (PG8_LAS unsigned char*)lds_raw;
    float* stats1 = (float*)(ws + WS_ST1); float* cs1 = (float*)(ws + WS_CS1); float* bw1 = cs1 + 1024;
    int* route_e = (int*)(ws + WS_ROUTE); float* route_g = (float*)(ws + WS_ROUTE + (size_t)T * 8);
    int* blkcnt = (int*)(ws + WS_BLKCNT); int* segw = (int*)(ws + WS_SEG); int* rank = (int*)(ws + WS_RANK);
    int* pair_tok = (int*)(ws + WS_PTOK); float* pair_gate = (float*)(ws + WS_PGATE); int* tokpos = (int*)(ws + WS_TOKPOS); bf16* Yb = (bf16*)(ws + WS_DD); bf16* z2b = (bf16*)(ws + WS_DD);

    const int lo = p.ph_lo, hi = p.ph_hi;
    int ph = 0;
    unsigned long long tprev = (PROBE_T >= 0) ? __builtin_amdgcn_s_memrealtime() : 0ull, tprobe = 0ull, tmark = 0ull; (void)tmark;
    volatile __attribute__((address_space(3))) unsigned* bst = (volatile __attribute__((address_space(3))) unsigned*)(ldsp + LDS_BYTES_K - 64);
    if (threadIdx.x == 0) { bst[0] = 0u; bst[1] = 0u; }
    __syncthreads();
    const XcdBarrier xbar = xcd_barrier_post((unsigned*)(ws + WS_CTL), bst);
    if (lo > hi) grid.sync();
#define PM(k) do { if (PROBE_T == 100 + (k)) tmark = __builtin_amdgcn_s_memrealtime(); } while (0)
#define PME(k) do { if (PROBE_T == 100 + (k)) tprobe += __builtin_amdgcn_s_memrealtime() - tmark; } while (0)
#define PHASE_BEGIN if (lo <= ph && ph < hi) { for (int rep_ = 0; rep_ < ((((unsigned)PROBE_MASK >> ph) & 1u) ? 2 : 1); ++rep_) { const int tid = wid_s * 64 + lane_fresh(); const int lane = tid & 63, wave = tid >> 6, gw = bid * 8 + wave; (void)lane; (void)wave; (void)gw;
#define PHASE_END } } if (lo <= ph && ph + 1 < hi) xcd_barrier(xbar, wid_s * 64 + lane_fresh()); if (PROBE_T >= 0) { const unsigned long long tn_ = __builtin_amdgcn_s_memrealtime(); if (ph == PROBE_T) tprobe = tn_ - tprev; tprev = tn_; } ++ph;

    PHASE_BEGIN
    {
        const size_t n4 = (size_t)T * D / 4, stride = (size_t)G * 512;
        for (size_t i0 = (size_t)bid * 512 + tid; i0 < n4; i0 += 8 * stride) { f32x4 v[8];
#pragma unroll
            for (int q = 0; q < 8; ++q) { const size_t i = i0 + q * stride; v[q] = (i < n4) ? __builtin_nontemporal_load((const f32x4*)x + i) : (f32x4){0.f, 0.f, 0.f, 0.f}; }
#pragma unroll
            for (int q = 0; q < 8; ++q) { const size_t i = i0 + q * stride; if (i < n4) { u32x2 w; w.x = pk2(v[q].x, v[q].y); w.y = pk2(v[q].z, v[q].w); ((u32x2*)xb)[i] = w; } } } }
    for (size_t i = (size_t)bid * 512 + tid; i < (size_t)NMEM * D / 4; i += (size_t)G * 512) { const f32x4 v = ((const f32x4*)mem)[i]; u32x2 w; w.x = pk2(v.x, v.y); w.y = pk2(v.z, v.w); ((u32x2*)memb)[i] = w; }
    {
        LAS float* scr = (LAS float*)(ldsp + wave * 16384);
        constexpr int I_IN = 16 * 56, I_KV = 16 * 64;
        for (int it = gw; it < I_IN + I_KV; it += NGW) { int r = it;
            if (r < I_IN) { const int kb = r / 56, nb = r % 56, n0 = nb * 32; const int dr = n0 < 512 ? (n0 >> 7) * 256 + (n0 & 127) : (n0 < 1024 ? ((n0 - 512) >> 7) * 256 + 128 + (n0 & 127) : n0);
                transpose_item(w_in, D_IN, Wt_in, 1024, kb * 64, n0, dr, scr, lane); continue; } r -= I_IN;
            transpose_item(w_mkv, 2048, Wt_mkv, 1024, (r / 64) * 64, (r % 64) * 32, (r % 64) * 32, scr, lane); }
    }
    PHASE_END

    PHASE_BEGIN
    for (int pass = 0; pass < 2; ++pass) {
      if ((pass == 0) == ((bid & 1) == 0)) {
        const int tl = wid_s * 64 + lane_fresh(), ll = tl & 63, wl = tl >> 6;
        LAS float* scr = (LAS float*)(ldsp + wl * 16384);
        constexpr int I_SQ = 16 * 32, I_EX = 16 * 256, N_T = 2 * I_SQ + 3 * I_EX, N_Q = 1024, N_B = 256, N_ALL = N_T + N_Q + N_B;
        int nb2 = 464 - G; nb2 = nb2 < 0 ? 0 : (nb2 > G ? G : nb2);
        const int NVB = nb2 + (G - nb2) * 3, nmine = (bid < nb2) ? 1 : 3, vb0 = (bid < nb2) ? bid : nb2 + (bid - nb2) * 3;
        auto decode = [&](int r, TItem& t) {
            if (r < I_SQ) { t = TItem{w_out, Wt_out, nullptr, 1024, 1024, (r / 32) * 64, (r % 32) * 32, (r % 32) * 32}; return; } r -= I_SQ;
            if (r < I_SQ) { t = TItem{w_mo, Wt_mo, nullptr, 1024, 1024, (r / 32) * 64, (r % 32) * 32, (r % 32) * 32}; return; } r -= I_SQ;
            if (r < I_EX) { const int e = r / 256, q = r % 256, n0 = (q % 16) * 32; t = TItem{w_gate + (size_t)e * D * DE, Wt_gu + (size_t)e * 1024 * 1024, nullptr, DE, 1024, (q / 16) * 64, n0, (n0 >> 7) * 256 + (n0 & 127)}; return; } r -= I_EX;
            if (r < I_EX) { const int e = r / 256, q = r % 256, n0 = (q % 16) * 32; t = TItem{w_up + (size_t)e * D * DE, Wt_gu + (size_t)e * 1024 * 1024, nullptr, DE, 1024, (q / 16) * 64, n0, (n0 >> 7) * 256 + 128 + (n0 & 127)}; return; } r -= I_EX;
            { const int e = r / 256, q = r % 256; t = TItem{w_down + (size_t)e * DE * D, Wt_dn + (size_t)e * 1024 * 512, nullptr, D, 512, (q / 32) * 64, (q % 32) * 32, (q % 32) * 32}; } };
        for (int vk = 0; vk < nmine; ++vk) {
          int it = (vb0 + vk) * 8 + wl;
          for (; it + NVB * 8 < N_T; it += 2 * NVB * 8) {
              TItem ta, tb; decode(it, ta); decode(it + NVB * 8, tb); float wa[32], wb[32];
              titem_load(ta, wa, ll); titem_load(tb, wb, ll); titem_store(ta, wa, scr, ll); titem_store(tb, wb, scr, ll); }
          for (; it < N_ALL; it += NVB * 8) { int r = it;
            if (r < N_T) { TItem ta; decode(r, ta); float wa[32]; titem_load(ta, wa, ll); titem_store(ta, wa, scr, ll); continue; } r -= N_T;
            if (r < N_Q) {
                f32x4 v[4];
#pragma unroll
                for (int q = 0; q < 4; ++q) v[q] = ((const f32x4*)w_mq)[(size_t)r * 256 + ll + 64 * q];
                const float gk = g_ln1[r];
#pragma unroll
                for (int q = 0; q < 4; ++q) { const f32x4 t = v[q] * gk; u32x2 w; w.x = pk2(t.x, t.y); w.y = pk2(t.z, t.w); ((u32x2*)Wqb)[(size_t)r * 256 + ll + 64 * q] = w; }
                continue; } r -= N_Q;
            {
                f32x4 b4 = (f32x4){0.f, 0.f, 0.f, 0.f};
#pragma unroll 4
                for (int i2 = 0; i2 < 16; ++i2) { const int k = ll + 64 * i2; const f32x4 w = *(const f32x4*)(w_mq + (size_t)k * 1024 + 4 * r); b4 += w * b_ln1[k]; }
#pragma unroll
                for (int e = 0; e < 4; ++e) b4[e] = wave_sum(b4[e]);
                if (ll == 0) *(f32x4*)(bw1 + 4 * r) = b4; }
          }
        }
        __syncthreads();
      } else {
        struct SchedP1 { const char *xb, *win, *memb, *wkv; int G, c;
            __device__ __forceinline__ bool next(int i, pg8::Unit& u) const { const int L = i * G + c; u.aux = 0;
                if (L < 448) { pg8::tile_of(L, 64, 7, u.pm, u.pn); u.A = xb + (size_t)u.pm * 256 * 2048; u.B = win + (size_t)u.pn * 256 * 2048; u.kind = u.pn < 4 ? 0 : 1; return true; }
                if (L < 464) { const int r = L - 448; u.pm = r >> 3; u.pn = r & 7; u.A = memb + (size_t)u.pm * 256 * 2048; u.B = wkv + (size_t)u.pn * 256 * 2048; u.kind = 2; return true; }
                return false; } };
        const SchedP1 S{(const char*)xb, (const char*)Wt_in, (const char*)memb, (const char*)Wt_mkv, G, bid};
        const pg8::EpiP1 E{hglu, qkv, kvm, b_in};
        pg8::gemm_phase(wid_s * 64 + lane_fresh(), ldsp, pg8::Gemm{1024, 1024, 1024}, S, E);
      }
    }
    PHASE_END

    PHASE_BEGIN
    PM(0);
    {   constexpr int NCU = T / 32, NSU = BATCH * NKV * (SEQ / 128);
        u32x4 pre[8], kk[4], vq[4]; ConvW cw; conv_weights(w_dw, b_dw, g_cn, b_cn, tid, cw);
        if (bid < NCU) conv_load(hglu, bid, tid, pre);
        for (int cu = bid; cu < NCU; cu += G) {
            conv_stage(lds_raw, tid, pre); __syncthreads();
            if (cu + G < NCU) conv_load(hglu, cu + G, tid, pre);
            const bool lastc = !(cu + G < NCU);
            conv_unit(lds_raw, cw, ycat, cu, tid, [&]() { if (lastc && bid < NSU) swa_load(qkv, bid >> 7, (bid >> 6) & 1, bid & 63, tid, kk, vq); });
        }
        PME(0); PM(1);
        if (bid >= NCU && bid < NSU) swa_load(qkv, bid >> 7, (bid >> 6) & 1, bid & 63, tid, kk, vq);
        for (int u = bid; u < NSU; u += G) {
            swa_unit(lds_raw, qkv, sinks, ycat, u >> 7, (u >> 6) & 1, u & 63, tid, kk, vq, tprobe);
            if (u + G < NSU) swa_load(qkv, (u + G) >> 7, ((u + G) >> 6) & 1, (u + G) & 63, tid, kk, vq);
        }
    }
    PME(1);
    PM(2);
    {
        struct SchedMT { const char *kvm, *wq; int c;
            __device__ __forceinline__ bool next(int i, pg8::Unit& u) const { if (i > 0 || c < 0 || c >= 32) return false; const int b = c >> 4, h = (c >> 2) & 3, pn = c & 3; u.pm = h; u.pn = pn; u.aux = b; u.kind = 0;
                u.A = kvm + ((size_t)(b * 256) * 2048 + h * 256) * 2; u.B = wq + ((size_t)(pn * 256) * 1024 + h * 256) * 2; return true; } };
        struct SchedNT { const char *wo, *kvm; int c;
            __device__ __forceinline__ bool next(int i, pg8::Unit& u) const { if (i > 0 || c < 0 || c >= 32) return false; const int b = c >> 4, h = (c >> 2) & 3, pm = c & 3; u.pm = pm; u.pn = h; u.aux = b; u.kind = 0;
                u.A = wo + ((size_t)(pm * 256) * 1024 + h * 256) * 2; u.B = kvm + ((size_t)(b * 256) * 2048 + 1024 + h * 256) * 2; return true; } };
        const SchedMT S1{(const char*)kvm, (const char*)Wqb, bid}; const pg8::EpiPre E1{MT, csp};
        pg8::gemm_phase(wid_s * 64 + lane_fresh(), ldsp, pg8::Gemm{2048, 1024, 256}, S1, E1);
        const SchedNT S2{(const char*)Wt_mo, (const char*)kvm, bid - 32}; const pg8::EpiPre E2{NT, nullptr};
        pg8::gemm_phase(wid_s * 64 + lane_fresh(), ldsp, pg8::Gemm{1024, 2048, 256}, S2, E2);
    }
    PME(2);
    PHASE_END

    PHASE_BEGIN
    for (int r = gw; r < 2048; r += NGW) { const int b = r >> 10, hk = r & 1023, h = hk >> 8, key = hk & 255;
        const float c = wave_sum(lane < 16 ? csp[(size_t)r * 16 + lane] : 0.f);
        const u32x2 kk = *(const u32x2*)(kvm + (size_t)(b * 256 + key) * 2048 + h * 256 + 4 * lane); const f32x4 bq = *(const f32x4*)(bw1 + h * 256 + 4 * lane);
        const float w = wave_sum((bflo(kk.x) * bq[0] + bfhi(kk.x) * bq[1]) + (bflo(kk.y) * bq[2] + bfhi(kk.y) * bq[3]));
        if (lane == 0) { csS[r] = c; bwS[r] = w; } }
    { const pg8::DenseSched S{(const char*)ycat, (const char*)Wt_out, 64, 4, G, bid, (size_t)256 * 2048, (size_t)256 * 2048};
      const pg8::EpiResStats E{xb, x1b, stats1, ALPHA}; PM(7); pg8::gemm_phase(tid, ldsp, pg8::Gemm{1024, 1024, 1024}, S, E); PME(7); }
    PHASE_END
    PHASE_BEGIN
    {   struct SchedS { const char *z, *mt; int G, c;
            __device__ __forceinline__ bool next(int i, pg8::Unit& u) const { const int L = i * G + c; if (L >= 256) return false; pg8::tile_of(L, 64, 4, u.pm, u.pn); u.kind = 0; u.aux = u.pm >> 5;
                u.A = z + (size_t)u.pm * 256 * 2048; u.B = mt + ((size_t)u.aux * 1024 * 1024 + (size_t)u.pn * 256 * 1024) * 2; return true; } };
        const SchedS S{(const char*)x1b, (const char*)MT, G, bid};
        const pg8::EpiSoftmaxLn E{Pb2, (PG8_LAS float*)(ldsp + 131072), stats1, csS, bwS};
        PM(8); pg8::gemm_phase(tid, ldsp, pg8::Gemm{1024, 1024, 1024}, S, E); PME(8);
    }
    PHASE_END
    PHASE_BEGIN
    {   struct SchedN { const char *P, *nt; int G, c;
            __device__ __forceinline__ bool next(int i, pg8::Unit& u) const { const int L = i * G + c; if (L >= 256) return false; pg8::tile_of(L, 64, 4, u.pm, u.pn); u.kind = 0; u.aux = u.pm >> 5;
                u.A = P + (size_t)u.pm * 256 * 2048; u.B = nt + ((size_t)u.aux * 1024 * 1024 + (size_t)u.pn * 256 * 1024) * 2; return true; } };
        const SchedN S{(const char*)Pb2, (const char*)NT, G, bid};
        const pg8::EpiResLn E{z2b, x1b, stats1, g_ln1, b_ln1, ALPHA}; pg8::gemm_phase(tid, ldsp, pg8::Gemm{1024, 1024, 1024}, S, E);
    }
    PHASE_END
    const int TPB = (T + G - 1) / G;
    PHASE_BEGIN
    { const int t0 = bid * TPB, t1 = (t0 + TPB < T) ? t0 + TPB : T;
      float* Wl = ldsf;
      int* le = (int*)(lds_raw + 81920);
      for (int k = tid; k < D; k += 512) { const f32x4 wg = *(const f32x4*)(w_group + (size_t)k * 4);
          Wl[0 * D + k] = wg.x; Wl[1 * D + k] = wg.y; Wl[2 * D + k] = wg.z; Wl[3 * D + k] = wg.w;
#pragma unroll
          for (int gq = 0; gq < 4; ++gq) { const f32x4 wr = *(const f32x4*)(w_router + ((size_t)gq * D + k) * 4);
              Wl[(4 + gq * 4 + 0) * D + k] = wr.x; Wl[(4 + gq * 4 + 1) * D + k] = wr.y; Wl[(4 + gq * 4 + 2) * D + k] = wr.z; Wl[(4 + gq * 4 + 3) * D + k] = wr.w; } }
      __syncthreads();
      PM(4);
      const int TPW = (TPB + 7) / 8;
      const int mend = (t0 + (wave + 1) * TPW < t1) ? t0 + (wave + 1) * TPW : t1;
      float bgr[4], brt[16];
#pragma unroll
      for (int i = 0; i < 4; ++i) bgr[i] = b_group[i];
#pragma unroll
      for (int i = 0; i < 16; ++i) brt[i] = b_router[i];
      f32x4 raw[2][4];
      { const int mb0 = t0 + wave * TPW; if (mb0 < mend) { ld_row_bf16(z2b + (size_t)mb0 * D, raw[0], lane); ld_row_bf16(z2b + (size_t)((mb0 + 1 < mend) ? mb0 + 1 : mb0) * D, raw[1], lane); } }
      for (int mb = t0 + wave * TPW; mb < mend; mb += 2) {
        f32x4 v[2][4];
        const bool has1 = (mb + 1 < mend);
#pragma unroll
        for (int jj = 0; jj < 4; ++jj) { v[0][jj] = raw[0][jj]; v[1][jj] = raw[1][jj]; }
        if (mb + 2 < mend) { ld_row_bf16(z2b + (size_t)(mb + 2) * D, raw[0], lane); ld_row_bf16(z2b + (size_t)((mb + 3 < mend) ? mb + 3 : mb + 2) * D, raw[1], lane); }
        ln_regs(v[0], g_ln2, b_ln2, lane);
        st_row_bf16(x2b + (size_t)mb * D, v[0], lane);
        ln_regs(v[1], g_ln2, b_ln2, lane);
        if (has1) st_row_bf16(x2b + (size_t)(mb + 1) * D, v[1], lane);
        float pa[20], pb[20];
#pragma unroll
        for (int c = 0; c < 20; ++c) {
            typedef float f32x2 __attribute__((ext_vector_type(2)));
            f32x2 p0 = (f32x2){0.f, 0.f}, p1 = p0;
#pragma unroll
            for (int jj = 0; jj < 4; ++jj) { const f32x4 w4 = ((const f32x4*)(Wl + c * D))[lane + 64 * jj]; const f32x2 wl2 = (f32x2){w4.x, w4.y}, wh2 = (f32x2){w4.z, w4.w};
                p0 = __builtin_elementwise_fma((f32x2){v[0][jj].x, v[0][jj].y}, wl2, p0); p0 = __builtin_elementwise_fma((f32x2){v[0][jj].z, v[0][jj].w}, wh2, p0);
                p1 = __builtin_elementwise_fma((f32x2){v[1][jj].x, v[1][jj].y}, wl2, p1); p1 = __builtin_elementwise_fma((f32x2){v[1][jj].z, v[1][jj].w}, wh2, p1); }
            pa[c] = p0.x + p0.y; pb[c] = p1.x + p1.y;
        }
        float* red = (float*)(lds_raw + 98304) + wave * 64;
        red[lane] = reduce40(pa, pb, lane);
        asm volatile("s_waitcnt lgkmcnt(0)" ::: "memory");
        float my[20];
#pragma unroll
        for (int c = 0; c < 20; ++c) { constexpr int mm[5] = {0, 1, 2, 4, 5}; my[c] = red[32 * (lane & 1) + 16 * (c / 10) + 8 * ((c % 10) / 5) + mm[c % 5]]; }
        asm volatile("s_waitcnt lgkmcnt(0)" ::: "memory");
        const int m = mb + lane;
        if (lane < 2 && m < mend) {
            float gl[4]; int gi = 0; float gmx = -INFINITY;
#pragma unroll
            for (int i = 0; i < 4; ++i) { gl[i] = my[i] + bgr[i]; if (gl[i] > gmx) { gmx = gl[i]; gi = i; } }
            float gs = 0.f;
#pragma unroll
            for (int i = 0; i < 4; ++i) gs += __expf(gl[i] - gmx);
            const float gp = 1.f / gs;
            float el[4];
#pragma unroll
            for (int i = 0; i < 4; ++i) { float a = my[4 + i], bq = brt[i];
                a = (gi == 1) ? my[8 + i] : a; a = (gi == 2) ? my[12 + i] : a; a = (gi == 3) ? my[16 + i] : a;
                bq = (gi == 1) ? brt[4 + i] : bq; bq = (gi == 2) ? brt[8 + i] : bq; bq = (gi == 3) ? brt[12 + i] : bq;
                el[i] = a + bq; }
            int i0 = 0; float v0 = el[0];
#pragma unroll
            for (int i = 1; i < 4; ++i) if (el[i] > v0) { v0 = el[i]; i0 = i; }
            int i1 = -1; float v1 = -INFINITY;
#pragma unroll
            for (int i = 0; i < 4; ++i) if (i != i0 && el[i] > v1) { v1 = el[i]; i1 = i; }
            const float w0 = 1.f / (1.f + __expf(v1 - v0)), w1 = 1.f - w0;
            route_e[2 * m] = gi * 4 + i0; route_e[2 * m + 1] = gi * 4 + i1; route_g[2 * m] = gp * w0; route_g[2 * m + 1] = gp * w1;
            le[2 * (m - t0)] = gi * 4 + i0; le[2 * (m - t0) + 1] = gi * 4 + i1;
        }
      }
      __syncthreads();
      PME(4); PM(5);
      const int np = 2 * (t1 - t0);
      for (int i = tid; i < np; i += 512) { const int e = le[i]; int r = 0; for (int j2 = 0; j2 < i; ++j2) r += (le[j2] == e) ? 1 : 0; rank[2 * t0 + i] = r; }
      if (tid < 16) { int c = 0; for (int j2 = 0; j2 < np; ++j2) c += (le[j2] == tid) ? 1 : 0; blkcnt[bid * 16 + tid] = c; }
      PME(5);
    }
    PHASE_END
    PHASE_BEGIN
    {
        int* sh = (int*)lds_raw;
        const int t0 = bid * TPB, t1 = (t0 + TPB < T) ? t0 + TPB : T, np = 2 * (t1 - t0);
        int my_e = 0, my_r = 0; float my_g = 0.f;
        if (tid < np) { const int pi = 2 * t0 + tid; my_e = route_e[pi]; my_r = rank[pi]; my_g = route_g[pi]; }
        { const int e = tid & 15, part = tid >> 4; int tot = 0, base = 0; int cv[8];
#pragma unroll
          for (int q = 0; q < 8; ++q) { const int b = part + 32 * q; cv[q] = (b < G) ? blkcnt[b * 16 + e] : 0; }
#pragma unroll
          for (int q = 0; q < 8; ++q) { const int b = part + 32 * q; tot += cv[q]; if (b < bid) base += cv[q]; }
          for (int b = part + 256; b < G; b += 32) { const int c = blkcnt[b * 16 + e]; tot += c; if (b < bid) base += c; }
          sh[128 + part * 16 + e] = tot; sh[640 + part * 16 + e] = base; }
        __syncthreads();
        if (tid < 16) { int tot = 0, base = 0;
#pragma unroll 8
            for (int part = 0; part < 32; ++part) { tot += sh[128 + part * 16 + tid]; base += sh[640 + part * 16 + tid]; } sh[tid] = base; sh[64 + tid] = tot; }
        __syncthreads();
        if (tid == 0) { int sacc = 0, nF = 0, nH = 0;
            for (int e = 0; e < 16; ++e) { const int n = sh[64 + e], nf = n >> 8, nh = ((n & 255) + 127) >> 7; sh[16 + e] = sacc; sacc += nf * 256 + nh * 128; nF += nf; nH += nh; }
            sh[32] = sacc;
            if (bid == 0) { segw[0] = nF; segw[1] = nH; int tf = 0, th = nF;
                for (int e = 0; e < 16; ++e) { const int n = sh[64 + e], nf = n >> 8, nh = ((n & 255) + 127) >> 7;
                    for (int k = 0; k < nf; ++k) { segw[2 + tf] = sh[16 + e] + 256 * k; segw[2 + 192 + tf] = e; ++tf; }
                    for (int k = 0; k < nh; ++k) { segw[2 + th] = sh[16 + e] + 256 * nf + 128 * k; segw[2 + 192 + th] = e; ++th; } } } }
        __syncthreads();
        if (bid == 0) { for (int e = 0; e < 16; ++e) for (int pos = sh[16 + e] + sh[64 + e] + tid; pos < sh[16 + e + 1]; pos += 512) { pair_tok[pos] = -1; pair_gate[pos] = 0.f; } }
        if (tid < np) { const int pi = 2 * t0 + tid, pos = sh[16 + my_e] + sh[my_e] + my_r; pair_tok[pos] = pi >> 1; pair_gate[pos] = my_g; tokpos[pi] = pos; }
    }
    PHASE_END
    PHASE_BEGIN
    { const SchedMoE S{(const char*)x2b, (const char*)Wt_gu, segw, pair_tok, segw[0], segw[1], G, bid, (size_t)2048, (size_t)1024 * 2048, (size_t)256 * 2048};
      const pg8::EpiGateUp E{Hs, pair_gate}; PM(6); pg8::gemm_phase<true, true>(tid, ldsp, pg8::Gemm{1024, 1024, 1024}, S, E); PME(6); }
    PHASE_END
    PHASE_BEGIN
    { const SchedMoE S{(const char*)Hs, (const char*)Wt_dn, segw, nullptr, segw[0], segw[1], G, bid, (size_t)1024, (size_t)1024 * 1024, (size_t)256 * 1024};
      const pg8::EpiY E{Yb}; PM(9); pg8::gemm_phase<false, true>(tid, ldsp, pg8::Gemm{512, 512, 512}, S, E); PME(9); }
    PHASE_END
    PHASE_BEGIN
    for (int mbase = gw; mbase < T; mbase += 8 * NGW) {
        int tp = 0;
        if (lane < 16) { const int mm = mbase + (lane >> 1) * NGW; if (mm < T) tp = tokpos[2 * mm + (lane & 1)]; }
        u32x2 xa[4], ya[4], yb[4];
#define P9_LOAD(mm, ii) do { const int p0_ = __builtin_amdgcn_readlane(tp, 2 * (ii)), p1_ = __builtin_amdgcn_readlane(tp, 2 * (ii) + 1); \
        _Pragma("unroll") for (int jj = 0; jj < 4; ++jj) { xa[jj] = ((const u32x2*)(x2b + (size_t)(mm) * D))[lane + 64 * jj]; ya[jj] = ((const u32x2*)(Yb + (size_t)p0_ * D))[lane + 64 * jj]; yb[jj] = ((const u32x2*)(Yb + (size_t)p1_ * D))[lane + 64 * jj]; } } while (0)
        P9_LOAD(mbase, 0);
        for (int i = 0; i < 8; ++i) { const int m = mbase + i * NGW; if (m >= T) break;
            f32x4 v[4]; float sacc = 0.f;
#pragma unroll
            for (int jj = 0; jj < 4; ++jj) { f32x4 z;
                z.x = bflo(xa[jj].x) * ALPHA + (bflo(ya[jj].x) + bflo(yb[jj].x)); z.y = bfhi(xa[jj].x) * ALPHA + (bfhi(ya[jj].x) + bfhi(yb[jj].x));
                z.z = bflo(xa[jj].y) * ALPHA + (bflo(ya[jj].y) + bflo(yb[jj].y)); z.w = bfhi(xa[jj].y) * ALPHA + (bfhi(ya[jj].y) + bfhi(yb[jj].y)); v[jj] = z; sacc += (z.x + z.y) + (z.z + z.w); }
            if (i + 1 < 8 && m + NGW < T) P9_LOAD(m + NGW, i + 1);
            const float mean = wave_sum(sacc) * (1.f / D); float s2 = 0.f;
#pragma unroll
            for (int jj = 0; jj < 4; ++jj) { v[jj] = v[jj] - mean; s2 += (v[jj].x * v[jj].x + v[jj].y * v[jj].y) + (v[jj].z * v[jj].z + v[jj].w * v[jj].w); }
            const float rstd = 1.f / sqrtf(wave_sum(s2) * (1.f / D) + LN_EPS);
            float* row = out + (size_t)m * D;
#pragma unroll
            for (int jj = 0; jj < 4; ++jj) { const f32x4 gg = ((const f32x4*)g_ln3)[lane + 64 * jj], bb = ((const f32x4*)b_ln3)[lane + 64 * jj]; ((f32x4*)row)[lane + 64 * jj] = v[jj] * rstd * gg + bb; } }
#undef P9_LOAD
    }
    PHASE_END
    if (PROBE_T >= 0 && blockIdx.x == 0) { const unsigned long long tend = __builtin_amdgcn_s_memrealtime() + 9ull * tprobe; while (__builtin_amdgcn_s_memrealtime() < tend) __builtin_amdgcn_s_sleep(8); }
}

constexpr int N_PHASES = 11;
constexpr int LDS_BYTES = 147456;

extern "C" void kernel_launch(void* const* d_in, const int* in_sizes, int n_in, void* d_out, int out_size, void* d_ws, size_t ws_size, hipStream_t stream) {
    static int grid = 0;
    if (grid == 0) {
        int dev = 0, cus = 0, per_cu = 0;
        hipGetDevice(&dev);
        hipDeviceGetAttribute(&cus, hipDeviceAttributeMultiprocessorCount, dev);
        hipFuncSetAttribute((const void*)fwd_kernel, hipFuncAttributeMaxDynamicSharedMemorySize, LDS_BYTES);
        hipOccupancyMaxActiveBlocksPerMultiprocessor(&per_cu, (const void*)fwd_kernel, 512, LDS_BYTES);
        if (per_cu < 1) { fprintf(stderr, "occupancy query returned %d\n", per_cu); per_cu = 1; }
        grid = cus * 1;
        if (ws_size < WS_END) { fprintf(stderr, "workspace too small\n"); grid = -1; }
    }
    if (grid < 0) return;
    if (hipMemsetAsync((char*)d_ws + WS_CTL, 0, 65536, stream) != hipSuccess) { fprintf(stderr, "memset failed\n"); return; }
    Params p{};
    for (int i = 0; i < 26; ++i) p.in[i] = (const float*)d_in[i];
    p.out = (float*)d_out; p.ws = (unsigned char*)d_ws;
#if MK_N_LAUNCHES == 1
    p.ph_lo = 0; p.ph_hi = 64;
    void* args[] = {&p};
    hipError_t e = hipLaunchCooperativeKernel((const void*)fwd_kernel, dim3(grid), dim3(512), args, LDS_BYTES, stream);
    if (e != hipSuccess) fprintf(stderr, "cooperative launch failed: %s (grid %d)\n", hipGetErrorString(e), grid);
#else
    for (int ph = 0; ph < N_PHASES; ++ph) { p.ph_lo = ph; p.ph_hi = ph + 1; hipLaunchKernelGGL(fwd_kernel, dim3(grid), dim3(512), LDS_BYTES, stream, p); }
#endif
}
```

```cpp
#include <hip/hip_runtime.h>
#include <hip/hip_cooperative_groups.h>
#include <cstdio>
#include <cstdint>
namespace cg = cooperative_groups;

#ifndef PROBE_MASK
#define PROBE_MASK 0
#endif
#ifndef PROBE_T
#define PROBE_T -1
#endif
#ifndef MK_N_LAUNCHES
#define MK_N_LAUNCHES 1
#endif

typedef unsigned short bf16;
typedef float f32x4 __attribute__((ext_vector_type(4)));
typedef unsigned u32x4 __attribute__((ext_vector_type(4)));
typedef unsigned u32x2 __attribute__((ext_vector_type(2)));

constexpr int BATCH = 2, SEQ = 8192, D = 1024, T = BATCH * SEQ, MEM = 256, NMEM = BATCH * MEM;
constexpr int CONV_CH = 512, CONV_W = 31, NH = 8, NKV = 2, HD = 64, ATTN_W = 512, KV_W = 128, WINDOW = 128;
constexpr int D_IN = 1792, MH = 4, MHD = 256, NG = 4, EPG = 4, NE = 16, DE = 512;
constexpr float ALPHA = 1.189207115002721f, LN_EPS = 1e-5f;
constexpr int NPAIR = 2 * T, NPAIR_PAD = NPAIR + NE * 256;
constexpr int LDS_BYTES_K = 147456;

constexpr size_t MiB = 1u << 20;
constexpr size_t WS_CTL = 0;
constexpr size_t WS_ROUTE = 1 * MiB;
constexpr size_t WS_BLKCNT = 1 * MiB + 512 * 1024;
constexpr size_t WS_SEG = 1 * MiB + 640 * 1024;
constexpr size_t WS_RANK = 2 * MiB;
constexpr size_t WS_PTOK = 2 * MiB + 256 * 1024;
constexpr size_t WS_PGATE = 2 * MiB + 512 * 1024;
constexpr size_t WS_TOKPOS = 2 * MiB + 768 * 1024;
constexpr size_t WS_KVM = 3 * MiB;
constexpr size_t WS_MEMB = 5 * MiB;
constexpr size_t WS_A = 8 * MiB;
constexpr size_t WS_B = 48 * MiB;
constexpr size_t WS_DD = 88 * MiB;
constexpr size_t WS_WIN = 164 * MiB;
constexpr size_t WS_WOUT = 168 * MiB, WS_WMQ = 170 * MiB, WS_WMKV = 172 * MiB, WS_WMO = 176 * MiB;
constexpr size_t WS_WGU = 178 * MiB;
constexpr size_t WS_WDN = 210 * MiB;
constexpr size_t WS_ST1 = 226 * MiB;
constexpr size_t WS_CS1 = 128 * 1024;
constexpr size_t WS_MT = 228 * MiB;
constexpr size_t WS_NT = 232 * MiB;
constexpr size_t WS_CSS = 192 * 1024;
constexpr size_t WS_CSP = 256 * 1024;
constexpr size_t WS_END = 236 * MiB;

struct Params { const float* in[26]; float* out; unsigned char* ws; int ph_lo, ph_hi; };

__device__ __forceinline__ unsigned f2bf(float f) { unsigned u = __builtin_bit_cast(unsigned, f); return (u + 0x7fffu + ((u >> 16) & 1u)) >> 16; }
__device__ __forceinline__ float bf2f(bf16 b) { return __builtin_bit_cast(float, (unsigned)b << 16); }
__device__ __forceinline__ unsigned pk2(float lo, float hi) { return f2bf(lo) | (f2bf(hi) << 16); }
template <int CTRL, int ROWMASK> __device__ __forceinline__ float dpp_f(float v) { return __builtin_bit_cast(float, __builtin_amdgcn_update_dpp(0, __builtin_bit_cast(int, v), CTRL, ROWMASK, 0xF, false)); }
__device__ __forceinline__ float wave_sum(float v) {
    v += dpp_f<0xB1, 0xF>(v);
    v += dpp_f<0x4E, 0xF>(v);
    v += dpp_f<0x141, 0xF>(v);
    v += dpp_f<0x140, 0xF>(v);
    v += dpp_f<0x142, 0xA>(v);
    v += dpp_f<0x143, 0xC>(v);
    return __builtin_bit_cast(float, __builtin_amdgcn_readlane(__builtin_bit_cast(int, v), 63));
}
__device__ __forceinline__ float wave_max(float v) {
    v = fmaxf(v, __builtin_bit_cast(float, __builtin_amdgcn_update_dpp(__builtin_bit_cast(int, v), __builtin_bit_cast(int, v), 0xB1, 0xF, 0xF, false)));
    v = fmaxf(v, __builtin_bit_cast(float, __builtin_amdgcn_update_dpp(__builtin_bit_cast(int, v), __builtin_bit_cast(int, v), 0x4E, 0xF, 0xF, false)));
    v = fmaxf(v, __builtin_bit_cast(float, __builtin_amdgcn_update_dpp(__builtin_bit_cast(int, v), __builtin_bit_cast(int, v), 0x141, 0xF, 0xF, false)));
    v = fmaxf(v, __builtin_bit_cast(float, __builtin_amdgcn_update_dpp(__builtin_bit_cast(int, v), __builtin_bit_cast(int, v), 0x140, 0xF, 0xF, false)));
    v = fmaxf(v, __builtin_bit_cast(float, __builtin_amdgcn_update_dpp(__builtin_bit_cast(int, v), __builtin_bit_cast(int, v), 0x142, 0xA, 0xF, false)));
    v = fmaxf(v, __builtin_bit_cast(float, __builtin_amdgcn_update_dpp(__builtin_bit_cast(int, v), __builtin_bit_cast(int, v), 0x143, 0xC, 0xF, false)));
    return __builtin_bit_cast(float, __builtin_amdgcn_readlane(__builtin_bit_cast(int, v), 63));
}
__device__ __forceinline__ int lane_fresh() { int l; asm volatile("v_mbcnt_lo_u32_b32 %0, -1, 0\n\tv_mbcnt_hi_u32_b32 %0, -1, %0" : "=v"(l)); return l; }


template <int CTRL> __device__ __forceinline__ float dpp_mov(float v) { return __builtin_bit_cast(float, __builtin_amdgcn_update_dpp(0, __builtin_bit_cast(int, v), CTRL, 0xF, 0xF, false)); }
__device__ __forceinline__ float reduce40(const float (&p0)[20], const float (&p1)[20], int lane) {
    float r5[20];
#pragma unroll
    for (int c = 0; c < 20; ++c) { float a = p0[c], b = p1[c];
        asm volatile("s_nop 1\n\tv_permlane32_swap_b32 %0, %1\n\ts_nop 1" : "+v"(a), "+v"(b));
        r5[c] = a + b; }
    float r4[10];
#pragma unroll
    for (int c = 0; c < 10; ++c) { float a = r5[c], b = r5[c + 10];
        asm volatile("s_nop 1\n\tv_permlane16_swap_b32 %0, %1\n\ts_nop 1" : "+v"(a), "+v"(b));
        r4[c] = a + b; }
    const bool b3 = (lane & 8) != 0, b2 = (lane & 4) != 0, b1 = (lane & 2) != 0, b0 = (lane & 1) != 0;
    float r3[5];
#pragma unroll
    for (int c = 0; c < 5; ++c) { const float a = r4[c] + dpp_mov<0x128>(r4[c]), b = r4[c + 5] + dpp_mov<0x128>(r4[c + 5]); r3[c] = b3 ? b : a; }
    float r2[3];
    { const float a0 = r3[0] + dpp_mov<0x141>(r3[0]), a3 = r3[3] + dpp_mov<0x141>(r3[3]), a1 = r3[1] + dpp_mov<0x141>(r3[1]), a4 = r3[4] + dpp_mov<0x141>(r3[4]);
      r2[0] = b2 ? a3 : a0; r2[1] = b2 ? a4 : a1; r2[2] = r3[2] + dpp_mov<0x141>(r3[2]); }
    float r1[2];
    { const float a0 = r2[0] + dpp_mov<0x4E>(r2[0]), a2 = r2[2] + dpp_mov<0x4E>(r2[2]); r1[0] = b1 ? a2 : a0; r1[1] = r2[1] + dpp_mov<0x4E>(r2[1]); }
    const float a0 = r1[0] + dpp_mov<0xB1>(r1[0]), a1 = r1[1] + dpp_mov<0xB1>(r1[1]);
    return b0 ? a1 : a0;
}

__device__ __forceinline__ void ln_row(const float* src, const float* g, const float* b, f32x4 (&v)[4], int lane) {
    const f32x4* xr = (const f32x4*)src + lane; float s = 0.f;
#pragma unroll
    for (int j = 0; j < 4; ++j) { v[j] = xr[64 * j]; s += (v[j].x + v[j].y) + (v[j].z + v[j].w); }
    const float mean = wave_sum(s) * (1.f / D); float s2 = 0.f;
#pragma unroll
    for (int j = 0; j < 4; ++j) { v[j] = v[j] - mean; s2 += (v[j].x * v[j].x + v[j].y * v[j].y) + (v[j].z * v[j].z + v[j].w * v[j].w); }
    const float rstd = 1.f / sqrtf(wave_sum(s2) * (1.f / D) + LN_EPS);
#pragma unroll
    for (int j = 0; j < 4; ++j) { const f32x4 gg = ((const f32x4*)g)[lane + 64 * j], bb = ((const f32x4*)b)[lane + 64 * j]; v[j] = v[j] * rstd * gg + bb; }
}
__device__ __forceinline__ void ld_row(const float* src, f32x4 (&v)[4], int lane) {
#pragma unroll
    for (int j = 0; j < 4; ++j) v[j] = ((const f32x4*)src)[lane + 64 * j];
}
__device__ __forceinline__ void ld_row_bf16(const bf16* src, f32x4 (&v)[4], int lane) {
#pragma unroll
    for (int j = 0; j < 4; ++j) { const u32x2 q = ((const u32x2*)src)[lane + 64 * j];
        v[j] = (f32x4){__builtin_bit_cast(float, q.x << 16), __builtin_bit_cast(float, q.x & 0xffff0000u), __builtin_bit_cast(float, q.y << 16), __builtin_bit_cast(float, q.y & 0xffff0000u)}; }
}
__device__ __forceinline__ void ln_regs(f32x4 (&v)[4], const float* g, const float* b, int lane) {
    float s = 0.f;
#pragma unroll
    for (int j = 0; j < 4; ++j) s += (v[j].x + v[j].y) + (v[j].z + v[j].w);
    const float mean = wave_sum(s) * (1.f / D); float s2 = 0.f;
#pragma unroll
    for (int j = 0; j < 4; ++j) { v[j] = v[j] - mean; s2 += (v[j].x * v[j].x + v[j].y * v[j].y) + (v[j].z * v[j].z + v[j].w * v[j].w); }
    const float rstd = 1.f / sqrtf(wave_sum(s2) * (1.f / D) + LN_EPS);
#pragma unroll
    for (int j = 0; j < 4; ++j) { const f32x4 gg = ((const f32x4*)g)[lane + 64 * j], bb = ((const f32x4*)b)[lane + 64 * j]; v[j] = v[j] * rstd * gg + bb; }
}
__device__ __forceinline__ void st_row_f32(float* dst, const f32x4 (&v)[4], float scale, int lane) {
#pragma unroll
    for (int j = 0; j < 4; ++j) ((f32x4*)dst)[lane + 64 * j] = v[j] * scale;
}
__device__ __forceinline__ void st_row_bf16(bf16* dst, const f32x4 (&v)[4], int lane) {
#pragma unroll
    for (int j = 0; j < 4; ++j) { u32x2 w; w.x = pk2(v[j].x, v[j].y); w.y = pk2(v[j].z, v[j].w); ((u32x2*)dst)[lane + 64 * j] = w; }
}


namespace pg8 {
#define PG8_LAS __attribute__((address_space(3)))
typedef unsigned short bf16_t;
typedef short bf16x8 __attribute__((ext_vector_type(8)));
constexpr int BM = 256, BK = 64, HALF = 128, HTB = HALF * BK * 2, STAGE_BYTES = 8 * HTB, NXCD = 8, WGM = 8;
__device__ __forceinline__ int lds_byte(int r, int c) { const int st = (r >> 4) * 2 + (c >> 5), rr = r & 15, cc = c & 31, ob = rr * 64 + cc * 2; return st * 1024 + (ob ^ (((ob >> 9) & 1) << 5)); }
__device__ __forceinline__ void stage_rc(int b, int& R, int& C) { const int st = b / 1024, sb = b % 1024, swz = sb ^ (((sb >> 9) & 1) << 5); R = (st >> 1) * 16 + swz / 64; C = (st & 1) * 32 + (swz % 64) / 2; }
__device__ __forceinline__ int perm32(int rho) { const int n = rho >> 4, i = rho & 15; return 8 * (i >> 2) + 4 * n + (i & 3); }
struct Unit { const char* A; const char* B; const int* rows; int pm, pn, kind, aux, rb, half; };
struct Gemm { int lda, ldb, K; };
__device__ __forceinline__ void tile_of(int L, int nM, int nN, int& pm, int& pn) {
    const int nwg = nM * nN; int wgid = L; { const int q = nwg / NXCD, r = nwg % NXCD, xcd = wgid % NXCD, off = wgid / NXCD; wgid = (xcd < r ? xcd * (q + 1) : r * (q + 1) + (xcd - r) * q) + off; }
    const int nig = WGM * nN, gid = wgid / nig, fm = gid * WGM, gsz = (nM - fm) < WGM ? (nM - fm) : WGM;
    pm = fm + ((wgid % nig) % gsz); pn = (wgid % nig) / gsz;
}
__device__ __forceinline__ unsigned cvt_pk_bf16(float lo, float hi) { unsigned r; asm volatile("v_cvt_pk_bf16_f32 %0, %1, %2" : "=v"(r) : "v"(lo), "v"(hi)); return r; }

template <bool GATHER = false, bool HALFU = false, class Epi, class Sched>
__device__ __forceinline__ void gemm_phase(int tid, PG8_LAS unsigned char* lds, const Gemm g, const Sched& S, const Epi& E) {
    const int wid = __builtin_amdgcn_readfirstlane(tid >> 6), lane = tid & 63, wr = wid >> 2, wc = wid & 3, fr = lane & 15, fq = lane >> 4;
    const int K = g.K, nt = K / BK;
    unsigned voffA[2], voffB[2]; int gR[2]; unsigned gC[2];
#pragma unroll
    for (int i = 0; i < 2; ++i) { int R, C; stage_rc(tid * 16 + i * 8192, R, C); const int Rb = Epi::PERM ? ((R & ~31) + perm32(R & 31)) : R;
        voffA[i] = (unsigned)(R * g.lda + C) * 2u; voffB[i] = (unsigned)(Rb * g.ldb + C) * 2u; gR[i] = R; gC[i] = (unsigned)C * 2u; }
    unsigned vgc[2][2], vgn[2][2];
    const size_t kstep = (size_t)(BK * 2);
    const size_t hstepA = (size_t)HALF * g.lda * 2, hstepB = (size_t)HALF * g.ldb * 2;
    const unsigned ldsw = (unsigned)wid * 1024u;
    const int aoff = lds_byte(wr * 64 + fr, fq * 8), boff = lds_byte(wc * 32 + fr, fq * 8);
#define PG8_SA(b, h) (((b) * 2 + (h)) * HTB)
#define PG8_SB(b, h) ((4 + (b) * 2 + (h)) * HTB)
#define PG8_STAGE(bufoff, gbase, voff) do { _Pragma("unroll") for (int _i = 0; _i < 2; ++_i) \
        __builtin_amdgcn_global_load_lds((const unsigned*)((const char*)(gbase) + (voff)[_i]), (PG8_LAS unsigned*)(lds + (bufoff) + ldsw + _i * 8192), 16, 0, 0); } while (0)
#define PG8_GOFF(dst, rows) do { _Pragma("unroll") for (int _h = 0; _h < 2; ++_h) _Pragma("unroll") for (int _i = 0; _i < 2; ++_i) { int _t = (rows)[_h * HALF + gR[_i]]; _t = _t < 0 ? 0 : _t; dst[_h][_i] = (unsigned)_t * (unsigned)(g.lda * 2) + gC[_i]; } } while (0)
#define PG8_STAGE_A(bufoff, h, kptr, useNext) do { if constexpr (GATHER) { unsigned _v[2]; _v[0] = (useNext) ? vgn[h][0] : vgc[h][0]; _v[1] = (useNext) ? vgn[h][1] : vgc[h][1]; PG8_STAGE(bufoff, kptr, _v); } \
        else { PG8_STAGE(bufoff, (kptr) + (h) * hstepA, voffA); } } while (0)
#define PG8_LDA(dst, b, h) do { _Pragma("unroll") for (int m = 0; m < 4; ++m) _Pragma("unroll") for (int k = 0; k < 2; ++k) dst[m][k] = *(const PG8_LAS bf16x8*)(lds + PG8_SA(b, h) + aoff + m * 2048 + k * 1024); } while (0)
#define PG8_LDB(dst, b, h) do { _Pragma("unroll") for (int n = 0; n < 2; ++n) _Pragma("unroll") for (int k = 0; k < 2; ++k) dst[n][k] = *(const PG8_LAS bf16x8*)(lds + PG8_SB(b, h) + boff + n * 2048 + k * 1024); } while (0)
#define PG8_MMA(ai, bj, At, Bt) do { __builtin_amdgcn_s_setprio(1); _Pragma("unroll") for (int m = 0; m < 4; ++m) _Pragma("unroll") for (int n = 0; n < 2; ++n) _Pragma("unroll") for (int k = 0; k < 2; ++k) \
        acc[ai][bj][m][n] = __builtin_amdgcn_mfma_f32_16x16x32_bf16(Bt[n][k], At[m][k], acc[ai][bj][m][n], 0, 0, 0); __builtin_amdgcn_s_setprio(0); } while (0)
#define PG8_WAIT_V(n) asm volatile("s_waitcnt vmcnt(" #n ")" ::: "memory")
#define PG8_WAIT_L(n) asm volatile("s_waitcnt lgkmcnt(" #n ")" ::: "memory")
#define PG8_BAR __builtin_amdgcn_s_barrier()
#define PG8_SCHED __builtin_amdgcn_sched_barrier(0)
    Unit cur, nxt; int ui = 0;
    if (!S.next(0, cur)) return;
    f32x4 acc[2][2][4][2];
#pragma unroll
    for (int a = 0; a < 2; ++a)
#pragma unroll
        for (int b = 0; b < 2; ++b)
#pragma unroll
            for (int m = 0; m < 4; ++m)
#pragma unroll
                for (int n = 0; n < 2; ++n) acc[a][b][m][n] = (f32x4){0.f, 0.f, 0.f, 0.f};
    bf16x8 At[4][2], B0[2][2], B1[2][2];
    const char* cA = cur.A; const char* cB = cur.B;
    if constexpr (GATHER) { PG8_GOFF(vgc, cur.rows); }
    PG8_STAGE(PG8_SB(0, 0), cB, voffB); PG8_STAGE(PG8_SB(0, 1), cB + hstepB, voffB); PG8_STAGE_A(PG8_SA(0, 0), 0, cA, false); PG8_STAGE_A(PG8_SA(0, 1), 1, cA, false);
    if (wr == 1) PG8_BAR;
    PG8_WAIT_V(2); PG8_BAR;
    PG8_STAGE(PG8_SB(1, 0), cB + kstep, voffB); PG8_STAGE_A(PG8_SA(1, 0), 0, cA + kstep, false); PG8_STAGE(PG8_SB(1, 1), cB + hstepB + kstep, voffB);
    PG8_WAIT_V(6); PG8_BAR;
    for (;;) {
        const bool has_next = S.next(ui + 1, nxt);
        const char* nA = has_next ? nxt.A : cA; const char* nB = has_next ? nxt.B : cB;
        if constexpr (GATHER) { if (has_next) { PG8_GOFF(vgn, nxt.rows); asm volatile("" : "+v"(vgn[0][0]), "+v"(vgn[0][1]), "+v"(vgn[1][0]), "+v"(vgn[1][1]));   } else { _Pragma("unroll") for (int _h = 0; _h < 2; ++_h) { vgn[_h][0] = vgc[_h][0]; vgn[_h][1] = vgc[_h][1]; } } }
        for (int t = 0; t < nt; t += 2) {
            const bool last = (t == nt - 2);
            const char* a1 = cA + (size_t)(t + 1) * kstep;
            const char* a2 = last ? nA : cA + (size_t)(t + 2) * kstep; const char* b2 = last ? nB : cB + (size_t)(t + 2) * kstep;
            const char* a3 = a2 + kstep; const char* b3 = b2 + kstep;
            PG8_LDB(B0, 0, 0); PG8_LDB(B1, 0, 1); PG8_SCHED; PG8_LDA(At, 0, 0); PG8_STAGE_A(PG8_SA(1, 1), 1, a1, false);
            PG8_WAIT_V(8); PG8_WAIT_L(0); PG8_BAR; PG8_MMA(0, 0, At, B0); PG8_MMA(0, 1, At, B1); PG8_BAR; PG8_SCHED;
            PG8_LDA(At, 0, 1); PG8_STAGE(PG8_SB(0, 0), b2, voffB); PG8_STAGE(PG8_SB(0, 1), b2 + hstepB, voffB); PG8_STAGE_A(PG8_SA(0, 0), 0, a2, last);
            PG8_WAIT_V(8); PG8_WAIT_L(0); PG8_BAR; if (!HALFU || !cur.half) { PG8_MMA(1, 0, At, B0); PG8_MMA(1, 1, At, B1); } PG8_BAR; PG8_SCHED;
            PG8_LDB(B0, 1, 0); PG8_LDB(B1, 1, 1); PG8_SCHED; PG8_LDA(At, 1, 0); PG8_STAGE_A(PG8_SA(0, 1), 1, a2, last);
            PG8_WAIT_V(8); PG8_WAIT_L(0); PG8_BAR; PG8_MMA(0, 0, At, B0); PG8_MMA(0, 1, At, B1); PG8_BAR; PG8_SCHED;
            PG8_LDA(At, 1, 1); PG8_STAGE(PG8_SB(1, 0), b3, voffB); PG8_STAGE(PG8_SB(1, 1), b3 + hstepB, voffB); PG8_STAGE_A(PG8_SA(1, 0), 0, a3, last);
            PG8_WAIT_V(8); PG8_WAIT_L(0); PG8_BAR; if (!HALFU || !cur.half) { PG8_MMA(1, 0, At, B0); PG8_MMA(1, 1, At, B1); } PG8_BAR; PG8_SCHED;
        }
        if (wr == 0) PG8_BAR;
        E(acc, cur, wr, wc, fr, fq);
        if (!has_next) break;
#pragma unroll
        for (int a = 0; a < 2; ++a)
#pragma unroll
            for (int b = 0; b < 2; ++b)
#pragma unroll
                for (int m = 0; m < 4; ++m)
#pragma unroll
                    for (int n = 0; n < 2; ++n) acc[a][b][m][n] = (f32x4){0.f, 0.f, 0.f, 0.f};
        cur = nxt; cA = nA; cB = nB; ++ui;
        if constexpr (GATHER) { _Pragma("unroll") for (int _h = 0; _h < 2; ++_h) { vgc[_h][0] = vgn[_h][0]; vgc[_h][1] = vgn[_h][1]; } }
        if (wr == 1) PG8_BAR;
    }
    PG8_WAIT_V(0);
    PG8_BAR;
#undef PG8_SA
#undef PG8_SB
#undef PG8_STAGE
#undef PG8_LDA
#undef PG8_GOFF
#undef PG8_STAGE_A
#undef PG8_LDB
#undef PG8_MMA
#undef PG8_WAIT_V
#undef PG8_WAIT_L
#undef PG8_BAR
#undef PG8_SCHED
}

__device__ __forceinline__ u32x4 pack8(const f32x4 v0, const f32x4 v1) { u32x4 w; w.x = cvt_pk_bf16(v0[0], v0[1]); w.y = cvt_pk_bf16(v0[2], v0[3]); w.z = cvt_pk_bf16(v1[0], v1[1]); w.w = cvt_pk_bf16(v1[2], v1[3]); return w; }
__device__ __forceinline__ float sigm(float g) { return __builtin_amdgcn_rcpf(1.f + __expf(-g)); }

struct EpiBf16 {
    static constexpr bool PERM = true;
    bf16_t* O; int ldc; const float* bias;
    __device__ __forceinline__ void operator()(const f32x4 (&acc)[2][2][4][2], const Unit& u, int wr, int wc, int fr, int fq) const {
        const int row0 = u.pm * BM + wr * 64 + fr, col0 = u.pn * BM + wc * 32 + 8 * fq;
        f32x4 bv[2][2];
#pragma unroll
        for (int bj = 0; bj < 2; ++bj)
#pragma unroll
            for (int n = 0; n < 2; ++n) bv[bj][n] = bias ? *(const f32x4*)(bias + col0 + bj * HALF + 4 * n) : (f32x4){0.f, 0.f, 0.f, 0.f};
#pragma unroll
        for (int ai = 0; ai < 2; ++ai)
#pragma unroll
            for (int m = 0; m < 4; ++m) { bf16_t* rowp = O + (size_t)(row0 + ai * HALF + m * 16) * ldc + col0;
#pragma unroll
                for (int bj = 0; bj < 2; ++bj) *(u32x4*)(rowp + bj * HALF) = pack8(acc[ai][bj][m][0] + bv[bj][0], acc[ai][bj][m][1] + bv[bj][1]); }
    }
};
struct EpiP1 {
    static constexpr bool PERM = true;
    bf16_t *hglu, *qkv, *kvm; const float* b_in;
    __device__ __forceinline__ void operator()(const f32x4 (&acc)[2][2][4][2], const Unit& u, int wr, int wc, int fr, int fq) const {
        if (u.kind == 0) {
            const int row0 = u.pm * BM + wr * 64 + fr, cb = u.pn * 128 + wc * 32 + 8 * fq;
            f32x4 ba[2], bg[2];
#pragma unroll
            for (int n = 0; n < 2; ++n) { ba[n] = *(const f32x4*)(b_in + cb + 4 * n); bg[n] = *(const f32x4*)(b_in + 512 + cb + 4 * n); }
#pragma unroll
            for (int ai = 0; ai < 2; ++ai)
#pragma unroll
                for (int m = 0; m < 4; ++m) { f32x4 h[2];
#pragma unroll
                    for (int n = 0; n < 2; ++n) { const f32x4 a = acc[ai][0][m][n] + ba[n], gt = acc[ai][1][m][n] + bg[n];
                        h[n] = (f32x4){a[0] * sigm(gt[0]), a[1] * sigm(gt[1]), a[2] * sigm(gt[2]), a[3] * sigm(gt[3])}; }
                    *(u32x4*)(hglu + (size_t)(row0 + ai * HALF + m * 16) * 512 + cb) = pack8(h[0], h[1]); }
        } else if (u.kind == 1) { EpiBf16 e{qkv - 1024, 768, b_in}; e(acc, u, wr, wc, fr, fq);
        } else { EpiBf16 e{kvm, 2048, nullptr}; e(acc, u, wr, wc, fr, fq); }
    }
};
struct EpiGateUp {
    static constexpr bool PERM = true;
    bf16_t* Hs; const float* pair_gate;
    __device__ __forceinline__ void operator()(const f32x4 (&acc)[2][2][4][2], const Unit& u, int wr, int wc, int fr, int fq) const {
        const int row0 = u.rb + wr * 64 + fr, cb = u.pn * 128 + wc * 32 + 8 * fq;
        float pgv[2][4];
#pragma unroll
        for (int ai = 0; ai < 2; ++ai)
#pragma unroll
            for (int m = 0; m < 4; ++m) pgv[ai][m] = (ai == 0 || !u.half) ? pair_gate[row0 + ai * HALF + m * 16] : 0.f;
#pragma unroll
        for (int ai = 0; ai < 2; ++ai) { if (ai == 1 && u.half) break;
#pragma unroll
            for (int m = 0; m < 4; ++m) { const int row = row0 + ai * HALF + m * 16; const float pg = pgv[ai][m]; f32x4 h[2];
#pragma unroll
                for (int n = 0; n < 2; ++n) { const f32x4 gt = acc[ai][0][m][n], up = acc[ai][1][m][n];
                    h[n] = (f32x4){gt[0] * sigm(gt[0]) * up[0] * pg, gt[1] * sigm(gt[1]) * up[1] * pg, gt[2] * sigm(gt[2]) * up[2] * pg, gt[3] * sigm(gt[3]) * up[3] * pg}; }
                if (pg == 0.f) { h[0] = (f32x4){0.f, 0.f, 0.f, 0.f}; h[1] = h[0]; }
                *(u32x4*)(Hs + (size_t)row * 512 + cb) = pack8(h[0], h[1]); } }
    }
};
struct EpiY {
    static constexpr bool PERM = true;
    bf16_t* Y;
    __device__ __forceinline__ void operator()(const f32x4 (&acc)[2][2][4][2], const Unit& u, int wr, int wc, int fr, int fq) const {
        const int row0 = u.rb + wr * 64 + fr, col0 = u.pn * BM + wc * 32 + 8 * fq;
#pragma unroll
        for (int ai = 0; ai < 2; ++ai) { if (ai == 1 && u.half) break;
#pragma unroll
            for (int m = 0; m < 4; ++m) { bf16_t* rowp = Y + (size_t)(row0 + ai * HALF + m * 16) * 1024 + col0;
#pragma unroll
                for (int bj = 0; bj < 2; ++bj) *(u32x4*)(rowp + bj * HALF) = pack8(acc[ai][bj][m][0], acc[ai][bj][m][1]); } }
    }
};
__device__ __forceinline__ void row_stats16(const float* stats, int row, int fq, float& mu, float& rstd) {
    const f32x4* sp = (const f32x4*)(stats + (size_t)row * 32 + fq * 8); const f32x4 a = sp[0], b = sp[1];
    float s = (a[0] + a[2]) + (b[0] + b[2]), ss = (a[1] + a[3]) + (b[1] + b[3]);
    s += __shfl_xor(s, 16); s += __shfl_xor(s, 32); ss += __shfl_xor(ss, 16); ss += __shfl_xor(ss, 32);
    mu = s * (1.f / 1024.f); const float var = ss * (1.f / 1024.f) - mu * mu; rstd = 1.f / sqrtf(var + 1e-5f);
}
__device__ __forceinline__ void row_stats16x4(const float* stats, int rowh, int fq, float (&mu)[4], float (&rstd)[4]) {
    f32x4 sa[4], sb[4];
#pragma unroll
    for (int m = 0; m < 4; ++m) { const f32x4* sp = (const f32x4*)(stats + (size_t)(rowh + m * 16) * 32 + fq * 8); sa[m] = sp[0]; sb[m] = sp[1]; }
#pragma unroll
    for (int m = 0; m < 4; ++m) { const f32x4 a = sa[m], b = sb[m];
        float s = (a[0] + a[2]) + (b[0] + b[2]), ss = (a[1] + a[3]) + (b[1] + b[3]);
        s += __shfl_xor(s, 16); s += __shfl_xor(s, 32); ss += __shfl_xor(ss, 16); ss += __shfl_xor(ss, 32);
        const float mm = s * (1.f / 1024.f); mu[m] = mm; rstd[m] = 1.f / sqrtf(ss * (1.f / 1024.f) - mm * mm + 1e-5f); }
}
struct EpiResStats {
    static constexpr bool PERM = false;
    const bf16_t* resb; bf16_t* zb; float* stats; float alpha;
    __device__ __forceinline__ void operator()(const f32x4 (&acc)[2][2][4][2], const Unit& u, int wr, int wc, int fr, int fq) const {
        const int row0 = u.pm * BM + wr * 64 + fr, col0 = u.pn * BM + wc * 32 + 4 * fq;
#pragma unroll
        for (int ai = 0; ai < 2; ++ai) {
            u32x2 rw[4][2][2];
#pragma unroll
            for (int m = 0; m < 4; ++m)
#pragma unroll
                for (int bj = 0; bj < 2; ++bj)
#pragma unroll
                    for (int n = 0; n < 2; ++n) rw[m][bj][n] = *(const u32x2*)(resb + (size_t)(row0 + ai * HALF + m * 16) * 1024 + col0 + bj * HALF + n * 16);
#pragma unroll
            for (int m = 0; m < 4; ++m) { const int row = row0 + ai * HALF + m * 16; const size_t off = (size_t)row * 1024 + col0; float sm = 0.f, ss = 0.f;
#pragma unroll
                for (int bj = 0; bj < 2; ++bj)
#pragma unroll
                    for (int n = 0; n < 2; ++n) { const u32x2 q = rw[m][bj][n];
                        const f32x4 r = (f32x4){__builtin_bit_cast(float, q.x << 16), __builtin_bit_cast(float, q.x & 0xffff0000u), __builtin_bit_cast(float, q.y << 16), __builtin_bit_cast(float, q.y & 0xffff0000u)};
                        const f32x4 z = r * alpha + acc[ai][bj][m][n];
                        u32x2 w; w.x = cvt_pk_bf16(z[0], z[1]); w.y = cvt_pk_bf16(z[2], z[3]); *(u32x2*)(zb + off + bj * HALF + n * 16) = w;
                        sm += (z[0] + z[1]) + (z[2] + z[3]); ss += (z[0] * z[0] + z[1] * z[1]) + (z[2] * z[2] + z[3] * z[3]); }
                sm += __shfl_xor(sm, 16); sm += __shfl_xor(sm, 32); ss += __shfl_xor(ss, 16); ss += __shfl_xor(ss, 32);
                if (fq == 0) *(float2*)(stats + (size_t)row * 32 + (u.pn * 4 + wc) * 2) = make_float2(sm, ss); } }
    }
};
struct EpiResLn {
    static constexpr bool PERM = false;
    bf16_t* out; const bf16_t* zb; const float* stats; const float* g; const float* b; float alpha;
    __device__ __forceinline__ void operator()(const f32x4 (&acc)[2][2][4][2], const Unit& u, int wr, int wc, int fr, int fq) const {
        const int row0 = u.pm * BM + wr * 64 + fr, col0 = u.pn * BM + wc * 32 + 4 * fq;
        f32x4 gv[2][2], bv[2][2];
#pragma unroll
        for (int bj = 0; bj < 2; ++bj)
#pragma unroll
            for (int n = 0; n < 2; ++n) { gv[bj][n] = *(const f32x4*)(g + col0 + bj * HALF + n * 16); bv[bj][n] = *(const f32x4*)(b + col0 + bj * HALF + n * 16); }
#pragma unroll
        for (int ai = 0; ai < 2; ++ai) {
            float mu[4], rstd[4]; row_stats16x4(stats, row0 + ai * HALF, fq, mu, rstd);
            u32x2 zw[4][2][2];
#pragma unroll
            for (int m = 0; m < 4; ++m)
#pragma unroll
                for (int bj = 0; bj < 2; ++bj)
#pragma unroll
                    for (int n = 0; n < 2; ++n) zw[m][bj][n] = *(const u32x2*)(zb + (size_t)(row0 + ai * HALF + m * 16) * 1024 + col0 + bj * HALF + n * 16);
#pragma unroll
            for (int m = 0; m < 4; ++m) { const size_t off = (size_t)(row0 + ai * HALF + m * 16) * 1024 + col0; const float mm = mu[m], rs = rstd[m];
#pragma unroll
                for (int bj = 0; bj < 2; ++bj)
#pragma unroll
                    for (int n = 0; n < 2; ++n) { const u32x2 q = zw[m][bj][n];
                        const f32x4 z = (f32x4){__builtin_bit_cast(float, q.x << 16), __builtin_bit_cast(float, q.x & 0xffff0000u), __builtin_bit_cast(float, q.y << 16), __builtin_bit_cast(float, q.y & 0xffff0000u)};
                        const f32x4 x1 = (z - mm) * rs * gv[bj][n] + bv[bj][n];
                        const f32x4 z2 = x1 * alpha + acc[ai][bj][m][n]; u32x2 w; w.x = cvt_pk_bf16(z2[0], z2[1]); w.y = cvt_pk_bf16(z2[2], z2[3]); *(u32x2*)(out + off + bj * HALF + n * 16) = w; } } }
    }
};
struct EpiPre {
    static constexpr bool PERM = true;
    bf16_t* O; float* csp;
    __device__ __forceinline__ void operator()(const f32x4 (&acc)[2][2][4][2], const Unit& u, int wr, int wc, int fr, int fq) const {
        const int row0 = u.pm * BM + wr * 64 + fr, col0 = u.pn * BM + wc * 32 + 8 * fq;
#pragma unroll
        for (int ai = 0; ai < 2; ++ai)
#pragma unroll
            for (int m = 0; m < 4; ++m) { const int row = row0 + ai * HALF + m * 16; bf16_t* rowp = O + ((size_t)u.aux * 1024 + row) * 1024 + col0; float sm = 0.f;
#pragma unroll
                for (int bj = 0; bj < 2; ++bj) { const u32x4 w = pack8(acc[ai][bj][m][0], acc[ai][bj][m][1]); *(u32x4*)(rowp + bj * HALF) = w;
#pragma unroll
                    for (int e = 0; e < 4; ++e) sm += __builtin_bit_cast(float, w[e] << 16) + __builtin_bit_cast(float, w[e] & 0xffff0000u); }
                if (csp) { sm += __shfl_xor(sm, 16); sm += __shfl_xor(sm, 32); if (fq == 0) csp[((size_t)u.aux * 1024 + row) * 16 + u.pn * 4 + wc] = sm; } }
    }
};
struct EpiSoftmaxLn {
    static constexpr bool PERM = true;
    bf16_t* P; PG8_LAS float* xl; const float* stats; const float* cs; const float* bw;
    __device__ __forceinline__ void operator()(f32x4 (&acc)[2][2][4][2], const Unit& u, int wr, int wc, int fr, int fq) const {
        const float sc = 0.0625f * 1.4426950408889634f;
        const int row0 = u.pm * BM + wr * 64 + fr, col0 = u.pn * BM + wc * 32 + 8 * fq;
        unsigned xw = (unsigned)(size_t)(xl + ((wr * 64 + fr) * 4 + wc) * 2), xr = (unsigned)(size_t)(xl + (wr * 64 + fr) * 8);
        asm volatile("" : "+v"(xw), "+v"(xr));
        PG8_LAS float* const xwp = (PG8_LAS float*)(size_t)xw; const PG8_LAS float* const xrp = (const PG8_LAS float*)(size_t)xr;
        { f32x4 cv[2][2], wv[2][2];
#pragma unroll
          for (int bj = 0; bj < 2; ++bj)
#pragma unroll
            for (int n = 0; n < 2; ++n) { cv[bj][n] = *(const f32x4*)(cs + u.aux * 1024 + col0 + bj * HALF + 4 * n); wv[bj][n] = *(const f32x4*)(bw + u.aux * 1024 + col0 + bj * HALF + 4 * n); }
#pragma unroll
          for (int ai = 0; ai < 2; ++ai) { float mu8[4], rs8[4];
#pragma unroll
            for (int m = 0; m < 4; ++m) row_stats16(stats, row0 + ai * HALF + m * 16, fq, mu8[m], rs8[m]);
#pragma unroll
            for (int m = 0; m < 4; ++m) {
#pragma unroll
                for (int bj = 0; bj < 2; ++bj)
#pragma unroll
                    for (int n = 0; n < 2; ++n) acc[ai][bj][m][n] = (acc[ai][bj][m][n] - cv[bj][n] * mu8[m]) * rs8[m] + wv[bj][n]; } } }
#pragma unroll
        for (int ai = 0; ai < 2; ++ai)
#pragma unroll
            for (int m = 0; m < 4; ++m) { float mx = -INFINITY;
#pragma unroll
                for (int bj = 0; bj < 2; ++bj)
#pragma unroll
                    for (int n = 0; n < 2; ++n) { const f32x4 v = acc[ai][bj][m][n]; mx = fmaxf(mx, fmaxf(fmaxf(v[0], v[1]), fmaxf(v[2], v[3]))); }
                mx = fmaxf(mx, __shfl_xor(mx, 16)); mx = fmaxf(mx, __shfl_xor(mx, 32));
                float sm = 0.f;
#pragma unroll
                for (int bj = 0; bj < 2; ++bj)
#pragma unroll
                    for (int n = 0; n < 2; ++n) { const f32x4 v = acc[ai][bj][m][n];
                        const f32x4 e = (f32x4){__builtin_amdgcn_exp2f((v[0] - mx) * sc), __builtin_amdgcn_exp2f((v[1] - mx) * sc), __builtin_amdgcn_exp2f((v[2] - mx) * sc), __builtin_amdgcn_exp2f((v[3] - mx) * sc)};
                        acc[ai][bj][m][n] = e; sm += (e[0] + e[1]) + (e[2] + e[3]); }
                sm += __shfl_xor(sm, 16); sm += __shfl_xor(sm, 32);
                if (fq == 0) { PG8_LAS float* q = xwp + (ai * HALF + m * 16) * 8; q[0] = mx; q[1] = sm; } }
        asm volatile("s_waitcnt lgkmcnt(0)" ::: "memory"); __builtin_amdgcn_s_barrier(); asm volatile("" ::: "memory");
#pragma unroll
        for (int ai = 0; ai < 2; ++ai)
#pragma unroll
            for (int m = 0; m < 4; ++m) { const PG8_LAS f32x4* q = (const PG8_LAS f32x4*)(xrp + (ai * HALF + m * 16) * 8); const f32x4 q0 = q[0], q1 = q[1];
                const float M = fmaxf(fmaxf(q0[0], q0[2]), fmaxf(q1[0], q1[2]));
                const float S = (q0[1] * __builtin_amdgcn_exp2f((q0[0] - M) * sc) + q0[3] * __builtin_amdgcn_exp2f((q0[2] - M) * sc)) + (q1[1] * __builtin_amdgcn_exp2f((q1[0] - M) * sc) + q1[3] * __builtin_amdgcn_exp2f((q1[2] - M) * sc));
                const float mine = (wc == 0) ? q0[0] : (wc == 1) ? q0[2] : (wc == 2) ? q1[0] : q1[2];
                const float fac = __builtin_amdgcn_exp2f((mine - M) * sc) / S; bf16_t* rowp = P + (size_t)(row0 + ai * HALF + m * 16) * 1024 + col0;
#pragma unroll
                for (int bj = 0; bj < 2; ++bj) *(u32x4*)(rowp + bj * HALF) = pack8(acc[ai][bj][m][0] * fac, acc[ai][bj][m][1] * fac); }
        asm volatile("s_waitcnt lgkmcnt(0)" ::: "memory"); __builtin_amdgcn_s_barrier(); asm volatile("" ::: "memory");
    }
};
struct DenseSched {
    const char* A; const char* B; int nM, nN, G, c; size_t strideA, strideB;
    __device__ __forceinline__ bool next(int i, Unit& u) const { const int L = i * G + c; if (L >= nM * nN) return false; tile_of(L, nM, nN, u.pm, u.pn); u.A = A + (size_t)u.pm * strideA; u.B = B + (size_t)u.pn * strideB; u.kind = 0; u.aux = 0; u.rows = nullptr; return true; }
};
}


#define LAS __attribute__((address_space(3)))
struct TItem { const float* W; bf16* WT; const float* gk; int N, Kd, k0, n0, drow0; };
__device__ __forceinline__ void titem_load(const TItem& t, float (&wv)[32], int lane) {
#pragma unroll
    for (int i = 0; i < 32; ++i) { const int kk = 2 * i + (lane >> 5); wv[i] = __builtin_nontemporal_load(t.W + (size_t)(t.k0 + kk) * t.N + t.n0 + (lane & 31)); }
}
__device__ __forceinline__ void titem_store(const TItem& t, const float (&wv)[32], LAS float* scr, int lane) {
#pragma unroll
    for (int i = 0; i < 32; ++i) { const int kk = 2 * i + (lane >> 5); float v = wv[i]; if (t.gk) v *= t.gk[t.k0 + kk]; scr[kk * 33 + (lane & 31)] = v; }
    asm volatile("s_waitcnt lgkmcnt(0)" ::: "memory");
    const int c = lane & 7;
#pragma unroll
    for (int j = 0; j < 4; ++j) { const int n = (lane >> 3) + 8 * j; const LAS float* sp = scr + (8 * c) * 33 + n;
        u32x4 o; o.x = pk2(sp[0 * 33], sp[1 * 33]); o.y = pk2(sp[2 * 33], sp[3 * 33]); o.z = pk2(sp[4 * 33], sp[5 * 33]); o.w = pk2(sp[6 * 33], sp[7 * 33]);
        *(u32x4*)(t.WT + (size_t)(t.drow0 + n) * t.Kd + t.k0 + 8 * c) = o; }
    asm volatile("s_waitcnt lgkmcnt(0)" ::: "memory");
}
__device__ __forceinline__ void transpose_item(const float* W, int N, bf16* WT, int Kd, int k0, int n0, int drow0, LAS float* scr, int lane, const float* gk = nullptr) {
    const TItem t{W, WT, gk, N, Kd, k0, n0, drow0}; float wv[32]; titem_load(t, wv, lane); titem_store(t, wv, scr, lane);
}

typedef short bf16x8v __attribute__((ext_vector_type(8)));
__device__ __forceinline__ float bflo(unsigned v) { return __builtin_bit_cast(float, v << 16); }
__device__ __forceinline__ float bfhi(unsigned v) { return __builtin_bit_cast(float, v & 0xffff0000u); }

__device__ __forceinline__ void conv_load(const bf16* hglu, int cu, int tid, u32x4 (&pre)[8]) {
    const int t0 = cu * 32, s0 = t0 % SEQ;
#pragma unroll
    for (int i = 0; i < 8; ++i) { const int c = tid + 512 * i, row = c >> 6, part = c & 63; u32x4 v = (u32x4){0u, 0u, 0u, 0u};
        if (c < 62 * 64 && s0 - 30 + row >= 0) v = *(const u32x4*)(hglu + (size_t)(t0 - 30 + row) * 512 + part * 8);
        pre[i] = v; }
}
__device__ __forceinline__ void conv_stage(unsigned char* lds, int tid, const u32x4 (&pre)[8]) {
    bf16* hin = (bf16*)lds;
#pragma unroll
    for (int i = 0; i < 8; ++i) { const int c = tid + 512 * i, row = c >> 6, part = c & 63; if (c < 62 * 64) *(u32x4*)(hin + row * 512 + part * 8) = pre[i]; }
}
typedef float f32x2c __attribute__((ext_vector_type(2)));
struct ConvW { f32x2c wj[CONV_W]; f32x2c bb; f32x4 g0, g1, c0, c1; };
__device__ __forceinline__ void conv_weights(const float* w_dw, const float* b_dw, const float* g_cn, const float* b_cn, int tid, ConvW& w) {
    const int cp = tid & 255, lane = tid & 63;
#pragma unroll
    for (int j = 0; j < CONV_W; ++j) w.wj[j] = *(const f32x2c*)(w_dw + j * CONV_CH + 2 * cp);
    w.bb = *(const f32x2c*)(b_dw + 2 * cp);
    w.g0 = *(const f32x4*)(g_cn + 8 * lane); w.g1 = *(const f32x4*)(g_cn + 8 * lane + 4); w.c0 = *(const f32x4*)(b_cn + 8 * lane); w.c1 = *(const f32x4*)(b_cn + 8 * lane + 4);
}
__device__ __forceinline__ void conv_unit(unsigned char* lds, const ConvW& w, bf16* ycat, int cu, int tid) {
    const int lane = tid & 63, wave = tid >> 6;
    bf16* hin = (bf16*)lds; float* cout = (float*)(lds + 63488);
    const int t0 = cu * 32;
    {
        const int cp = tid & 255, th = tid >> 8;
#pragma unroll 1
        for (int grp = 0; grp < 2; ++grp) { const int tt0 = th * 16 + grp * 8;
            f32x2c ac[8];
#pragma unroll
            for (int o = 0; o < 8; ++o) ac[o] = w.bb;
#pragma unroll
            for (int r = 0; r < 38; ++r) { const unsigned v = *(const unsigned*)(hin + (tt0 + r) * 512 + 2 * cp); const f32x2c hv = (f32x2c){bflo(v), bfhi(v)};
#pragma unroll
                for (int o = 0; o < 8; ++o) { const int j = r - o; if (j >= 0 && j < CONV_W) ac[o] = __builtin_elementwise_fma(w.wj[j], hv, ac[o]); } }
#pragma unroll
            for (int o = 0; o < 8; ++o) *(f32x2c*)(cout + (tt0 + o) * 512 + 2 * cp) = ac[o];
        }
    }
    __syncthreads();
    {
        f32x4 v0[4], v1[4]; float mean[4], rstd[4];
#pragma unroll
        for (int i = 0; i < 4; ++i) { const int tt = wave * 4 + i; v0[i] = *(const f32x4*)(cout + tt * 512 + 8 * lane); v1[i] = *(const f32x4*)(cout + tt * 512 + 8 * lane + 4); }
#pragma unroll
        for (int i = 0; i < 4; ++i) mean[i] = wave_sum((v0[i].x + v0[i].y) + (v0[i].z + v0[i].w) + (v1[i].x + v1[i].y) + (v1[i].z + v1[i].w)) * (1.f / 512.f);
#pragma unroll
        for (int i = 0; i < 4; ++i) { v0[i] = v0[i] - mean[i]; v1[i] = v1[i] - mean[i];
            rstd[i] = wave_sum((v0[i].x * v0[i].x + v0[i].y * v0[i].y) + (v0[i].z * v0[i].z + v0[i].w * v0[i].w) + (v1[i].x * v1[i].x + v1[i].y * v1[i].y) + (v1[i].z * v1[i].z + v1[i].w * v1[i].w)) * (1.f / 512.f); }
#pragma unroll
        for (int i = 0; i < 4; ++i) { const int tt = wave * 4 + i; const float rs = 1.f / sqrtf(rstd[i] + LN_EPS);
            f32x4 y0 = v0[i] * rs * w.g0 + w.c0, y1 = v1[i] * rs * w.g1 + w.c1;
#pragma unroll
            for (int e = 0; e < 4; ++e) { y0[e] = y0[e] * pg8::sigm(y0[e]); y1[e] = y1[e] * pg8::sigm(y1[e]); }
            *(u32x4*)(ycat + (size_t)(t0 + tt) * 1024 + 8 * lane) = pg8::pack8(y0, y1); }
    }
    __syncthreads();
}

__device__ __forceinline__ void swa_load(const bf16* qkv, int b, int kvh, int qb, int tid, u32x4 (&kk)[4], u32x4 (&vq)[4]) {
    const long tk0 = (long)b * SEQ + (long)qb * 128 - 128;
#pragma unroll
    for (int i = 0; i < 4; ++i) { const int c = tid + 512 * i, row = c >> 3, part = c & 7; const bool ok = (qb > 0) || (row >= 128);
        u32x4 kv = (u32x4){0u, 0u, 0u, 0u}, vv = kv;
        if (ok) { const bf16* rp = qkv + (tk0 + row) * 768 + 512 + kvh * 64 + part * 8; kv = *(const u32x4*)rp; vv = *(const u32x4*)(rp + 128); }
        kk[i] = kv; vq[i] = vv; }
}
__device__ __forceinline__ void swa_unit(unsigned char* lds, const bf16* qkv, const float* sinks, bf16* ycat, int b, int kvh, int qb, int tid, const u32x4 (&kk)[4], const u32x4 (&vq)[4], unsigned long long& tpr) {
    const int lane = tid & 63, wave = tid >> 6, q4 = lane >> 4, c16 = lane & 15;
    bf16* Ks = (bf16*)lds; bf16* VT = (bf16*)(lds + 36864);
    const long t0 = (long)b * SEQ + (long)qb * 128;
#pragma unroll
    for (int i = 0; i < 4; ++i) { const int c = tid + 512 * i, row = c >> 3, part = c & 7;
        const u32x4 kv = kk[i], vv = vq[i];
        *(u32x4*)(Ks + row * 72 + part * 8) = kv;
#pragma unroll
        for (int e = 0; e < 4; ++e) { VT[(part * 8 + 2 * e) * 264 + row] = (bf16)(vv[e] & 0xffffu); VT[(part * 8 + 2 * e + 1) * 264 + row] = (bf16)(vv[e] >> 16); } }
    __syncthreads();
    unsigned long long tsw = 0; if (PROBE_T == 111) tsw = __builtin_amdgcn_s_memrealtime();
    const int g = wave >> 1, hq = kvh * 4 + g, i0 = (wave & 1) * 64;
    const float L2E = 1.4426950408889634f, sc = 0.125f * L2E, sink2 = sinks[hq] * L2E;
    bf16x8v Qc[2][2], Qn[2][2];
#pragma unroll
    for (int h = 0; h < 2; ++h) { const bf16* qp = qkv + (t0 + i0 + h * 16 + c16) * 768 + hq * 64 + 8 * q4; Qc[h][0] = *(const bf16x8v*)qp; Qc[h][1] = *(const bf16x8v*)(qp + 32); }
#pragma unroll 1
    for (int qp2 = 0; qp2 < 2; ++qp2) {
        if (qp2 == 0) {
#pragma unroll
            for (int h = 0; h < 2; ++h) { const bf16* qp = qkv + (t0 + i0 + (2 + h) * 16 + c16) * 768 + hq * 64 + 8 * q4; Qn[h][0] = *(const bf16x8v*)qp; Qn[h][1] = *(const bf16x8v*)(qp + 32); } }
        int kt0[2], iqc[2]; f32x4 sv[2][9]; float inv[2];
#pragma unroll
        for (int h = 0; h < 2; ++h) { const int iq = i0 + (2 * qp2 + h) * 16; kt0[h] = iq >> 4; iqc[h] = iq + c16; }
#pragma unroll
        for (int kt = 0; kt < 9; ++kt)
#pragma unroll
            for (int h = 0; h < 2; ++h) { const bf16* kp = Ks + ((kt0[h] + kt) * 16 + c16) * 72 + 8 * q4;
                f32x4 a = (f32x4){0.f, 0.f, 0.f, 0.f};
                a = __builtin_amdgcn_mfma_f32_16x16x32_bf16(*(const bf16x8v*)kp, Qc[h][0], a, 0, 0, 0);
                a = __builtin_amdgcn_mfma_f32_16x16x32_bf16(*(const bf16x8v*)(kp + 32), Qc[h][1], a, 0, 0, 0);
                sv[h][kt] = a; }
        float mx[2], sum[2];
#pragma unroll
        for (int h = 0; h < 2; ++h) { float m_ = sink2;
#pragma unroll
            for (int kt = 0; kt < 9; ++kt)
#pragma unroll
                for (int r = 0; r < 4; ++r) { const int j2 = (kt0[h] + kt) * 16 + 4 * q4 + r; const bool ok = (j2 > iqc[h]) && (j2 <= iqc[h] + 128) && (qb > 0 || j2 >= 128);
                    const float v = ok ? sv[h][kt][r] * sc : -INFINITY; sv[h][kt][r] = v; m_ = fmaxf(m_, v); }
            mx[h] = m_; }
#pragma unroll
        for (int h = 0; h < 2; ++h) mx[h] = fmaxf(mx[h], __shfl_xor(mx[h], 16));
#pragma unroll
        for (int h = 0; h < 2; ++h) mx[h] = fmaxf(mx[h], __shfl_xor(mx[h], 32));
#pragma unroll
        for (int h = 0; h < 2; ++h) { float s_ = 0.f;
#pragma unroll
            for (int kt = 0; kt < 9; ++kt)
#pragma unroll
                for (int r = 0; r < 4; ++r) { const float pv = __builtin_amdgcn_exp2f(sv[h][kt][r] - mx[h]); sv[h][kt][r] = pv; s_ += pv; }
            sum[h] = s_; }
#pragma unroll
        for (int h = 0; h < 2; ++h) sum[h] += __shfl_xor(sum[h], 16);
#pragma unroll
        for (int h = 0; h < 2; ++h) sum[h] += __shfl_xor(sum[h], 32);
#pragma unroll
        for (int h = 0; h < 2; ++h) inv[h] = 1.f / (sum[h] + __builtin_amdgcn_exp2f(sink2 - mx[h]));
        f32x4 o[2][4];
#pragma unroll
        for (int h = 0; h < 2; ++h)
#pragma unroll
            for (int dt = 0; dt < 4; ++dt) o[h][dt] = (f32x4){0.f, 0.f, 0.f, 0.f};
#pragma unroll
        for (int pp = 0; pp < 5; ++pp)
#pragma unroll
            for (int h = 0; h < 2; ++h) { const int T0 = kt0[h] + 2 * pp, T1 = (pp < 4) ? T0 + 1 : T0;
                const f32x4 pa = sv[h][2 * pp], pb = (pp < 4) ? sv[h][2 * pp + 1] : (f32x4){0.f, 0.f, 0.f, 0.f};
                const u32x4 pw = pg8::pack8(pa, pb); const bf16x8v Bp = __builtin_bit_cast(bf16x8v, pw);
#pragma unroll
                for (int dt = 0; dt < 4; ++dt) { const bf16* vp = VT + (dt * 16 + c16) * 264 + 4 * q4;
                    const u32x2 lo = *(const u32x2*)(vp + T0 * 16), hi = *(const u32x2*)(vp + T1 * 16);
                    const u32x4 aw = (u32x4){lo.x, lo.y, hi.x, hi.y};
                    o[h][dt] = __builtin_amdgcn_mfma_f32_16x16x32_bf16(__builtin_bit_cast(bf16x8v, aw), Bp, o[h][dt], 0, 0, 0); } }
#pragma unroll
        for (int h = 0; h < 2; ++h) { bf16* op = ycat + (t0 + iqc[h]) * 1024 + 512 + hq * 64 + 4 * q4;
#pragma unroll
            for (int dt = 0; dt < 4; ++dt) { u32x2 w; w.x = pg8::cvt_pk_bf16(o[h][dt][0] * inv[h], o[h][dt][1] * inv[h]); w.y = pg8::cvt_pk_bf16(o[h][dt][2] * inv[h], o[h][dt][3] * inv[h]); *(u32x2*)(op + dt * 16) = w; } }
#pragma unroll
        for (int h = 0; h < 2; ++h) { Qc[h][0] = Qn[h][0]; Qc[h][1] = Qn[h][1]; }
    }
    if (PROBE_T == 111) tpr += __builtin_amdgcn_s_memrealtime() - tsw;
    __syncthreads();
}


#define XB_TMO      128
#define XB_XCNT(j)  (256  + 64 * (j))
#define XB_XSUB(j)  (1280 + 64 * (j))
#define XB_XGEN(j)  (2304 + 64 * (j))
#define XB_TOP      3328
#define XB_TOPGEN   3392
#define XCD_BAR_WORDS 3456
#define XB_SPIN_CAP (1u << 20)
__device__ __forceinline__ unsigned xb_ld(unsigned* p)              { return __hip_atomic_load(p, __ATOMIC_RELAXED, __HIP_MEMORY_SCOPE_AGENT); }
__device__ __forceinline__ unsigned xb_add(unsigned* p, unsigned v) { return __hip_atomic_fetch_add(p, v, __ATOMIC_RELAXED, __HIP_MEMORY_SCOPE_AGENT); }
__device__ __forceinline__ unsigned xb_xcc_id() { return (unsigned)__builtin_amdgcn_s_getreg((3 << 11) | 20) & 0xFu; }
#define XB_SPIN(cond, bar) do { unsigned _sp = 0; while (cond) { __builtin_amdgcn_s_sleep(1); \
    if ((++_sp & 255u) == 0u) { if (xb_ld(&(bar)[XB_TMO])) break; if (_sp > XB_SPIN_CAP) { atomicAdd(&(bar)[XB_TMO], 1u); break; } } } } while (0)
struct XcdBarrier { unsigned* bar; unsigned x; volatile __attribute__((address_space(3))) unsigned* st; };
__device__ __forceinline__ XcdBarrier xcd_barrier_post(unsigned* bar, volatile __attribute__((address_space(3))) unsigned* st) {
    XcdBarrier b; b.bar = bar; b.x = xb_xcc_id(); b.st = st;
    if (threadIdx.x == 0) (void)xb_add(&bar[XB_XCNT(b.x)], 1u);
    return b;
}
__device__ __forceinline__ void xcd_barrier_complete(unsigned* bar, unsigned x, unsigned& nloc, unsigned& nx) {
    const unsigned G = gridDim.x * gridDim.y * gridDim.z;
    unsigned sum, cnt, mine, sp = 0u;
    for (;;) {
        sum = 0u; cnt = 0u; mine = 0u;
#pragma unroll
        for (unsigned j = 0; j < 16; ++j) { const unsigned c = xb_ld(&bar[XB_XCNT(j)]); sum += c; cnt += (c > 0u) ? 1u : 0u; mine = (j == x) ? c : mine; }
        if (sum == G) break;
        __builtin_amdgcn_s_sleep(1);
        if ((++sp & 255u) == 0u) { if (xb_ld(&bar[XB_TMO])) break; if (sp > XB_SPIN_CAP) { atomicAdd(&bar[XB_TMO], 1u); break; } }
    }
    nloc = mine > 0u ? mine : 1u; nx = cnt > 0u ? cnt : 1u;
}
__device__ __forceinline__ void xcd_barrier(const XcdBarrier& b, int tid) {
    asm volatile("s_waitcnt vmcnt(0)" ::: "memory");
    __syncthreads();
    if (tid == 0) {
        unsigned* bar = b.bar;
        __builtin_amdgcn_s_waitcnt(0);
        unsigned nloc = b.st[0], nx = b.st[1];
        if (nloc == 0u) { xcd_barrier_complete(bar, b.x, nloc, nx); b.st[0] = nloc; b.st[1] = nx; }
        const unsigned old = xb_add(&bar[XB_XSUB(b.x)], 1u);
        const unsigned gen = old / nloc;
        if (old + 1u == (gen + 1u) * nloc) {
            __builtin_amdgcn_fence(__ATOMIC_RELEASE, "agent");
            asm volatile("s_waitcnt vmcnt(0)" ::: "memory");
            const unsigned og = xb_add(&bar[XB_TOP], 1u);
            const unsigned tg = og / nx;
            if (og + 1u == (tg + 1u) * nx) xb_add(&bar[XB_TOPGEN], 1u);
            else XB_SPIN(xb_ld(&bar[XB_TOPGEN]) == tg, bar);
            __builtin_amdgcn_fence(__ATOMIC_ACQUIRE, "agent");
            xb_add(&bar[XB_XGEN(b.x)], 1u);
            asm volatile("s_waitcnt vmcnt(0)" ::: "memory");
        } else {
            XB_SPIN(xb_ld(&bar[XB_XGEN(b.x)]) == gen, bar);
            __builtin_amdgcn_fence(__ATOMIC_ACQUIRE, "agent");
            asm volatile("s_waitcnt vmcnt(0)" ::: "memory");
        }
    }
    __syncthreads();
}

struct SchedMoE { const char* A; const char* W; const int* tab; const int* rows; int nF, nH, G, c; size_t lda2, strideE, strideN;
    __device__ __forceinline__ bool next(int i, pg8::Unit& u) const { const int L = i * G + c; int t;
        if (L < nF * 4) { pg8::tile_of(L, nF, 4, t, u.pn); u.half = 0; } else if (L < (nF + nH) * 4) { pg8::tile_of(L - nF * 4, nH, 4, t, u.pn); t += nF; u.half = 1; } else return false;
        const int rb = tab[2 + t], e = tab[2 + 192 + t];
        u.pm = t; u.kind = 0; u.aux = e; u.rb = rb; u.rows = rows ? rows + rb : nullptr; u.A = rows ? A : A + (size_t)rb * lda2; u.B = W + (size_t)e * strideE + (size_t)u.pn * strideN; return true; } };

__global__ void __launch_bounds__(512, 2) fwd_kernel(Params p) {
    extern __shared__ __attribute__((aligned(16))) unsigned char lds_raw[];
    float* ldsf = (float*)lds_raw;
    const int G = gridDim.x, bid = blockIdx.x, NGW = G * 8;
    const int wid_s = __builtin_amdgcn_readfirstlane((int)threadIdx.x >> 6);
    unsigned char* ws = p.ws;
    const float *x = p.in[0], *mem = p.in[1], *w_in = p.in[2], *b_in = p.in[3], *w_dw = p.in[4], *b_dw = p.in[5], *g_cn = p.in[6], *b_cn = p.in[7], *sinks = p.in[8],
                *w_out = p.in[9], *g_ln1 = p.in[10], *b_ln1 = p.in[11], *w_mq = p.in[12], *w_mkv = p.in[13], *w_mo = p.in[14], *g_ln2 = p.in[15], *b_ln2 = p.in[16],
                *w_group = p.in[17], *b_group = p.in[18], *w_router = p.in[19], *b_router = p.in[20], *w_gate = p.in[21], *w_up = p.in[22], *w_down = p.in[23],
                *g_ln3 = p.in[24], *b_ln3 = p.in[25];
    float* out = p.out;
    bf16* xb = (bf16*)(ws + WS_DD); bf16* ycat = (bf16*)(ws + WS_A); bf16* Hs = (bf16*)(ws + WS_A);
    bf16* hglu = (bf16*)(ws + WS_B); bf16* qkv = (bf16*)(ws + WS_B + (size_t)T * 512 * 2); bf16* x1b = (bf16*)(ws + WS_B); bf16* Pb2 = (bf16*)(ws + WS_A); bf16* x2b = (bf16*)(ws + WS_B);
    float* Sbuf = (float*)(ws + WS_DD); bf16* Xs = (bf16*)(ws + WS_DD);
    bf16* kvm = (bf16*)(ws + WS_KVM); bf16* memb = (bf16*)(ws + WS_MEMB); bf16* MT = (bf16*)(ws + WS_MT); bf16* NT = (bf16*)(ws + WS_NT);
    float* csS = (float*)(ws + WS_CSS); float* bwS = csS + 2048; float* csp = (float*)(ws + WS_CSP);
    bf16* Wt_in = (bf16*)(ws + WS_WIN); bf16* Wt_out = (bf16*)(ws + WS_WOUT); bf16* Wqb = (bf16*)(ws + WS_WMQ); bf16* Wt_mkv = (bf16*)(ws + WS_WMKV); bf16* Wt_mo = (bf16*)(ws + WS_WMO);
    bf16* Wt_gu = (bf16*)(ws + WS_WGU); bf16* Wt_dn = (bf16*)(ws + WS_WDN);
    PG8_LAS unsigned char* ldsp = (PG8_LAS unsigned char*)lds_raw;
    float* stats1 = (float*)(ws + WS_ST1); float* cs1 = (float*)(ws + WS_CS1); float* bw1 = cs1 + 1024;
    int* route_e = (int*)(ws + WS_ROUTE); float* route_g = (float*)(ws + WS_ROUTE + (size_t)T * 8);
    int* blkcnt = (int*)(ws + WS_BLKCNT); int* segw = (int*)(ws + WS_SEG); int* rank = (int*)(ws + WS_RANK);
    int* pair_tok = (int*)(ws + WS_PTOK); float* pair_gate = (float*)(ws + WS_PGATE); int* tokpos = (int*)(ws + WS_TOKPOS); bf16* Yb = (bf16*)(ws + WS_DD); bf16* z2b = (bf16*)(ws + WS_DD);

    const int lo = p.ph_lo, hi = p.ph_hi;
    int ph = 0;
    unsigned long long tprev = (PROBE_T >= 0) ? __builtin_amdgcn_s_memrealtime() : 0ull, tprobe = 0ull, tmark = 0ull; (void)tmark;
    volatile __attribute__((address_space(3))) unsigned* bst = (volatile __attribute__((address_space(3))) unsigned*)(ldsp + LDS_BYTES_K - 64);
    if (threadIdx.x == 0) { bst[0] = 0u; bst[1] = 0u; }
    __syncthreads();
    const XcdBarrier xbar = xcd_barrier_post((unsigned*)(ws + WS_CTL), bst);
#define PM(k) do { if (PROBE_T == 100 + (k)) tmark = __builtin_amdgcn_s_memrealtime(); } while (0)
#define PME(k) do { if (PROBE_T == 100 + (k)) tprobe += __builtin_amdgcn_s_memrealtime() - tmark; } while (0)
#define PHASE_BEGIN if (lo <= ph && ph < hi) { for (int rep_ = 0; rep_ < ((((unsigned)PROBE_MASK >> ph) & 1u) ? 2 : 1); ++rep_) { const int tid = wid_s * 64 + lane_fresh(); const int lane = tid & 63, wave = tid >> 6, gw = bid * 8 + wave; (void)lane; (void)wave; (void)gw;
#define PHASE_END } } if (lo <= ph && ph + 1 < hi) xcd_barrier(xbar, wid_s * 64 + lane_fresh()); if (PROBE_T >= 0) { const unsigned long long tn_ = __builtin_amdgcn_s_memrealtime(); if (ph == PROBE_T) tprobe = tn_ - tprev; tprev = tn_; } ++ph;

    PHASE_BEGIN
    {
        const size_t n4 = (size_t)T * D / 4, stride = (size_t)G * 512;
        for (size_t i0 = (size_t)bid * 512 + tid; i0 < n4; i0 += 8 * stride) { f32x4 v[8];
#pragma unroll
            for (int q = 0; q < 8; ++q) { const size_t i = i0 + q * stride; v[q] = (i < n4) ? __builtin_nontemporal_load((const f32x4*)x + i) : (f32x4){0.f, 0.f, 0.f, 0.f}; }
#pragma unroll
            for (int q = 0; q < 8; ++q) { const size_t i = i0 + q * stride; if (i < n4) { u32x2 w; w.x = pk2(v[q].x, v[q].y); w.y = pk2(v[q].z, v[q].w); ((u32x2*)xb)[i] = w; } } } }
    for (size_t i = (size_t)bid * 512 + tid; i < (size_t)NMEM * D / 4; i += (size_t)G * 512) { const f32x4 v = ((const f32x4*)mem)[i]; u32x2 w; w.x = pk2(v.x, v.y); w.y = pk2(v.z, v.w); ((u32x2*)memb)[i] = w; }
    {
        LAS float* scr = (LAS float*)(ldsp + wave * 16384);
        constexpr int I_IN = 16 * 56, I_KV = 16 * 64;
        for (int it = gw; it < I_IN + I_KV; it += NGW) { int r = it;
            if (r < I_IN) { const int kb = r / 56, nb = r % 56, n0 = nb * 32; const int dr = n0 < 512 ? (n0 >> 7) * 256 + (n0 & 127) : (n0 < 1024 ? ((n0 - 512) >> 7) * 256 + 128 + (n0 & 127) : n0);
                transpose_item(w_in, D_IN, Wt_in, 1024, kb * 64, n0, dr, scr, lane); continue; } r -= I_IN;
            transpose_item(w_mkv, 2048, Wt_mkv, 1024, (r / 64) * 64, (r % 64) * 32, (r % 64) * 32, scr, lane); }
    }
    PHASE_END

    PHASE_BEGIN
    for (int pass = 0; pass < 2; ++pass) {
      if ((pass == 0) == ((bid & 1) == 0)) {
        const int tl = wid_s * 64 + lane_fresh(), ll = tl & 63, wl = tl >> 6;
        LAS float* scr = (LAS float*)(ldsp + wl * 16384);
        constexpr int I_SQ = 16 * 32, I_EX = 16 * 256, N_T = 2 * I_SQ + 3 * I_EX, N_Q = 1024, N_B = 256, N_ALL = N_T + N_Q + N_B;
        int nb2 = 464 - G; nb2 = nb2 < 0 ? 0 : (nb2 > G ? G : nb2);
        const int NVB = nb2 + (G - nb2) * 3, nmine = (bid < nb2) ? 1 : 3, vb0 = (bid < nb2) ? bid : nb2 + (bid - nb2) * 3;
        auto decode = [&](int r, TItem& t) {
            if (r < I_SQ) { t = TItem{w_out, Wt_out, nullptr, 1024, 1024, (r / 32) * 64, (r % 32) * 32, (r % 32) * 32}; return; } r -= I_SQ;
            if (r < I_SQ) { t = TItem{w_mo, Wt_mo, nullptr, 1024, 1024, (r / 32) * 64, (r % 32) * 32, (r % 32) * 32}; return; } r -= I_SQ;
            if (r < I_EX) { const int e = r / 256, q = r % 256, n0 = (q % 16) * 32; t = TItem{w_gate + (size_t)e * D * DE, Wt_gu + (size_t)e * 1024 * 1024, nullptr, DE, 1024, (q / 16) * 64, n0, (n0 >> 7) * 256 + (n0 & 127)}; return; } r -= I_EX;
            if (r < I_EX) { const int e = r / 256, q = r % 256, n0 = (q % 16) * 32; t = TItem{w_up + (size_t)e * D * DE, Wt_gu + (size_t)e * 1024 * 1024, nullptr, DE, 1024, (q / 16) * 64, n0, (n0 >> 7) * 256 + 128 + (n0 & 127)}; return; } r -= I_EX;
            { const int e = r / 256, q = r % 256; t = TItem{w_down + (size_t)e * DE * D, Wt_dn + (size_t)e * 1024 * 512, nullptr, D, 512, (q / 32) * 64, (q % 32) * 32, (q % 32) * 32}; } };
        for (int vk = 0; vk < nmine; ++vk) {
          int it = (vb0 + vk) * 8 + wl;
          for (; it + NVB * 8 < N_T; it += 2 * NVB * 8) {
              TItem ta, tb; decode(it, ta); decode(it + NVB * 8, tb); float wa[32], wb[32];
              titem_load(ta, wa, ll); titem_load(tb, wb, ll); titem_store(ta, wa, scr, ll); titem_store(tb, wb, scr, ll); }
          for (; it < N_ALL; it += NVB * 8) { int r = it;
            if (r < N_T) { TItem ta; decode(r, ta); float wa[32]; titem_load(ta, wa, ll); titem_store(ta, wa, scr, ll); continue; } r -= N_T;
            if (r < N_Q) {
                f32x4 v[4];
#pragma unroll
                for (int q = 0; q < 4; ++q) v[q] = ((const f32x4*)w_mq)[(size_t)r * 256 + ll + 64 * q];
                const float gk = g_ln1[r];
#pragma unroll
                for (int q = 0; q < 4; ++q) { const f32x4 t = v[q] * gk; u32x2 w; w.x = pk2(t.x, t.y); w.y = pk2(t.z, t.w); ((u32x2*)Wqb)[(size_t)r * 256 + ll + 64 * q] = w; }
                continue; } r -= N_Q;
            {
                f32x4 b4 = (f32x4){0.f, 0.f, 0.f, 0.f};
#pragma unroll 4
                for (int i2 = 0; i2 < 16; ++i2) { const int k = ll + 64 * i2; const f32x4 w = *(const f32x4*)(w_mq + (size_t)k * 1024 + 4 * r); b4 += w * b_ln1[k]; }
#pragma unroll
                for (int e = 0; e < 4; ++e) b4[e] = wave_sum(b4[e]);
                if (ll == 0) *(f32x4*)(bw1 + 4 * r) = b4; }
          }
        }
        __syncthreads();
      } else {
        struct SchedP1 { const char *xb, *win, *memb, *wkv; int G, c;
            __device__ __forceinline__ bool next(int i, pg8::Unit& u) const { const int L = i * G + c; u.aux = 0;
                if (L < 448) { pg8::tile_of(L, 64, 7, u.pm, u.pn); u.A = xb + (size_t)u.pm * 256 * 2048; u.B = win + (size_t)u.pn * 256 * 2048; u.kind = u.pn < 4 ? 0 : 1; return true; }
                if (L < 464) { const int r = L - 448; u.pm = r >> 3; u.pn = r & 7; u.A = memb + (size_t)u.pm * 256 * 2048; u.B = wkv + (size_t)u.pn * 256 * 2048; u.kind = 2; return true; }
                return false; } };
        const SchedP1 S{(const char*)xb, (const char*)Wt_in, (const char*)memb, (const char*)Wt_mkv, G, bid};
        const pg8::EpiP1 E{hglu, qkv, kvm, b_in};
        pg8::gemm_phase(wid_s * 64 + lane_fresh(), ldsp, pg8::Gemm{1024, 1024, 1024}, S, E);
      }
    }
    PHASE_END

    PHASE_BEGIN
    PM(0);
    {   constexpr int NCU = T / 32, NSU = BATCH * NKV * (SEQ / 128);
        u32x4 pre[8], kk[4], vq[4]; ConvW cw; conv_weights(w_dw, b_dw, g_cn, b_cn, tid, cw);
        if (bid < NCU) conv_load(hglu, bid, tid, pre);
        for (int cu = bid; cu < NCU; cu += G) {
            conv_stage(lds_raw, tid, pre); __syncthreads();
            if (cu + G < NCU) conv_load(hglu, cu + G, tid, pre);
            conv_unit(lds_raw, cw, ycat, cu, tid);
        }
        PME(0); PM(1);
        if (bid < NSU) swa_load(qkv, bid >> 7, (bid >> 6) & 1, bid & 63, tid, kk, vq);
        for (int u = bid; u < NSU; u += G) {
            swa_unit(lds_raw, qkv, sinks, ycat, u >> 7, (u >> 6) & 1, u & 63, tid, kk, vq, tprobe);
            if (u + G < NSU) swa_load(qkv, (u + G) >> 7, ((u + G) >> 6) & 1, (u + G) & 63, tid, kk, vq);
        }
    }
    PME(1);
    PM(2);
    {
        struct SchedMT { const char *kvm, *wq; int c;
            __device__ __forceinline__ bool next(int i, pg8::Unit& u) const { if (i > 0 || c < 0 || c >= 32) return false; const int b = c >> 4, h = (c >> 2) & 3, pn = c & 3; u.pm = h; u.pn = pn; u.aux = b; u.kind = 0;
                u.A = kvm + ((size_t)(b * 256) * 2048 + h * 256) * 2; u.B = wq + ((size_t)(pn * 256) * 1024 + h * 256) * 2; return true; } };
        struct SchedNT { const char *wo, *kvm; int c;
            __device__ __forceinline__ bool next(int i, pg8::Unit& u) const { if (i > 0 || c < 0 || c >= 32) return false; const int b = c >> 4, h = (c >> 2) & 3, pm = c & 3; u.pm = pm; u.pn = h; u.aux = b; u.kind = 0;
                u.A = wo + ((size_t)(pm * 256) * 1024 + h * 256) * 2; u.B = kvm + ((size_t)(b * 256) * 2048 + 1024 + h * 256) * 2; return true; } };
        const SchedMT S1{(const char*)kvm, (const char*)Wqb, bid}; const pg8::EpiPre E1{MT, csp};
        pg8::gemm_phase(wid_s * 64 + lane_fresh(), ldsp, pg8::Gemm{2048, 1024, 256}, S1, E1);
        const SchedNT S2{(const char*)Wt_mo, (const char*)kvm, bid - 32}; const pg8::EpiPre E2{NT, nullptr};
        pg8::gemm_phase(wid_s * 64 + lane_fresh(), ldsp, pg8::Gemm{1024, 2048, 256}, S2, E2);
    }
    PME(2);
    PHASE_END

    PHASE_BEGIN
    for (int r = gw; r < 2048; r += NGW) { const int b = r >> 10, hk = r & 1023, h = hk >> 8, key = hk & 255;
        const float c = wave_sum(lane < 16 ? csp[(size_t)r * 16 + lane] : 0.f);
        const u32x2 kk = *(const u32x2*)(kvm + (size_t)(b * 256 + key) * 2048 + h * 256 + 4 * lane); const f32x4 bq = *(const f32x4*)(bw1 + h * 256 + 4 * lane);
        const float w = wave_sum((bflo(kk.x) * bq[0] + bfhi(kk.x) * bq[1]) + (bflo(kk.y) * bq[2] + bfhi(kk.y) * bq[3]));
        if (lane == 0) { csS[r] = c; bwS[r] = w; } }
    { const pg8::DenseSched S{(const char*)ycat, (const char*)Wt_out, 64, 4, G, bid, (size_t)256 * 2048, (size_t)256 * 2048};
      const pg8::EpiResStats E{xb, x1b, stats1, ALPHA}; PM(7); pg8::gemm_phase(tid, ldsp, pg8::Gemm{1024, 1024, 1024}, S, E); PME(7); }
    PHASE_END
    PHASE_BEGIN
    {   struct SchedS { const char *z, *mt; int G, c;
            __device__ __forceinline__ bool next(int i, pg8::Unit& u) const { const int L = i * G + c; if (L >= 256) return false; pg8::tile_of(L, 64, 4, u.pm, u.pn); u.kind = 0; u.aux = u.pm >> 5;
                u.A = z + (size_t)u.pm * 256 * 2048; u.B = mt + ((size_t)u.aux * 1024 * 1024 + (size_t)u.pn * 256 * 1024) * 2; return true; } };
        const SchedS S{(const char*)x1b, (const char*)MT, G, bid};
        const pg8::EpiSoftmaxLn E{Pb2, (PG8_LAS float*)(ldsp + 131072), stats1, csS, bwS};
        PM(8); pg8::gemm_phase(tid, ldsp, pg8::Gemm{1024, 1024, 1024}, S, E); PME(8);
    }
    PHASE_END
    PHASE_BEGIN
    {   struct SchedN { const char *P, *nt; int G, c;
            __device__ __forceinline__ bool next(int i, pg8::Unit& u) const { const int L = i * G + c; if (L >= 256) return false; pg8::tile_of(L, 64, 4, u.pm, u.pn); u.kind = 0; u.aux = u.pm >> 5;
                u.A = P + (size_t)u.pm * 256 * 2048; u.B = nt + ((size_t)u.aux * 1024 * 1024 + (size_t)u.pn * 256 * 1024) * 2; return true; } };
        const SchedN S{(const char*)Pb2, (const char*)NT, G, bid};
        const pg8::EpiResLn E{z2b, x1b, stats1, g_ln1, b_ln1, ALPHA}; pg8::gemm_phase(tid, ldsp, pg8::Gemm{1024, 1024, 1024}, S, E);
    }
    PHASE_END
    const int TPB = (T + G - 1) / G;
    PHASE_BEGIN
    { const int t0 = bid * TPB, t1 = (t0 + TPB < T) ? t0 + TPB : T;
      float* Wl = ldsf;
      int* le = (int*)(lds_raw + 81920);
      for (int k = tid; k < D; k += 512) { const f32x4 wg = *(const f32x4*)(w_group + (size_t)k * 4);
          Wl[0 * D + k] = wg.x; Wl[1 * D + k] = wg.y; Wl[2 * D + k] = wg.z; Wl[3 * D + k] = wg.w;
#pragma unroll
          for (int gq = 0; gq < 4; ++gq) { const f32x4 wr = *(const f32x4*)(w_router + ((size_t)gq * D + k) * 4);
              Wl[(4 + gq * 4 + 0) * D + k] = wr.x; Wl[(4 + gq * 4 + 1) * D + k] = wr.y; Wl[(4 + gq * 4 + 2) * D + k] = wr.z; Wl[(4 + gq * 4 + 3) * D + k] = wr.w; } }
      __syncthreads();
      PM(4);
      const int TPW = (TPB + 7) / 8;
      const int mend = (t0 + (wave + 1) * TPW < t1) ? t0 + (wave + 1) * TPW : t1;
      float bgr[4], brt[16];
#pragma unroll
      for (int i = 0; i < 4; ++i) bgr[i] = b_group[i];
#pragma unroll
      for (int i = 0; i < 16; ++i) brt[i] = b_router[i];
      f32x4 raw[2][4];
      { const int mb0 = t0 + wave * TPW; if (mb0 < mend) { ld_row_bf16(z2b + (size_t)mb0 * D, raw[0], lane); ld_row_bf16(z2b + (size_t)((mb0 + 1 < mend) ? mb0 + 1 : mb0) * D, raw[1], lane); } }
      for (int mb = t0 + wave * TPW; mb < mend; mb += 2) {
        f32x4 v[2][4];
        const bool has1 = (mb + 1 < mend);
#pragma unroll
        for (int jj = 0; jj < 4; ++jj) { v[0][jj] = raw[0][jj]; v[1][jj] = raw[1][jj]; }
        if (mb + 2 < mend) { ld_row_bf16(z2b + (size_t)(mb + 2) * D, raw[0], lane); ld_row_bf16(z2b + (size_t)((mb + 3 < mend) ? mb + 3 : mb + 2) * D, raw[1], lane); }
        ln_regs(v[0], g_ln2, b_ln2, lane);
        st_row_bf16(x2b + (size_t)mb * D, v[0], lane);
        ln_regs(v[1], g_ln2, b_ln2, lane);
        if (has1) st_row_bf16(x2b + (size_t)(mb + 1) * D, v[1], lane);
        float pa[20], pb[20];
#pragma unroll
        for (int c = 0; c < 20; ++c) {
            typedef float f32x2 __attribute__((ext_vector_type(2)));
            f32x2 p0 = (f32x2){0.f, 0.f}, p1 = p0;
#pragma unroll
            for (int jj = 0; jj < 4; ++jj) { const f32x4 w4 = ((const f32x4*)(Wl + c * D))[lane + 64 * jj]; const f32x2 wl2 = (f32x2){w4.x, w4.y}, wh2 = (f32x2){w4.z, w4.w};
                p0 = __builtin_elementwise_fma((f32x2){v[0][jj].x, v[0][jj].y}, wl2, p0); p0 = __builtin_elementwise_fma((f32x2){v[0][jj].z, v[0][jj].w}, wh2, p0);
                p1 = __builtin_elementwise_fma((f32x2){v[1][jj].x, v[1][jj].y}, wl2, p1); p1 = __builtin_elementwise_fma((f32x2){v[1][jj].z, v[1][jj].w}, wh2, p1); }
            pa[c] = p0.x + p0.y; pb[c] = p1.x + p1.y;
        }
        float* red = (float*)(lds_raw + 98304) + wave * 64;
        red[lane] = reduce40(pa, pb, lane);
        asm volatile("s_waitcnt lgkmcnt(0)" ::: "memory");
        float my[20];
#pragma unroll
        for (int c = 0; c < 20; ++c) { constexpr int mm[5] = {0, 1, 2, 4, 5}; my[c] = red[32 * (lane & 1) + 16 * (c / 10) + 8 * ((c % 10) / 5) + mm[c % 5]]; }
        asm volatile("s_waitcnt lgkmcnt(0)" ::: "memory");
        const int m = mb + lane;
        if (lane < 2 && m < mend) {
            float gl[4]; int gi = 0; float gmx = -INFINITY;
#pragma unroll
            for (int i = 0; i < 4; ++i) { gl[i] = my[i] + bgr[i]; if (gl[i] > gmx) { gmx = gl[i]; gi = i; } }
            float gs = 0.f;
#pragma unroll
            for (int i = 0; i < 4; ++i) gs += __expf(gl[i] - gmx);
            const float gp = 1.f / gs;
            float el[4];
#pragma unroll
            for (int i = 0; i < 4; ++i) { float a = my[4 + i], bq = brt[i];
                a = (gi == 1) ? my[8 + i] : a; a = (gi == 2) ? my[12 + i] : a; a = (gi == 3) ? my[16 + i] : a;
                bq = (gi == 1) ? brt[4 + i] : bq; bq = (gi == 2) ? brt[8 + i] : bq; bq = (gi == 3) ? brt[12 + i] : bq;
                el[i] = a + bq; }
            int i0 = 0; float v0 = el[0];
#pragma unroll
            for (int i = 1; i < 4; ++i) if (el[i] > v0) { v0 = el[i]; i0 = i; }
            int i1 = -1; float v1 = -INFINITY;
#pragma unroll
            for (int i = 0; i < 4; ++i) if (i != i0 && el[i] > v1) { v1 = el[i]; i1 = i; }
            const float w0 = 1.f / (1.f + __expf(v1 - v0)), w1 = 1.f - w0;
            route_e[2 * m] = gi * 4 + i0; route_e[2 * m + 1] = gi * 4 + i1; route_g[2 * m] = gp * w0; route_g[2 * m + 1] = gp * w1;
            le[2 * (m - t0)] = gi * 4 + i0; le[2 * (m - t0) + 1] = gi * 4 + i1;
        }
      }
      __syncthreads();
      PME(4); PM(5);
      const int np = 2 * (t1 - t0);
      for (int i = tid; i < np; i += 512) { const int e = le[i]; int r = 0; for (int j2 = 0; j2 < i; ++j2) r += (le[j2] == e) ? 1 : 0; rank[2 * t0 + i] = r; }
      if (tid < 16) { int c = 0; for (int j2 = 0; j2 < np; ++j2) c += (le[j2] == tid) ? 1 : 0; blkcnt[bid * 16 + tid] = c; }
      PME(5);
    }
    PHASE_END
    PHASE_BEGIN
    {
        int* sh = (int*)lds_raw;
        const int t0 = bid * TPB, t1 = (t0 + TPB < T) ? t0 + TPB : T, np = 2 * (t1 - t0);
        int my_e = 0, my_r = 0; float my_g = 0.f;
        if (tid < np) { const int pi = 2 * t0 + tid; my_e = route_e[pi]; my_r = rank[pi]; my_g = route_g[pi]; }
        { const int e = tid & 15, part = tid >> 4; int tot = 0, base = 0; int cv[8];
#pragma unroll
          for (int q = 0; q < 8; ++q) { const int b = part + 32 * q; cv[q] = (b < G) ? blkcnt[b * 16 + e] : 0; }
#pragma unroll
          for (int q = 0; q < 8; ++q) { const int b = part + 32 * q; tot += cv[q]; if (b < bid) base += cv[q]; }
          for (int b = part + 256; b < G; b += 32) { const int c = blkcnt[b * 16 + e]; tot += c; if (b < bid) base += c; }
          sh[128 + part * 16 + e] = tot; sh[640 + part * 16 + e] = base; }
        __syncthreads();
        if (tid < 16) { int tot = 0, base = 0;
#pragma unroll 8
            for (int part = 0; part < 32; ++part) { tot += sh[128 + part * 16 + tid]; base += sh[640 + part * 16 + tid]; } sh[tid] = base; sh[64 + tid] = tot; }
        __syncthreads();
        if (tid == 0) { int sacc = 0, nF = 0, nH = 0;
            for (int e = 0; e < 16; ++e) { const int n = sh[64 + e], nf = n >> 8, nh = ((n & 255) + 127) >> 7; sh[16 + e] = sacc; sacc += nf * 256 + nh * 128; nF += nf; nH += nh; }
            sh[32] = sacc;
            if (bid == 0) { segw[0] = nF; segw[1] = nH; int tf = 0, th = nF;
                for (int e = 0; e < 16; ++e) { const int n = sh[64 + e], nf = n >> 8, nh = ((n & 255) + 127) >> 7;
                    for (int k = 0; k < nf; ++k) { segw[2 + tf] = sh[16 + e] + 256 * k; segw[2 + 192 + tf] = e; ++tf; }
                    for (int k = 0; k < nh; ++k) { segw[2 + th] = sh[16 + e] + 256 * nf + 128 * k; segw[2 + 192 + th] = e; ++th; } } } }
        __syncthreads();
        if (bid == 0) { for (int e = 0; e < 16; ++e) for (int pos = sh[16 + e] + sh[64 + e] + tid; pos < sh[16 + e + 1]; pos += 512) { pair_tok[pos] = -1; pair_gate[pos] = 0.f; } }
        if (tid < np) { const int pi = 2 * t0 + tid, pos = sh[16 + my_e] + sh[my_e] + my_r; pair_tok[pos] = pi >> 1; pair_gate[pos] = my_g; tokpos[pi] = pos; }
    }
    PHASE_END
    PHASE_BEGIN
    { const SchedMoE S{(const char*)x2b, (const char*)Wt_gu, segw, pair_tok, segw[0], segw[1], G, bid, (size_t)2048, (size_t)1024 * 2048, (size_t)256 * 2048};
      const pg8::EpiGateUp E{Hs, pair_gate}; PM(6); pg8::gemm_phase<true, true>(tid, ldsp, pg8::Gemm{1024, 1024, 1024}, S, E); PME(6); }
    PHASE_END
    PHASE_BEGIN
    { const SchedMoE S{(const char*)Hs, (const char*)Wt_dn, segw, nullptr, segw[0], segw[1], G, bid, (size_t)1024, (size_t)1024 * 1024, (size_t)256 * 1024};
      const pg8::EpiY E{Yb}; PM(9); pg8::gemm_phase<false, true>(tid, ldsp, pg8::Gemm{512, 512, 512}, S, E); PME(9); }
    PHASE_END
    PHASE_BEGIN
    for (int mbase = gw; mbase < T; mbase += 8 * NGW) {
        int tp = 0;
        if (lane < 16) { const int mm = mbase + (lane >> 1) * NGW; if (mm < T) tp = tokpos[2 * mm + (lane & 1)]; }
        u32x2 xa[4], ya[4], yb[4];
#define P9_LOAD(mm, ii) do { const int p0_ = __builtin_amdgcn_readlane(tp, 2 * (ii)), p1_ = __builtin_amdgcn_readlane(tp, 2 * (ii) + 1); \
        _Pragma("unroll") for (int jj = 0; jj < 4; ++jj) { xa[jj] = ((const u32x2*)(x2b + (size_t)(mm) * D))[lane + 64 * jj]; ya[jj] = ((const u32x2*)(Yb + (size_t)p0_ * D))[lane + 64 * jj]; yb[jj] = ((const u32x2*)(Yb + (size_t)p1_ * D))[lane + 64 * jj]; } } while (0)
        P9_LOAD(mbase, 0);
        for (int i = 0; i < 8; ++i) { const int m = mbase + i * NGW; if (m >= T) break;
            f32x4 v[4]; float sacc = 0.f;
#pragma unroll
            for (int jj = 0; jj < 4; ++jj) { f32x4 z;
                z.x = bflo(xa[jj].x) * ALPHA + (bflo(ya[jj].x) + bflo(yb[jj].x)); z.y = bfhi(xa[jj].x) * ALPHA + (bfhi(ya[jj].x) + bfhi(yb[jj].x));
                z.z = bflo(xa[jj].y) * ALPHA + (bflo(ya[jj].y) + bflo(yb[jj].y)); z.w = bfhi(xa[jj].y) * ALPHA + (bfhi(ya[jj].y) + bfhi(yb[jj].y)); v[jj] = z; sacc += (z.x + z.y) + (z.z + z.w); }
            if (i + 1 < 8 && m + NGW < T) P9_LOAD(m + NGW, i + 1);
            const float mean = wave_sum(sacc) * (1.f / D); float s2 = 0.f;
#pragma unroll
            for (int jj = 0; jj < 4; ++jj) { v[jj] = v[jj] - mean; s2 += (v[jj].x * v[jj].x + v[jj].y * v[jj].y) + (v[jj].z * v[jj].z + v[jj].w * v[jj].w); }
            const float rstd = 1.f / sqrtf(wave_sum(s2) * (1.f / D) + LN_EPS);
            float* row = out + (size_t)m * D;
#pragma unroll
            for (int jj = 0; jj < 4; ++jj) { const f32x4 gg = ((const f32x4*)g_ln3)[lane + 64 * jj], bb = ((const f32x4*)b_ln3)[lane + 64 * jj]; ((f32x4*)row)[lane + 64 * jj] = v[jj] * rstd * gg + bb; } }
#undef P9_LOAD
    }
    PHASE_END
    if (PROBE_T >= 0 && blockIdx.x == 0) { const unsigned long long tend = __builtin_amdgcn_s_memrealtime() + 9ull * tprobe; while (__builtin_amdgcn_s_memrealtime() < tend) __builtin_amdgcn_s_sleep(8); }
}

constexpr int N_PHASES = 11;
constexpr int LDS_BYTES = 147456;

extern "C" void kernel_launch(void* const* d_in, const int* in_sizes, int n_in, void* d_out, int out_size, void* d_ws, size_t ws_size, hipStream_t stream) {
    static int grid = 0;
    if (grid == 0) {
        int dev = 0, cus = 0, per_cu = 0;
        hipGetDevice(&dev);
        hipDeviceGetAttribute(&cus, hipDeviceAttributeMultiprocessorCount, dev);
        hipFuncSetAttribute((const void*)fwd_kernel, hipFuncAttributeMaxDynamicSharedMemorySize, LDS_BYTES);
        hipOccupancyMaxActiveBlocksPerMultiprocessor(&per_cu, (const void*)fwd_kernel, 512, LDS_BYTES);
        grid = cus * 1;
        if (per_cu < 1) { fprintf(stderr, "occupancy query returned %d: the persistent grid would not be resident; nothing launched\n", per_cu); grid = -1; }
        if (ws_size < WS_END) { fprintf(stderr, "workspace too small\n"); grid = -1; }
    }
    if (grid < 0) return;
    if (hipMemsetAsync((char*)d_ws + WS_CTL, 0, 65536, stream) != hipSuccess) { fprintf(stderr, "memset failed\n"); return; }
    Params p{};
    for (int i = 0; i < 26; ++i) p.in[i] = (const float*)d_in[i];
    p.out = (float*)d_out; p.ws = (unsigned char*)d_ws;
#if MK_N_LAUNCHES == 1
    p.ph_lo = 0; p.ph_hi = 64;
    void* args[] = {&p};
    hipError_t e = hipLaunchCooperativeKernel((const void*)fwd_kernel, dim3(grid), dim3(512), args, LDS_BYTES, stream);
    if (e != hipSuccess) fprintf(stderr, "cooperative launch failed: %s (grid %d)\n", hipGetErrorString(e), grid);
#else
    for (int ph = 0; ph < N_PHASES; ++ph) { p.ph_lo = ph; p.ph_hi = ph + 1; hipLaunchKernelGGL(fwd_kernel, dim3(grid), dim3(512), LDS_BYTES, stream, p); }
#endif
}
```

```cpp
#include <hip/hip_runtime.h>
#include <hip/hip_cooperative_groups.h>
#include <cstdio>
#include <cstdint>
namespace cg = cooperative_groups;

#ifndef PROBE_MASK
#define PROBE_MASK 0
#endif
#ifndef PROBE_T
#define PROBE_T -1
#endif
#ifndef MK_N_LAUNCHES
#define MK_N_LAUNCHES 1
#endif

typedef unsigned short bf16;
typedef float f32x4 __attribute__((ext_vector_type(4)));
typedef unsigned u32x4 __attribute__((ext_vector_type(4)));
typedef unsigned u32x2 __attribute__((ext_vector_type(2)));

constexpr int BATCH = 2, SEQ = 8192, D = 1024, T = BATCH * SEQ, MEM = 256, NMEM = BATCH * MEM;
constexpr int CONV_CH = 512, CONV_W = 31, NH = 8, NKV = 2, HD = 64, ATTN_W = 512, KV_W = 128, WINDOW = 128;
constexpr int D_IN = 1792, MH = 4, MHD = 256, NG = 4, EPG = 4, NE = 16, DE = 512;
constexpr float ALPHA = 1.189207115002721f, LN_EPS = 1e-5f;
constexpr int NPAIR = 2 * T, NPAIR_PAD = NPAIR + NE * 256;
constexpr int LDS_BYTES_K = 147456;

constexpr size_t MiB = 1u << 20;
constexpr size_t WS_CTL = 0;
constexpr size_t WS_ROUTE = 1 * MiB;
constexpr size_t WS_BLKCNT = 1 * MiB + 512 * 1024;
constexpr size_t WS_SEG = 1 * MiB + 640 * 1024;
constexpr size_t WS_RANK = 2 * MiB;
constexpr size_t WS_PTOK = 2 * MiB + 256 * 1024;
constexpr size_t WS_PGATE = 2 * MiB + 512 * 1024;
constexpr size_t WS_TOKPOS = 2 * MiB + 768 * 1024;
constexpr size_t WS_KVM = 3 * MiB;
constexpr size_t WS_MEMB = 5 * MiB;
constexpr size_t WS_A = 8 * MiB;
constexpr size_t WS_B = 48 * MiB;
constexpr size_t WS_DD = 88 * MiB;
constexpr size_t WS_WIN = 164 * MiB;
constexpr size_t WS_WOUT = 168 * MiB, WS_WMQ = 170 * MiB, WS_WMKV = 172 * MiB, WS_WMO = 176 * MiB;
constexpr size_t WS_WGU = 178 * MiB;
constexpr size_t WS_WDN = 210 * MiB;
constexpr size_t WS_ST1 = 226 * MiB;
constexpr size_t WS_CS1 = 128 * 1024;
constexpr size_t WS_MT = 228 * MiB;
constexpr size_t WS_NT = 232 * MiB;
constexpr size_t WS_CSS = 192 * 1024;
constexpr size_t WS_CSP = 256 * 1024;
constexpr size_t WS_END = 236 * MiB;

struct Params { const float* in[26]; float* out; unsigned char* ws; int ph_lo, ph_hi; };

__device__ __forceinline__ unsigned f2bf(float f) { unsigned u = __builtin_bit_cast(unsigned, f); return (u + 0x7fffu + ((u >> 16) & 1u)) >> 16; }
__device__ __forceinline__ float bf2f(bf16 b) { return __builtin_bit_cast(float, (unsigned)b << 16); }
__device__ __forceinline__ unsigned pk2(float lo, float hi) { return f2bf(lo) | (f2bf(hi) << 16); }
template <int CTRL, int ROWMASK> __device__ __forceinline__ float dpp_f(float v) { return __builtin_bit_cast(float, __builtin_amdgcn_update_dpp(0, __builtin_bit_cast(int, v), CTRL, ROWMASK, 0xF, false)); }
__device__ __forceinline__ float wave_sum(float v) {
    v += dpp_f<0xB1, 0xF>(v);
    v += dpp_f<0x4E, 0xF>(v);
    v += dpp_f<0x141, 0xF>(v);
    v += dpp_f<0x140, 0xF>(v);
    v += dpp_f<0x142, 0xA>(v);
    v += dpp_f<0x143, 0xC>(v);
    return __builtin_bit_cast(float, __builtin_amdgcn_readlane(__builtin_bit_cast(int, v), 63));
}
__device__ __forceinline__ float wave_max(float v) {
    v = fmaxf(v, __builtin_bit_cast(float, __builtin_amdgcn_update_dpp(__builtin_bit_cast(int, v), __builtin_bit_cast(int, v), 0xB1, 0xF, 0xF, false)));
    v = fmaxf(v, __builtin_bit_cast(float, __builtin_amdgcn_update_dpp(__builtin_bit_cast(int, v), __builtin_bit_cast(int, v), 0x4E, 0xF, 0xF, false)));
    v = fmaxf(v, __builtin_bit_cast(float, __builtin_amdgcn_update_dpp(__builtin_bit_cast(int, v), __builtin_bit_cast(int, v), 0x141, 0xF, 0xF, false)));
    v = fmaxf(v, __builtin_bit_cast(float, __builtin_amdgcn_update_dpp(__builtin_bit_cast(int, v), __builtin_bit_cast(int, v), 0x140, 0xF, 0xF, false)));
    v = fmaxf(v, __builtin_bit_cast(float, __builtin_amdgcn_update_dpp(__builtin_bit_cast(int, v), __builtin_bit_cast(int, v), 0x142, 0xA, 0xF, false)));
    v = fmaxf(v, __builtin_bit_cast(float, __builtin_amdgcn_update_dpp(__builtin_bit_cast(int, v), __builtin_bit_cast(int, v), 0x143, 0xC, 0xF, false)));
    return __builtin_bit_cast(float, __builtin_amdgcn_readlane(__builtin_bit_cast(int, v), 63));
}
__device__ __forceinline__ int lane_fresh() { int l; asm volatile("v_mbcnt_lo_u32_b32 %0, -1, 0\n\tv_mbcnt_hi_u32_b32 %0, -1, %0" : "=v"(l)); return l; }


template <int CTRL> __device__ __forceinline__ float dpp_mov(float v) { return __builtin_bit_cast(float, __builtin_amdgcn_update_dpp(0, __builtin_bit_cast(int, v), CTRL, 0xF, 0xF, false)); }
__device__ __forceinline__ float reduce40(const float (&p0)[20], const float (&p1)[20], int lane) {
    float r5[20];
#pragma unroll
    for (int c = 0; c < 20; ++c) { float a = p0[c], b = p1[c];
        asm volatile("s_nop 1\n\tv_permlane32_swap_b32 %0, %1\n\ts_nop 1" : "+v"(a), "+v"(b));
        r5[c] = a + b; }
    float r4[10];
#pragma unroll
    for (int c = 0; c < 10; ++c) { float a = r5[c], b = r5[c + 10];
        asm volatile("s_nop 1\n\tv_permlane16_swap_b32 %0, %1\n\ts_nop 1" : "+v"(a), "+v"(b));
        r4[c] = a + b; }
    const bool b3 = (lane & 8) != 0, b2 = (lane & 4) != 0, b1 = (lane & 2) != 0, b0 = (lane & 1) != 0;
    float r3[5];
#pragma unroll
    for (int c = 0; c < 5; ++c) { const float a = r4[c] + dpp_mov<0x128>(r4[c]), b = r4[c + 5] + dpp_mov<0x128>(r4[c + 5]); r3[c] = b3 ? b : a; }
    float r2[3];
    { const float a0 = r3[0] + dpp_mov<0x141>(r3[0]), a3 = r3[3] + dpp_mov<0x141>(r3[3]), a1 = r3[1] + dpp_mov<0x141>(r3[1]), a4 = r3[4] + dpp_mov<0x141>(r3[4]);
      r2[0] = b2 ? a3 : a0; r2[1] = b2 ? a4 : a1; r2[2] = r3[2] + dpp_mov<0x141>(r3[2]); }
    float r1[2];
    { const float a0 = r2[0] + dpp_mov<0x4E>(r2[0]), a2 = r2[2] + dpp_mov<0x4E>(r2[2]); r1[0] = b1 ? a2 : a0; r1[1] = r2[1] + dpp_mov<0x4E>(r2[1]); }
    const float a0 = r1[0] + dpp_mov<0xB1>(r1[0]), a1 = r1[1] + dpp_mov<0xB1>(r1[1]);
    return b0 ? a1 : a0;
}

__device__ __forceinline__ void ln_row(const float* src, const float* g, const float* b, f32x4 (&v)[4], int lane) {
    const f32x4* xr = (const f32x4*)src + lane; float s = 0.f;
#pragma unroll
    for (int j = 0; j < 4; ++j) { v[j] = xr[64 * j]; s += (v[j].x + v[j].y) + (v[j].z + v[j].w); }
    const float mean = wave_sum(s) * (1.f / D); float s2 = 0.f;
#pragma unroll
    for (int j = 0; j < 4; ++j) { v[j] = v[j] - mean; s2 += (v[j].x * v[j].x + v[j].y * v[j].y) + (v[j].z * v[j].z + v[j].w * v[j].w); }
    const float rstd = 1.f / sqrtf(wave_sum(s2) * (1.f / D) + LN_EPS);
#pragma unroll
    for (int j = 0; j < 4; ++j) { const f32x4 gg = ((const f32x4*)g)[lane + 64 * j], bb = ((const f32x4*)b)[lane + 64 * j]; v[j] = v[j] * rstd * gg + bb; }
}
__device__ __forceinline__ void ld_row(const float* src, f32x4 (&v)[4], int lane) {
#pragma unroll
    for (int j = 0; j < 4; ++j) v[j] = ((const f32x4*)src)[lane + 64 * j];
}
__device__ __forceinline__ void ld_row_bf16(const bf16* src, f32x4 (&v)[4], int lane) {
#pragma unroll
    for (int j = 0; j < 4; ++j) { const u32x2 q = ((const u32x2*)src)[lane + 64 * j];
        v[j] = (f32x4){__builtin_bit_cast(float, q.x << 16), __builtin_bit_cast(float, q.x & 0xffff0000u), __builtin_bit_cast(float, q.y << 16), __builtin_bit_cast(float, q.y & 0xffff0000u)}; }
}
__device__ __forceinline__ void ln_regs(f32x4 (&v)[4], const float* g, const float* b, int lane) {
    float s = 0.f;
#pragma unroll
    for (int j = 0; j < 4; ++j) s += (v[j].x + v[j].y) + (v[j].z + v[j].w);
    const float mean = wave_sum(s) * (1.f / D); float s2 = 0.f;
#pragma unroll
    for (int j = 0; j < 4; ++j) { v[j] = v[j] - mean; s2 += (v[j].x * v[j].x + v[j].y * v[j].y) + (v[j].z * v[j].z + v[j].w * v[j].w); }
    const float rstd = 1.f / sqrtf(wave_sum(s2) * (1.f / D) + LN_EPS);
#pragma unroll
    for (int j = 0; j < 4; ++j) { const f32x4 gg = ((const f32x4*)g)[lane + 64 * j], bb = ((const f32x4*)b)[lane + 64 * j]; v[j] = v[j] * rstd * gg + bb; }
}
__device__ __forceinline__ void st_row_f32(float* dst, const f32x4 (&v)[4], float scale, int lane) {
#pragma unroll
    for (int j = 0; j < 4; ++j) ((f32x4*)dst)[lane + 64 * j] = v[j] * scale;
}
__device__ __forceinline__ void st_row_bf16(bf16* dst, const f32x4 (&v)[4], int lane) {
#pragma unroll
    for (int j = 0; j < 4; ++j) { u32x2 w; w.x = pk2(v[j].x, v[j].y); w.y = pk2(v[j].z, v[j].w); ((u32x2*)dst)[lane + 64 * j] = w; }
}


namespace pg8 {
#define PG8_LAS __attribute__((address_space(3)))
typedef unsigned short bf16_t;
typedef short bf16x8 __attribute__((ext_vector_type(8)));
constexpr int BM = 256, BK = 64, HALF = 128, HTB = HALF * BK * 2, STAGE_BYTES = 8 * HTB, NXCD = 8, WGM = 8;
__device__ __forceinline__ int lds_byte(int r, int c) { const int st = (r >> 4) * 2 + (c >> 5), rr = r & 15, cc = c & 31, ob = rr * 64 + cc * 2; return st * 1024 + (ob ^ (((ob >> 9) & 1) << 5)); }
__device__ __forceinline__ void stage_rc(int b, int& R, int& C) { const int st = b / 1024, sb = b % 1024, swz = sb ^ (((sb >> 9) & 1) << 5); R = (st >> 1) * 16 + swz / 64; C = (st & 1) * 32 + (swz % 64) / 2; }
__device__ __forceinline__ int perm32(int rho) { const int n = rho >> 4, i = rho & 15; return 8 * (i >> 2) + 4 * n + (i & 3); }
struct Unit { const char* A; const char* B; const int* rows; int pm, pn, kind, aux, rb, half; };
struct Gemm { int lda, ldb, K; };
__device__ __forceinline__ void tile_of(int L, int nM, int nN, int& pm, int& pn) {
    const int nwg = nM * nN; int wgid = L; { const int q = nwg / NXCD, r = nwg % NXCD, xcd = wgid % NXCD, off = wgid / NXCD; wgid = (xcd < r ? xcd * (q + 1) : r * (q + 1) + (xcd - r) * q) + off; }
    const int nig = WGM * nN, gid = wgid / nig, fm = gid * WGM, gsz = (nM - fm) < WGM ? (nM - fm) : WGM;
    pm = fm + ((wgid % nig) % gsz); pn = (wgid % nig) / gsz;
}
__device__ __forceinline__ unsigned cvt_pk_bf16(float lo, float hi) { unsigned r; asm volatile("v_cvt_pk_bf16_f32 %0, %1, %2" : "=v"(r) : "v"(lo), "v"(hi)); return r; }

template <bool GATHER = false, bool HALFU = false, class Epi, class Sched>
__device__ __forceinline__ void gemm_phase(int tid, PG8_LAS unsigned char* lds, const Gemm g, const Sched& S, const Epi& E) {
    const int wid = __builtin_amdgcn_readfirstlane(tid >> 6), lane = tid & 63, wr = wid >> 2, wc = wid & 3, fr = lane & 15, fq = lane >> 4;
    const int K = g.K, nt = K / BK;
    unsigned voffA[2], voffB[2]; int gR[2]; unsigned gC[2];
#pragma unroll
    for (int i = 0; i < 2; ++i) { int R, C; stage_rc(tid * 16 + i * 8192, R, C); const int Rb = Epi::PERM ? ((R & ~31) + perm32(R & 31)) : R;
        voffA[i] = (unsigned)(R * g.lda + C) * 2u; voffB[i] = (unsigned)(Rb * g.ldb + C) * 2u; gR[i] = R; gC[i] = (unsigned)C * 2u; }
    unsigned vgc[2][2], vgn[2][2];
    const size_t kstep = (size_t)(BK * 2);
    const size_t hstepA = (size_t)HALF * g.lda * 2, hstepB = (size_t)HALF * g.ldb * 2;
    const unsigned ldsw = (unsigned)wid * 1024u;
    const int aoff = lds_byte(wr * 64 + fr, fq * 8), boff = lds_byte(wc * 32 + fr, fq * 8);
#define PG8_SA(b, h) (((b) * 2 + (h)) * HTB)
#define PG8_SB(b, h) ((4 + (b) * 2 + (h)) * HTB)
#define PG8_STAGE(bufoff, gbase, voff) do { _Pragma("unroll") for (int _i = 0; _i < 2; ++_i) \
        __builtin_amdgcn_global_load_lds((const unsigned*)((const char*)(gbase) + (voff)[_i]), (PG8_LAS unsigned*)(lds + (bufoff) + ldsw + _i * 8192), 16, 0, 0); } while (0)
#define PG8_GOFF(dst, rows) do { _Pragma("unroll") for (int _h = 0; _h < 2; ++_h) _Pragma("unroll") for (int _i = 0; _i < 2; ++_i) { int _t = (rows)[_h * HALF + gR[_i]]; _t = _t < 0 ? 0 : _t; dst[_h][_i] = (unsigned)_t * (unsigned)(g.lda * 2) + gC[_i]; } } while (0)
#define PG8_STAGE_A(bufoff, h, kptr, useNext) do { if constexpr (GATHER) { unsigned _v[2]; _v[0] = (useNext) ? vgn[h][0] : vgc[h][0]; _v[1] = (useNext) ? vgn[h][1] : vgc[h][1]; PG8_STAGE(bufoff, kptr, _v); } \
        else { PG8_STAGE(bufoff, (kptr) + (h) * hstepA, voffA); } } while (0)
#define PG8_LDA(dst, b, h) do { _Pragma("unroll") for (int m = 0; m < 4; ++m) _Pragma("unroll") for (int k = 0; k < 2; ++k) dst[m][k] = *(const PG8_LAS bf16x8*)(lds + PG8_SA(b, h) + aoff + m * 2048 + k * 1024); } while (0)
#define PG8_LDB(dst, b, h) do { _Pragma("unroll") for (int n = 0; n < 2; ++n) _Pragma("unroll") for (int k = 0; k < 2; ++k) dst[n][k] = *(const PG8_LAS bf16x8*)(lds + PG8_SB(b, h) + boff + n * 2048 + k * 1024); } while (0)
#define PG8_MMA(ai, bj, At, Bt) do { __builtin_amdgcn_s_setprio(1); _Pragma("unroll") for (int m = 0; m < 4; ++m) _Pragma("unroll") for (int n = 0; n < 2; ++n) _Pragma("unroll") for (int k = 0; k < 2; ++k) \
        acc[ai][bj][m][n] = __builtin_amdgcn_mfma_f32_16x16x32_bf16(Bt[n][k], At[m][k], acc[ai][bj][m][n], 0, 0, 0); __builtin_amdgcn_s_setprio(0); } while (0)
#define PG8_WAIT_V(n) asm volatile("s_waitcnt vmcnt(" #n ")" ::: "memory")
#define PG8_WAIT_L(n) asm volatile("s_waitcnt lgkmcnt(" #n ")" ::: "memory")
#define PG8_BAR __builtin_amdgcn_s_barrier()
#define PG8_SCHED __builtin_amdgcn_sched_barrier(0)
    Unit cur, nxt; int ui = 0;
    if (!S.next(0, cur)) return;
    f32x4 acc[2][2][4][2];
#pragma unroll
    for (int a = 0; a < 2; ++a)
#pragma unroll
        for (int b = 0; b < 2; ++b)
#pragma unroll
            for (int m = 0; m < 4; ++m)
#pragma unroll
                for (int n = 0; n < 2; ++n) acc[a][b][m][n] = (f32x4){0.f, 0.f, 0.f, 0.f};
    bf16x8 At[4][2], B0[2][2], B1[2][2];
    const char* cA = cur.A; const char* cB = cur.B;
    if constexpr (GATHER) { PG8_GOFF(vgc, cur.rows); }
    PG8_STAGE(PG8_SB(0, 0), cB, voffB); PG8_STAGE(PG8_SB(0, 1), cB + hstepB, voffB); PG8_STAGE_A(PG8_SA(0, 0), 0, cA, false); PG8_STAGE_A(PG8_SA(0, 1), 1, cA, false);
    if (wr == 1) PG8_BAR;
    PG8_WAIT_V(2); PG8_BAR;
    PG8_STAGE(PG8_SB(1, 0), cB + kstep, voffB); PG8_STAGE_A(PG8_SA(1, 0), 0, cA + kstep, false); PG8_STAGE(PG8_SB(1, 1), cB + hstepB + kstep, voffB);
    PG8_WAIT_V(6); PG8_BAR;
    for (;;) {
        const bool has_next = S.next(ui + 1, nxt);
        const char* nA = has_next ? nxt.A : cA; const char* nB = has_next ? nxt.B : cB;
        if constexpr (GATHER) { if (has_next) { PG8_GOFF(vgn, nxt.rows); asm volatile("" : "+v"(vgn[0][0]), "+v"(vgn[0][1]), "+v"(vgn[1][0]), "+v"(vgn[1][1]));   } else { _Pragma("unroll") for (int _h = 0; _h < 2; ++_h) { vgn[_h][0] = vgc[_h][0]; vgn[_h][1] = vgc[_h][1]; } } }
        for (int t = 0; t < nt; t += 2) {
            const bool last = (t == nt - 2);
            const char* a1 = cA + (size_t)(t + 1) * kstep;
            const char* a2 = last ? nA : cA + (size_t)(t + 2) * kstep; const char* b2 = last ? nB : cB + (size_t)(t + 2) * kstep;
            const char* a3 = a2 + kstep; const char* b3 = b2 + kstep;
            PG8_LDB(B0, 0, 0); PG8_LDB(B1, 0, 1); PG8_SCHED; PG8_LDA(At, 0, 0); PG8_STAGE_A(PG8_SA(1, 1), 1, a1, false);
            PG8_WAIT_V(8); PG8_WAIT_L(0); PG8_BAR; PG8_MMA(0, 0, At, B0); PG8_MMA(0, 1, At, B1); PG8_BAR; PG8_SCHED;
            PG8_LDA(At, 0, 1); PG8_STAGE(PG8_SB(0, 0), b2, voffB); PG8_STAGE(PG8_SB(0, 1), b2 + hstepB, voffB); PG8_STAGE_A(PG8_SA(0, 0), 0, a2, last);
            PG8_WAIT_V(8); PG8_WAIT_L(0); PG8_BAR; if (!HALFU || !cur.half) { PG8_MMA(1, 0, At, B0); PG8_MMA(1, 1, At, B1); } PG8_BAR; PG8_SCHED;
            PG8_LDB(B0, 1, 0); PG8_LDB(B1, 1, 1); PG8_SCHED; PG8_LDA(At, 1, 0); PG8_STAGE_A(PG8_SA(0, 1), 1, a2, last);
            PG8_WAIT_V(8); PG8_WAIT_L(0); PG8_BAR; PG8_MMA(0, 0, At, B0); PG8_MMA(0, 1, At, B1); PG8_BAR; PG8_SCHED;
            PG8_LDA(At, 1, 1); PG8_STAGE(PG8_SB(1, 0), b3, voffB); PG8_STAGE(PG8_SB(1, 1), b3 + hstepB, voffB); PG8_STAGE_A(PG8_SA(1, 0), 0, a3, last);
            PG8_WAIT_V(8); PG8_WAIT_L(0); PG8_BAR; if (!HALFU || !cur.half) { PG8_MMA(1, 0, At, B0); PG8_MMA(1, 1, At, B1); } PG8_BAR; PG8_SCHED;
        }
        if (wr == 0) PG8_BAR;
        E(acc, cur, wr, wc, fr, fq);
        if (!has_next) break;
#pragma unroll
        for (int a = 0; a < 2; ++a)
#pragma unroll
            for (int b = 0; b < 2; ++b)
#pragma unroll
                for (int m = 0; m < 4; ++m)
#pragma unroll
                    for (int n = 0; n < 2; ++n) acc[a][b][m][n] = (f32x4){0.f, 0.f, 0.f, 0.f};
        cur = nxt; cA = nA; cB = nB; ++ui;
        if constexpr (GATHER) { _Pragma("unroll") for (int _h = 0; _h < 2; ++_h) { vgc[_h][0] = vgn[_h][0]; vgc[_h][1] = vgn[_h][1]; } }
        if (wr == 1) PG8_BAR;
    }
    PG8_WAIT_V(0);
    PG8_BAR;
#undef PG8_SA
#undef PG8_SB
#undef PG8_STAGE
#undef PG8_LDA
#undef PG8_GOFF
#undef PG8_STAGE_A
#undef PG8_LDB
#undef PG8_MMA
#undef PG8_WAIT_V
#undef PG8_WAIT_L
#undef PG8_BAR
#undef PG8_SCHED
}

__device__ __forceinline__ u32x4 pack8(const f32x4 v0, const f32x4 v1) { u32x4 w; w.x = cvt_pk_bf16(v0[0], v0[1]); w.y = cvt_pk_bf16(v0[2], v0[3]); w.z = cvt_pk_bf16(v1[0], v1[1]); w.w = cvt_pk_bf16(v1[2], v1[3]); return w; }
__device__ __forceinline__ float sigm(float g) { return __builtin_amdgcn_rcpf(1.f + __expf(-g)); }

struct EpiBf16 {
    static constexpr bool PERM = true;
    bf16_t* O; int ldc; const float* bias;
    __device__ __forceinline__ void operator()(const f32x4 (&acc)[2][2][4][2], const Unit& u, int wr, int wc, int fr, int fq) const {
        const int row0 = u.pm * BM + wr * 64 + fr, col0 = u.pn * BM + wc * 32 + 8 * fq;
        f32x4 bv[2][2];
#pragma unroll
        for (int bj = 0; bj < 2; ++bj)
#pragma unroll
            for (int n = 0; n < 2; ++n) bv[bj][n] = bias ? *(const f32x4*)(bias + col0 + bj * HALF + 4 * n) : (f32x4){0.f, 0.f, 0.f, 0.f};
#pragma unroll
        for (int ai = 0; ai < 2; ++ai)
#pragma unroll
            for (int m = 0; m < 4; ++m) { bf16_t* rowp = O + (size_t)(row0 + ai * HALF + m * 16) * ldc + col0;
#pragma unroll
                for (int bj = 0; bj < 2; ++bj) *(u32x4*)(rowp + bj * HALF) = pack8(acc[ai][bj][m][0] + bv[bj][0], acc[ai][bj][m][1] + bv[bj][1]); }
    }
};
struct EpiP1 {
    static constexpr bool PERM = true;
    bf16_t *hglu, *qkv, *kvm; const float* b_in;
    __device__ __forceinline__ void operator()(const f32x4 (&acc)[2][2][4][2], const Unit& u, int wr, int wc, int fr, int fq) const {
        if (u.kind == 0) {
            const int row0 = u.pm * BM + wr * 64 + fr, cb = u.pn * 128 + wc * 32 + 8 * fq;
            f32x4 ba[2], bg[2];
#pragma unroll
            for (int n = 0; n < 2; ++n) { ba[n] = *(const f32x4*)(b_in + cb + 4 * n); bg[n] = *(const f32x4*)(b_in + 512 + cb + 4 * n); }
#pragma unroll
            for (int ai = 0; ai < 2; ++ai)
#pragma unroll
                for (int m = 0; m < 4; ++m) { f32x4 h[2];
#pragma unroll
                    for (int n = 0; n < 2; ++n) { const f32x4 a = acc[ai][0][m][n] + ba[n], gt = acc[ai][1][m][n] + bg[n];
                        h[n] = (f32x4){a[0] * sigm(gt[0]), a[1] * sigm(gt[1]), a[2] * sigm(gt[2]), a[3] * sigm(gt[3])}; }
                    *(u32x4*)(hglu + (size_t)(row0 + ai * HALF + m * 16) * 512 + cb) = pack8(h[0], h[1]); }
        } else if (u.kind == 1) { EpiBf16 e{qkv - 1024, 768, b_in}; e(acc, u, wr, wc, fr, fq);
        } else { EpiBf16 e{kvm, 2048, nullptr}; e(acc, u, wr, wc, fr, fq); }
    }
};
struct EpiGateUp {
    static constexpr bool PERM = true;
    bf16_t* Hs; const float* pair_gate;
    __device__ __forceinline__ void operator()(const f32x4 (&acc)[2][2][4][2], const Unit& u, int wr, int wc, int fr, int fq) const {
        const int row0 = u.rb + wr * 64 + fr, cb = u.pn * 128 + wc * 32 + 8 * fq;
        float pgv[2][4];
#pragma unroll
        for (int ai = 0; ai < 2; ++ai)
#pragma unroll
            for (int m = 0; m < 4; ++m) pgv[ai][m] = (ai == 0 || !u.half) ? pair_gate[row0 + ai * HALF + m * 16] : 0.f;
#pragma unroll
        for (int ai = 0; ai < 2; ++ai) { if (ai == 1 && u.half) break;
#pragma unroll
            for (int m = 0; m < 4; ++m) { const int row = row0 + ai * HALF + m * 16; const float pg = pgv[ai][m]; f32x4 h[2];
#pragma unroll
                for (int n = 0; n < 2; ++n) { const f32x4 gt = acc[ai][0][m][n], up = acc[ai][1][m][n];
                    h[n] = (f32x4){gt[0] * sigm(gt[0]) * up[0] * pg, gt[1] * sigm(gt[1]) * up[1] * pg, gt[2] * sigm(gt[2]) * up[2] * pg, gt[3] * sigm(gt[3]) * up[3] * pg}; }
                if (pg == 0.f) { h[0] = (f32x4){0.f, 0.f, 0.f, 0.f}; h[1] = h[0]; }
                *(u32x4*)(Hs + (size_t)row * 512 + cb) = pack8(h[0], h[1]); } }
    }
};
struct EpiY {
    static constexpr bool PERM = true;
    bf16_t* Y;
    __device__ __forceinline__ void operator()(const f32x4 (&acc)[2][2][4][2], const Unit& u, int wr, int wc, int fr, int fq) const {
        const int row0 = u.rb + wr * 64 + fr, col0 = u.pn * BM + wc * 32 + 8 * fq;
#pragma unroll
        for (int ai = 0; ai < 2; ++ai) { if (ai == 1 && u.half) break;
#pragma unroll
            for (int m = 0; m < 4; ++m) { bf16_t* rowp = Y + (size_t)(row0 + ai * HALF + m * 16) * 1024 + col0;
#pragma unroll
                for (int bj = 0; bj < 2; ++bj) *(u32x4*)(rowp + bj * HALF) = pack8(acc[ai][bj][m][0], acc[ai][bj][m][1]); } }
    }
};
__device__ __forceinline__ void row_stats16(const float* stats, int row, int fq, float& mu, float& rstd) {
    const f32x4* sp = (const f32x4*)(stats + (size_t)row * 32 + fq * 8); const f32x4 a = sp[0], b = sp[1];
    float s = (a[0] + a[2]) + (b[0] + b[2]), ss = (a[1] + a[3]) + (b[1] + b[3]);
    s += __shfl_xor(s, 16); s += __shfl_xor(s, 32); ss += __shfl_xor(ss, 16); ss += __shfl_xor(ss, 32);
    mu = s * (1.f / 1024.f); const float var = ss * (1.f / 1024.f) - mu * mu; rstd = 1.f / sqrtf(var + 1e-5f);
}
__device__ __forceinline__ void row_stats16x4(const float* stats, int rowh, int fq, float (&mu)[4], float (&rstd)[4]) {
    f32x4 sa[4], sb[4];
#pragma unroll
    for (int m = 0; m < 4; ++m) { const f32x4* sp = (const f32x4*)(stats + (size_t)(rowh + m * 16) * 32 + fq * 8); sa[m] = sp[0]; sb[m] = sp[1]; }
#pragma unroll
    for (int m = 0; m < 4; ++m) { const f32x4 a = sa[m], b = sb[m];
        float s = (a[0] + a[2]) + (b[0] + b[2]), ss = (a[1] + a[3]) + (b[1] + b[3]);
        s += __shfl_xor(s, 16); s += __shfl_xor(s, 32); ss += __shfl_xor(ss, 16); ss += __shfl_xor(ss, 32);
        const float mm = s * (1.f / 1024.f); mu[m] = mm; rstd[m] = 1.f / sqrtf(ss * (1.f / 1024.f) - mm * mm + 1e-5f); }
}
struct EpiResStats {
    static constexpr bool PERM = true;
    const bf16_t* resb; bf16_t* zb; float* stats; float alpha;
    __device__ __forceinline__ void operator()(const f32x4 (&acc)[2][2][4][2], const Unit& u, int wr, int wc, int fr, int fq) const {
        const int row0 = u.pm * BM + wr * 64 + fr, col0 = u.pn * BM + wc * 32 + 8 * fq;
#pragma unroll
        for (int ai = 0; ai < 2; ++ai) {
            u32x4 rw[4][2];
#pragma unroll
            for (int m = 0; m < 4; ++m)
#pragma unroll
                for (int bj = 0; bj < 2; ++bj) rw[m][bj] = *(const u32x4*)(resb + (size_t)(row0 + ai * HALF + m * 16) * 1024 + col0 + bj * HALF);
#pragma unroll
            for (int m = 0; m < 4; ++m) { const int row = row0 + ai * HALF + m * 16; const size_t off = (size_t)row * 1024 + col0; float sm = 0.f, ss = 0.f;
#pragma unroll
                for (int bj = 0; bj < 2; ++bj) { const u32x4 q = rw[m][bj];
                    const f32x4 r0 = (f32x4){__builtin_bit_cast(float, q.x << 16), __builtin_bit_cast(float, q.x & 0xffff0000u), __builtin_bit_cast(float, q.y << 16), __builtin_bit_cast(float, q.y & 0xffff0000u)};
                    const f32x4 r1 = (f32x4){__builtin_bit_cast(float, q.z << 16), __builtin_bit_cast(float, q.z & 0xffff0000u), __builtin_bit_cast(float, q.w << 16), __builtin_bit_cast(float, q.w & 0xffff0000u)};
                    const f32x4 z0 = r0 * alpha + acc[ai][bj][m][0], z1 = r1 * alpha + acc[ai][bj][m][1];
                    *(u32x4*)(zb + off + bj * HALF) = pack8(z0, z1);
                    sm += ((z0[0] + z0[1]) + (z0[2] + z0[3])) + ((z1[0] + z1[1]) + (z1[2] + z1[3]));
                    ss += ((z0[0] * z0[0] + z0[1] * z0[1]) + (z0[2] * z0[2] + z0[3] * z0[3])) + ((z1[0] * z1[0] + z1[1] * z1[1]) + (z1[2] * z1[2] + z1[3] * z1[3])); }
                sm += __shfl_xor(sm, 16); sm += __shfl_xor(sm, 32); ss += __shfl_xor(ss, 16); ss += __shfl_xor(ss, 32);
                if (fq == 0) *(float2*)(stats + (size_t)row * 32 + (u.pn * 4 + wc) * 2) = make_float2(sm, ss); } }
    }
};
struct EpiResLn {
    static constexpr bool PERM = true;
    bf16_t* out; const bf16_t* zb; const float* stats; const float* g; const float* b; float alpha;
    __device__ __forceinline__ void operator()(const f32x4 (&acc)[2][2][4][2], const Unit& u, int wr, int wc, int fr, int fq) const {
        const int row0 = u.pm * BM + wr * 64 + fr, col0 = u.pn * BM + wc * 32 + 8 * fq;
        f32x4 gv[2][2], bv[2][2];
#pragma unroll
        for (int bj = 0; bj < 2; ++bj)
#pragma unroll
            for (int n = 0; n < 2; ++n) { gv[bj][n] = *(const f32x4*)(g + col0 + bj * HALF + 4 * n); bv[bj][n] = *(const f32x4*)(b + col0 + bj * HALF + 4 * n); }
#pragma unroll
        for (int ai = 0; ai < 2; ++ai) {
            float mu[4], rstd[4]; row_stats16x4(stats, row0 + ai * HALF, fq, mu, rstd);
            u32x4 zw[4][2];
#pragma unroll
            for (int m = 0; m < 4; ++m)
#pragma unroll
                for (int bj = 0; bj < 2; ++bj) zw[m][bj] = *(const u32x4*)(zb + (size_t)(row0 + ai * HALF + m * 16) * 1024 + col0 + bj * HALF);
#pragma unroll
            for (int m = 0; m < 4; ++m) { const size_t off = (size_t)(row0 + ai * HALF + m * 16) * 1024 + col0; const float mm = mu[m], rs = rstd[m];
#pragma unroll
                for (int bj = 0; bj < 2; ++bj) { const u32x4 q = zw[m][bj];
                    const f32x4 z0 = (f32x4){__builtin_bit_cast(float, q.x << 16), __builtin_bit_cast(float, q.x & 0xffff0000u), __builtin_bit_cast(float, q.y << 16), __builtin_bit_cast(float, q.y & 0xffff0000u)};
                    const f32x4 z1 = (f32x4){__builtin_bit_cast(float, q.z << 16), __builtin_bit_cast(float, q.z & 0xffff0000u), __builtin_bit_cast(float, q.w << 16), __builtin_bit_cast(float, q.w & 0xffff0000u)};
                    const f32x4 o0 = ((z0 - mm) * rs * gv[bj][0] + bv[bj][0]) * alpha + acc[ai][bj][m][0], o1 = ((z1 - mm) * rs * gv[bj][1] + bv[bj][1]) * alpha + acc[ai][bj][m][1];
                    *(u32x4*)(out + off + bj * HALF) = pack8(o0, o1); } } }
    }
};
struct EpiPre {
    static constexpr bool PERM = true;
    bf16_t* O; float* csp;
    __device__ __forceinline__ void operator()(const f32x4 (&acc)[2][2][4][2], const Unit& u, int wr, int wc, int fr, int fq) const {
        const int row0 = u.pm * BM + wr * 64 + fr, col0 = u.pn * BM + wc * 32 + 8 * fq;
#pragma unroll
        for (int ai = 0; ai < 2; ++ai)
#pragma unroll
            for (int m = 0; m < 4; ++m) { const int row = row0 + ai * HALF + m * 16; bf16_t* rowp = O + ((size_t)u.aux * 1024 + row) * 1024 + col0; float sm = 0.f;
#pragma unroll
                for (int bj = 0; bj < 2; ++bj) { const u32x4 w = pack8(acc[ai][bj][m][0], acc[ai][bj][m][1]); *(u32x4*)(rowp + bj * HALF) = w;
#pragma unroll
                    for (int e = 0; e < 4; ++e) sm += __builtin_bit_cast(float, w[e] << 16) + __builtin_bit_cast(float, w[e] & 0xffff0000u); }
                if (csp) { sm += __shfl_xor(sm, 16); sm += __shfl_xor(sm, 32); if (fq == 0) csp[((size_t)u.aux * 1024 + row) * 16 + u.pn * 4 + wc] = sm; } }
    }
};
struct EpiSoftmaxLn {
    static constexpr bool PERM = true;
    bf16_t* P; PG8_LAS float* xl; const float* stats; const float* cs; const float* bw;
    __device__ __forceinline__ void operator()(f32x4 (&acc)[2][2][4][2], const Unit& u, int wr, int wc, int fr, int fq) const {
        const float sc = 0.0625f * 1.4426950408889634f;
        const int row0 = u.pm * BM + wr * 64 + fr, col0 = u.pn * BM + wc * 32 + 8 * fq;
        unsigned xw = (unsigned)(size_t)(xl + ((wr * 64 + fr) * 4 + wc) * 2), xr = (unsigned)(size_t)(xl + (wr * 64 + fr) * 8);
        asm volatile("" : "+v"(xw), "+v"(xr));
        PG8_LAS float* const xwp = (PG8_LAS float*)(size_t)xw; const PG8_LAS float* const xrp = (const PG8_LAS float*)(size_t)xr;
        { f32x4 cv[2][2], wv[2][2];
#pragma unroll
          for (int bj = 0; bj < 2; ++bj)
#pragma unroll
            for (int n = 0; n < 2; ++n) { cv[bj][n] = *(const f32x4*)(cs + u.aux * 1024 + col0 + bj * HALF + 4 * n); wv[bj][n] = *(const f32x4*)(bw + u.aux * 1024 + col0 + bj * HALF + 4 * n); }
#pragma unroll
          for (int ai = 0; ai < 2; ++ai) { float mu8[4], rs8[4];
#pragma unroll
            for (int m = 0; m < 4; ++m) row_stats16(stats, row0 + ai * HALF + m * 16, fq, mu8[m], rs8[m]);
#pragma unroll
            for (int m = 0; m < 4; ++m) {
#pragma unroll
                for (int bj = 0; bj < 2; ++bj)
#pragma unroll
                    for (int n = 0; n < 2; ++n) acc[ai][bj][m][n] = (acc[ai][bj][m][n] - cv[bj][n] * mu8[m]) * rs8[m] + wv[bj][n]; } } }
#pragma unroll
        for (int ai = 0; ai < 2; ++ai)
#pragma unroll
            for (int m = 0; m < 4; ++m) { float mx = -INFINITY;
#pragma unroll
                for (int bj = 0; bj < 2; ++bj)
#pragma unroll
                    for (int n = 0; n < 2; ++n) { const f32x4 v = acc[ai][bj][m][n]; mx = fmaxf(mx, fmaxf(fmaxf(v[0], v[1]), fmaxf(v[2], v[3]))); }
                mx = fmaxf(mx, __shfl_xor(mx, 16)); mx = fmaxf(mx, __shfl_xor(mx, 32));
                float sm = 0.f;
#pragma unroll
                for (int bj = 0; bj < 2; ++bj)
#pragma unroll
                    for (int n = 0; n < 2; ++n) { const f32x4 v = acc[ai][bj][m][n];
                        const f32x4 e = (f32x4){__builtin_amdgcn_exp2f((v[0] - mx) * sc), __builtin_amdgcn_exp2f((v[1] - mx) * sc), __builtin_amdgcn_exp2f((v[2] - mx) * sc), __builtin_amdgcn_exp2f((v[3] - mx) * sc)};
                        acc[ai][bj][m][n] = e; sm += (e[0] + e[1]) + (e[2] + e[3]); }
                sm += __shfl_xor(sm, 16); sm += __shfl_xor(sm, 32);
                if (fq == 0) { PG8_LAS float* q = xwp + (ai * HALF + m * 16) * 8; q[0] = mx; q[1] = sm; } }
        asm volatile("s_waitcnt lgkmcnt(0)" ::: "memory"); __builtin_amdgcn_s_barrier(); asm volatile("" ::: "memory");
#pragma unroll
        for (int ai = 0; ai < 2; ++ai)
#pragma unroll
            for (int m = 0; m < 4; ++m) { const PG8_LAS f32x4* q = (const PG8_LAS f32x4*)(xrp + (ai * HALF + m * 16) * 8); const f32x4 q0 = q[0], q1 = q[1];
                const float M = fmaxf(fmaxf(q0[0], q0[2]), fmaxf(q1[0], q1[2]));
                const float S = (q0[1] * __builtin_amdgcn_exp2f((q0[0] - M) * sc) + q0[3] * __builtin_amdgcn_exp2f((q0[2] - M) * sc)) + (q1[1] * __builtin_amdgcn_exp2f((q1[0] - M) * sc) + q1[3] * __builtin_amdgcn_exp2f((q1[2] - M) * sc));
                const float mine = (wc == 0) ? q0[0] : (wc == 1) ? q0[2] : (wc == 2) ? q1[0] : q1[2];
                const float fac = __builtin_amdgcn_exp2f((mine - M) * sc) / S; bf16_t* rowp = P + (size_t)(row0 + ai * HALF + m * 16) * 1024 + col0;
#pragma unroll
                for (int bj = 0; bj < 2; ++bj) *(u32x4*)(rowp + bj * HALF) = pack8(acc[ai][bj][m][0] * fac, acc[ai][bj][m][1] * fac); }
        asm volatile("s_waitcnt lgkmcnt(0)" ::: "memory"); __builtin_amdgcn_s_barrier(); asm volatile("" ::: "memory");
    }
};
struct DenseSched {
    const char* A; const char* B; int nM, nN, G, c; size_t strideA, strideB;
    __device__ __forceinline__ bool next(int i, Unit& u) const { const int L = i * G + c; if (L >= nM * nN) return false; tile_of(L, nM, nN, u.pm, u.pn); u.A = A + (size_t)u.pm * strideA; u.B = B + (size_t)u.pn * strideB; u.kind = 0; u.aux = 0; u.rows = nullptr; return true; }
};
}


#define LAS __attribute__((address_space(3)))
struct TItem { const float* W; bf16* WT; const float* gk; int N, Kd, k0, n0, drow0; };
__device__ __forceinline__ void titem_load(const TItem& t, float (&wv)[32], int lane) {
#pragma unroll
    for (int i = 0; i < 32; ++i) { const int kk = 2 * i + (lane >> 5); wv[i] = __builtin_nontemporal_load(t.W + (size_t)(t.k0 + kk) * t.N + t.n0 + (lane & 31)); }
}
__device__ __forceinline__ void titem_store(const TItem& t, const float (&wv)[32], LAS float* scr, int lane) {
#pragma unroll
    for (int i = 0; i < 32; ++i) { const int kk = 2 * i + (lane >> 5); float v = wv[i]; if (t.gk) v *= t.gk[t.k0 + kk]; scr[kk * 33 + (lane & 31)] = v; }
    asm volatile("s_waitcnt lgkmcnt(0)" ::: "memory");
    const int c = lane & 7;
#pragma unroll
    for (int j = 0; j < 4; ++j) { const int n = (lane >> 3) + 8 * j; const LAS float* sp = scr + (8 * c) * 33 + n;
        u32x4 o; o.x = pk2(sp[0 * 33], sp[1 * 33]); o.y = pk2(sp[2 * 33], sp[3 * 33]); o.z = pk2(sp[4 * 33], sp[5 * 33]); o.w = pk2(sp[6 * 33], sp[7 * 33]);
        *(u32x4*)(t.WT + (size_t)(t.drow0 + n) * t.Kd + t.k0 + 8 * c) = o; }
    asm volatile("s_waitcnt lgkmcnt(0)" ::: "memory");
}
__device__ __forceinline__ void transpose_item(const float* W, int N, bf16* WT, int Kd, int k0, int n0, int drow0, LAS float* scr, int lane, const float* gk = nullptr) {
    const TItem t{W, WT, gk, N, Kd, k0, n0, drow0}; float wv[32]; titem_load(t, wv, lane); titem_store(t, wv, scr, lane);
}

typedef short bf16x8v __attribute__((ext_vector_type(8)));
__device__ __forceinline__ float bflo(unsigned v) { return __builtin_bit_cast(float, v << 16); }
__device__ __forceinline__ float bfhi(unsigned v) { return __builtin_bit_cast(float, v & 0xffff0000u); }

__device__ __forceinline__ void conv_load(const bf16* hglu, int cu, int tid, u32x4 (&pre)[8]) {
    const int t0 = cu * 32, s0 = t0 % SEQ;
#pragma unroll
    for (int i = 0; i < 8; ++i) { const int c = tid + 512 * i, row = c >> 6, part = c & 63; u32x4 v = (u32x4){0u, 0u, 0u, 0u};
        if (c < 62 * 64 && s0 - 30 + row >= 0) v = *(const u32x4*)(hglu + (size_t)(t0 - 30 + row) * 512 + part * 8);
        pre[i] = v; }
}
__device__ __forceinline__ void conv_stage(unsigned char* lds, int tid, const u32x4 (&pre)[8]) {
    bf16* hin = (bf16*)lds;
#pragma unroll
    for (int i = 0; i < 8; ++i) { const int c = tid + 512 * i, row = c >> 6, part = c & 63; if (c < 62 * 64) *(u32x4*)(hin + row * 512 + part * 8) = pre[i]; }
}
typedef float f32x2c __attribute__((ext_vector_type(2)));
struct ConvW { f32x2c wj[CONV_W]; f32x2c bb; f32x4 g0, g1, c0, c1; };
__device__ __forceinline__ void conv_weights(const float* w_dw, const float* b_dw, const float* g_cn, const float* b_cn, int tid, ConvW& w) {
    const int cp = tid & 255, lane = tid & 63;
#pragma unroll
    for (int j = 0; j < CONV_W; ++j) w.wj[j] = *(const f32x2c*)(w_dw + j * CONV_CH + 2 * cp);
    w.bb = *(const f32x2c*)(b_dw + 2 * cp);
    w.g0 = *(const f32x4*)(g_cn + 8 * lane); w.g1 = *(const f32x4*)(g_cn + 8 * lane + 4); w.c0 = *(const f32x4*)(b_cn + 8 * lane); w.c1 = *(const f32x4*)(b_cn + 8 * lane + 4);
}
__device__ __forceinline__ void conv_unit(unsigned char* lds, const ConvW& w, bf16* ycat, int cu, int tid) {
    const int lane = tid & 63, wave = tid >> 6;
    bf16* hin = (bf16*)lds; float* cout = (float*)(lds + 63488);
    const int t0 = cu * 32;
    {
        const int cp = tid & 255, th = tid >> 8;
#pragma unroll 1
        for (int grp = 0; grp < 2; ++grp) { const int tt0 = th * 16 + grp * 8;
            f32x2c ac[8];
#pragma unroll
            for (int o = 0; o < 8; ++o) ac[o] = w.bb;
#pragma unroll
            for (int r = 0; r < 38; ++r) { const unsigned v = *(const unsigned*)(hin + (tt0 + r) * 512 + 2 * cp); const f32x2c hv = (f32x2c){bflo(v), bfhi(v)};
#pragma unroll
                for (int o = 0; o < 8; ++o) { const int j = r - o; if (j >= 0 && j < CONV_W) ac[o] = __builtin_elementwise_fma(w.wj[j], hv, ac[o]); } }
#pragma unroll
            for (int o = 0; o < 8; ++o) *(f32x2c*)(cout + (tt0 + o) * 512 + 2 * cp) = ac[o];
        }
    }
    __syncthreads();
    {
        f32x4 v0[4], v1[4]; float mean[4], rstd[4];
#pragma unroll
        for (int i = 0; i < 4; ++i) { const int tt = wave * 4 + i; v0[i] = *(const f32x4*)(cout + tt * 512 + 8 * lane); v1[i] = *(const f32x4*)(cout + tt * 512 + 8 * lane + 4); }
#pragma unroll
        for (int i = 0; i < 4; ++i) mean[i] = wave_sum((v0[i].x + v0[i].y) + (v0[i].z + v0[i].w) + (v1[i].x + v1[i].y) + (v1[i].z + v1[i].w)) * (1.f / 512.f);
#pragma unroll
        for (int i = 0; i < 4; ++i) { v0[i] = v0[i] - mean[i]; v1[i] = v1[i] - mean[i];
            rstd[i] = wave_sum((v0[i].x * v0[i].x + v0[i].y * v0[i].y) + (v0[i].z * v0[i].z + v0[i].w * v0[i].w) + (v1[i].x * v1[i].x + v1[i].y * v1[i].y) + (v1[i].z * v1[i].z + v1[i].w * v1[i].w)) * (1.f / 512.f); }
#pragma unroll
        for (int i = 0; i < 4; ++i) { const int tt = wave * 4 + i; const float rs = 1.f / sqrtf(rstd[i] + LN_EPS);
            f32x4 y0 = v0[i] * rs * w.g0 + w.c0, y1 = v1[i] * rs * w.g1 + w.c1;
#pragma unroll
            for (int e = 0; e < 4; ++e) { y0[e] = y0[e] * pg8::sigm(y0[e]); y1[e] = y1[e] * pg8::sigm(y1[e]); }
            *(u32x4*)(ycat + (size_t)(t0 + tt) * 1024 + 8 * lane) = pg8::pack8(y0, y1); }
    }
    __syncthreads();
}

__device__ __forceinline__ void swa_load(const bf16* qkv, int b, int kvh, int qb, int tid, u32x4 (&kk)[4], u32x4 (&vq)[4]) {
    const long tk0 = (long)b * SEQ + (long)qb * 128 - 128;
#pragma unroll
    for (int i = 0; i < 4; ++i) { const int c = tid + 512 * i, row = c >> 3, part = c & 7; const bool ok = (qb > 0) || (row >= 128);
        u32x4 kv = (u32x4){0u, 0u, 0u, 0u}, vv = kv;
        if (ok) { const bf16* rp = qkv + (tk0 + row) * 768 + 512 + kvh * 64 + part * 8; kv = *(const u32x4*)rp; vv = *(const u32x4*)(rp + 128); }
        kk[i] = kv; vq[i] = vv; }
}
__device__ __forceinline__ void swa_unit(unsigned char* lds, const bf16* qkv, const float* sinks, bf16* ycat, int b, int kvh, int qb, int tid, const u32x4 (&kk)[4], const u32x4 (&vq)[4], unsigned long long& tpr) {
    const int lane = tid & 63, wave = tid >> 6, q4 = lane >> 4, c16 = lane & 15;
    bf16* Ks = (bf16*)lds; bf16* VT = (bf16*)(lds + 36864);
    const long t0 = (long)b * SEQ + (long)qb * 128;
#pragma unroll
    for (int i = 0; i < 4; ++i) { const int c = tid + 512 * i, row = c >> 3, part = c & 7;
        const u32x4 kv = kk[i], vv = vq[i];
        *(u32x4*)(Ks + row * 72 + part * 8) = kv;
#pragma unroll
        for (int e = 0; e < 4; ++e) { VT[(part * 8 + 2 * e) * 264 + row] = (bf16)(vv[e] & 0xffffu); VT[(part * 8 + 2 * e + 1) * 264 + row] = (bf16)(vv[e] >> 16); } }
    __syncthreads();
    unsigned long long tsw = 0; if (PROBE_T == 111) tsw = __builtin_amdgcn_s_memrealtime();
    const int g = wave >> 1, hq = kvh * 4 + g, i0 = (wave & 1) * 64;
    const float L2E = 1.4426950408889634f, sc = 0.125f * L2E, sink2 = sinks[hq] * L2E;
    bf16x8v Qc[2][2], Qn[2][2];
#pragma unroll
    for (int h = 0; h < 2; ++h) { const bf16* qp = qkv + (t0 + i0 + h * 16 + c16) * 768 + hq * 64 + 8 * q4; Qc[h][0] = *(const bf16x8v*)qp; Qc[h][1] = *(const bf16x8v*)(qp + 32); }
#pragma unroll 1
    for (int qp2 = 0; qp2 < 2; ++qp2) {
        if (qp2 == 0) {
#pragma unroll
            for (int h = 0; h < 2; ++h) { const bf16* qp = qkv + (t0 + i0 + (2 + h) * 16 + c16) * 768 + hq * 64 + 8 * q4; Qn[h][0] = *(const bf16x8v*)qp; Qn[h][1] = *(const bf16x8v*)(qp + 32); } }
        int kt0[2], iqc[2]; f32x4 sv[2][9]; float inv[2];
#pragma unroll
        for (int h = 0; h < 2; ++h) { const int iq = i0 + (2 * qp2 + h) * 16; kt0[h] = iq >> 4; iqc[h] = iq + c16; }
#pragma unroll
        for (int kt = 0; kt < 9; ++kt)
#pragma unroll
            for (int h = 0; h < 2; ++h) { const bf16* kp = Ks + ((kt0[h] + kt) * 16 + c16) * 72 + 8 * q4;
                f32x4 a = (f32x4){0.f, 0.f, 0.f, 0.f};
                a = __builtin_amdgcn_mfma_f32_16x16x32_bf16(*(const bf16x8v*)kp, Qc[h][0], a, 0, 0, 0);
                a = __builtin_amdgcn_mfma_f32_16x16x32_bf16(*(const bf16x8v*)(kp + 32), Qc[h][1], a, 0, 0, 0);
                sv[h][kt] = a; }
        float mx[2], sum[2];
#pragma unroll
        for (int h = 0; h < 2; ++h) { float m_ = sink2;
#pragma unroll
            for (int kt = 0; kt < 9; ++kt)
#pragma unroll
                for (int r = 0; r < 4; ++r) { const int j2 = (kt0[h] + kt) * 16 + 4 * q4 + r; const bool ok = (j2 > iqc[h]) && (j2 <= iqc[h] + 128) && (qb > 0 || j2 >= 128);
                    const float v = ok ? sv[h][kt][r] * sc : -INFINITY; sv[h][kt][r] = v; m_ = fmaxf(m_, v); }
            mx[h] = m_; }
#pragma unroll
        for (int h = 0; h < 2; ++h) mx[h] = fmaxf(mx[h], __shfl_xor(mx[h], 16));
#pragma unroll
        for (int h = 0; h < 2; ++h) mx[h] = fmaxf(mx[h], __shfl_xor(mx[h], 32));
#pragma unroll
        for (int h = 0; h < 2; ++h) { float s_ = 0.f;
#pragma unroll
            for (int kt = 0; kt < 9; ++kt)
#pragma unroll
                for (int r = 0; r < 4; ++r) { const float pv = __builtin_amdgcn_exp2f(sv[h][kt][r] - mx[h]); sv[h][kt][r] = pv; s_ += pv; }
            sum[h] = s_; }
#pragma unroll
        for (int h = 0; h < 2; ++h) sum[h] += __shfl_xor(sum[h], 16);
#pragma unroll
        for (int h = 0; h < 2; ++h) sum[h] += __shfl_xor(sum[h], 32);
#pragma unroll
        for (int h = 0; h < 2; ++h) inv[h] = 1.f / (sum[h] + __builtin_amdgcn_exp2f(sink2 - mx[h]));
        f32x4 o[2][4];
#pragma unroll
        for (int h = 0; h < 2; ++h)
#pragma unroll
            for (int dt = 0; dt < 4; ++dt) o[h][dt] = (f32x4){0.f, 0.f, 0.f, 0.f};
#pragma unroll
        for (int pp = 0; pp < 5; ++pp)
#pragma unroll
            for (int h = 0; h < 2; ++h) { const int T0 = kt0[h] + 2 * pp, T1 = (pp < 4) ? T0 + 1 : T0;
                const f32x4 pa = sv[h][2 * pp], pb = (pp < 4) ? sv[h][2 * pp + 1] : (f32x4){0.f, 0.f, 0.f, 0.f};
                const u32x4 pw = pg8::pack8(pa, pb); const bf16x8v Bp = __builtin_bit_cast(bf16x8v, pw);
#pragma unroll
                for (int dt = 0; dt < 4; ++dt) { const bf16* vp = VT + (dt * 16 + c16) * 264 + 4 * q4;
                    const u32x2 lo = *(const u32x2*)(vp + T0 * 16), hi = *(const u32x2*)(vp + T1 * 16);
                    const u32x4 aw = (u32x4){lo.x, lo.y, hi.x, hi.y};
                    o[h][dt] = __builtin_amdgcn_mfma_f32_16x16x32_bf16(__builtin_bit_cast(bf16x8v, aw), Bp, o[h][dt], 0, 0, 0); } }
#pragma unroll
        for (int h = 0; h < 2; ++h) { bf16* op = ycat + (t0 + iqc[h]) * 1024 + 512 + hq * 64 + 4 * q4;
#pragma unroll
            for (int dt = 0; dt < 4; ++dt) { u32x2 w; w.x = pg8::cvt_pk_bf16(o[h][dt][0] * inv[h], o[h][dt][1] * inv[h]); w.y = pg8::cvt_pk_bf16(o[h][dt][2] * inv[h], o[h][dt][3] * inv[h]); *(u32x2*)(op + dt * 16) = w; } }
#pragma unroll
        for (int h = 0; h < 2; ++h) { Qc[h][0] = Qn[h][0]; Qc[h][1] = Qn[h][1]; }
    }
    if (PROBE_T == 111) tpr += __builtin_amdgcn_s_memrealtime() - tsw;
    __syncthreads();
}


#define XB_TMO      128
#define XB_XCNT(j)  (256  + 64 * (j))
#define XB_XSUB(j)  (1280 + 64 * (j))
#define XB_XGEN(j)  (2304 + 64 * (j))
#define XB_TOP      3328
#define XB_TOPGEN   3392
#define XCD_BAR_WORDS 3456
#define XB_SPIN_CAP (1u << 20)
__device__ __forceinline__ unsigned xb_ld(unsigned* p)              { return __hip_atomic_load(p, __ATOMIC_RELAXED, __HIP_MEMORY_SCOPE_AGENT); }
__device__ __forceinline__ unsigned xb_add(unsigned* p, unsigned v) { return __hip_atomic_fetch_add(p, v, __ATOMIC_RELAXED, __HIP_MEMORY_SCOPE_AGENT); }
__device__ __forceinline__ unsigned xb_xcc_id() { return (unsigned)__builtin_amdgcn_s_getreg((3 << 11) | 20) & 0xFu; }
#define XB_SPIN(cond, bar) do { unsigned _sp = 0; while (cond) { __builtin_amdgcn_s_sleep(1); \
    if ((++_sp & 255u) == 0u) { if (xb_ld(&(bar)[XB_TMO])) break; if (_sp > XB_SPIN_CAP) { atomicAdd(&(bar)[XB_TMO], 1u); break; } } } } while (0)
struct XcdBarrier { unsigned* bar; unsigned x; volatile __attribute__((address_space(3))) unsigned* st; };
__device__ __forceinline__ XcdBarrier xcd_barrier_post(unsigned* bar, volatile __attribute__((address_space(3))) unsigned* st) {
    XcdBarrier b; b.bar = bar; b.x = xb_xcc_id(); b.st = st;
    if (threadIdx.x == 0) (void)xb_add(&bar[XB_XCNT(b.x)], 1u);
    return b;
}
__device__ __forceinline__ void xcd_barrier_complete(unsigned* bar, unsigned x, unsigned& nloc, unsigned& nx) {
    const unsigned G = gridDim.x * gridDim.y * gridDim.z;
    unsigned sum, cnt, mine, sp = 0u;
    for (;;) {
        sum = 0u; cnt = 0u; mine = 0u;
#pragma unroll
        for (unsigned j = 0; j < 16; ++j) { const unsigned c = xb_ld(&bar[XB_XCNT(j)]); sum += c; cnt += (c > 0u) ? 1u : 0u; mine = (j == x) ? c : mine; }
        if (sum == G) break;
        __builtin_amdgcn_s_sleep(1);
        if ((++sp & 255u) == 0u) { if (xb_ld(&bar[XB_TMO])) break; if (sp > XB_SPIN_CAP) { atomicAdd(&bar[XB_TMO], 1u); break; } }
    }
    nloc = mine > 0u ? mine : 1u; nx = cnt > 0u ? cnt : 1u;
}
__device__ __forceinline__ void xcd_barrier(const XcdBarrier& b, int tid) {
    asm volatile("s_waitcnt vmcnt(0)" ::: "memory");
    __syncthreads();
    if (tid == 0) {
        unsigned* bar = b.bar;
        __builtin_amdgcn_s_waitcnt(0);
        unsigned nloc = b.st[0], nx = b.st[1];
        if (nloc == 0u) { xcd_barrier_complete(bar, b.x, nloc, nx); b.st[0] = nloc; b.st[1] = nx; }
        const unsigned old = xb_add(&bar[XB_XSUB(b.x)], 1u);
        const unsigned gen = old / nloc;
        if (old + 1u == (gen + 1u) * nloc) {
            __builtin_amdgcn_fence(__ATOMIC_RELEASE, "agent");
            asm volatile("s_waitcnt vmcnt(0)" ::: "memory");
            const unsigned og = xb_add(&bar[XB_TOP], 1u);
            const unsigned tg = og / nx;
            if (og + 1u == (tg + 1u) * nx) xb_add(&bar[XB_TOPGEN], 1u);
            else XB_SPIN(xb_ld(&bar[XB_TOPGEN]) == tg, bar);
            __builtin_amdgcn_fence(__ATOMIC_ACQUIRE, "agent");
            xb_add(&bar[XB_XGEN(b.x)], 1u);
            asm volatile("s_waitcnt vmcnt(0)" ::: "memory");
        } else {
            XB_SPIN(xb_ld(&bar[XB_XGEN(b.x)]) == gen, bar);
            __builtin_amdgcn_fence(__ATOMIC_ACQUIRE, "agent");
            asm volatile("s_waitcnt vmcnt(0)" ::: "memory");
        }
    }
    __syncthreads();
}

struct SchedMoE { const char* A; const char* W; const int* tab; const int* rows; int nF, nH, G, c; size_t lda2, strideE, strideN;
    __device__ __forceinline__ bool next(int i, pg8::Unit& u) const { const int L = i * G + c; int t;
        if (L < nF * 4) { pg8::tile_of(L, nF, 4, t, u.pn); u.half = 0; } else if (L < (nF + nH) * 4) { pg8::tile_of(L - nF * 4, nH, 4, t, u.pn); t += nF; u.half = 1; } else return false;
        const int rb = tab[2 + t], e = tab[2 + 192 + t];
        u.pm = t; u.kind = 0; u.aux = e; u.rb = rb; u.rows = rows ? rows + rb : nullptr; u.A = rows ? A : A + (size_t)rb * lda2; u.B = W + (size_t)e * strideE + (size_t)u.pn * strideN; return true; } };

__global__ void __launch_bounds__(512, 2) fwd_kernel(Params p) {
    extern __shared__ __attribute__((aligned(16))) unsigned char lds_raw[];
    float* ldsf = (float*)lds_raw;
    const int G = gridDim.x, bid = blockIdx.x, NGW = G * 8;
    const int wid_s = __builtin_amdgcn_readfirstlane((int)threadIdx.x >> 6);
    unsigned char* ws = p.ws;
    const float *x = p.in[0], *mem = p.in[1], *w_in = p.in[2], *b_in = p.in[3], *w_dw = p.in[4], *b_dw = p.in[5], *g_cn = p.in[6], *b_cn = p.in[7], *sinks = p.in[8],
                *w_out = p.in[9], *g_ln1 = p.in[10], *b_ln1 = p.in[11], *w_mq = p.in[12], *w_mkv = p.in[13], *w_mo = p.in[14], *g_ln2 = p.in[15], *b_ln2 = p.in[16],
                *w_group = p.in[17], *b_group = p.in[18], *w_router = p.in[19], *b_router = p.in[20], *w_gate = p.in[21], *w_up = p.in[22], *w_down = p.in[23],
                *g_ln3 = p.in[24], *b_ln3 = p.in[25];
    float* out = p.out;
    bf16* xb = (bf16*)(ws + WS_DD); bf16* ycat = (bf16*)(ws + WS_A); bf16* Hs = (bf16*)(ws + WS_A);
    bf16* hglu = (bf16*)(ws + WS_B); bf16* qkv = (bf16*)(ws + WS_B + (size_t)T * 512 * 2); bf16* x1b = (bf16*)(ws + WS_B); bf16* Pb2 = (bf16*)(ws + WS_A); bf16* x2b = (bf16*)(ws + WS_B);
    float* Sbuf = (float*)(ws + WS_DD); bf16* Xs = (bf16*)(ws + WS_DD);
    bf16* kvm = (bf16*)(ws + WS_KVM); bf16* memb = (bf16*)(ws + WS_MEMB); bf16* MT = (bf16*)(ws + WS_MT); bf16* NT = (bf16*)(ws + WS_NT);
    float* csS = (float*)(ws + WS_CSS); float* bwS = csS + 2048; float* csp = (float*)(ws + WS_CSP);
    bf16* Wt_in = (bf16*)(ws + WS_WIN); bf16* Wt_out = (bf16*)(ws + WS_WOUT); bf16* Wqb = (bf16*)(ws + WS_WMQ); bf16* Wt_mkv = (bf16*)(ws + WS_WMKV); bf16* Wt_mo = (bf16*)(ws + WS_WMO);
    bf16* Wt_gu = (bf16*)(ws + WS_WGU); bf16* Wt_dn = (bf16*)(ws + WS_WDN);
    PG8_LAS unsigned char* ldsp = (PG8_LAS unsigned char*)lds_raw;
    float* stats1 = (float*)(ws + WS_ST1); float* cs1 = (float*)(ws + WS_CS1); float* bw1 = cs1 + 1024;
    int* route_e = (int*)(ws + WS_ROUTE); float* route_g = (float*)(ws + WS_ROUTE + (size_t)T * 8);
    int* blkcnt = (int*)(ws + WS_BLKCNT); int* segw = (int*)(ws + WS_SEG); int* rank = (int*)(ws + WS_RANK);
    int* pair_tok = (int*)(ws + WS_PTOK); float* pair_gate = (float*)(ws + WS_PGATE); int* tokpos = (int*)(ws + WS_TOKPOS); bf16* Yb = (bf16*)(ws + WS_DD); bf16* z2b = (bf16*)(ws + WS_DD);

    const int lo = p.ph_lo, hi = p.ph_hi;
    int ph = 0;
    unsigned long long tprev = (PROBE_T >= 0) ? __builtin_amdgcn_s_memrealtime() : 0ull, tprobe = 0ull, tmark = 0ull; (void)tmark;
    volatile __attribute__((address_space(3))) unsigned* bst = (volatile __attribute__((address_space(3))) unsigned*)(ldsp + LDS_BYTES_K - 64);
    if (threadIdx.x == 0) { bst[0] = 0u; bst[1] = 0u; }
    __syncthreads();
    const XcdBarrier xbar = xcd_barrier_post((unsigned*)(ws + WS_CTL), bst);
#define PM(k) do { if (PROBE_T == 100 + (k)) tmark = __builtin_amdgcn_s_memrealtime(); } while (0)
#define PME(k) do { if (PROBE_T == 100 + (k)) tprobe += __builtin_amdgcn_s_memrealtime() - tmark; } while (0)
#define PHASE_BEGIN if (lo <= ph && ph < hi) { for (int rep_ = 0; rep_ < ((((unsigned)PROBE_MASK >> ph) & 1u) ? 2 : 1); ++rep_) { const int tid = wid_s * 64 + lane_fresh(); const int lane = tid & 63, wave = tid >> 6, gw = bid * 8 + wave; (void)lane; (void)wave; (void)gw;
#define PHASE_END } } if (lo <= ph && ph + 1 < hi) xcd_barrier(xbar, wid_s * 64 + lane_fresh()); if (PROBE_T >= 0) { const unsigned long long tn_ = __builtin_amdgcn_s_memrealtime(); if (ph == PROBE_T) tprobe = tn_ - tprev; tprev = tn_; } ++ph;

    PHASE_BEGIN
    {
        const size_t n4 = (size_t)T * D / 4, stride = (size_t)G * 512;
        for (size_t i0 = (size_t)bid * 512 + tid; i0 < n4; i0 += 8 * stride) { f32x4 v[8];
#pragma unroll
            for (int q = 0; q < 8; ++q) { const size_t i = i0 + q * stride; v[q] = (i < n4) ? __builtin_nontemporal_load((const f32x4*)x + i) : (f32x4){0.f, 0.f, 0.f, 0.f}; }
#pragma unroll
            for (int q = 0; q < 8; ++q) { const size_t i = i0 + q * stride; if (i < n4) { u32x2 w; w.x = pk2(v[q].x, v[q].y); w.y = pk2(v[q].z, v[q].w); ((u32x2*)xb)[i] = w; } } } }
    for (size_t i = (size_t)bid * 512 + tid; i < (size_t)NMEM * D / 4; i += (size_t)G * 512) { const f32x4 v = ((const f32x4*)mem)[i]; u32x2 w; w.x = pk2(v.x, v.y); w.y = pk2(v.z, v.w); ((u32x2*)memb)[i] = w; }
    {
        LAS float* scr = (LAS float*)(ldsp + wave * 16384);
        constexpr int I_IN = 16 * 56, I_KV = 16 * 64;
        for (int it = gw; it < I_IN + I_KV; it += NGW) { int r = it;
            if (r < I_IN) { const int kb = r / 56, nb = r % 56, n0 = nb * 32; const int dr = n0 < 512 ? (n0 >> 7) * 256 + (n0 & 127) : (n0 < 1024 ? ((n0 - 512) >> 7) * 256 + 128 + (n0 & 127) : n0);
                transpose_item(w_in, D_IN, Wt_in, 1024, kb * 64, n0, dr, scr, lane); continue; } r -= I_IN;
            transpose_item(w_mkv, 2048, Wt_mkv, 1024, (r / 64) * 64, (r % 64) * 32, (r % 64) * 32, scr, lane); }
    }
    PHASE_END

    PHASE_BEGIN
    for (int pass = 0; pass < 2; ++pass) {
      if ((pass == 0) == ((bid & 1) == 0)) {
        const int tl = wid_s * 64 + lane_fresh(), ll = tl & 63, wl = tl >> 6;
        LAS float* scr = (LAS float*)(ldsp + wl * 16384);
        constexpr int I_SQ = 16 * 32, I_EX = 16 * 256, N_T = 2 * I_SQ + 3 * I_EX, N_Q = 1024, N_B = 256, N_ALL = N_T + N_Q + N_B;
        int nb2 = 464 - G; nb2 = nb2 < 0 ? 0 : (nb2 > G ? G : nb2);
        const int NVB = nb2 + (G - nb2) * 3, nmine = (bid < nb2) ? 1 : 3, vb0 = (bid < nb2) ? bid : nb2 + (bid - nb2) * 3;
        auto decode = [&](int r, TItem& t) {
            if (r < I_SQ) { t = TItem{w_out, Wt_out, nullptr, 1024, 1024, (r / 32) * 64, (r % 32) * 32, (r % 32) * 32}; return; } r -= I_SQ;
            if (r < I_SQ) { t = TItem{w_mo, Wt_mo, nullptr, 1024, 1024, (r / 32) * 64, (r % 32) * 32, (r % 32) * 32}; return; } r -= I_SQ;
            if (r < I_EX) { const int e = r / 256, q = r % 256, n0 = (q % 16) * 32; t = TItem{w_gate + (size_t)e * D * DE, Wt_gu + (size_t)e * 1024 * 1024, nullptr, DE, 1024, (q / 16) * 64, n0, (n0 >> 7) * 256 + (n0 & 127)}; return; } r -= I_EX;
            if (r < I_EX) { const int e = r / 256, q = r % 256, n0 = (q % 16) * 32; t = TItem{w_up + (size_t)e * D * DE, Wt_gu + (size_t)e * 1024 * 1024, nullptr, DE, 1024, (q / 16) * 64, n0, (n0 >> 7) * 256 + 128 + (n0 & 127)}; return; } r -= I_EX;
            { const int e = r / 256, q = r % 256; t = TItem{w_down + (size_t)e * DE * D, Wt_dn + (size_t)e * 1024 * 512, nullptr, D, 512, (q / 32) * 64, (q % 32) * 32, (q % 32) * 32}; } };
        for (int vk = 0; vk < nmine; ++vk) {
          int it = (vb0 + vk) * 8 + wl;
          for (; it + NVB * 8 < N_T; it += 2 * NVB * 8) {
              TItem ta, tb; decode(it, ta); decode(it + NVB * 8, tb); float wa[32], wb[32];
              titem_load(ta, wa, ll); titem_load(tb, wb, ll); titem_store(ta, wa, scr, ll); titem_store(tb, wb, scr, ll); }
          for (; it < N_ALL; it += NVB * 8) { int r = it;
            if (r < N_T) { TItem ta; decode(r, ta); float wa[32]; titem_load(ta, wa, ll); titem_store(ta, wa, scr, ll); continue; } r -= N_T;
            if (r < N_Q) {
                f32x4 v[4];
#pragma unroll
                for (int q = 0; q < 4; ++q) v[q] = ((const f32x4*)w_mq)[(size_t)r * 256 + ll + 64 * q];
                const float gk = g_ln1[r];
#pragma unroll
                for (int q = 0; q < 4; ++q) { const f32x4 t = v[q] * gk; u32x2 w; w.x = pk2(t.x, t.y); w.y = pk2(t.z, t.w); ((u32x2*)Wqb)[(size_t)r * 256 + ll + 64 * q] = w; }
                continue; } r -= N_Q;
            {
                f32x4 b4 = (f32x4){0.f, 0.f, 0.f, 0.f};
#pragma unroll 4
                for (int i2 = 0; i2 < 16; ++i2) { const int k = ll + 64 * i2; const f32x4 w = *(const f32x4*)(w_mq + (size_t)k * 1024 + 4 * r); b4 += w * b_ln1[k]; }
#pragma unroll
                for (int e = 0; e < 4; ++e) b4[e] = wave_sum(b4[e]);
                if (ll == 0) *(f32x4*)(bw1 + 4 * r) = b4; }
          }
        }
        __syncthreads();
      } else {
        struct SchedP1 { const char *xb, *win, *memb, *wkv; int G, c;
            __device__ __forceinline__ bool next(int i, pg8::Unit& u) const { const int L = i * G + c; u.aux = 0;
                if (L < 448) { pg8::tile_of(L, 64, 7, u.pm, u.pn); u.A = xb + (size_t)u.pm * 256 * 2048; u.B = win + (size_t)u.pn * 256 * 2048; u.kind = u.pn < 4 ? 0 : 1; return true; }
                if (L < 464) { const int r = L - 448; u.pm = r >> 3; u.pn = r & 7; u.A = memb + (size_t)u.pm * 256 * 2048; u.B = wkv + (size_t)u.pn * 256 * 2048; u.kind = 2; return true; }
                return false; } };
        const SchedP1 S{(const char*)xb, (const char*)Wt_in, (const char*)memb, (const char*)Wt_mkv, G, bid};
        const pg8::EpiP1 E{hglu, qkv, kvm, b_in};
        pg8::gemm_phase(wid_s * 64 + lane_fresh(), ldsp, pg8::Gemm{1024, 1024, 1024}, S, E);
      }
    }
    PHASE_END

    PHASE_BEGIN
    PM(0);
    {   constexpr int NCU = T / 32, NSU = BATCH * NKV * (SEQ / 128);
        u32x4 pre[8], kk[4], vq[4]; ConvW cw; conv_weights(w_dw, b_dw, g_cn, b_cn, tid, cw);
        if (bid < NCU) conv_load(hglu, bid, tid, pre);
        for (int cu = bid; cu < NCU; cu += G) {
            conv_stage(lds_raw, tid, pre); __syncthreads();
            if (cu + G < NCU) conv_load(hglu, cu + G, tid, pre);
            conv_unit(lds_raw, cw, ycat, cu, tid);
        }
        PME(0); PM(1);
        if (bid < NSU) swa_load(qkv, bid >> 7, (bid >> 6) & 1, bid & 63, tid, kk, vq);
        for (int u = bid; u < NSU; u += G) {
            swa_unit(lds_raw, qkv, sinks, ycat, u >> 7, (u >> 6) & 1, u & 63, tid, kk, vq, tprobe);
            if (u + G < NSU) swa_load(qkv, (u + G) >> 7, ((u + G) >> 6) & 1, (u + G) & 63, tid, kk, vq);
        }
    }
    PME(1);
    PM(2);
    {
        struct SchedMT { const char *kvm, *wq; int c;
            __device__ __forceinline__ bool next(int i, pg8::Unit& u) const { if (i > 0 || c < 0 || c >= 32) return false; const int b = c >> 4, h = (c >> 2) & 3, pn = c & 3; u.pm = h; u.pn = pn; u.aux = b; u.kind = 0;
                u.A = kvm + ((size_t)(b * 256) * 2048 + h * 256) * 2; u.B = wq + ((size_t)(pn * 256) * 1024 + h * 256) * 2; return true; } };
        struct SchedNT { const char *wo, *kvm; int c;
            __device__ __forceinline__ bool next(int i, pg8::Unit& u) const { if (i > 0 || c < 0 || c >= 32) return false; const int b = c >> 4, h = (c >> 2) & 3, pm = c & 3; u.pm = pm; u.pn = h; u.aux = b; u.kind = 0;
                u.A = wo + ((size_t)(pm * 256) * 1024 + h * 256) * 2; u.B = kvm + ((size_t)(b * 256) * 2048 + 1024 + h * 256) * 2; return true; } };
        const SchedMT S1{(const char*)kvm, (const char*)Wqb, bid}; const pg8::EpiPre E1{MT, csp};
        pg8::gemm_phase(wid_s * 64 + lane_fresh(), ldsp, pg8::Gemm{2048, 1024, 256}, S1, E1);
        const SchedNT S2{(const char*)Wt_mo, (const char*)kvm, bid - 32}; const pg8::EpiPre E2{NT, nullptr};
        pg8::gemm_phase(wid_s * 64 + lane_fresh(), ldsp, pg8::Gemm{1024, 2048, 256}, S2, E2);
    }
    PME(2);
    PHASE_END

    PHASE_BEGIN
    for (int r = gw; r < 2048; r += NGW) { const int b = r >> 10, hk = r & 1023, h = hk >> 8, key = hk & 255;
        const float c = wave_sum(lane < 16 ? csp[(size_t)r * 16 + lane] : 0.f);
        const u32x2 kk = *(const u32x2*)(kvm + (size_t)(b * 256 + key) * 2048 + h * 256 + 4 * lane); const f32x4 bq = *(const f32x4*)(bw1 + h * 256 + 4 * lane);
        const float w = wave_sum((bflo(kk.x) * bq[0] + bfhi(kk.x) * bq[1]) + (bflo(kk.y) * bq[2] + bfhi(kk.y) * bq[3]));
        if (lane == 0) { csS[r] = c; bwS[r] = w; } }
    { const pg8::DenseSched S{(const char*)ycat, (const char*)Wt_out, 64, 4, G, bid, (size_t)256 * 2048, (size_t)256 * 2048};
      const pg8::EpiResStats E{xb, x1b, stats1, ALPHA}; PM(7); pg8::gemm_phase(tid, ldsp, pg8::Gemm{1024, 1024, 1024}, S, E); PME(7); }
    PHASE_END
    PHASE_BEGIN
    {   struct SchedS { const char *z, *mt; int G, c;
            __device__ __forceinline__ bool next(int i, pg8::Unit& u) const { const int L = i * G + c; if (L >= 256) return false; pg8::tile_of(L, 64, 4, u.pm, u.pn); u.kind = 0; u.aux = u.pm >> 5;
                u.A = z + (size_t)u.pm * 256 * 2048; u.B = mt + ((size_t)u.aux * 1024 * 1024 + (size_t)u.pn * 256 * 1024) * 2; return true; } };
        const SchedS S{(const char*)x1b, (const char*)MT, G, bid};
        const pg8::EpiSoftmaxLn E{Pb2, (PG8_LAS float*)(ldsp + 131072), stats1, csS, bwS};
        PM(8); pg8::gemm_phase(tid, ldsp, pg8::Gemm{1024, 1024, 1024}, S, E); PME(8);
    }
    PHASE_END
    PHASE_BEGIN
    {   struct SchedN { const char *P, *nt; int G, c;
            __device__ __forceinline__ bool next(int i, pg8::Unit& u) const { const int L = i * G + c; if (L >= 256) return false; pg8::tile_of(L, 64, 4, u.pm, u.pn); u.kind = 0; u.aux = u.pm >> 5;
                u.A = P + (size_t)u.pm * 256 * 2048; u.B = nt + ((size_t)u.aux * 1024 * 1024 + (size_t)u.pn * 256 * 1024) * 2; return true; } };
        const SchedN S{(const char*)Pb2, (const char*)NT, G, bid};
        const pg8::EpiResLn E{z2b, x1b, stats1, g_ln1, b_ln1, ALPHA}; pg8::gemm_phase(tid, ldsp, pg8::Gemm{1024, 1024, 1024}, S, E);
    }
    PHASE_END
    const int TPB = (T + G - 1) / G;
    PHASE_BEGIN
    { const int t0 = bid * TPB, t1 = (t0 + TPB < T) ? t0 + TPB : T;
      float* Wl = ldsf;
      int* le = (int*)(lds_raw + 81920);
      for (int k = tid; k < D; k += 512) { const f32x4 wg = *(const f32x4*)(w_group + (size_t)k * 4);
          Wl[0 * D + k] = wg.x; Wl[1 * D + k] = wg.y; Wl[2 * D + k] = wg.z; Wl[3 * D + k] = wg.w;
#pragma unroll
          for (int gq = 0; gq < 4; ++gq) { const f32x4 wr = *(const f32x4*)(w_router + ((size_t)gq * D + k) * 4);
              Wl[(4 + gq * 4 + 0) * D + k] = wr.x; Wl[(4 + gq * 4 + 1) * D + k] = wr.y; Wl[(4 + gq * 4 + 2) * D + k] = wr.z; Wl[(4 + gq * 4 + 3) * D + k] = wr.w; } }
      __syncthreads();
      PM(4);
      const int TPW = (TPB + 7) / 8;
      const int mend = (t0 + (wave + 1) * TPW < t1) ? t0 + (wave + 1) * TPW : t1;
      float bgr[4], brt[16];
#pragma unroll
      for (int i = 0; i < 4; ++i) bgr[i] = b_group[i];
#pragma unroll
      for (int i = 0; i < 16; ++i) brt[i] = b_router[i];
      f32x4 raw[2][4];
      { const int mb0 = t0 + wave * TPW; if (mb0 < mend) { ld_row_bf16(z2b + (size_t)mb0 * D, raw[0], lane); ld_row_bf16(z2b + (size_t)((mb0 + 1 < mend) ? mb0 + 1 : mb0) * D, raw[1], lane); } }
      for (int mb = t0 + wave * TPW; mb < mend; mb += 2) {
        f32x4 v[2][4];
        const bool has1 = (mb + 1 < mend);
#pragma unroll
        for (int jj = 0; jj < 4; ++jj) { v[0][jj] = raw[0][jj]; v[1][jj] = raw[1][jj]; }
        if (mb + 2 < mend) { ld_row_bf16(z2b + (size_t)(mb + 2) * D, raw[0], lane); ld_row_bf16(z2b + (size_t)((mb + 3 < mend) ? mb + 3 : mb + 2) * D, raw[1], lane); }
        ln_regs(v[0], g_ln2, b_ln2, lane);
        st_row_bf16(x2b + (size_t)mb * D, v[0], lane);
        ln_regs(v[1], g_ln2, b_ln2, lane);
        if (has1) st_row_bf16(x2b + (size_t)(mb + 1) * D, v[1], lane);
        float pa[20], pb[20];
#pragma unroll
        for (int c = 0; c < 20; ++c) {
            typedef float f32x2 __attribute__((ext_vector_type(2)));
            f32x2 p0 = (f32x2){0.f, 0.f}, p1 = p0;
#pragma unroll
            for (int jj = 0; jj < 4; ++jj) { const f32x4 w4 = ((const f32x4*)(Wl + c * D))[lane + 64 * jj]; const f32x2 wl2 = (f32x2){w4.x, w4.y}, wh2 = (f32x2){w4.z, w4.w};
                p0 = __builtin_elementwise_fma((f32x2){v[0][jj].x, v[0][jj].y}, wl2, p0); p0 = __builtin_elementwise_fma((f32x2){v[0][jj].z, v[0][jj].w}, wh2, p0);
                p1 = __builtin_elementwise_fma((f32x2){v[1][jj].x, v[1][jj].y}, wl2, p1); p1 = __builtin_elementwise_fma((f32x2){v[1][jj].z, v[1][jj].w}, wh2, p1); }
            pa[c] = p0.x + p0.y; pb[c] = p1.x + p1.y;
        }
        float* red = (float*)(lds_raw + 98304) + wave * 64;
        red[lane] = reduce40(pa, pb, lane);
        asm volatile("s_waitcnt lgkmcnt(0)" ::: "memory");
        float my[20];
#pragma unroll
        for (int c = 0; c < 20; ++c) { constexpr int mm[5] = {0, 1, 2, 4, 5}; my[c] = red[32 * (lane & 1) + 16 * (c / 10) + 8 * ((c % 10) / 5) + mm[c % 5]]; }
        asm volatile("s_waitcnt lgkmcnt(0)" ::: "memory");
        const int m = mb + lane;
        if (lane < 2 && m < mend) {
            float gl[4]; int gi = 0; float gmx = -INFINITY;
#pragma unroll
            for (int i = 0; i < 4; ++i) { gl[i] = my[i] + bgr[i]; if (gl[i] > gmx) { gmx = gl[i]; gi = i; } }
            float gs = 0.f;
#pragma unroll
            for (int i = 0; i < 4; ++i) gs += __expf(gl[i] - gmx);
            const float gp = 1.f / gs;
            float el[4];
#pragma unroll
            for (int i = 0; i < 4; ++i) { float a = my[4 + i], bq = brt[i];
                a = (gi == 1) ? my[8 + i] : a; a = (gi == 2) ? my[12 + i] : a; a = (gi == 3) ? my[16 + i] : a;
                bq = (gi == 1) ? brt[4 + i] : bq; bq = (gi == 2) ? brt[8 + i] : bq; bq = (gi == 3) ? brt[12 + i] : bq;
                el[i] = a + bq; }
            int i0 = 0; float v0 = el[0];
#pragma unroll
            for (int i = 1; i < 4; ++i) if (el[i] > v0) { v0 = el[i]; i0 = i; }
            int i1 = -1; float v1 = -INFINITY;
#pragma unroll
            for (int i = 0; i < 4; ++i) if (i != i0 && el[i] > v1) { v1 = el[i]; i1 = i; }
            const float w0 = 1.f / (1.f + __expf(v1 - v0)), w1 = 1.f - w0;
            route_e[2 * m] = gi * 4 + i0; route_e[2 * m + 1] = gi * 4 + i1; route_g[2 * m] = gp * w0; route_g[2 * m + 1] = gp * w1;
            le[2 * (m - t0)] = gi * 4 + i0; le[2 * (m - t0) + 1] = gi * 4 + i1;
        }
      }
      __syncthreads();
      PME(4); PM(5);
      const int np = 2 * (t1 - t0);
      for (int i = tid; i < np; i += 512) { const int e = le[i]; int r = 0; for (int j2 = 0; j2 < i; ++j2) r += (le[j2] == e) ? 1 : 0; rank[2 * t0 + i] = r; }
      if (tid < 16) { int c = 0; for (int j2 = 0; j2 < np; ++j2) c += (le[j2] == tid) ? 1 : 0; blkcnt[bid * 16 + tid] = c; }
      PME(5);
    }
    PHASE_END
    PHASE_BEGIN
    {
        int* sh = (int*)lds_raw;
        const int t0 = bid * TPB, t1 = (t0 + TPB < T) ? t0 + TPB : T, np = 2 * (t1 - t0);
        int my_e = 0, my_r = 0; float my_g = 0.f;
        if (tid < np) { const int pi = 2 * t0 + tid; my_e = route_e[pi]; my_r = rank[pi]; my_g = route_g[pi]; }
        { const int e = tid & 15, part = tid >> 4; int tot = 0, base = 0; int cv[8];
#pragma unroll
          for (int q = 0; q < 8; ++q) { const int b = part + 32 * q; cv[q] = (b < G) ? blkcnt[b * 16 + e] : 0; }
#pragma unroll
          for (int q = 0; q < 8; ++q) { const int b = part + 32 * q; tot += cv[q]; if (b < bid) base += cv[q]; }
          for (int b = part + 256; b < G; b += 32) { const int c = blkcnt[b * 16 + e]; tot += c; if (b < bid) base += c; }
          sh[128 + part * 16 + e] = tot; sh[640 + part * 16 + e] = base; }
        __syncthreads();
        if (tid < 16) { int tot = 0, base = 0;
#pragma unroll 8
            for (int part = 0; part < 32; ++part) { tot += sh[128 + part * 16 + tid]; base += sh[640 + part * 16 + tid]; } sh[tid] = base; sh[64 + tid] = tot; }
        __syncthreads();
        if (tid == 0) { int sacc = 0, nF = 0, nH = 0;
            for (int e = 0; e < 16; ++e) { const int n = sh[64 + e], nf = n >> 8, nh = ((n & 255) + 127) >> 7; sh[16 + e] = sacc; sacc += nf * 256 + nh * 128; nF += nf; nH += nh; }
            sh[32] = sacc;
            if (bid == 0) { segw[0] = nF; segw[1] = nH; int tf = 0, th = nF;
                for (int e = 0; e < 16; ++e) { const int n = sh[64 + e], nf = n >> 8, nh = ((n & 255) + 127) >> 7;
                    for (int k = 0; k < nf; ++k) { segw[2 + tf] = sh[16 + e] + 256 * k; segw[2 + 192 + tf] = e; ++tf; }
                    for (int k = 0; k < nh; ++k) { segw[2 + th] = sh[16 + e] + 256 * nf + 128 * k; segw[2 + 192 + th] = e; ++th; } } } }
        __syncthreads();
        if (bid == 0) { for (int e = 0; e < 16; ++e) for (int pos = sh[16 + e] + sh[64 + e] + tid; pos < sh[16 + e + 1]; pos += 512) { pair_tok[pos] = -1; pair_gate[pos] = 0.f; } }
        if (tid < np) { const int pi = 2 * t0 + tid, pos = sh[16 + my_e] + sh[my_e] + my_r; pair_tok[pos] = pi >> 1; pair_gate[pos] = my_g; tokpos[pi] = pos; }
    }
    PHASE_END
    PHASE_BEGIN
    { const SchedMoE S{(const char*)x2b, (const char*)Wt_gu, segw, pair_tok, segw[0], segw[1], G, bid, (size_t)2048, (size_t)1024 * 2048, (size_t)256 * 2048};
      const pg8::EpiGateUp E{Hs, pair_gate}; PM(6); pg8::gemm_phase<true, true>(tid, ldsp, pg8::Gemm{1024, 1024, 1024}, S, E); PME(6); }
    PHASE_END
    PHASE_BEGIN
    { const SchedMoE S{(const char*)Hs, (const char*)Wt_dn, segw, nullptr, segw[0], segw[1], G, bid, (size_t)1024, (size_t)1024 * 1024, (size_t)256 * 1024};
      const pg8::EpiY E{Yb}; PM(9); pg8::gemm_phase<false, true>(tid, ldsp, pg8::Gemm{512, 512, 512}, S, E); PME(9); }
    PHASE_END
    PHASE_BEGIN
    for (int mbase = gw; mbase < T; mbase += 8 * NGW) {
        int tp = 0;
        if (lane < 16) { const int mm = mbase + (lane >> 1) * NGW; if (mm < T) tp = tokpos[2 * mm + (lane & 1)]; }
        u32x2 xa[4], ya[4], yb[4];
#define P9_LOAD(mm, ii) do { const int p0_ = __builtin_amdgcn_readlane(tp, 2 * (ii)), p1_ = __builtin_amdgcn_readlane(tp, 2 * (ii) + 1); \
        _Pragma("unroll") for (int jj = 0; jj < 4; ++jj) { xa[jj] = ((const u32x2*)(x2b + (size_t)(mm) * D))[lane + 64 * jj]; ya[jj] = ((const u32x2*)(Yb + (size_t)p0_ * D))[lane + 64 * jj]; yb[jj] = ((const u32x2*)(Yb + (size_t)p1_ * D))[lane + 64 * jj]; } } while (0)
        P9_LOAD(mbase, 0);
        for (int i = 0; i < 8; ++i) { const int m = mbase + i * NGW; if (m >= T) break;
            f32x4 v[4]; float sacc = 0.f;
#pragma unroll
            for (int jj = 0; jj < 4; ++jj) { f32x4 z;
                z.x = bflo(xa[jj].x) * ALPHA + (bflo(ya[jj].x) + bflo(yb[jj].x)); z.y = bfhi(xa[jj].x) * ALPHA + (bfhi(ya[jj].x) + bfhi(yb[jj].x));
                z.z = bflo(xa[jj].y) * ALPHA + (bflo(ya[jj].y) + bflo(yb[jj].y)); z.w = bfhi(xa[jj].y) * ALPHA + (bfhi(ya[jj].y) + bfhi(yb[jj].y)); v[jj] = z; sacc += (z.x + z.y) + (z.z + z.w); }
            if (i + 1 < 8 && m + NGW < T) P9_LOAD(m + NGW, i + 1);
            const float mean = wave_sum(sacc) * (1.f / D); float s2 = 0.f;
#pragma unroll
            for (int jj = 0; jj < 4; ++jj) { v[jj] = v[jj] - mean; s2 += (v[jj].x * v[jj].x + v[jj].y * v[jj].y) + (v[jj].z * v[jj].z + v[jj].w * v[jj].w); }
            const float rstd = 1.f / sqrtf(wave_sum(s2) * (1.f / D) + LN_EPS);
            float* row = out + (size_t)m * D;
#pragma unroll
            for (int jj = 0; jj < 4; ++jj) { const f32x4 gg = ((const f32x4*)g_ln3)[lane + 64 * jj], bb = ((const f32x4*)b_ln3)[lane + 64 * jj]; ((f32x4*)row)[lane + 64 * jj] = v[jj] * rstd * gg + bb; } }
#undef P9_LOAD
    }
    PHASE_END
    if (PROBE_T >= 0 && blockIdx.x == 0) { const unsigned long long tend = __builtin_amdgcn_s_memrealtime() + 9ull * tprobe; while (__builtin_amdgcn_s_memrealtime() < tend) __builtin_amdgcn_s_sleep(8); }
}

constexpr int N_PHASES = 11;
constexpr int LDS_BYTES = 147456;

extern "C" void kernel_launch(void* const* d_in, const int* in_sizes, int n_in, void* d_out, int out_size, void* d_ws, size_t ws_size, hipStream_t stream) {
    static int grid = 0;
    if (grid == 0) {
        int dev = 0, cus = 0, per_cu = 0;
        hipGetDevice(&dev);
        hipDeviceGetAttribute(&cus, hipDeviceAttributeMultiprocessorCount, dev);
        hipFuncSetAttribute((const void*)fwd_kernel, hipFuncAttributeMaxDynamicSharedMemorySize, LDS_BYTES);
        hipOccupancyMaxActiveBlocksPerMultiprocessor(&per_cu, (const void*)fwd_kernel, 512, LDS_BYTES);
        grid = cus * 1;
        if (per_cu < 1) { fprintf(stderr, "occupancy query returned %d: the persistent grid would not be resident; nothing launched\n", per_cu); grid = -1; }
        if (ws_size < WS_END) { fprintf(stderr, "workspace too small\n"); grid = -1; }
    }
    if (grid < 0) return;
    if (hipMemsetAsync((char*)d_ws + WS_CTL, 0, 65536, stream) != hipSuccess) { fprintf(stderr, "memset failed\n"); return; }
    Params p{};
    for (int i = 0; i < 26; ++i) p.in[i] = (const float*)d_in[i];
    p.out = (float*)d_out; p.ws = (unsigned char*)d_ws;
#if MK_N_LAUNCHES == 1
    p.ph_lo = 0; p.ph_hi = 64;
    void* args[] = {&p};
    hipError_t e = hipLaunchCooperativeKernel((const void*)fwd_kernel, dim3(grid), dim3(512), args, LDS_BYTES, stream);
    if (e != hipSuccess) fprintf(stderr, "cooperative launch failed: %s (grid %d)\n", hipGetErrorString(e), grid);
#else
    for (int ph = 0; ph < N_PHASES; ++ph) { p.ph_lo = ph; p.ph_hi = ph + 1; hipLaunchKernelGGL(fwd_kernel, dim3(grid), dim3(512), LDS_BYTES, stream, p); }
#endif
}
```
